# Optimizing an MI355X kernel written in HIP

```python
import jax, jax.numpy as jnp
from jax import lax
import numpy as np

D_MODEL = 1024
BATCH = 8
SEQ = 8192
DEPTH = 2

HEAD_DIM = 64
N_Q_HEADS = 8
N_KV_HEADS = 2
Q_PER_KV = N_Q_HEADS // N_KV_HEADS
ATTN_WIDTH = N_Q_HEADS * HEAD_DIM
KV_WIDTH = N_KV_HEADS * HEAD_DIM
WINDOW = 128
ATTN_BLOCK = WINDOW
ROT_DIM = HEAD_DIM // 4
ROPE_THETA = 500000.0
POOL_WINDOWS = (2, 4, 8, 16)
N_POOL_GROUPS = len(POOL_WINDOWS)
POOL_WIDTH = D_MODEL - ATTN_WIDTH
POOL_GROUP_DIM = POOL_WIDTH // N_POOL_GROUPS
MIX_WIDTH = ATTN_WIDTH + POOL_WIDTH
IN_WIDTH = ATTN_WIDTH + 2 * KV_WIDTH + POOL_WIDTH
N_EXPERTS = 32
TOP_K = 4
D_FF = D_MODEL
SWIGLU_LIMIT = 7.0
SWIGLU_ALPHA = 1.702
MOE_BLOCK = 256
EPS = 1e-6
MAX_POS_OFFSET = 4096

kernel_name = "hybrid_swa_sink_pool_moe_adaln"

F32 = jnp.float32


def rmsnorm(t, g):
    tf = t.astype(F32)
    y = tf * lax.rsqrt(jnp.mean(tf * tf, axis=-1, keepdims=True) + EPS)
    return (y * g.astype(F32)).astype(t.dtype)


def partial_rope(t, cos, sin):
    half = ROT_DIM // 2
    tf = t.astype(F32)
    t1 = tf[..., :half]
    t2 = tf[..., half:ROT_DIM]
    out = jnp.concatenate([t1 * cos - t2 * sin, t2 * cos + t1 * sin, tf[..., ROT_DIM:]], axis=-1)
    return out.astype(t.dtype)


def sliding_window_attention(q, k, v, sinks):
    b, s_len = q.shape[0], q.shape[1]
    T = ATTN_BLOCK
    nb = s_len // T
    qb = q.reshape(b, nb, T, N_KV_HEADS, Q_PER_KV, HEAD_DIM)

    def band(t):
        tb = t.reshape(b, nb, T, N_KV_HEADS, HEAD_DIM)
        prev = jnp.pad(tb[:, :-1], ((0, 0), (1, 0), (0, 0), (0, 0), (0, 0)))
        return jnp.concatenate([prev, tb], axis=2)

    kk, vv = band(k), band(v)
    scores = jnp.einsum('bnqhgd,bnkhd->bnhgqk', qb, kk,
                        preferred_element_type=F32) * (HEAD_DIM ** -0.5)
    qi = jnp.arange(T)[:, None]
    kj = jnp.arange(2 * T)[None, :]
    diff = qi + T - kj
    blk = jnp.arange(nb)[:, None, None]
    allowed = (diff >= 0) & (diff < WINDOW) & ((blk > 0) | (kj >= T))
    scores = jnp.where(allowed[None, :, None, None], scores, -jnp.inf)
    sink = sinks.astype(F32).reshape(1, 1, N_KV_HEADS, Q_PER_KV, 1, 1)
    m = jnp.maximum(jnp.max(scores, axis=-1, keepdims=True), sink)
    p = jnp.exp(scores - m)
    denom = jnp.sum(p, axis=-1, keepdims=True) + jnp.exp(sink - m)
    o = jnp.einsum('bnhgqk,bnkhd->bnhgqd', p.astype(v.dtype), vv,
                   preferred_element_type=F32) / denom
    o = jnp.transpose(o, (0, 1, 4, 2, 3, 5))
    return o.reshape(b, s_len, ATTN_WIDTH).astype(q.dtype)


def multiscale_pool(u, w_pool, b_pool, scale):
    b, s_len = u.shape[0], u.shape[1]
    ug = u.astype(F32).reshape(b, s_len, N_POOL_GROUPS, POOL_GROUP_DIM)
    cs = jnp.cumsum(ug, axis=1)
    count = jnp.arange(1, s_len + 1, dtype=F32)
    outs = []
    for g, w in enumerate(POOL_WINDOWS):
        c_g = cs[:, :, g]
        lag = jnp.pad(c_g, ((0, 0), (w, 0), (0, 0)))[:, :s_len]
        mean = (c_g - lag) / jnp.minimum(count, float(w))[None, :, None]
        outs.append(mean - ug[:, :, g])
    pooled = jnp.stack(outs, axis=2).astype(u.dtype)
    y = jnp.einsum('bsgc,gcd->bsgd', pooled, w_pool) + b_pool
    y = y * scale.reshape(N_POOL_GROUPS, POOL_GROUP_DIM)
    return y.reshape(b, s_len, POOL_WIDTH)


def moe(h, router_w, router_b, w_gu, b_gu, w_down, b_down):
    b, s_len, d = h.shape
    n_tok = b * s_len
    hf = h.reshape(n_tok, d)
    logits = (hf @ router_w).astype(F32) + router_b.astype(F32)
    top_vals, top_idx = lax.top_k(logits, TOP_K)
    gates = jax.nn.softmax(top_vals, axis=-1)
    n_asg = n_tok * TOP_K
    e_flat = top_idx.reshape(n_asg)
    tok_flat = jnp.arange(n_asg, dtype=jnp.int32) // TOP_K
    g_flat = gates.reshape(n_asg)
    order = jnp.argsort(e_flat)
    e_sorted = e_flat[order]
    counts = jnp.bincount(e_flat, length=N_EXPERTS)
    padded = (counts + MOE_BLOCK - 1) // MOE_BLOCK * MOE_BLOCK
    starts = jnp.cumsum(counts) - counts
    pends = jnp.cumsum(padded)
    pstarts = pends - padded
    rank = jnp.arange(n_asg, dtype=jnp.int32) - starts[e_sorted]
    dest = pstarts[e_sorted] + rank
    n_blocks = -(-n_asg // MOE_BLOCK) + N_EXPERTS
    n_slots = n_blocks * MOE_BLOCK
    slot_tok = jnp.zeros((n_slots,), jnp.int32).at[dest].set(tok_flat[order])
    slot_gate = jnp.zeros((n_slots,), F32).at[dest].set(g_flat[order])
    block_expert = jnp.minimum(
        jnp.searchsorted(pends, jnp.arange(n_blocks) * MOE_BLOCK, side='right'),
        N_EXPERTS - 1).astype(jnp.int32)

    def expert_block(args):
        e, tok, gate = args
        xb = hf[tok]
        gu = xb @ w_gu[e] + b_gu[e]
        g_lin = jnp.minimum(gu[:, :D_FF], SWIGLU_LIMIT)
        u_lin = jnp.clip(gu[:, D_FF:], -SWIGLU_LIMIT, SWIGLU_LIMIT)
        act = g_lin * jax.nn.sigmoid(g_lin * SWIGLU_ALPHA) * (u_lin + 1.0)
        yb = act @ w_down[e] + b_down[e]
        return yb * gate[:, None].astype(yb.dtype)

    yb = lax.map(expert_block, (block_expert,
                                slot_tok.reshape(n_blocks, MOE_BLOCK),
                                slot_gate.reshape(n_blocks, MOE_BLOCK)))
    y = jnp.zeros((n_tok, d), yb.dtype).at[slot_tok].add(yb.reshape(n_slots, d))
    return y.reshape(b, s_len, d).astype(h.dtype)


def setup_inputs(seed: int = 0) -> dict:
    key = jax.random.key(seed)
    ks = jax.random.split(key, 22)
    nrm = lambda k, shape, s: jax.random.normal(k, shape, F32) * s
    L, D, E, F = DEPTH, D_MODEL, N_EXPERTS, D_FF
    x = jax.random.normal(ks[0], (BATCH, SEQ, D), F32)
    c = jax.random.normal(ks[1], (BATCH, D), F32)
    positions = (jnp.arange(SEQ, dtype=jnp.int32)[None, :]
                 + jax.random.randint(ks[2], (BATCH, 1), 0, MAX_POS_OFFSET, dtype=jnp.int32))
    return {
        "x": x,
        "c": c,
        "positions": positions,
        "ada_w": nrm(ks[3], (L, D, 6 * D), 0.5 * D ** -0.5),
        "ada_b": nrm(ks[4], (L, 6 * D), 0.02),
        "norm1_g": 1.0 + nrm(ks[5], (L, D), 0.02),
        "w_in": nrm(ks[6], (L, D, IN_WIDTH), D ** -0.5),
        "q_norm_g": 1.0 + nrm(ks[7], (L, HEAD_DIM), 0.02),
        "k_norm_g": 1.0 + nrm(ks[8], (L, HEAD_DIM), 0.02),
        "attn_sinks": nrm(ks[9], (L, N_Q_HEADS), 0.5),
        "pool_w": nrm(ks[10], (L, N_POOL_GROUPS, POOL_GROUP_DIM, POOL_GROUP_DIM), POOL_GROUP_DIM ** -0.5),
        "pool_b": nrm(ks[11], (L, N_POOL_GROUPS, POOL_GROUP_DIM), 0.02),
        "pool_scale": 1.0 + nrm(ks[12], (L, POOL_WIDTH), 0.05),
        "w_out": nrm(ks[13], (L, MIX_WIDTH, D), MIX_WIDTH ** -0.5),
        "norm2_g": 1.0 + nrm(ks[14], (L, D), 0.02),
        "router_w": nrm(ks[15], (L, D, E), D ** -0.5),
        "router_b": nrm(ks[16], (L, E), 0.01),
        "expert_w_gu": nrm(ks[17], (L, E, D, 2 * F), D ** -0.5),
        "expert_b_gu": nrm(ks[18], (L, E, 2 * F), 0.02),
        "expert_w_down": nrm(ks[19], (L, E, F, D), F ** -0.5),
        "expert_b_down": nrm(ks[20], (L, E, D), 0.02),
    }


def reference(x, c, positions, ada_w, ada_b, norm1_g, w_in, q_norm_g, k_norm_g, attn_sinks,
              pool_w, pool_b, pool_scale, w_out, norm2_g, router_w, router_b,
              expert_w_gu, expert_b_gu, expert_w_down, expert_b_down):
    b, s_len, _ = x.shape
    inv_freq = ROPE_THETA ** (-jnp.arange(0, ROT_DIM, 2, dtype=F32) / ROT_DIM)
    ang = positions.astype(F32)[..., None] * inv_freq
    cos = jnp.cos(ang)[:, :, None, :]
    sin = jnp.sin(ang)[:, :, None, :]
    c_act = jax.nn.silu(c.astype(F32))
    for l in range(DEPTH):
        mod = (c_act @ ada_w[l].astype(F32) + ada_b[l].astype(F32)).astype(x.dtype)
        shift1, scale1, gate1, shift2, scale2, gate2 = jnp.split(mod[:, None, :], 6, axis=-1)

        h = rmsnorm(x, norm1_g[l]) * (1.0 + scale1) + shift1
        proj = h @ w_in[l]
        q, k, v, u = jnp.split(proj, [ATTN_WIDTH, ATTN_WIDTH + KV_WIDTH,
                                      ATTN_WIDTH + 2 * KV_WIDTH], axis=-1)
        q = q.reshape(b, s_len, N_Q_HEADS, HEAD_DIM)
        k = k.reshape(b, s_len, N_KV_HEADS, HEAD_DIM)
        v = v.reshape(b, s_len, N_KV_HEADS, HEAD_DIM)
        q = partial_rope(rmsnorm(q, q_norm_g[l]), cos, sin)
        k = partial_rope(rmsnorm(k, k_norm_g[l]), cos, sin)
        attn_out = sliding_window_attention(q, k, v, attn_sinks[l])
        pool_out = multiscale_pool(u, pool_w[l], pool_b[l], pool_scale[l])
        mixed = jnp.concatenate([attn_out, pool_out.astype(attn_out.dtype)], axis=-1) @ w_out[l]
        x = x + gate1 * mixed

        h2 = rmsnorm(x, norm2_g[l]) * (1.0 + scale2) + shift2
        x = x + gate2 * moe(h2, router_w[l], router_b[l], expert_w_gu[l], expert_b_gu[l],
                            expert_w_down[l], expert_b_down[l])
    return x
```

```cpp
#include <hip/hip_runtime.h>
#include <cstdio>
#include <cstdint>

#ifndef ONE_LAUNCH
#define ONE_LAUNCH 0
#endif

#define LAS __attribute__((address_space(3)))
typedef unsigned short bf16;
typedef short bf16x8 __attribute__((ext_vector_type(8)));
typedef short s16x4 __attribute__((ext_vector_type(4)));
typedef float f32x4 __attribute__((ext_vector_type(4)));
typedef float f32x16 __attribute__((ext_vector_type(16)));
typedef unsigned u32x4 __attribute__((ext_vector_type(4)));
typedef unsigned u32x2 __attribute__((ext_vector_type(2)));

constexpr int D = 1024, NB = 8, SEQ = 8192, NTOK = NB * SEQ, DEPTH = 2, NE = 32, NIN = 1280, NMOD = 6 * D;
constexpr int NT = 512;
constexpr float EPS = 1e-6f;
constexpr float LOG2E = 1.4426950408889634f;
constexpr float QSCALE = 0.18033688011112042f;
constexpr int MAXTILES = NTOK * 4 / 256 + NE;

constexpr size_t MiB = 1u << 20;
constexpr size_t WS_CTL = 0, CTL_ZERO_BYTES = 1 * MiB;
constexpr size_t WS_MOD = 1 * MiB;
constexpr size_t WS_ROPE = 2 * MiB;
constexpr size_t WS_WIN = 8 * MiB;
constexpr size_t WS_WOUT = 16 * MiB;
constexpr size_t WS_GATES = 20 * MiB;
constexpr size_t WS_LIST = 24 * MiB;
constexpr size_t WS_WGU = 32 * MiB;
constexpr size_t WS_WDN = 288 * MiB;
constexpr size_t WS_H = 416 * MiB;
constexpr size_t WS_PROJ = 544 * MiB;
constexpr size_t WS_MIX = 704 * MiB;
constexpr size_t WS_ACT = 544 * MiB;
constexpr size_t WS_YBUF = 1072 * MiB;
constexpr size_t WS_END = 1584 * MiB;
static_assert(WS_ACT + (size_t)MAXTILES * 256 * 1024 * 2 <= WS_YBUF, "act fits");
constexpr int CW_BAR = 4096;
constexpr int CW_CNT = 8192;

constexpr int LDS_BYTES = 147456;

struct Params {
    const float *x, *c; const int* pos; const float *ada_w, *ada_b, *n1g, *w_in, *qg, *kg, *sinks, *pool_w, *pool_b, *pool_s, *w_out, *n2g, *rw, *rb, *wgu, *bgu, *wdn, *bdn;
    float* out; unsigned char* ws;
};

__device__ __forceinline__ unsigned cvt_pk_bf16(float lo, float hi) { unsigned r; asm("v_cvt_pk_bf16_f32 %0, %1, %2" : "=v"(r) : "v"(lo), "v"(hi)); return r; }
__device__ __forceinline__ float bf_lo(unsigned w) { return __uint_as_float(w << 16); }
__device__ __forceinline__ float bf_hi(unsigned w) { return __uint_as_float(w & 0xffff0000u); }
__device__ __forceinline__ float wave_sum(float v) {
#pragma unroll
    for (int o = 1; o < 64; o <<= 1) v += __shfl_xor(v, o);
    return v;
}
__device__ __forceinline__ int perm32(int rho) { const int n = rho >> 4, i = rho & 15; return 8 * (i >> 2) + 4 * n + (i & 3); }
__device__ __forceinline__ int wave_id() { return __builtin_amdgcn_readfirstlane((int)threadIdx.x >> 6); }

__device__ __forceinline__ void tr_item_src(const Params& P, int it, const float*& src, int& ldw, bf16*& dst, int& k0, int& n0) {
    unsigned char* ws = P.ws;
    if (it < 16384) { const int m = it >> 8, r = it & 255; src = P.wgu + (size_t)m * (1024 * 2048); ldw = 2048; dst = (bf16*)(ws + WS_WGU) + (size_t)m * (2048 * 1024); k0 = 128 * (r >> 5); n0 = 64 * (r & 31); return; }
    it -= 16384;
    if (it < 8192) { const int m = it >> 7, r = it & 127; src = P.wdn + (size_t)m * (1024 * 1024); ldw = 1024; dst = (bf16*)(ws + WS_WDN) + (size_t)m * (1024 * 1024); k0 = 128 * (r >> 4); n0 = 64 * (r & 15); return; }
    it -= 8192;
    if (it < 192) { const int l = it / 96, r = it % 96; src = P.w_in + (size_t)l * (1024 * 1280); ldw = 1280; dst = (bf16*)(ws + WS_WIN) + (size_t)l * (1280 * 1024); k0 = 128 * (r / 12); n0 = 64 * (r % 12); return; }
    it -= 192;
    { const int l = it >> 7, r = it & 127; src = P.w_out + (size_t)l * (1024 * 1024); ldw = 1024; dst = (bf16*)(ws + WS_WOUT) + (size_t)l * (1024 * 1024); k0 = 128 * (r >> 4); n0 = 64 * (r & 15); }
}
constexpr int N_TR_ITEMS = 16384 + 8192 + 192 + 256;

__device__ __forceinline__ void p0_prologue(const Params& P, LAS unsigned char* lds, int bid, int nblk) {
    const int tid = threadIdx.x, wid = wave_id(), lane = tid & 63;
    unsigned char* ws = P.ws;
    {
        LAS float* cact = (LAS float*)lds;
        LAS float* red = (LAS float*)(lds + 32768);
        if (bid < 192 || nblk < 192) {
            for (int i = tid; i < NB * D; i += NT) { const float v = P.c[i]; cact[i] = v / (1.0f + __expf(-v)); }
            __syncthreads();
            for (int it = bid; it < 192; it += nblk) {
                const int l = it / 96, n0 = 64 * (it % 96);
                float acc[NB];
#pragma unroll
                for (int b = 0; b < NB; ++b) acc[b] = 0.f;
                const float* wp = P.ada_w + (size_t)l * D * NMOD + n0 + lane;
                for (int k = 128 * wid; k < 128 * wid + 128; k += 16) {
                    float wv[16];
#pragma unroll
                    for (int q = 0; q < 16; ++q) wv[q] = wp[(size_t)(k + q) * NMOD];
#pragma unroll
                    for (int q = 0; q < 16; ++q)
#pragma unroll
                        for (int b = 0; b < NB; ++b) acc[b] += cact[b * D + k + q] * wv[q];
                }
#pragma unroll
                for (int b = 0; b < NB; ++b) red[(wid * NB + b) * 64 + lane] = acc[b];
                __syncthreads();
                { const int b = tid >> 6; float s = P.ada_b[l * NMOD + n0 + lane];
#pragma unroll
                  for (int w = 0; w < 8; ++w) s += red[(w * NB + b) * 64 + lane];
                  ((float*)(ws + WS_MOD))[(size_t)(l * NB + b) * NMOD + n0 + lane] = s; }
                __syncthreads();
            }
        }
    }
    for (int it = bid; it < 128; it += nblk) {
        const int l = it >> 6, g = (it >> 4) & 3, k0 = 64 * (it & 15);
        LAS float* At = (LAS float*)lds;
        LAS float* Pw = (LAS float*)(lds + 33024);
        __syncthreads();
        for (int j = 0; j < 16; ++j) { const int idx = tid + NT * j, k = idx >> 7, c = idx & 127; At[k * 129 + c] = P.w_in[(size_t)l * (1024 * 1280) + (size_t)(k0 + k) * 1280 + 768 + 128 * g + c]; }
        for (int j = 0; j < 32; ++j) { const int idx = tid + NT * j; Pw[idx] = P.pool_w[(size_t)(l * 4 + g) * 16384 + idx]; }
        __syncthreads();
        const int n = tid & 127, ks = tid >> 7;
        float acc[16];
#pragma unroll
        for (int i = 0; i < 16; ++i) acc[i] = 0.f;
        for (int c = 0; c < 128; ++c) { const float pw = Pw[c * 128 + n];
#pragma unroll
            for (int i = 0; i < 16; ++i) acc[i] += At[(16 * ks + i) * 129 + c] * pw; }
        bf16* dst = (bf16*)(ws + WS_WIN) + (size_t)l * (1280 * 1024) + (size_t)(768 + 128 * g + n) * 1024 + k0 + 16 * ks;
        u32x4 o0, o1;
        o0.x = cvt_pk_bf16(acc[0], acc[1]); o0.y = cvt_pk_bf16(acc[2], acc[3]); o0.z = cvt_pk_bf16(acc[4], acc[5]); o0.w = cvt_pk_bf16(acc[6], acc[7]);
        o1.x = cvt_pk_bf16(acc[8], acc[9]); o1.y = cvt_pk_bf16(acc[10], acc[11]); o1.z = cvt_pk_bf16(acc[12], acc[13]); o1.w = cvt_pk_bf16(acc[14], acc[15]);
        *(u32x4*)dst = o0; *(u32x4*)(dst + 8) = o1;
    }
    {
        const double invf[8] = {1.0, 0.19392274474868576, 0.03760603093086393, 0.007292664737217109, 0.001414213562373095, 0.0002742481756762073, 5.318295896944988e-05, 1.031338537721246e-05};
        float* rope = (float*)(ws + WS_ROPE);
        for (int idx = bid * NT + tid; idx < NTOK * 8; idx += nblk * NT) {
            const int tok = idx >> 3, i = idx & 7;
            double f = 1.0;
#pragma unroll
            for (int q = 0; q < 8; ++q) f = (i == q) ? invf[q] : f;
            const double ang = (double)P.pos[tok] * f;
            const double kq = __builtin_rint(ang * 0.6366197723675814);
            const double r = (ang - kq * 1.5707963267948966) - kq * 6.123233995736766e-17;
            const double r2 = r * r;
            double sn = r * (1.0 + r2 * (-1.0 / 6 + r2 * (1.0 / 120 + r2 * (-1.0 / 5040 + r2 * (1.0 / 362880 + r2 * (-1.0 / 39916800 + r2 * (1.0 / 6227020800.0)))))));
            double cs = 1.0 + r2 * (-0.5 + r2 * (1.0 / 24 + r2 * (-1.0 / 720 + r2 * (1.0 / 40320 + r2 * (-1.0 / 3628800 + r2 * (1.0 / 479001600.0 + r2 * (-1.0 / 87178291200.0)))))));
            const int q = ((int)(long long)kq) & 3;
            double s2 = (q & 1) ? cs : sn, c2 = (q & 1) ? sn : cs;
            if (q == 1 || q == 2) c2 = -c2;
            if (q >= 2) s2 = -s2;
            rope[tok * 16 + i] = (float)c2; rope[tok * 16 + 8 + i] = (float)s2;
        }
    }
    {
        LAS float* tile = (LAS float*)lds;
        __syncthreads();
        f32x4 r[4];
        const float* src; int ldw, k0, n0; bf16* dst;
        int it = bid;
        if (it < N_TR_ITEMS) { tr_item_src(P, it, src, ldw, dst, k0, n0);
#pragma unroll
            for (int j = 0; j < 4; ++j) { const int idx = tid + NT * j, row = idx >> 4, c4 = idx & 15; r[j] = *(const f32x4*)(src + (size_t)(k0 + row) * ldw + n0 + 4 * c4); } }
        for (; it < N_TR_ITEMS; it += nblk) {
#pragma unroll
            for (int j = 0; j < 4; ++j) { const int idx = tid + NT * j, row = idx >> 4, c4 = idx & 15; LAS float* t = tile + row * 65 + 4 * c4; t[0] = r[j].x; t[1] = r[j].y; t[2] = r[j].z; t[3] = r[j].w; }
            __syncthreads();
            bf16* cdst = dst; const int ck0 = k0, cn0 = n0;
            if (it + nblk < N_TR_ITEMS) { tr_item_src(P, it + nblk, src, ldw, dst, k0, n0);
#pragma unroll
                for (int j = 0; j < 4; ++j) { const int idx = tid + NT * j, row = idx >> 4, c4 = idx & 15; r[j] = *(const f32x4*)(src + (size_t)(k0 + row) * ldw + n0 + 4 * c4); } }
#pragma unroll
            for (int j = 0; j < 2; ++j) { const int p = tid + NT * j, n = p >> 4, c = p & 15; const LAS float* t = tile + (8 * c) * 65 + n;
                u32x4 o; o.x = cvt_pk_bf16(t[0], t[65]); o.y = cvt_pk_bf16(t[2 * 65], t[3 * 65]); o.z = cvt_pk_bf16(t[4 * 65], t[5 * 65]); o.w = cvt_pk_bf16(t[6 * 65], t[7 * 65]);
                *(u32x4*)(cdst + (size_t)(cn0 + n) * 1024 + ck0 + 8 * c) = o; }
            __syncthreads();
        }
    }
}

template <int MODE>
__device__ __forceinline__ void norm1_phase(const Params& P, int l, int bid, int nblk) {
    const int tid = threadIdx.x, wid = wave_id(), lane = tid & 63;
    unsigned char* ws = P.ws;
    const float* mod = (const float*)(ws + WS_MOD);
    const float* xin = (MODE == 0) ? P.x : P.out;
    bf16* H = (bf16*)(ws + WS_H);
    const float* gates = (const float*)(ws + WS_GATES);
    const bf16* Y = (const bf16*)(ws + WS_YBUF);
    for (int ch = bid * 8 + wid; ch < NTOK / 32; ch += nblk * 8) {
        const int b = (ch * 32) >> 13;
        f32x4 ca[4], cc[4], cg[4];
#pragma unroll
        for (int j = 0; j < 4; ++j) {
            const int col = 256 * j + 4 * lane;
            if (MODE <= 1) { const f32x4 g = *(const f32x4*)(P.n1g + l * D + col); const f32x4 sc = *(const f32x4*)(mod + (size_t)(l * NB + b) * NMOD + 1 * D + col);
                ca[j] = g * (1.0f + sc); cc[j] = *(const f32x4*)(mod + (size_t)(l * NB + b) * NMOD + 0 * D + col); }
            if (MODE >= 1) { const int lp = (MODE == 2) ? (DEPTH - 1) : (l - 1); cg[j] = *(const f32x4*)(mod + (size_t)(lp * NB + b) * NMOD + 5 * D + col); }
        }
        for (int rr = 0; rr < 32; ++rr) {
            const int row = ch * 32 + rr;
            f32x4 v[4];
#pragma unroll
            for (int j = 0; j < 4; ++j) v[j] = *(const f32x4*)(xin + (size_t)row * D + 256 * j + 4 * lane);
            if (MODE >= 1) {
                const f32x4 gt = *(const f32x4*)(gates + (size_t)row * 4);
                f32x4 a[4];
#pragma unroll
                for (int j = 0; j < 4; ++j) a[j] = (f32x4){0.f, 0.f, 0.f, 0.f};
#pragma unroll
                for (int k = 0; k < 4; ++k) {
                    const float gk = gt[k];
#pragma unroll
                    for (int j = 0; j < 4; ++j) { const u32x2 y = *(const u32x2*)(Y + ((size_t)row * 4 + k) * D + 256 * j + 4 * lane);
                        a[j].x += gk * bf_lo(y.x); a[j].y += gk * bf_hi(y.x); a[j].z += gk * bf_lo(y.y); a[j].w += gk * bf_hi(y.y); }
                }
#pragma unroll
                for (int j = 0; j < 4; ++j) { v[j] += cg[j] * a[j]; *(f32x4*)(P.out + (size_t)row * D + 256 * j + 4 * lane) = v[j]; }
            }
            if (MODE <= 1) {
                float ss = 0.f;
#pragma unroll
                for (int j = 0; j < 4; ++j) ss += (v[j].x * v[j].x + v[j].y * v[j].y) + (v[j].z * v[j].z + v[j].w * v[j].w);
                const float rstd = 1.0f / sqrtf(wave_sum(ss) * (1.0f / D) + EPS);
#pragma unroll
                for (int j = 0; j < 4; ++j) { const f32x4 h = v[j] * rstd * ca[j] + cc[j]; u32x2 o; o.x = cvt_pk_bf16(h.x, h.y); o.y = cvt_pk_bf16(h.z, h.w);
                    *(u32x2*)(H + (size_t)row * D + 256 * j + 4 * lane) = o; }
            }
        }
    }
}

struct Unit { int pm, pn, e, nrows, tbase; };
typedef f32x4 Acc[2][2][4][2];

template <class Pb>
__device__ __forceinline__ void gemm_simple(LAS unsigned char* lds, const Pb& pb, int bid, int nblk) {
    const int tid = threadIdx.x, wid = wave_id(), lane = tid & 63, wr = wid >> 2, wc = wid & 3, fr = lane & 15, fq = lane >> 4;
    constexpr int PITCH = 144;
    LAS unsigned char* sA = lds; LAS unsigned char* sB = lds + 256 * PITCH;
    Unit u;
    for (int i = 0; pb.next(i, bid, nblk, u); ++i) {
        Acc acc;
#pragma unroll
        for (int a = 0; a < 2; ++a)
#pragma unroll
            for (int b = 0; b < 2; ++b)
#pragma unroll
                for (int m = 0; m < 4; ++m)
#pragma unroll
                    for (int n = 0; n < 2; ++n) acc[a][b][m][n] = (f32x4){0.f, 0.f, 0.f, 0.f};
        const char* ap[4]; const char* bp[4];
#pragma unroll
        for (int j = 0; j < 4; ++j) { const int q = tid + NT * j, row = q >> 3, c8 = q & 7;
            ap[j] = pb.A + (size_t)pb.a_row(u, row) * (pb.K * 2) + c8 * 16; bp[j] = pb.B + (size_t)pb.b_row(u, row) * (pb.K * 2) + c8 * 16; }
        for (int kt = 0; kt < pb.K / 64; ++kt) {
            u32x4 ra[4], rb[4];
#pragma unroll
            for (int j = 0; j < 4; ++j) { ra[j] = *(const u32x4*)(ap[j] + kt * 128); rb[j] = *(const u32x4*)(bp[j] + kt * 128); }
            __syncthreads();
#pragma unroll
            for (int j = 0; j < 4; ++j) { const int q = tid + NT * j, row = q >> 3, c8 = q & 7; *(LAS u32x4*)(sA + row * PITCH + c8 * 16) = ra[j]; *(LAS u32x4*)(sB + row * PITCH + c8 * 16) = rb[j]; }
            __syncthreads();
#pragma unroll
            for (int kk = 0; kk < 2; ++kk) {
                bf16x8 af[2][4], bfr[2][2];
#pragma unroll
                for (int a = 0; a < 2; ++a)
#pragma unroll
                    for (int m = 0; m < 4; ++m) af[a][m] = *(const LAS bf16x8*)(sA + (128 * a + 64 * wr + 16 * m + fr) * PITCH + (kk * 32 + fq * 8) * 2);
#pragma unroll
                for (int b = 0; b < 2; ++b)
#pragma unroll
                    for (int n = 0; n < 2; ++n) bfr[b][n] = *(const LAS bf16x8*)(sB + (128 * b + 32 * wc + 16 * n + fr) * PITCH + (kk * 32 + fq * 8) * 2);
#pragma unroll
                for (int a = 0; a < 2; ++a)
#pragma unroll
                    for (int b = 0; b < 2; ++b)
#pragma unroll
                        for (int m = 0; m < 4; ++m)
#pragma unroll
                            for (int n = 0; n < 2; ++n) acc[a][b][m][n] = __builtin_amdgcn_mfma_f32_16x16x32_bf16(bfr[b][n], af[a][m], acc[a][b][m][n], 0, 0, 0);
            }
        }
        pb.epi(acc, u, wr, wc, fr, fq);
    }
    __syncthreads();
}

struct PbInProj {
    const char* A; const char* B; int K;
    bf16* proj; const float* qg; const float* kg; const float* rope;
    __device__ __forceinline__ bool next(int i, int bid, int nblk, Unit& u) const { const int L = i * nblk + bid; if (L >= 256 * 5) return false; u.pm = L / 5; u.pn = L % 5; u.e = 0; u.nrows = 256; u.tbase = 0; return true; }
    __device__ __forceinline__ int a_row(const Unit& u, int r) const { return 256 * u.pm + r; }
    __device__ __forceinline__ int b_row(const Unit& u, int rho) const { return 256 * u.pn + 64 * ((rho >> 5) & 3) + 32 * (rho >> 7) + perm32(rho & 31); }
    __device__ __forceinline__ void epi(const Acc& acc, const Unit& u, int wr, int wc, int fr, int fq) const {
        const int hg = 4 * u.pn + wc;
        const bool nrm = hg < 10;
        const float* gsrc = (hg < 8) ? qg : kg;
        f32x4 gv[2][2];
#pragma unroll
        for (int bj = 0; bj < 2; ++bj)
#pragma unroll
            for (int n = 0; n < 2; ++n) gv[bj][n] = nrm ? *(const f32x4*)(gsrc + 32 * bj + 8 * fq + 4 * n) : (f32x4){1.f, 1.f, 1.f, 1.f};
        const float qs = (hg < 8) ? QSCALE : 1.0f;
#pragma unroll
        for (int ai = 0; ai < 2; ++ai)
#pragma unroll
            for (int m = 0; m < 4; ++m) {
                const int row = 256 * u.pm + 128 * ai + 64 * wr + 16 * m + fr;
                f32x4 v[2][2];
#pragma unroll
                for (int bj = 0; bj < 2; ++bj)
#pragma unroll
                    for (int n = 0; n < 2; ++n) v[bj][n] = acc[ai][bj][m][n];
                if (nrm) {
                    float ss = 0.f;
#pragma unroll
                    for (int bj = 0; bj < 2; ++bj)
#pragma unroll
                        for (int n = 0; n < 2; ++n) ss += (v[bj][n].x * v[bj][n].x + v[bj][n].y * v[bj][n].y) + (v[bj][n].z * v[bj][n].z + v[bj][n].w * v[bj][n].w);
                    ss += __shfl_xor(ss, 16); ss += __shfl_xor(ss, 32);
                    const float rstd = 1.0f / sqrtf(ss * (1.0f / 64.0f) + EPS);
#pragma unroll
                    for (int bj = 0; bj < 2; ++bj)
#pragma unroll
                        for (int n = 0; n < 2; ++n) v[bj][n] = v[bj][n] * rstd * gv[bj][n];
#pragma unroll
                    for (int n = 0; n < 2; ++n) {
                        f32x4 pr;
                        pr.x = __shfl_xor(v[0][n].x, 16); pr.y = __shfl_xor(v[0][n].y, 16); pr.z = __shfl_xor(v[0][n].z, 16); pr.w = __shfl_xor(v[0][n].w, 16);
                        if (fq < 2) {
                            const f32x4 cs = *(const f32x4*)(rope + (size_t)row * 16 + 4 * n), sn = *(const f32x4*)(rope + (size_t)row * 16 + 8 + 4 * n);
                            v[0][n] = (fq == 0) ? (v[0][n] * cs - pr * sn) : (v[0][n] * cs + pr * sn);
                        }
                    }
                }
#pragma unroll
                for (int bj = 0; bj < 2; ++bj) {
                    u32x4 o; o.x = cvt_pk_bf16(v[bj][0].x * qs, v[bj][0].y * qs); o.y = cvt_pk_bf16(v[bj][0].z * qs, v[bj][0].w * qs);
                    o.z = cvt_pk_bf16(v[bj][1].x * qs, v[bj][1].y * qs); o.w = cvt_pk_bf16(v[bj][1].z * qs, v[bj][1].w * qs);
                    *(u32x4*)(proj + (size_t)row * NIN + 64 * hg + 32 * bj + 8 * fq) = o;
                }
            }
    }
};

struct PbOutProj {
    const char* A; const char* B; int K;
    const float* xin; float* xout; const float* gate1;
    __device__ __forceinline__ bool next(int i, int bid, int nblk, Unit& u) const { const int L = i * nblk + bid; if (L >= 256 * 4) return false; u.pm = L >> 2; u.pn = L & 3; u.e = 0; u.nrows = 256; u.tbase = 0; return true; }
    __device__ __forceinline__ int a_row(const Unit& u, int r) const { return 256 * u.pm + r; }
    __device__ __forceinline__ int b_row(const Unit& u, int rho) const { return 256 * u.pn + rho; }
    __device__ __forceinline__ void epi(const Acc& acc, const Unit& u, int wr, int wc, int fr, int fq) const {
        const int b = (256 * u.pm) >> 13;
        const int col0 = 256 * u.pn + 32 * wc + 4 * fq;
        f32x4 g[2][2];
#pragma unroll
        for (int bj = 0; bj < 2; ++bj)
#pragma unroll
            for (int n = 0; n < 2; ++n) g[bj][n] = *(const f32x4*)(gate1 + (size_t)b * NMOD + col0 + 128 * bj + 16 * n);
#pragma unroll
        for (int ai = 0; ai < 2; ++ai)
#pragma unroll
            for (int m = 0; m < 4; ++m) {
                const size_t off = (size_t)(256 * u.pm + 128 * ai + 64 * wr + 16 * m + fr) * D + col0;
#pragma unroll
                for (int bj = 0; bj < 2; ++bj)
#pragma unroll
                    for (int n = 0; n < 2; ++n) { const f32x4 xi = *(const f32x4*)(xin + off + 128 * bj + 16 * n); *(f32x4*)(xout + off + 128 * bj + 16 * n) = xi + g[bj][n] * acc[ai][bj][m][n]; }
            }
    }
};

struct MoeTab { const LAS int* cnt; const LAS int* tp; };
__device__ __forceinline__ void moe_build_tab(LAS int* tab, const unsigned* gcount) {
    if (threadIdx.x == 0) { int t = 0; for (int e = 0; e < NE; ++e) { const int c = (int)__hip_atomic_load(gcount + e * 64, __ATOMIC_RELAXED, __HIP_MEMORY_SCOPE_AGENT); tab[e] = c; tab[32 + e] = t; t += (c + 255) >> 8; } tab[64] = t; }
    __syncthreads();
}
__device__ __forceinline__ bool moe_unit(const LAS int* tab, int L, int ntn, Unit& u) {
    const int gt = L / ntn; if (gt >= tab[64]) return false;
    int e = 0;
    for (int q = 1; q < NE; ++q) e = (tab[32 + q] <= gt) ? q : e;
    u.e = e; u.pm = gt - tab[32 + e]; u.pn = L % ntn; u.tbase = gt * 256; const int rem = tab[e] - 256 * u.pm; u.nrows = rem < 256 ? rem : 256; return true;
}

struct PbGU {
    const char* A; const char* B; int K;
    const LAS int* tab; const int* list; const float* bgu; bf16* act;
    __device__ __forceinline__ bool next(int i, int bid, int nblk, Unit& u) const { return moe_unit(tab, i * nblk + bid, 8, u); }
    __device__ __forceinline__ int a_row(const Unit& u, int r) const { const int rr = r < u.nrows ? r : 0; return list[(size_t)u.e * NTOK + 256 * u.pm + rr] >> 2; }
    __device__ __forceinline__ int b_row(const Unit& u, int rho) const { const int i = rho & 127; return u.e * 2048 + ((rho >> 7) ? 1024 : 0) + 128 * u.pn + (i & ~31) + perm32(i & 31); }
    __device__ __forceinline__ void epi(const Acc& acc, const Unit& u, int wr, int wc, int fr, int fq) const {
        const int col0 = 128 * u.pn + 32 * wc + 8 * fq;
        f32x4 bg[2], bu[2];
#pragma unroll
        for (int n = 0; n < 2; ++n) { bg[n] = *(const f32x4*)(bgu + (size_t)u.e * 2048 + col0 + 4 * n); bu[n] = *(const f32x4*)(bgu + (size_t)u.e * 2048 + 1024 + col0 + 4 * n); }
#pragma unroll
        for (int ai = 0; ai < 2; ++ai)
#pragma unroll
            for (int m = 0; m < 4; ++m) {
                const int r = 128 * ai + 64 * wr + 16 * m + fr;
                float o[8];
#pragma unroll
                for (int n = 0; n < 2; ++n)
#pragma unroll
                    for (int j = 0; j < 4; ++j) {
                        float g = acc[ai][0][m][n][j] + bg[n][j], uu = acc[ai][1][m][n][j] + bu[n][j];
                        g = fminf(g, 7.0f); uu = fminf(fmaxf(uu, -7.0f), 7.0f);
                        const float sg = 1.0f / (1.0f + __builtin_amdgcn_exp2f(-1.702f * LOG2E * g));
                        o[4 * n + j] = g * sg * (uu + 1.0f);
                    }
                u32x4 w; w.x = cvt_pk_bf16(o[0], o[1]); w.y = cvt_pk_bf16(o[2], o[3]); w.z = cvt_pk_bf16(o[4], o[5]); w.w = cvt_pk_bf16(o[6], o[7]);
                *(u32x4*)(act + (size_t)(u.tbase + r) * 1024 + col0) = w;
            }
    }
};

struct PbDown {
    const char* A; const char* B; int K;
    const LAS int* tab; const int* list; const float* bdn; bf16* ybuf;
    __device__ __forceinline__ bool next(int i, int bid, int nblk, Unit& u) const { return moe_unit(tab, i * nblk + bid, 4, u); }
    __device__ __forceinline__ int a_row(const Unit& u, int r) const { return u.tbase + r; }
    __device__ __forceinline__ int b_row(const Unit& u, int rho) const { return u.e * 1024 + 256 * u.pn + (rho & ~31) + perm32(rho & 31); }
    __device__ __forceinline__ void epi(const Acc& acc, const Unit& u, int wr, int wc, int fr, int fq) const {
        const int col0 = 256 * u.pn + 32 * wc + 8 * fq;
        f32x4 bv[2][2];
#pragma unroll
        for (int bj = 0; bj < 2; ++bj)
#pragma unroll
            for (int n = 0; n < 2; ++n) bv[bj][n] = *(const f32x4*)(bdn + (size_t)u.e * 1024 + col0 + 128 * bj + 4 * n);
#pragma unroll
        for (int ai = 0; ai < 2; ++ai)
#pragma unroll
            for (int m = 0; m < 4; ++m) {
                const int r = 128 * ai + 64 * wr + 16 * m + fr;
                if (r < u.nrows) {
                    const int dest = list[(size_t)u.e * NTOK + 256 * u.pm + r];
#pragma unroll
                    for (int bj = 0; bj < 2; ++bj) {
                        const f32x4 v0 = acc[ai][bj][m][0] + bv[bj][0], v1 = acc[ai][bj][m][1] + bv[bj][1];
                        u32x4 w; w.x = cvt_pk_bf16(v0.x, v0.y); w.y = cvt_pk_bf16(v0.z, v0.w); w.z = cvt_pk_bf16(v1.x, v1.y); w.w = cvt_pk_bf16(v1.z, v1.w);
                        *(u32x4*)(ybuf + (size_t)dest * 1024 + col0 + 128 * bj) = w;
                    }
                }
            }
    }
};

__device__ __forceinline__ s16x4 lds_tr16(const LAS unsigned char* p) { return __builtin_bit_cast(s16x4, __builtin_amdgcn_ds_read_tr16_b64_v4i16((LAS s16x4*)p)); }

__device__ __forceinline__ void attn_phase(const Params& P, LAS unsigned char* lds, int l, int bid, int nblk) {
    const int tid = threadIdx.x, wid = wave_id(), lane = tid & 63, r32 = lane & 31, hi = lane >> 5;
    unsigned char* ws = P.ws;
    const bf16* proj = (const bf16*)(ws + WS_PROJ);
    bf16* mix = (bf16*)(ws + WS_MIX);
    constexpr int KP = 144;
    LAS unsigned char* sK = lds; LAS unsigned char* sV = lds + 256 * KP;
    for (int unit = bid; unit < NB * 64 * 2; unit += nblk) {
        const int kvh = unit & 1, n = (unit >> 1) & 63, b = unit >> 7;
        const int tok0 = b * SEQ + n * 128 - 128;
        __syncthreads();
#pragma unroll
        for (int j = 0; j < 4; ++j) {
            const int q = tid + NT * j, key = q >> 3, c8 = q & 7;
            u32x4 kv = (u32x4){0u, 0u, 0u, 0u}, vv = (u32x4){0u, 0u, 0u, 0u};
            if (n > 0 || key >= 128) { const bf16* src = proj + (size_t)(tok0 + key) * NIN + 512 + kvh * 64 + c8 * 8; kv = *(const u32x4*)src; vv = *(const u32x4*)(src + 128); }
            *(LAS u32x4*)(sK + key * KP + c8 * 16) = kv; *(LAS u32x4*)(sV + key * KP + c8 * 16) = vv;
        }
        __syncthreads();
        const int hq = kvh * 4 + (wid >> 1);
        const float sink2 = P.sinks[l * 8 + hq] * LOG2E;
#pragma unroll 1
        for (int qt = 0; qt < 2; ++qt) {
            const int q0 = 64 * (wid & 1) + 32 * qt, qi = q0 + r32;
            const size_t qtok = (size_t)b * SEQ + n * 128 + qi;
            bf16x8 qf[4];
#pragma unroll
            for (int s = 0; s < 4; ++s) qf[s] = *(const bf16x8*)(proj + qtok * NIN + hq * 64 + 16 * s + 8 * hi);
            f32x16 st[5];
#pragma unroll
            for (int kt = 0; kt < 5; ++kt) {
#pragma unroll
                for (int r = 0; r < 16; ++r) st[kt][r] = 0.f;
#pragma unroll
                for (int s = 0; s < 4; ++s) { const bf16x8 kf = *(const LAS bf16x8*)(sK + (q0 + 32 * kt + r32) * KP + (16 * s + 8 * hi) * 2); st[kt] = __builtin_amdgcn_mfma_f32_32x32x16_bf16(kf, qf[s], st[kt], 0, 0, 0); }
            }
            float mx = sink2;
#pragma unroll
            for (int kt = 0; kt < 5; ++kt)
#pragma unroll
                for (int r = 0; r < 16; ++r) {
                    const int kj = q0 + 32 * kt + (r & 3) + 8 * (r >> 2) + 4 * hi;
                    const bool ok = (kj > qi) && (kj <= qi + 128) && (n > 0 || kj >= 128);
                    const float s = ok ? st[kt][r] : -__builtin_inff(); st[kt][r] = s; mx = fmaxf(mx, s);
                }
            mx = fmaxf(mx, __shfl_xor(mx, 32));
            float sum = 0.f;
#pragma unroll
            for (int kt = 0; kt < 5; ++kt)
#pragma unroll
                for (int r = 0; r < 16; ++r) { const float p = __builtin_amdgcn_exp2f(st[kt][r] - mx); st[kt][r] = p; sum += p; }
            sum += __shfl_xor(sum, 32);
            sum += __builtin_amdgcn_exp2f(sink2 - mx);
            f32x16 o[2];
#pragma unroll
            for (int dt = 0; dt < 2; ++dt)
#pragma unroll
                for (int r = 0; r < 16; ++r) o[dt][r] = 0.f;
#pragma unroll
            for (int kt = 0; kt < 5; ++kt)
#pragma unroll
                for (int s2 = 0; s2 < 2; ++s2) {
                    u32x4 pw; pw.x = cvt_pk_bf16(st[kt][8 * s2 + 0], st[kt][8 * s2 + 1]); pw.y = cvt_pk_bf16(st[kt][8 * s2 + 2], st[kt][8 * s2 + 3]);
                    pw.z = cvt_pk_bf16(st[kt][8 * s2 + 4], st[kt][8 * s2 + 5]); pw.w = cvt_pk_bf16(st[kt][8 * s2 + 6], st[kt][8 * s2 + 7]);
                    const bf16x8 pf = __builtin_bit_cast(bf16x8, pw);
                    const int kb = q0 + 32 * kt + 16 * s2 + 4 * hi, i16 = lane & 15;
#pragma unroll
                    for (int dt = 0; dt < 2; ++dt) {
                        const int d0 = 32 * dt + 16 * ((lane >> 4) & 1);
                        const LAS unsigned char* a0 = sV + (kb + (i16 >> 2)) * KP + (d0 + 4 * (i16 & 3)) * 2;
                        const s16x4 v0 = lds_tr16(a0), v1 = lds_tr16(a0 + 8 * KP);
                        bf16x8 vf; vf[0] = v0[0]; vf[1] = v0[1]; vf[2] = v0[2]; vf[3] = v0[3]; vf[4] = v1[0]; vf[5] = v1[1]; vf[6] = v1[2]; vf[7] = v1[3];
                        o[dt] = __builtin_amdgcn_mfma_f32_32x32x16_bf16(vf, pf, o[dt], 0, 0, 0);
                    }
                }
            const float inv = 1.0f / sum;
#pragma unroll
            for (int dt = 0; dt < 2; ++dt)
#pragma unroll
                for (int g4 = 0; g4 < 4; ++g4) {
                    u32x2 w; w.x = cvt_pk_bf16(o[dt][4 * g4 + 0] * inv, o[dt][4 * g4 + 1] * inv); w.y = cvt_pk_bf16(o[dt][4 * g4 + 2] * inv, o[dt][4 * g4 + 3] * inv);
                    *(u32x2*)(mix + qtok * D + hq * 64 + 32 * dt + 8 * g4 + 4 * hi) = w;
                }
        }
    }
    for (int ch = bid * 8 + wid; ch < NTOK / 32; ch += nblk * 8) {
        const int t0 = ch * 32, p0 = t0 & (SEQ - 1);
        const int col = 8 * lane, g = lane >> 4, w = 2 << g;
        float pb_[8], ps_[8];
#pragma unroll
        for (int i = 0; i < 8; i += 4) { const f32x4 a = *(const f32x4*)(P.pool_b + l * 512 + col + i), s = *(const f32x4*)(P.pool_s + l * 512 + col + i);
            pb_[i] = a.x; pb_[i + 1] = a.y; pb_[i + 2] = a.z; pb_[i + 3] = a.w; ps_[i] = s.x; ps_[i + 1] = s.y; ps_[i + 2] = s.z; ps_[i + 3] = s.w; }
        float sum[8];
#pragma unroll
        for (int i = 0; i < 8; ++i) sum[i] = 0.f;
        for (int j = 1; j < w; ++j) if (p0 - j >= 0) {
            const u32x4 z = *(const u32x4*)(proj + (size_t)(t0 - j) * NIN + 768 + col);
            sum[0] += bf_lo(z.x); sum[1] += bf_hi(z.x); sum[2] += bf_lo(z.y); sum[3] += bf_hi(z.y); sum[4] += bf_lo(z.z); sum[5] += bf_hi(z.z); sum[6] += bf_lo(z.w); sum[7] += bf_hi(z.w);
        }
        for (int t = 0; t < 32; ++t) {
            const u32x4 z = *(const u32x4*)(proj + (size_t)(t0 + t) * NIN + 768 + col);
            float zz[8] = {bf_lo(z.x), bf_hi(z.x), bf_lo(z.y), bf_hi(z.y), bf_lo(z.z), bf_hi(z.z), bf_lo(z.w), bf_hi(z.w)};
            const int pos = p0 + t; const float ic = 1.0f / (float)((pos + 1 < w) ? (pos + 1) : w);
            float o[8];
#pragma unroll
            for (int i = 0; i < 8; ++i) { sum[i] += zz[i]; o[i] = (sum[i] * ic - zz[i] + pb_[i]) * ps_[i]; }
            u32x4 ow; ow.x = cvt_pk_bf16(o[0], o[1]); ow.y = cvt_pk_bf16(o[2], o[3]); ow.z = cvt_pk_bf16(o[4], o[5]); ow.w = cvt_pk_bf16(o[6], o[7]);
            *(u32x4*)(mix + (size_t)(t0 + t) * D + 512 + col) = ow;
            if (pos - w + 1 >= 0) {
                const u32x4 y = *(const u32x4*)(proj + (size_t)(t0 + t - w + 1) * NIN + 768 + col);
                sum[0] -= bf_lo(y.x); sum[1] -= bf_hi(y.x); sum[2] -= bf_lo(y.y); sum[3] -= bf_hi(y.y); sum[4] -= bf_lo(y.z); sum[5] -= bf_hi(y.z); sum[6] -= bf_lo(y.w); sum[7] -= bf_hi(y.w);
            }
        }
    }
}

__device__ __forceinline__ void router_phase(const Params& P, LAS unsigned char* lds, int l, int bid, int nblk) {
    const int tid = threadIdx.x, wid = wave_id(), lane = tid & 63, fr = lane & 15, fq = lane >> 4;
    unsigned char* ws = P.ws;
    const float* mod = (const float*)(ws + WS_MOD);
    bf16* H = (bf16*)(ws + WS_H);
    float* gates = (float*)(ws + WS_GATES);
    int* list = (int*)(ws + WS_LIST);
    unsigned* gcount = (unsigned*)(ws + WS_CTL) + CW_CNT + l * 32 * 64;
    constexpr int RP = 2064;
    LAS unsigned char* rwT = lds;
    LAS float* lg = (LAS float*)(lds + 66048);
    LAS int* lcnt = (LAS int*)(lds + 66048 + 33792);
    LAS int* lbase = lcnt + 32;
    LAS unsigned short* sel = (LAS unsigned short*)(lcnt + 64);
    LAS unsigned short* selr = sel + 1024;
    __syncthreads();
    for (int idx = tid; idx < 1024 * 32; idx += NT) { const int k = idx >> 5, e = idx & 31; const float v = P.rw[(size_t)l * 32768 + idx];
        *(LAS unsigned short*)(rwT + e * RP + k * 2) = (unsigned short)(cvt_pk_bf16(v, 0.f) & 0xffffu); }
    for (int tile = bid; tile < NTOK / 256; tile += nblk) {
        const int tok0 = tile * 256, b = tok0 >> 13;
        if (tid < 32) lcnt[tid] = 0;
        {
            f32x4 ca[4], cc[4];
#pragma unroll
            for (int j = 0; j < 4; ++j) { const int col = 256 * j + 4 * lane; const f32x4 g = *(const f32x4*)(P.n2g + l * D + col); const f32x4 sc = *(const f32x4*)(mod + (size_t)(l * NB + b) * NMOD + 4 * D + col);
                ca[j] = g * (1.0f + sc); cc[j] = *(const f32x4*)(mod + (size_t)(l * NB + b) * NMOD + 3 * D + col); }
            for (int rr = 0; rr < 32; ++rr) {
                const int row = tok0 + wid * 32 + rr;
                f32x4 v[4]; float ss = 0.f;
#pragma unroll
                for (int j = 0; j < 4; ++j) { v[j] = *(const f32x4*)(P.out + (size_t)row * D + 256 * j + 4 * lane); ss += (v[j].x * v[j].x + v[j].y * v[j].y) + (v[j].z * v[j].z + v[j].w * v[j].w); }
                const float rstd = 1.0f / sqrtf(wave_sum(ss) * (1.0f / D) + EPS);
#pragma unroll
                for (int j = 0; j < 4; ++j) { const f32x4 h = v[j] * rstd * ca[j] + cc[j]; u32x2 o; o.x = cvt_pk_bf16(h.x, h.y); o.y = cvt_pk_bf16(h.z, h.w); *(u32x2*)(H + (size_t)row * D + 256 * j + 4 * lane) = o; }
            }
        }
        asm volatile("s_waitcnt vmcnt(0)" ::: "memory");
        __syncthreads();
#pragma unroll 1
        for (int rg = 0; rg < 2; ++rg) {
            f32x4 a0 = (f32x4){0.f, 0.f, 0.f, 0.f}, a1 = a0;
            const bf16* hp = H + (size_t)(tok0 + 32 * wid + 16 * rg + fr) * D + 8 * fq;
            for (int s = 0; s < 32; ++s) {
                const bf16x8 af = *(const bf16x8*)(hp + 32 * s);
                const bf16x8 b0 = *(const LAS bf16x8*)(rwT + fr * RP + (32 * s + 8 * fq) * 2), b1 = *(const LAS bf16x8*)(rwT + (16 + fr) * RP + (32 * s + 8 * fq) * 2);
                a0 = __builtin_amdgcn_mfma_f32_16x16x32_bf16(af, b0, a0, 0, 0, 0); a1 = __builtin_amdgcn_mfma_f32_16x16x32_bf16(af, b1, a1, 0, 0, 0);
            }
            const float rb0 = P.rb[l * 32 + fr], rb1 = P.rb[l * 32 + 16 + fr];
#pragma unroll
            for (int r = 0; r < 4; ++r) { const int row = 32 * wid + 16 * rg + 4 * fq + r; lg[row * 33 + fr] = a0[r] + rb0; lg[row * 33 + 16 + fr] = a1[r] + rb1; }
        }
        __syncthreads();
        if (tid < 256) {
            float v[32];
#pragma unroll
            for (int e = 0; e < 32; ++e) v[e] = lg[tid * 33 + e];
            float tv[4]; int ti[4];
#pragma unroll
            for (int k = 0; k < 4; ++k) {
                float best = -__builtin_inff(); int bi = 0;
#pragma unroll
                for (int e = 0; e < 32; ++e) { const bool gt = v[e] > best; best = gt ? v[e] : best; bi = gt ? e : bi; }
                tv[k] = best; ti[k] = bi;
#pragma unroll
                for (int e = 0; e < 32; ++e) v[e] = (e == bi) ? -__builtin_inff() : v[e];
            }
            const float e1 = __expf(tv[1] - tv[0]), e2 = __expf(tv[2] - tv[0]), e3 = __expf(tv[3] - tv[0]);
            const float inv = 1.0f / (1.0f + e1 + e2 + e3);
            *(f32x4*)(gates + (size_t)(tok0 + tid) * 4) = (f32x4){inv, e1 * inv, e2 * inv, e3 * inv};
#pragma unroll
            for (int k = 0; k < 4; ++k) { const int r = __hip_atomic_fetch_add(lcnt + ti[k], 1, __ATOMIC_RELAXED, __HIP_MEMORY_SCOPE_WORKGROUP); sel[tid * 4 + k] = (unsigned short)ti[k]; selr[tid * 4 + k] = (unsigned short)r; }
        }
        __syncthreads();
        if (tid < 32) lbase[tid] = (int)__hip_atomic_fetch_add(gcount + tid * 64, (unsigned)lcnt[tid], __ATOMIC_RELAXED, __HIP_MEMORY_SCOPE_AGENT);
        __syncthreads();
        if (tid < 256) {
#pragma unroll
            for (int k = 0; k < 4; ++k) { const int e = sel[tid * 4 + k]; list[(size_t)e * NTOK + lbase[e] + selr[tid * 4 + k]] = (tok0 + tid) * 4 + k; }
        }
        __syncthreads();
    }
}

__device__ __forceinline__ void inproj_phase(const Params& P, LAS unsigned char* lds, int l, int bid, int nblk) {
    unsigned char* ws = P.ws;
    PbInProj pb; pb.A = (const char*)(ws + WS_H); pb.B = (const char*)(ws + WS_WIN) + (size_t)l * (1280 * 1024 * 2); pb.K = 1024;
    pb.proj = (bf16*)(ws + WS_PROJ); pb.qg = P.qg + l * 64; pb.kg = P.kg + l * 64; pb.rope = (const float*)(ws + WS_ROPE);
    gemm_simple(lds, pb, bid, nblk);
}
__device__ __forceinline__ void outproj_phase(const Params& P, LAS unsigned char* lds, int l, int bid, int nblk) {
    unsigned char* ws = P.ws;
    PbOutProj pb; pb.A = (const char*)(ws + WS_MIX); pb.B = (const char*)(ws + WS_WOUT) + (size_t)l * (1024 * 1024 * 2); pb.K = 1024;
    pb.xin = (l == 0) ? P.x : P.out; pb.xout = P.out; pb.gate1 = (const float*)(ws + WS_MOD) + (size_t)l * NB * NMOD + 2 * D;
    gemm_simple(lds, pb, bid, nblk);
}
__device__ __forceinline__ void gu_phase(const Params& P, LAS unsigned char* lds, int l, int bid, int nblk) {
    unsigned char* ws = P.ws;
    LAS int* tab = (LAS int*)(lds + 131072);
    __syncthreads();
    moe_build_tab(tab, (const unsigned*)(ws + WS_CTL) + CW_CNT + l * 32 * 64);
    PbGU pb; pb.A = (const char*)(ws + WS_H); pb.B = (const char*)(ws + WS_WGU) + (size_t)l * 32 * (2048 * 1024 * 2); pb.K = 1024;
    pb.tab = tab; pb.list = (const int*)(ws + WS_LIST); pb.bgu = P.bgu + (size_t)l * 32 * 2048; pb.act = (bf16*)(ws + WS_ACT);
    gemm_simple(lds, pb, bid, nblk);
}
__device__ __forceinline__ void down_phase(const Params& P, LAS unsigned char* lds, int l, int bid, int nblk) {
    unsigned char* ws = P.ws;
    LAS int* tab = (LAS int*)(lds + 131072);
    __syncthreads();
    moe_build_tab(tab, (const unsigned*)(ws + WS_CTL) + CW_CNT + l * 32 * 64);
    PbDown pb; pb.A = (const char*)(ws + WS_ACT); pb.B = (const char*)(ws + WS_WDN) + (size_t)l * 32 * (1024 * 1024 * 2); pb.K = 1024;
    pb.tab = tab; pb.list = (const int*)(ws + WS_LIST); pb.bdn = P.bdn + (size_t)l * 32 * 1024; pb.ybuf = (bf16*)(ws + WS_YBUF);
    gemm_simple(lds, pb, bid, nblk);
}

extern __shared__ __attribute__((aligned(16))) unsigned char dyn_lds[];
#define KLDS ((LAS unsigned char*)dyn_lds)
__global__ void __launch_bounds__(NT, 2) k_prologue(Params P) { p0_prologue(P, KLDS, blockIdx.x, gridDim.x); }
__global__ void __launch_bounds__(NT, 2) k_norm1_0(Params P, int l) { norm1_phase<0>(P, l, blockIdx.x, gridDim.x); }
__global__ void __launch_bounds__(NT, 2) k_norm1_1(Params P, int l) { norm1_phase<1>(P, l, blockIdx.x, gridDim.x); }
__global__ void __launch_bounds__(NT, 2) k_final(Params P) { norm1_phase<2>(P, 0, blockIdx.x, gridDim.x); }
__global__ void __launch_bounds__(NT, 2) k_inproj(Params P, int l) { inproj_phase(P, KLDS, l, blockIdx.x, gridDim.x); }
__global__ void __launch_bounds__(NT, 2) k_attn(Params P, int l) { attn_phase(P, KLDS, l, blockIdx.x, gridDim.x); }
__global__ void __launch_bounds__(NT, 2) k_outproj(Params P, int l) { outproj_phase(P, KLDS, l, blockIdx.x, gridDim.x); }
__global__ void __launch_bounds__(NT, 2) k_router(Params P, int l) { router_phase(P, KLDS, l, blockIdx.x, gridDim.x); }
__global__ void __launch_bounds__(NT, 2) k_gu(Params P, int l) { gu_phase(P, KLDS, l, blockIdx.x, gridDim.x); }
__global__ void __launch_bounds__(NT, 2) k_down(Params P, int l) { down_phase(P, KLDS, l, blockIdx.x, gridDim.x); }

extern "C" void kernel_launch(void* const* d_in, const int* in_sizes, int n_in, void* d_out, int out_size, void* d_ws, size_t ws_size, hipStream_t stream) {
    static int ready = 0;
    if (ready == 0) {
        if (n_in != 21 || out_size != NTOK * D || ws_size < WS_END) { fprintf(stderr, "kernel_launch: unexpected shapes (n_in %d out %d ws %zu)\n", n_in, out_size, ws_size); ready = -1; return; }
        const void* ks[] = {(const void*)k_prologue, (const void*)k_norm1_0, (const void*)k_norm1_1, (const void*)k_final, (const void*)k_inproj, (const void*)k_attn, (const void*)k_outproj, (const void*)k_router, (const void*)k_gu, (const void*)k_down};
        for (auto k : ks) if (hipFuncSetAttribute(k, hipFuncAttributeMaxDynamicSharedMemorySize, LDS_BYTES) != hipSuccess) { fprintf(stderr, "kernel_launch: hipFuncSetAttribute failed\n"); ready = -1; return; }
        ready = 1;
    }
    if (ready < 0) return;
    (void)hipMemsetAsync((char*)d_ws + WS_CTL, 0, CTL_ZERO_BYTES, stream);
    Params P{};
    P.x = (const float*)d_in[0]; P.c = (const float*)d_in[1]; P.pos = (const int*)d_in[2]; P.ada_w = (const float*)d_in[3]; P.ada_b = (const float*)d_in[4]; P.n1g = (const float*)d_in[5];
    P.w_in = (const float*)d_in[6]; P.qg = (const float*)d_in[7]; P.kg = (const float*)d_in[8]; P.sinks = (const float*)d_in[9]; P.pool_w = (const float*)d_in[10]; P.pool_b = (const float*)d_in[11];
    P.pool_s = (const float*)d_in[12]; P.w_out = (const float*)d_in[13]; P.n2g = (const float*)d_in[14]; P.rw = (const float*)d_in[15]; P.rb = (const float*)d_in[16]; P.wgu = (const float*)d_in[17];
    P.bgu = (const float*)d_in[18]; P.wdn = (const float*)d_in[19]; P.bdn = (const float*)d_in[20]; P.out = (float*)d_out; P.ws = (unsigned char*)d_ws;
    const dim3 g(256), b(NT);
    hipLaunchKernelGGL(k_prologue, g, b, LDS_BYTES, stream, P);
    for (int l = 0; l < DEPTH; ++l) {
        if (l == 0) hipLaunchKernelGGL(k_norm1_0, g, b, LDS_BYTES, stream, P, l); else hipLaunchKernelGGL(k_norm1_1, g, b, LDS_BYTES, stream, P, l);
        hipLaunchKernelGGL(k_inproj, g, b, LDS_BYTES, stream, P, l);
        hipLaunchKernelGGL(k_attn, g, b, LDS_BYTES, stream, P, l);
        hipLaunchKernelGGL(k_outproj, g, b, LDS_BYTES, stream, P, l);
        hipLaunchKernelGGL(k_router, g, b, LDS_BYTES, stream, P, l);
        hipLaunchKernelGGL(k_gu, g, b, LDS_BYTES, stream, P, l);
        hipLaunchKernelGGL(k_down, g, b, LDS_BYTES, stream, P, l);
    }
    hipLaunchKernelGGL(k_final, g, b, LDS_BYTES, stream, P);
}
```

```cpp
#include <hip/hip_runtime.h>
#include <cstdio>
#include <cstdint>

#ifndef ONE_LAUNCH
#define ONE_LAUNCH 1
#endif

#define LAS __attribute__((address_space(3)))
typedef unsigned short bf16;
typedef short bf16x8 __attribute__((ext_vector_type(8)));
typedef short s16x4 __attribute__((ext_vector_type(4)));
typedef float f32x4 __attribute__((ext_vector_type(4)));
typedef float f32x16 __attribute__((ext_vector_type(16)));
typedef unsigned u32x4 __attribute__((ext_vector_type(4)));
typedef unsigned u32x2 __attribute__((ext_vector_type(2)));

constexpr int D = 1024, NB = 8, SEQ = 8192, NTOK = NB * SEQ, DEPTH = 2, NE = 32, NIN = 1280, NMOD = 6 * D;
constexpr int NT = 512;
constexpr float EPS = 1e-6f;
constexpr float LOG2E = 1.4426950408889634f;
constexpr float QSCALE = 0.18033688011112042f;
constexpr int MAXTILES = NTOK * 4 / 256 + NE;

constexpr size_t MiB = 1u << 20;
constexpr size_t WS_CTL = 0, CTL_ZERO_BYTES = 1 * MiB;
constexpr size_t WS_MOD = 1 * MiB;
constexpr size_t WS_ROPE = 2 * MiB;
constexpr size_t WS_WIN = 8 * MiB;
constexpr size_t WS_WOUT = 16 * MiB;
constexpr size_t WS_GATES = 20 * MiB;
constexpr size_t WS_LIST = 24 * MiB;
constexpr size_t WS_WGU = 32 * MiB;
constexpr size_t WS_WDN = 288 * MiB;
constexpr size_t WS_H = 416 * MiB;
constexpr size_t WS_PROJ = 544 * MiB;
constexpr size_t WS_MIX = 704 * MiB;
constexpr size_t WS_ACT = 544 * MiB;
constexpr size_t WS_YBUF = 1072 * MiB;
constexpr size_t WS_END = 1584 * MiB;
static_assert(WS_ACT + (size_t)MAXTILES * 256 * 1024 * 2 <= WS_YBUF, "act fits");
constexpr int CW_BAR = 4096;
constexpr int CW_CNT = 8192;

constexpr int LDS_BYTES = 147456;

struct Params {
    const float *x, *c; const int* pos; const float *ada_w, *ada_b, *n1g, *w_in, *qg, *kg, *sinks, *pool_w, *pool_b, *pool_s, *w_out, *n2g, *rw, *rb, *wgu, *bgu, *wdn, *bdn;
    float* out; unsigned char* ws;
};

__device__ __forceinline__ unsigned cvt_pk_bf16(float lo, float hi) { unsigned r; asm("v_cvt_pk_bf16_f32 %0, %1, %2" : "=v"(r) : "v"(lo), "v"(hi)); return r; }
__device__ __forceinline__ float bf_lo(unsigned w) { return __uint_as_float(w << 16); }
__device__ __forceinline__ float bf_hi(unsigned w) { return __uint_as_float(w & 0xffff0000u); }
__device__ __forceinline__ float wave_sum(float v) {
#pragma unroll
    for (int o = 1; o < 64; o <<= 1) v += __shfl_xor(v, o);
    return v;
}
__device__ __forceinline__ int perm32(int rho) { const int n = rho >> 4, i = rho & 15; return 8 * (i >> 2) + 4 * n + (i & 3); }
__device__ __forceinline__ int opaque_tid() { int t = threadIdx.x; asm volatile("" : "+v"(t)); return t; }

__device__ __forceinline__ void tr_item_src(const Params& P, int it, const float*& src, int& ldw, bf16*& dst, int& k0, int& n0) {
    unsigned char* ws = P.ws;
    if (it < 16384) { const int m = it >> 8, r = it & 255; src = P.wgu + (size_t)m * (1024 * 2048); ldw = 2048; dst = (bf16*)(ws + WS_WGU) + (size_t)m * (2048 * 1024); k0 = 128 * (r >> 5); n0 = 64 * (r & 31); return; }
    it -= 16384;
    if (it < 8192) { const int m = it >> 7, r = it & 127; src = P.wdn + (size_t)m * (1024 * 1024); ldw = 1024; dst = (bf16*)(ws + WS_WDN) + (size_t)m * (1024 * 1024); k0 = 128 * (r >> 4); n0 = 64 * (r & 15); return; }
    it -= 8192;
    if (it < 192) { const int l = it / 96, r = it % 96; src = P.w_in + (size_t)l * (1024 * 1280); ldw = 1280; dst = (bf16*)(ws + WS_WIN) + (size_t)l * (1280 * 1024); k0 = 128 * (r / 12); n0 = 64 * (r % 12); return; }
    it -= 192;
    { const int l = it >> 7, r = it & 127; src = P.w_out + (size_t)l * (1024 * 1024); ldw = 1024; dst = (bf16*)(ws + WS_WOUT) + (size_t)l * (1024 * 1024); k0 = 128 * (r >> 4); n0 = 64 * (r & 15); }
}
constexpr int N_TR_ITEMS = 16384 + 8192 + 192 + 256;

__device__ __forceinline__ void p0_prologue(const Params& P, LAS unsigned char* lds, int bid, int nblk) {
    const int tid = opaque_tid(), wid = __builtin_amdgcn_readfirstlane(tid >> 6), lane = tid & 63;
    unsigned char* ws = P.ws;
    {
        LAS float* cact = (LAS float*)lds;
        LAS float* red = (LAS float*)(lds + 32768);
        if (bid < 192 || nblk < 192) {
            for (int i = tid; i < NB * D; i += NT) { const float v = P.c[i]; cact[i] = v / (1.0f + __expf(-v)); }
            __syncthreads();
            for (int it = bid; it < 192; it += nblk) {
                const int l = it / 96, n0 = 64 * (it % 96);
                float acc[NB];
#pragma unroll
                for (int b = 0; b < NB; ++b) acc[b] = 0.f;
                const float* wp = P.ada_w + (size_t)l * D * NMOD + n0 + lane;
                for (int k = 128 * wid; k < 128 * wid + 128; k += 16) {
                    float wv[16];
#pragma unroll
                    for (int q = 0; q < 16; ++q) wv[q] = wp[(size_t)(k + q) * NMOD];
#pragma unroll
                    for (int q = 0; q < 16; ++q)
#pragma unroll
                        for (int b = 0; b < NB; ++b) acc[b] += cact[b * D + k + q] * wv[q];
                }
#pragma unroll
                for (int b = 0; b < NB; ++b) red[(wid * NB + b) * 64 + lane] = acc[b];
                __syncthreads();
                { const int b = tid >> 6; float s = P.ada_b[l * NMOD + n0 + lane];
#pragma unroll
                  for (int w = 0; w < 8; ++w) s += red[(w * NB + b) * 64 + lane];
                  ((float*)(ws + WS_MOD))[(size_t)(l * NB + b) * NMOD + n0 + lane] = s; }
                __syncthreads();
            }
        }
    }
    for (int it = bid; it < 128; it += nblk) {
        const int l = it >> 6, g = (it >> 4) & 3, k0 = 64 * (it & 15);
        LAS float* At = (LAS float*)lds;
        LAS float* Pw = (LAS float*)(lds + 33024);
        __syncthreads();
        for (int j = 0; j < 16; ++j) { const int idx = tid + NT * j, k = idx >> 7, c = idx & 127; At[k * 129 + c] = P.w_in[(size_t)l * (1024 * 1280) + (size_t)(k0 + k) * 1280 + 768 + 128 * g + c]; }
        for (int j = 0; j < 32; ++j) { const int idx = tid + NT * j; Pw[idx] = P.pool_w[(size_t)(l * 4 + g) * 16384 + idx]; }
        __syncthreads();
        const int n = tid & 127, ks = tid >> 7;
        float acc[16];
#pragma unroll
        for (int i = 0; i < 16; ++i) acc[i] = 0.f;
        for (int c = 0; c < 128; ++c) { const float pw = Pw[c * 128 + n];
#pragma unroll
            for (int i = 0; i < 16; ++i) acc[i] += At[(16 * ks + i) * 129 + c] * pw; }
        bf16* dst = (bf16*)(ws + WS_WIN) + (size_t)l * (1280 * 1024) + (size_t)(768 + 128 * g + n) * 1024 + k0 + 16 * ks;
        u32x4 o0, o1;
        o0.x = cvt_pk_bf16(acc[0], acc[1]); o0.y = cvt_pk_bf16(acc[2], acc[3]); o0.z = cvt_pk_bf16(acc[4], acc[5]); o0.w = cvt_pk_bf16(acc[6], acc[7]);
        o1.x = cvt_pk_bf16(acc[8], acc[9]); o1.y = cvt_pk_bf16(acc[10], acc[11]); o1.z = cvt_pk_bf16(acc[12], acc[13]); o1.w = cvt_pk_bf16(acc[14], acc[15]);
        *(u32x4*)dst = o0; *(u32x4*)(dst + 8) = o1;
    }
    {
        const double invf[8] = {1.0, 0.19392274474868576, 0.03760603093086393, 0.007292664737217109, 0.001414213562373095, 0.0002742481756762073, 5.318295896944988e-05, 1.031338537721246e-05};
        float* rope = (float*)(ws + WS_ROPE);
        for (int idx = bid * NT + tid; idx < NTOK * 8; idx += nblk * NT) {
            const int tok = idx >> 3, i = idx & 7;
            double f = 1.0;
#pragma unroll
            for (int q = 0; q < 8; ++q) f = (i == q) ? invf[q] : f;
            const double ang = (double)P.pos[tok] * f;
            const double kq = __builtin_rint(ang * 0.6366197723675814);
            const double r = (ang - kq * 1.5707963267948966) - kq * 6.123233995736766e-17;
            const double r2 = r * r;
            double sn = r * (1.0 + r2 * (-1.0 / 6 + r2 * (1.0 / 120 + r2 * (-1.0 / 5040 + r2 * (1.0 / 362880 + r2 * (-1.0 / 39916800 + r2 * (1.0 / 6227020800.0)))))));
            double cs = 1.0 + r2 * (-0.5 + r2 * (1.0 / 24 + r2 * (-1.0 / 720 + r2 * (1.0 / 40320 + r2 * (-1.0 / 3628800 + r2 * (1.0 / 479001600.0 + r2 * (-1.0 / 87178291200.0)))))));
            const int q = ((int)(long long)kq) & 3;
            double s2 = (q & 1) ? cs : sn, c2 = (q & 1) ? sn : cs;
            if (q == 1 || q == 2) c2 = -c2;
            if (q >= 2) s2 = -s2;
            rope[tok * 16 + i] = (float)c2; rope[tok * 16 + 8 + i] = (float)s2;
        }
    }
    {
        LAS float* tile = (LAS float*)lds;
        __syncthreads();
        f32x4 r[4];
        const float* src; int ldw, k0, n0; bf16* dst;
        int it = bid;
        if (it < N_TR_ITEMS) { tr_item_src(P, it, src, ldw, dst, k0, n0);
#pragma unroll
            for (int j = 0; j < 4; ++j) { const int idx = tid + NT * j, row = idx >> 4, c4 = idx & 15; r[j] = *(const f32x4*)(src + (size_t)(k0 + row) * ldw + n0 + 4 * c4); } }
        for (; it < N_TR_ITEMS; it += nblk) {
#pragma unroll
            for (int j = 0; j < 4; ++j) { const int idx = tid + NT * j, row = idx >> 4, c4 = idx & 15; LAS float* t = tile + row * 65 + 4 * c4; t[0] = r[j].x; t[1] = r[j].y; t[2] = r[j].z; t[3] = r[j].w; }
            __syncthreads();
            bf16* cdst = dst; const int ck0 = k0, cn0 = n0;
            if (it + nblk < N_TR_ITEMS) { tr_item_src(P, it + nblk, src, ldw, dst, k0, n0);
#pragma unroll
                for (int j = 0; j < 4; ++j) { const int idx = tid + NT * j, row = idx >> 4, c4 = idx & 15; r[j] = *(const f32x4*)(src + (size_t)(k0 + row) * ldw + n0 + 4 * c4); } }
#pragma unroll
            for (int j = 0; j < 2; ++j) { const int p = tid + NT * j, n = p >> 4, c = p & 15; const LAS float* t = tile + (8 * c) * 65 + n;
                u32x4 o; o.x = cvt_pk_bf16(t[0], t[65]); o.y = cvt_pk_bf16(t[2 * 65], t[3 * 65]); o.z = cvt_pk_bf16(t[4 * 65], t[5 * 65]); o.w = cvt_pk_bf16(t[6 * 65], t[7 * 65]);
                *(u32x4*)(cdst + (size_t)(cn0 + n) * 1024 + ck0 + 8 * c) = o; }
            __syncthreads();
        }
    }
}

template <int MODE>
__device__ __forceinline__ void norm1_phase(const Params& P, int l, int bid, int nblk) {
    const int tid = opaque_tid(), wid = __builtin_amdgcn_readfirstlane(tid >> 6), lane = tid & 63;
    unsigned char* ws = P.ws;
    const float* mod = (const float*)(ws + WS_MOD);
    const float* xin = (MODE == 0) ? P.x : P.out;
    bf16* H = (bf16*)(ws + WS_H);
    const float* gates = (const float*)(ws + WS_GATES);
    const bf16* Y = (const bf16*)(ws + WS_YBUF);
    for (int ch = bid * 8 + wid; ch < NTOK / 32; ch += nblk * 8) {
        const int b = (ch * 32) >> 13;
        f32x4 ca[4], cc[4], cg[4];
#pragma unroll
        for (int j = 0; j < 4; ++j) {
            const int col = 256 * j + 4 * lane;
            if (MODE <= 1) { const f32x4 g = *(const f32x4*)(P.n1g + l * D + col); const f32x4 sc = *(const f32x4*)(mod + (size_t)(l * NB + b) * NMOD + 1 * D + col);
                ca[j] = g * (1.0f + sc); cc[j] = *(const f32x4*)(mod + (size_t)(l * NB + b) * NMOD + 0 * D + col); }
            if (MODE >= 1) { const int lp = (MODE == 2) ? (DEPTH - 1) : (l - 1); cg[j] = *(const f32x4*)(mod + (size_t)(lp * NB + b) * NMOD + 5 * D + col); }
        }
        for (int rr = 0; rr < 32; ++rr) {
            const int row = ch * 32 + rr;
            f32x4 v[4];
#pragma unroll
            for (int j = 0; j < 4; ++j) v[j] = *(const f32x4*)(xin + (size_t)row * D + 256 * j + 4 * lane);
            if (MODE >= 1) {
                const f32x4 gt = *(const f32x4*)(gates + (size_t)row * 4);
                f32x4 a[4];
#pragma unroll
                for (int j = 0; j < 4; ++j) a[j] = (f32x4){0.f, 0.f, 0.f, 0.f};
#pragma unroll
                for (int k = 0; k < 4; ++k) {
                    const float gk = gt[k];
#pragma unroll
                    for (int j = 0; j < 4; ++j) { const u32x2 y = *(const u32x2*)(Y + ((size_t)row * 4 + k) * D + 256 * j + 4 * lane);
                        a[j].x += gk * bf_lo(y.x); a[j].y += gk * bf_hi(y.x); a[j].z += gk * bf_lo(y.y); a[j].w += gk * bf_hi(y.y); }
                }
#pragma unroll
                for (int j = 0; j < 4; ++j) { v[j] += cg[j] * a[j]; *(f32x4*)(P.out + (size_t)row * D + 256 * j + 4 * lane) = v[j]; }
            }
            if (MODE <= 1) {
                float ss = 0.f;
#pragma unroll
                for (int j = 0; j < 4; ++j) ss += (v[j].x * v[j].x + v[j].y * v[j].y) + (v[j].z * v[j].z + v[j].w * v[j].w);
                const float rstd = 1.0f / sqrtf(wave_sum(ss) * (1.0f / D) + EPS);
#pragma unroll
                for (int j = 0; j < 4; ++j) { const f32x4 h = v[j] * rstd * ca[j] + cc[j]; u32x2 o; o.x = cvt_pk_bf16(h.x, h.y); o.y = cvt_pk_bf16(h.z, h.w);
                    *(u32x2*)(H + (size_t)row * D + 256 * j + 4 * lane) = o; }
            }
        }
    }
}

struct Unit { int pm, pn, e, nrows, tbase; };
typedef f32x4 Acc[2][2][4][2];

template <class Pb>
__device__ __forceinline__ void gemm_simple(LAS unsigned char* lds, const Pb& pb, int bid, int nblk) {
    const int tid = opaque_tid(), wid = __builtin_amdgcn_readfirstlane(tid >> 6), lane = tid & 63, wr = wid >> 2, wc = wid & 3, fr = lane & 15, fq = lane >> 4;
    constexpr int PITCH = 144;
    LAS unsigned char* sA = lds; LAS unsigned char* sB = lds + 256 * PITCH;
    Unit u;
    for (int i = 0; pb.next(i, bid, nblk, u); ++i) {
        Acc acc;
#pragma unroll
        for (int a = 0; a < 2; ++a)
#pragma unroll
            for (int b = 0; b < 2; ++b)
#pragma unroll
                for (int m = 0; m < 4; ++m)
#pragma unroll
                    for (int n = 0; n < 2; ++n) acc[a][b][m][n] = (f32x4){0.f, 0.f, 0.f, 0.f};
        unsigned ao[4], bo[4];
#pragma unroll
        for (int j = 0; j < 4; ++j) { const int q = tid + NT * j, row = q >> 3, c8 = q & 7;
            ao[j] = (unsigned)pb.a_row(u, row) * (unsigned)(pb.K * 2) + c8 * 16; bo[j] = (unsigned)pb.b_row(u, row) * (unsigned)(pb.K * 2) + c8 * 16; }
        for (int kt = 0; kt < pb.K / 64; ++kt) {
            u32x4 ra[4], rb[4];
#pragma unroll
            for (int j = 0; j < 4; ++j) { ra[j] = *(const u32x4*)(pb.A + ao[j] + kt * 128); rb[j] = *(const u32x4*)(pb.B + bo[j] + kt * 128); }
            __syncthreads();
#pragma unroll
            for (int j = 0; j < 4; ++j) { const int q = tid + NT * j, row = q >> 3, c8 = q & 7; *(LAS u32x4*)(sA + row * PITCH + c8 * 16) = ra[j]; *(LAS u32x4*)(sB + row * PITCH + c8 * 16) = rb[j]; }
            __syncthreads();
#pragma unroll
            for (int kk = 0; kk < 2; ++kk) {
                bf16x8 bfr[2][2];
#pragma unroll
                for (int b = 0; b < 2; ++b)
#pragma unroll
                    for (int n = 0; n < 2; ++n) bfr[b][n] = *(const LAS bf16x8*)(sB + (128 * b + 32 * wc + 16 * n + fr) * PITCH + (kk * 32 + fq * 8) * 2);
#pragma unroll
                for (int a = 0; a < 2; ++a) {
                    bf16x8 af[4];
#pragma unroll
                    for (int m = 0; m < 4; ++m) af[m] = *(const LAS bf16x8*)(sA + (128 * a + 64 * wr + 16 * m + fr) * PITCH + (kk * 32 + fq * 8) * 2);
#pragma unroll
                    for (int b = 0; b < 2; ++b)
#pragma unroll
                        for (int m = 0; m < 4; ++m)
#pragma unroll
                            for (int n = 0; n < 2; ++n) acc[a][b][m][n] = __builtin_amdgcn_mfma_f32_16x16x32_bf16(bfr[b][n], af[m], acc[a][b][m][n], 0, 0, 0);
                }
            }
        }
        pb.epi(acc, u, wr, wc, fr, fq);
    }
    __syncthreads();
}

struct PbInProj {
    const char* A; const char* B; int K;
    bf16* proj; const float* qg; const float* kg; const float* rope;
    __device__ __forceinline__ bool next(int i, int bid, int nblk, Unit& u) const { const int L = i * nblk + bid; if (L >= 256 * 5) return false; u.pm = L / 5; u.pn = L % 5; u.e = 0; u.nrows = 256; u.tbase = 0; return true; }
    __device__ __forceinline__ int a_row(const Unit& u, int r) const { return 256 * u.pm + r; }
    __device__ __forceinline__ int b_row(const Unit& u, int rho) const { return 256 * u.pn + 64 * ((rho >> 5) & 3) + 32 * (rho >> 7) + perm32(rho & 31); }
    __device__ __forceinline__ void epi(const Acc& acc, const Unit& u, int wr, int wc, int fr, int fq) const {
        const int hg = 4 * u.pn + wc;
        const bool nrm = hg < 10;
        const float* gsrc = (hg < 8) ? qg : kg;
        f32x4 gv[2][2];
#pragma unroll
        for (int bj = 0; bj < 2; ++bj)
#pragma unroll
            for (int n = 0; n < 2; ++n) gv[bj][n] = nrm ? *(const f32x4*)(gsrc + 32 * bj + 8 * fq + 4 * n) : (f32x4){1.f, 1.f, 1.f, 1.f};
        const float qs = (hg < 8) ? QSCALE : 1.0f;
#pragma unroll
        for (int ai = 0; ai < 2; ++ai)
#pragma unroll
            for (int m = 0; m < 4; ++m) {
                const int row = 256 * u.pm + 128 * ai + 64 * wr + 16 * m + fr;
                f32x4 v[2][2];
#pragma unroll
                for (int bj = 0; bj < 2; ++bj)
#pragma unroll
                    for (int n = 0; n < 2; ++n) v[bj][n] = acc[ai][bj][m][n];
                if (nrm) {
                    float ss = 0.f;
#pragma unroll
                    for (int bj = 0; bj < 2; ++bj)
#pragma unroll
                        for (int n = 0; n < 2; ++n) ss += (v[bj][n].x * v[bj][n].x + v[bj][n].y * v[bj][n].y) + (v[bj][n].z * v[bj][n].z + v[bj][n].w * v[bj][n].w);
                    ss += __shfl_xor(ss, 16); ss += __shfl_xor(ss, 32);
                    const float rstd = 1.0f / sqrtf(ss * (1.0f / 64.0f) + EPS);
#pragma unroll
                    for (int bj = 0; bj < 2; ++bj)
#pragma unroll
                        for (int n = 0; n < 2; ++n) v[bj][n] = v[bj][n] * rstd * gv[bj][n];
#pragma unroll
                    for (int n = 0; n < 2; ++n) {
                        f32x4 pr;
                        pr.x = __shfl_xor(v[0][n].x, 16); pr.y = __shfl_xor(v[0][n].y, 16); pr.z = __shfl_xor(v[0][n].z, 16); pr.w = __shfl_xor(v[0][n].w, 16);
                        if (fq < 2) {
                            const f32x4 cs = *(const f32x4*)(rope + (size_t)row * 16 + 4 * n), sn = *(const f32x4*)(rope + (size_t)row * 16 + 8 + 4 * n);
                            v[0][n] = (fq == 0) ? (v[0][n] * cs - pr * sn) : (v[0][n] * cs + pr * sn);
                        }
                    }
                }
#pragma unroll
                for (int bj = 0; bj < 2; ++bj) {
                    u32x4 o; o.x = cvt_pk_bf16(v[bj][0].x * qs, v[bj][0].y * qs); o.y = cvt_pk_bf16(v[bj][0].z * qs, v[bj][0].w * qs);
                    o.z = cvt_pk_bf16(v[bj][1].x * qs, v[bj][1].y * qs); o.w = cvt_pk_bf16(v[bj][1].z * qs, v[bj][1].w * qs);
                    *(u32x4*)(proj + (size_t)row * NIN + 64 * hg + 32 * bj + 8 * fq) = o;
                }
            }
    }
};

struct PbOutProj {
    const char* A; const char* B; int K;
    const float* xin; float* xout; const float* gate1;
    __device__ __forceinline__ bool next(int i, int bid, int nblk, Unit& u) const { const int L = i * nblk + bid; if (L >= 256 * 4) return false; u.pm = L >> 2; u.pn = L & 3; u.e = 0; u.nrows = 256; u.tbase = 0; return true; }
    __device__ __forceinline__ int a_row(const Unit& u, int r) const { return 256 * u.pm + r; }
    __device__ __forceinline__ int b_row(const Unit& u, int rho) const { return 256 * u.pn + rho; }
    __device__ __forceinline__ void epi(const Acc& acc, const Unit& u, int wr, int wc, int fr, int fq) const {
        const int b = (256 * u.pm) >> 13;
        const int col0 = 256 * u.pn + 32 * wc + 4 * fq;
        f32x4 g[2][2];
#pragma unroll
        for (int bj = 0; bj < 2; ++bj)
#pragma unroll
            for (int n = 0; n < 2; ++n) g[bj][n] = *(const f32x4*)(gate1 + (size_t)b * NMOD + col0 + 128 * bj + 16 * n);
#pragma unroll
        for (int ai = 0; ai < 2; ++ai)
#pragma unroll
            for (int m = 0; m < 4; ++m) {
                const size_t off = (size_t)(256 * u.pm + 128 * ai + 64 * wr + 16 * m + fr) * D + col0;
#pragma unroll
                for (int bj = 0; bj < 2; ++bj)
#pragma unroll
                    for (int n = 0; n < 2; ++n) { const f32x4 xi = *(const f32x4*)(xin + off + 128 * bj + 16 * n); *(f32x4*)(xout + off + 128 * bj + 16 * n) = xi + g[bj][n] * acc[ai][bj][m][n]; }
            }
    }
};

struct MoeTab { const LAS int* cnt; const LAS int* tp; };
__device__ __forceinline__ void moe_build_tab(LAS int* tab, const unsigned* gcount) {
    if (threadIdx.x == 0) { int t = 0; for (int e = 0; e < NE; ++e) { const int c = (int)__hip_atomic_load(gcount + e * 64, __ATOMIC_RELAXED, __HIP_MEMORY_SCOPE_AGENT); tab[e] = c; tab[32 + e] = t; t += (c + 255) >> 8; } tab[64] = t; }
    __syncthreads();
}
__device__ __forceinline__ bool moe_unit(const LAS int* tab, int L, int ntn, Unit& u) {
    const int gt = L / ntn; if (gt >= tab[64]) return false;
    int e = 0;
    for (int q = 1; q < NE; ++q) e = (tab[32 + q] <= gt) ? q : e;
    u.e = e; u.pm = gt - tab[32 + e]; u.pn = L % ntn; u.tbase = gt * 256; const int rem = tab[e] - 256 * u.pm; u.nrows = rem < 256 ? rem : 256; return true;
}

struct PbGU {
    const char* A; const char* B; int K;
    const LAS int* tab; const int* list; const float* bgu; bf16* act;
    __device__ __forceinline__ bool next(int i, int bid, int nblk, Unit& u) const { return moe_unit(tab, i * nblk + bid, 8, u); }
    __device__ __forceinline__ int a_row(const Unit& u, int r) const { const int rr = r < u.nrows ? r : 0; return list[(size_t)u.e * NTOK + 256 * u.pm + rr] >> 2; }
    __device__ __forceinline__ int b_row(const Unit& u, int rho) const { const int i = rho & 127; return u.e * 2048 + ((rho >> 7) ? 1024 : 0) + 128 * u.pn + (i & ~31) + perm32(i & 31); }
    __device__ __forceinline__ void epi(const Acc& acc, const Unit& u, int wr, int wc, int fr, int fq) const {
        const int col0 = 128 * u.pn + 32 * wc + 8 * fq;
        f32x4 bg[2], bu[2];
#pragma unroll
        for (int n = 0; n < 2; ++n) { bg[n] = *(const f32x4*)(bgu + (size_t)u.e * 2048 + col0 + 4 * n); bu[n] = *(const f32x4*)(bgu + (size_t)u.e * 2048 + 1024 + col0 + 4 * n); }
#pragma unroll
        for (int ai = 0; ai < 2; ++ai)
#pragma unroll
            for (int m = 0; m < 4; ++m) {
                const int r = 128 * ai + 64 * wr + 16 * m + fr;
                float o[8];
#pragma unroll
                for (int n = 0; n < 2; ++n)
#pragma unroll
                    for (int j = 0; j < 4; ++j) {
                        float g = acc[ai][0][m][n][j] + bg[n][j], uu = acc[ai][1][m][n][j] + bu[n][j];
                        g = fminf(g, 7.0f); uu = fminf(fmaxf(uu, -7.0f), 7.0f);
                        const float sg = 1.0f / (1.0f + __builtin_amdgcn_exp2f(-1.702f * LOG2E * g));
                        o[4 * n + j] = g * sg * (uu + 1.0f);
                    }
                u32x4 w; w.x = cvt_pk_bf16(o[0], o[1]); w.y = cvt_pk_bf16(o[2], o[3]); w.z = cvt_pk_bf16(o[4], o[5]); w.w = cvt_pk_bf16(o[6], o[7]);
                *(u32x4*)(act + (size_t)(u.tbase + r) * 1024 + col0) = w;
            }
    }
};

struct PbDown {
    const char* A; const char* B; int K;
    const LAS int* tab; const int* list; const float* bdn; bf16* ybuf;
    __device__ __forceinline__ bool next(int i, int bid, int nblk, Unit& u) const { return moe_unit(tab, i * nblk + bid, 4, u); }
    __device__ __forceinline__ int a_row(const Unit& u, int r) const { return u.tbase + r; }
    __device__ __forceinline__ int b_row(const Unit& u, int rho) const { return u.e * 1024 + 256 * u.pn + (rho & ~31) + perm32(rho & 31); }
    __device__ __forceinline__ void epi(const Acc& acc, const Unit& u, int wr, int wc, int fr, int fq) const {
        const int col0 = 256 * u.pn + 32 * wc + 8 * fq;
        f32x4 bv[2][2];
#pragma unroll
        for (int bj = 0; bj < 2; ++bj)
#pragma unroll
            for (int n = 0; n < 2; ++n) bv[bj][n] = *(const f32x4*)(bdn + (size_t)u.e * 1024 + col0 + 128 * bj + 4 * n);
#pragma unroll
        for (int ai = 0; ai < 2; ++ai)
#pragma unroll
            for (int m = 0; m < 4; ++m) {
                const int r = 128 * ai + 64 * wr + 16 * m + fr;
                if (r < u.nrows) {
                    const int dest = list[(size_t)u.e * NTOK + 256 * u.pm + r];
#pragma unroll
                    for (int bj = 0; bj < 2; ++bj) {
                        const f32x4 v0 = acc[ai][bj][m][0] + bv[bj][0], v1 = acc[ai][bj][m][1] + bv[bj][1];
                        u32x4 w; w.x = cvt_pk_bf16(v0.x, v0.y); w.y = cvt_pk_bf16(v0.z, v0.w); w.z = cvt_pk_bf16(v1.x, v1.y); w.w = cvt_pk_bf16(v1.z, v1.w);
                        *(u32x4*)(ybuf + (size_t)dest * 1024 + col0 + 128 * bj) = w;
                    }
                }
            }
    }
};

__device__ __forceinline__ s16x4 lds_tr16(const LAS unsigned char* p) { return __builtin_bit_cast(s16x4, __builtin_amdgcn_ds_read_tr16_b64_v4i16((LAS s16x4*)p)); }

__device__ __forceinline__ void attn_phase(const Params& P, LAS unsigned char* lds, int l, int bid, int nblk) {
    const int tid = opaque_tid(), wid = __builtin_amdgcn_readfirstlane(tid >> 6), lane = tid & 63, r32 = lane & 31, hi = lane >> 5;
    unsigned char* ws = P.ws;
    const bf16* proj = (const bf16*)(ws + WS_PROJ);
    bf16* mix = (bf16*)(ws + WS_MIX);
    constexpr int KP = 144;
    LAS unsigned char* sK = lds; LAS unsigned char* sV = lds + 256 * KP;
    for (int unit = bid; unit < NB * 64 * 2; unit += nblk) {
        const int kvh = unit & 1, n = (unit >> 1) & 63, b = unit >> 7;
        const int tok0 = b * SEQ + n * 128 - 128;
        __syncthreads();
#pragma unroll
        for (int j = 0; j < 4; ++j) {
            const int q = tid + NT * j, key = q >> 3, c8 = q & 7;
            u32x4 kv = (u32x4){0u, 0u, 0u, 0u}, vv = (u32x4){0u, 0u, 0u, 0u};
            if (n > 0 || key >= 128) { const bf16* src = proj + (size_t)(tok0 + key) * NIN + 512 + kvh * 64 + c8 * 8; kv = *(const u32x4*)src; vv = *(const u32x4*)(src + 128); }
            *(LAS u32x4*)(sK + key * KP + c8 * 16) = kv; *(LAS u32x4*)(sV + key * KP + c8 * 16) = vv;
        }
        __syncthreads();
        const int hq = kvh * 4 + (wid >> 1);
        const float sink2 = P.sinks[l * 8 + hq] * LOG2E;
#pragma unroll 1
        for (int qt = 0; qt < 2; ++qt) {
            const int q0 = 64 * (wid & 1) + 32 * qt, qi = q0 + r32;
            const size_t qtok = (size_t)b * SEQ + n * 128 + qi;
            bf16x8 qf[4];
#pragma unroll
            for (int s = 0; s < 4; ++s) qf[s] = *(const bf16x8*)(proj + qtok * NIN + hq * 64 + 16 * s + 8 * hi);
            f32x16 st[5];
#pragma unroll
            for (int kt = 0; kt < 5; ++kt) {
#pragma unroll
                for (int r = 0; r < 16; ++r) st[kt][r] = 0.f;
#pragma unroll
                for (int s = 0; s < 4; ++s) { const bf16x8 kf = *(const LAS bf16x8*)(sK + (q0 + 32 * kt + r32) * KP + (16 * s + 8 * hi) * 2); st[kt] = __builtin_amdgcn_mfma_f32_32x32x16_bf16(kf, qf[s], st[kt], 0, 0, 0); }
            }
            float mx = sink2;
#pragma unroll
            for (int kt = 0; kt < 5; ++kt)
#pragma unroll
                for (int r = 0; r < 16; ++r) {
                    const int kj = q0 + 32 * kt + (r & 3) + 8 * (r >> 2) + 4 * hi;
                    const bool ok = (kj > qi) && (kj <= qi + 128) && (n > 0 || kj >= 128);
                    const float s = ok ? st[kt][r] : -__builtin_inff(); st[kt][r] = s; mx = fmaxf(mx, s);
                }
            mx = fmaxf(mx, __shfl_xor(mx, 32));
            float sum = 0.f;
#pragma unroll
            for (int kt = 0; kt < 5; ++kt)
#pragma unroll
                for (int r = 0; r < 16; ++r) { const float p = __builtin_amdgcn_exp2f(st[kt][r] - mx); st[kt][r] = p; sum += p; }
            sum += __shfl_xor(sum, 32);
            sum += __builtin_amdgcn_exp2f(sink2 - mx);
            f32x16 o[2];
#pragma unroll
            for (int dt = 0; dt < 2; ++dt)
#pragma unroll
                for (int r = 0; r < 16; ++r) o[dt][r] = 0.f;
#pragma unroll
            for (int kt = 0; kt < 5; ++kt)
#pragma unroll
                for (int s2 = 0; s2 < 2; ++s2) {
                    u32x4 pw; pw.x = cvt_pk_bf16(st[kt][8 * s2 + 0], st[kt][8 * s2 + 1]); pw.y = cvt_pk_bf16(st[kt][8 * s2 + 2], st[kt][8 * s2 + 3]);
                    pw.z = cvt_pk_bf16(st[kt][8 * s2 + 4], st[kt][8 * s2 + 5]); pw.w = cvt_pk_bf16(st[kt][8 * s2 + 6], st[kt][8 * s2 + 7]);
                    const bf16x8 pf = __builtin_bit_cast(bf16x8, pw);
                    const int kb = q0 + 32 * kt + 16 * s2 + 4 * hi, i16 = lane & 15;
#pragma unroll
                    for (int dt = 0; dt < 2; ++dt) {
                        const int d0 = 32 * dt + 16 * ((lane >> 4) & 1);
                        const LAS unsigned char* a0 = sV + (kb + (i16 >> 2)) * KP + (d0 + 4 * (i16 & 3)) * 2;
                        const s16x4 v0 = lds_tr16(a0), v1 = lds_tr16(a0 + 8 * KP);
                        bf16x8 vf; vf[0] = v0[0]; vf[1] = v0[1]; vf[2] = v0[2]; vf[3] = v0[3]; vf[4] = v1[0]; vf[5] = v1[1]; vf[6] = v1[2]; vf[7] = v1[3];
                        o[dt] = __builtin_amdgcn_mfma_f32_32x32x16_bf16(vf, pf, o[dt], 0, 0, 0);
                    }
                }
            const float inv = 1.0f / sum;
#pragma unroll
            for (int dt = 0; dt < 2; ++dt)
#pragma unroll
                for (int g4 = 0; g4 < 4; ++g4) {
                    u32x2 w; w.x = cvt_pk_bf16(o[dt][4 * g4 + 0] * inv, o[dt][4 * g4 + 1] * inv); w.y = cvt_pk_bf16(o[dt][4 * g4 + 2] * inv, o[dt][4 * g4 + 3] * inv);
                    *(u32x2*)(mix + qtok * D + hq * 64 + 32 * dt + 8 * g4 + 4 * hi) = w;
                }
        }
    }
    for (int ch = bid * 8 + wid; ch < NTOK / 32; ch += nblk * 8) {
        const int t0 = ch * 32, p0 = t0 & (SEQ - 1);
        const int col = 8 * lane, g = lane >> 4, w = 2 << g;
        float pb_[8], ps_[8];
#pragma unroll
        for (int i = 0; i < 8; i += 4) { const f32x4 a = *(const f32x4*)(P.pool_b + l * 512 + col + i), s = *(const f32x4*)(P.pool_s + l * 512 + col + i);
            pb_[i] = a.x; pb_[i + 1] = a.y; pb_[i + 2] = a.z; pb_[i + 3] = a.w; ps_[i] = s.x; ps_[i + 1] = s.y; ps_[i + 2] = s.z; ps_[i + 3] = s.w; }
        float sum[8];
#pragma unroll
        for (int i = 0; i < 8; ++i) sum[i] = 0.f;
        for (int j = 1; j < w; ++j) if (p0 - j >= 0) {
            const u32x4 z = *(const u32x4*)(proj + (size_t)(t0 - j) * NIN + 768 + col);
            sum[0] += bf_lo(z.x); sum[1] += bf_hi(z.x); sum[2] += bf_lo(z.y); sum[3] += bf_hi(z.y); sum[4] += bf_lo(z.z); sum[5] += bf_hi(z.z); sum[6] += bf_lo(z.w); sum[7] += bf_hi(z.w);
        }
        for (int t = 0; t < 32; ++t) {
            const u32x4 z = *(const u32x4*)(proj + (size_t)(t0 + t) * NIN + 768 + col);
            float zz[8] = {bf_lo(z.x), bf_hi(z.x), bf_lo(z.y), bf_hi(z.y), bf_lo(z.z), bf_hi(z.z), bf_lo(z.w), bf_hi(z.w)};
            const int pos = p0 + t; const float ic = 1.0f / (float)((pos + 1 < w) ? (pos + 1) : w);
            float o[8];
#pragma unroll
            for (int i = 0; i < 8; ++i) { sum[i] += zz[i]; o[i] = (sum[i] * ic - zz[i] + pb_[i]) * ps_[i]; }
            u32x4 ow; ow.x = cvt_pk_bf16(o[0], o[1]); ow.y = cvt_pk_bf16(o[2], o[3]); ow.z = cvt_pk_bf16(o[4], o[5]); ow.w = cvt_pk_bf16(o[6], o[7]);
            *(u32x4*)(mix + (size_t)(t0 + t) * D + 512 + col) = ow;
            if (pos - w + 1 >= 0) {
                const u32x4 y = *(const u32x4*)(proj + (size_t)(t0 + t - w + 1) * NIN + 768 + col);
                sum[0] -= bf_lo(y.x); sum[1] -= bf_hi(y.x); sum[2] -= bf_lo(y.y); sum[3] -= bf_hi(y.y); sum[4] -= bf_lo(y.z); sum[5] -= bf_hi(y.z); sum[6] -= bf_lo(y.w); sum[7] -= bf_hi(y.w);
            }
        }
    }
}

__device__ __forceinline__ void router_phase(const Params& P, LAS unsigned char* lds, int l, int bid, int nblk) {
    const int tid = opaque_tid(), wid = __builtin_amdgcn_readfirstlane(tid >> 6), lane = tid & 63, fr = lane & 15, fq = lane >> 4;
    unsigned char* ws = P.ws;
    const float* mod = (const float*)(ws + WS_MOD);
    bf16* H = (bf16*)(ws + WS_H);
    float* gates = (float*)(ws + WS_GATES);
    int* list = (int*)(ws + WS_LIST);
    unsigned* gcount = (unsigned*)(ws + WS_CTL) + CW_CNT + l * 32 * 64;
    constexpr int RP = 2064;
    LAS unsigned char* rwT = lds;
    LAS float* lg = (LAS float*)(lds + 66048);
    LAS int* lcnt = (LAS int*)(lds + 66048 + 33792);
    LAS int* lbase = lcnt + 32;
    LAS unsigned short* sel = (LAS unsigned short*)(lcnt + 64);
    LAS unsigned short* selr = sel + 1024;
    __syncthreads();
    for (int idx = tid; idx < 1024 * 32; idx += NT) { const int k = idx >> 5, e = idx & 31; const float v = P.rw[(size_t)l * 32768 + idx];
        *(LAS unsigned short*)(rwT + e * RP + k * 2) = (unsigned short)(cvt_pk_bf16(v, 0.f) & 0xffffu); }
    for (int tile = bid; tile < NTOK / 256; tile += nblk) {
        const int tok0 = tile * 256, b = tok0 >> 13;
        if (tid < 32) lcnt[tid] = 0;
        {
            f32x4 ca[4], cc[4];
#pragma unroll
            for (int j = 0; j < 4; ++j) { const int col = 256 * j + 4 * lane; const f32x4 g = *(const f32x4*)(P.n2g + l * D + col); const f32x4 sc = *(const f32x4*)(mod + (size_t)(l * NB + b) * NMOD + 4 * D + col);
                ca[j] = g * (1.0f + sc); cc[j] = *(const f32x4*)(mod + (size_t)(l * NB + b) * NMOD + 3 * D + col); }
            for (int rr = 0; rr < 32; ++rr) {
                const int row = tok0 + wid * 32 + rr;
                f32x4 v[4]; float ss = 0.f;
#pragma unroll
                for (int j = 0; j < 4; ++j) { v[j] = *(const f32x4*)(P.out + (size_t)row * D + 256 * j + 4 * lane); ss += (v[j].x * v[j].x + v[j].y * v[j].y) + (v[j].z * v[j].z + v[j].w * v[j].w); }
                const float rstd = 1.0f / sqrtf(wave_sum(ss) * (1.0f / D) + EPS);
#pragma unroll
                for (int j = 0; j < 4; ++j) { const f32x4 h = v[j] * rstd * ca[j] + cc[j]; u32x2 o; o.x = cvt_pk_bf16(h.x, h.y); o.y = cvt_pk_bf16(h.z, h.w); *(u32x2*)(H + (size_t)row * D + 256 * j + 4 * lane) = o; }
            }
        }
        asm volatile("s_waitcnt vmcnt(0)" ::: "memory");
        __syncthreads();
#pragma unroll 1
        for (int rg = 0; rg < 2; ++rg) {
            f32x4 a0 = (f32x4){0.f, 0.f, 0.f, 0.f}, a1 = a0;
            const bf16* hp = H + (size_t)(tok0 + 32 * wid + 16 * rg + fr) * D + 8 * fq;
            for (int s = 0; s < 32; ++s) {
                const bf16x8 af = *(const bf16x8*)(hp + 32 * s);
                const bf16x8 b0 = *(const LAS bf16x8*)(rwT + fr * RP + (32 * s + 8 * fq) * 2), b1 = *(const LAS bf16x8*)(rwT + (16 + fr) * RP + (32 * s + 8 * fq) * 2);
                a0 = __builtin_amdgcn_mfma_f32_16x16x32_bf16(af, b0, a0, 0, 0, 0); a1 = __builtin_amdgcn_mfma_f32_16x16x32_bf16(af, b1, a1, 0, 0, 0);
            }
            const float rb0 = P.rb[l * 32 + fr], rb1 = P.rb[l * 32 + 16 + fr];
#pragma unroll
            for (int r = 0; r < 4; ++r) { const int row = 32 * wid + 16 * rg + 4 * fq + r; lg[row * 33 + fr] = a0[r] + rb0; lg[row * 33 + 16 + fr] = a1[r] + rb1; }
        }
        __syncthreads();
        if (tid < 256) {
            float v[32];
#pragma unroll
            for (int e = 0; e < 32; ++e) v[e] = lg[tid * 33 + e];
            float tv[4]; int ti[4];
#pragma unroll
            for (int k = 0; k < 4; ++k) {
                float best = -__builtin_inff(); int bi = 0;
#pragma unroll
                for (int e = 0; e < 32; ++e) { const bool gt = v[e] > best; best = gt ? v[e] : best; bi = gt ? e : bi; }
                tv[k] = best; ti[k] = bi;
#pragma unroll
                for (int e = 0; e < 32; ++e) v[e] = (e == bi) ? -__builtin_inff() : v[e];
            }
            const float e1 = __expf(tv[1] - tv[0]), e2 = __expf(tv[2] - tv[0]), e3 = __expf(tv[3] - tv[0]);
            const float inv = 1.0f / (1.0f + e1 + e2 + e3);
            *(f32x4*)(gates + (size_t)(tok0 + tid) * 4) = (f32x4){inv, e1 * inv, e2 * inv, e3 * inv};
#pragma unroll
            for (int k = 0; k < 4; ++k) { const int r = __hip_atomic_fetch_add(lcnt + ti[k], 1, __ATOMIC_RELAXED, __HIP_MEMORY_SCOPE_WORKGROUP); sel[tid * 4 + k] = (unsigned short)ti[k]; selr[tid * 4 + k] = (unsigned short)r; }
        }
        __syncthreads();
        if (tid < 32) lbase[tid] = (int)__hip_atomic_fetch_add(gcount + tid * 64, (unsigned)lcnt[tid], __ATOMIC_RELAXED, __HIP_MEMORY_SCOPE_AGENT);
        __syncthreads();
        if (tid < 256) {
#pragma unroll
            for (int k = 0; k < 4; ++k) { const int e = sel[tid * 4 + k]; list[(size_t)e * NTOK + lbase[e] + selr[tid * 4 + k]] = (tok0 + tid) * 4 + k; }
        }
        __syncthreads();
    }
}

__device__ __forceinline__ void inproj_phase(const Params& P, LAS unsigned char* lds, int l, int bid, int nblk) {
    unsigned char* ws = P.ws;
    PbInProj pb; pb.A = (const char*)(ws + WS_H); pb.B = (const char*)(ws + WS_WIN) + (size_t)l * (1280 * 1024 * 2); pb.K = 1024;
    pb.proj = (bf16*)(ws + WS_PROJ); pb.qg = P.qg + l * 64; pb.kg = P.kg + l * 64; pb.rope = (const float*)(ws + WS_ROPE);
    gemm_simple(lds, pb, bid, nblk);
}
__device__ __forceinline__ void outproj_phase(const Params& P, LAS unsigned char* lds, int l, int bid, int nblk) {
    unsigned char* ws = P.ws;
    PbOutProj pb; pb.A = (const char*)(ws + WS_MIX); pb.B = (const char*)(ws + WS_WOUT) + (size_t)l * (1024 * 1024 * 2); pb.K = 1024;
    pb.xin = (l == 0) ? P.x : P.out; pb.xout = P.out; pb.gate1 = (const float*)(ws + WS_MOD) + (size_t)l * NB * NMOD + 2 * D;
    gemm_simple(lds, pb, bid, nblk);
}
__device__ __forceinline__ void gu_phase(const Params& P, LAS unsigned char* lds, int l, int bid, int nblk) {
    unsigned char* ws = P.ws;
    LAS int* tab = (LAS int*)(lds + 131072);
    __syncthreads();
    moe_build_tab(tab, (const unsigned*)(ws + WS_CTL) + CW_CNT + l * 32 * 64);
    PbGU pb; pb.A = (const char*)(ws + WS_H); pb.B = (const char*)(ws + WS_WGU) + (size_t)l * 32 * (2048 * 1024 * 2); pb.K = 1024;
    pb.tab = tab; pb.list = (const int*)(ws + WS_LIST); pb.bgu = P.bgu + (size_t)l * 32 * 2048; pb.act = (bf16*)(ws + WS_ACT);
    gemm_simple(lds, pb, bid, nblk);
}
__device__ __forceinline__ void down_phase(const Params& P, LAS unsigned char* lds, int l, int bid, int nblk) {
    unsigned char* ws = P.ws;
    LAS int* tab = (LAS int*)(lds + 131072);
    __syncthreads();
    moe_build_tab(tab, (const unsigned*)(ws + WS_CTL) + CW_CNT + l * 32 * 64);
    PbDown pb; pb.A = (const char*)(ws + WS_ACT); pb.B = (const char*)(ws + WS_WDN) + (size_t)l * 32 * (1024 * 1024 * 2); pb.K = 1024;
    pb.tab = tab; pb.list = (const int*)(ws + WS_LIST); pb.bdn = P.bdn + (size_t)l * 32 * 1024; pb.ybuf = (bf16*)(ws + WS_YBUF);
    gemm_simple(lds, pb, bid, nblk);
}

#define XB_TMO      128
#define XB_XCNT(j)  (256  + 64 * (j))
#define XB_XSUB(j)  (1280 + 64 * (j))
#define XB_XGEN(j)  (2304 + 64 * (j))
#define XB_TOP      3328
#define XB_TOPGEN   3392
#define XCD_BAR_WORDS 3456
#define XB_SPIN_CAP (1u << 18)
__device__ __forceinline__ unsigned xb_ld(unsigned* p)              { return __hip_atomic_load(p, __ATOMIC_RELAXED, __HIP_MEMORY_SCOPE_AGENT); }
__device__ __forceinline__ unsigned xb_add(unsigned* p, unsigned v) { return __hip_atomic_fetch_add(p, v, __ATOMIC_RELAXED, __HIP_MEMORY_SCOPE_AGENT); }
__device__ __forceinline__ unsigned xb_xcc_id() { return (unsigned)__builtin_amdgcn_s_getreg((3 << 11) | 20) & 0xFu; }
#define XB_SPIN(cond, bar) do { unsigned _sp = 0; while (cond) { __builtin_amdgcn_s_sleep(1); \
    if ((++_sp & 255u) == 0u) { if (xb_ld(&(bar)[XB_TMO])) break; if (_sp > XB_SPIN_CAP) { atomicAdd(&(bar)[XB_TMO], 1u); break; } } } } while (0)
struct XcdBarrier { unsigned* bar; unsigned x; volatile LAS unsigned* st; };
__device__ __forceinline__ XcdBarrier xcd_barrier_post(unsigned* bar, volatile LAS unsigned* st) {
    XcdBarrier b; b.bar = bar; b.x = xb_xcc_id(); b.st = st;
    if (threadIdx.x == 0) (void)xb_add(&bar[XB_XCNT(b.x)], 1u);
    return b;
}
__device__ __forceinline__ void xcd_barrier_complete(unsigned* bar, unsigned x, unsigned& nloc, unsigned& nx) {
    const unsigned G = gridDim.x * gridDim.y * gridDim.z;
    unsigned sum, cnt, mine, sp = 0u;
    for (;;) {
        sum = 0u; cnt = 0u; mine = 0u;
#pragma unroll
        for (unsigned j = 0; j < 16; ++j) { const unsigned c = xb_ld(&bar[XB_XCNT(j)]); sum += c; cnt += (c > 0u) ? 1u : 0u; mine = (j == x) ? c : mine; }
        if (sum == G) break;
        __builtin_amdgcn_s_sleep(1);
        if ((++sp & 255u) == 0u) { if (xb_ld(&bar[XB_TMO])) break; if (sp > XB_SPIN_CAP) { atomicAdd(&bar[XB_TMO], 1u); break; } }
    }
    nloc = mine > 0u ? mine : 1u; nx = cnt > 0u ? cnt : 1u;
}
__device__ __forceinline__ void xcd_barrier(const XcdBarrier& b) {
    asm volatile("s_waitcnt vmcnt(0)" ::: "memory");
    __syncthreads();
    if (threadIdx.x == 0) {
        unsigned* bar = b.bar; const unsigned bx = xb_xcc_id();
        __builtin_amdgcn_s_waitcnt(0);
        unsigned nloc = b.st[0], nx = b.st[1];
        if (nloc == 0u) { xcd_barrier_complete(bar, bx, nloc, nx); b.st[0] = nloc; b.st[1] = nx; }
        const unsigned old = xb_add(&bar[XB_XSUB(bx)], 1u);
        const unsigned gen = old / nloc;
        if (old + 1u == (gen + 1u) * nloc) {
            __builtin_amdgcn_fence(__ATOMIC_RELEASE, "agent");
            asm volatile("s_waitcnt vmcnt(0)" ::: "memory");
            const unsigned og = xb_add(&bar[XB_TOP], 1u);
            const unsigned tg = og / nx;
            if (og + 1u == (tg + 1u) * nx) xb_add(&bar[XB_TOPGEN], 1u);
            else XB_SPIN(xb_ld(&bar[XB_TOPGEN]) == tg, bar);
            __builtin_amdgcn_fence(__ATOMIC_ACQUIRE, "agent");
            xb_add(&bar[XB_XGEN(bx)], 1u);
            asm volatile("s_waitcnt vmcnt(0)" ::: "memory");
        } else {
            XB_SPIN(xb_ld(&bar[XB_XGEN(bx)]) == gen, bar);
            __builtin_amdgcn_fence(__ATOMIC_ACQUIRE, "agent");
            asm volatile("s_waitcnt vmcnt(0)" ::: "memory");
        }
    }
    __syncthreads();
}


#if ONE_LAUNCH
constexpr int TAB_OFF = 131072, MISC_OFF = 131072 + 512;
__global__ void __launch_bounds__(NT, 2) mega_fwd(Params P) {
    extern __shared__ __attribute__((aligned(16))) unsigned char dyn_lds[];
    LAS unsigned char* lds = (LAS unsigned char*)dyn_lds;
    volatile LAS unsigned* MISC = (volatile LAS unsigned*)(lds + MISC_OFF);
    if (threadIdx.x < 32) MISC[threadIdx.x] = 0u;
    __syncthreads();
    XcdBarrier bar = xcd_barrier_post((unsigned*)(P.ws + WS_CTL) + CW_BAR, MISC + 8);
    const int bid = blockIdx.x, nblk = gridDim.x;
    p0_prologue(P, lds, bid, nblk);
    xcd_barrier(bar);
    for (int l = 0; l < DEPTH; ++l) {
        if (l == 0) norm1_phase<0>(P, l, bid, nblk); else norm1_phase<1>(P, l, bid, nblk);
        xcd_barrier(bar);
        inproj_phase(P, lds, l, bid, nblk);
        xcd_barrier(bar);
        attn_phase(P, lds, l, bid, nblk);
        xcd_barrier(bar);
        outproj_phase(P, lds, l, bid, nblk);
        xcd_barrier(bar);
        router_phase(P, lds, l, bid, nblk);
        xcd_barrier(bar);
        gu_phase(P, lds, l, bid, nblk);
        xcd_barrier(bar);
        down_phase(P, lds, l, bid, nblk);
        xcd_barrier(bar);
    }
    norm1_phase<2>(P, 0, bid, nblk);
}
#else
extern __shared__ __attribute__((aligned(16))) unsigned char dyn_lds[];
#define KLDS ((LAS unsigned char*)dyn_lds)
__global__ void __launch_bounds__(NT, 2) k_prologue(Params P) { p0_prologue(P, KLDS, blockIdx.x, gridDim.x); }
__global__ void __launch_bounds__(NT, 2) k_norm1_0(Params P, int l) { norm1_phase<0>(P, l, blockIdx.x, gridDim.x); }
__global__ void __launch_bounds__(NT, 2) k_norm1_1(Params P, int l) { norm1_phase<1>(P, l, blockIdx.x, gridDim.x); }
__global__ void __launch_bounds__(NT, 2) k_final(Params P) { norm1_phase<2>(P, 0, blockIdx.x, gridDim.x); }
__global__ void __launch_bounds__(NT, 2) k_inproj(Params P, int l) { inproj_phase(P, KLDS, l, blockIdx.x, gridDim.x); }
__global__ void __launch_bounds__(NT, 2) k_attn(Params P, int l) { attn_phase(P, KLDS, l, blockIdx.x, gridDim.x); }
__global__ void __launch_bounds__(NT, 2) k_outproj(Params P, int l) { outproj_phase(P, KLDS, l, blockIdx.x, gridDim.x); }
__global__ void __launch_bounds__(NT, 2) k_router(Params P, int l) { router_phase(P, KLDS, l, blockIdx.x, gridDim.x); }
__global__ void __launch_bounds__(NT, 2) k_gu(Params P, int l) { gu_phase(P, KLDS, l, blockIdx.x, gridDim.x); }
__global__ void __launch_bounds__(NT, 2) k_down(Params P, int l) { down_phase(P, KLDS, l, blockIdx.x, gridDim.x); }

#endif

extern "C" void kernel_launch(void* const* d_in, const int* in_sizes, int n_in, void* d_out, int out_size, void* d_ws, size_t ws_size, hipStream_t stream) {
    static int ready = 0;
    if (ready == 0) {
        if (n_in != 21 || out_size != NTOK * D || ws_size < WS_END) { fprintf(stderr, "kernel_launch: unexpected shapes (n_in %d out %d ws %zu)\n", n_in, out_size, ws_size); ready = -1; return; }
#if ONE_LAUNCH
        const void* ks[] = {(const void*)mega_fwd};
#else
        const void* ks[] = {(const void*)k_prologue, (const void*)k_norm1_0, (const void*)k_norm1_1, (const void*)k_final, (const void*)k_inproj, (const void*)k_attn, (const void*)k_outproj, (const void*)k_router, (const void*)k_gu, (const void*)k_down};
#endif
        for (auto k : ks) if (hipFuncSetAttribute(k, hipFuncAttributeMaxDynamicSharedMemorySize, LDS_BYTES) != hipSuccess) { fprintf(stderr, "kernel_launch: hipFuncSetAttribute failed\n"); ready = -1; return; }
        ready = 1;
    }
    if (ready < 0) return;
    (void)hipMemsetAsync((char*)d_ws + WS_CTL, 0, CTL_ZERO_BYTES, stream);
    Params P{};
    P.x = (const float*)d_in[0]; P.c = (const float*)d_in[1]; P.pos = (const int*)d_in[2]; P.ada_w = (const float*)d_in[3]; P.ada_b = (const float*)d_in[4]; P.n1g = (const float*)d_in[5];
    P.w_in = (const float*)d_in[6]; P.qg = (const float*)d_in[7]; P.kg = (const float*)d_in[8]; P.sinks = (const float*)d_in[9]; P.pool_w = (const float*)d_in[10]; P.pool_b = (const float*)d_in[11];
    P.pool_s = (const float*)d_in[12]; P.w_out = (const float*)d_in[13]; P.n2g = (const float*)d_in[14]; P.rw = (const float*)d_in[15]; P.rb = (const float*)d_in[16]; P.wgu = (const float*)d_in[17];
    P.bgu = (const float*)d_in[18]; P.wdn = (const float*)d_in[19]; P.bdn = (const float*)d_in[20]; P.out = (float*)d_out; P.ws = (unsigned char*)d_ws;
    const dim3 g(256), b(NT);
#if ONE_LAUNCH
    hipLaunchKernelGGL(mega_fwd, g, b, LDS_BYTES, stream, P);
#else
    hipLaunchKernelGGL(k_prologue, g, b, LDS_BYTES, stream, P);
    for (int l = 0; l < DEPTH; ++l) {
        if (l == 0) hipLaunchKernelGGL(k_norm1_0, g, b, LDS_BYTES, stream, P, l); else hipLaunchKernelGGL(k_norm1_1, g, b, LDS_BYTES, stream, P, l);
        hipLaunchKernelGGL(k_inproj, g, b, LDS_BYTES, stream, P, l);
        hipLaunchKernelGGL(k_attn, g, b, LDS_BYTES, stream, P, l);
        hipLaunchKernelGGL(k_outproj, g, b, LDS_BYTES, stream, P, l);
        hipLaunchKernelGGL(k_router, g, b, LDS_BYTES, stream, P, l);
        hipLaunchKernelGGL(k_gu, g, b, LDS_BYTES, stream, P, l);
        hipLaunchKernelGGL(k_down, g, b, LDS_BYTES, stream, P, l);
    }
    hipLaunchKernelGGL(k_final, g, b, LDS_BYTES, stream, P);
#endif
}
```

```cpp
#include <hip/hip_runtime.h>
#include <cstdio>
#include <cstdint>

#ifndef ONE_LAUNCH
#define ONE_LAUNCH 1
#endif

#define LAS __attribute__((address_space(3)))
typedef unsigned short bf16;
typedef short bf16x8 __attribute__((ext_vector_type(8)));
typedef short s16x4 __attribute__((ext_vector_type(4)));
typedef float f32x4 __attribute__((ext_vector_type(4)));
typedef float f32x16 __attribute__((ext_vector_type(16)));
typedef unsigned u32x4 __attribute__((ext_vector_type(4)));
typedef unsigned u32x2 __attribute__((ext_vector_type(2)));

constexpr int D = 1024, NB = 8, SEQ = 8192, NTOK = NB * SEQ, DEPTH = 2, NE = 32, NIN = 1280, NMOD = 6 * D;
constexpr int NT = 512;
constexpr float EPS = 1e-6f;
constexpr float LOG2E = 1.4426950408889634f;
constexpr float QSCALE = 0.18033688011112042f;
constexpr int MAXTILES = NTOK * 4 / 256 + NE;

constexpr size_t MiB = 1u << 20;
constexpr size_t WS_CTL = 0, CTL_ZERO_BYTES = 1 * MiB;
constexpr size_t WS_MOD = 1 * MiB;
constexpr size_t WS_ROPE = 2 * MiB;
constexpr size_t WS_WIN = 8 * MiB;
constexpr size_t WS_WOUT = 16 * MiB;
constexpr size_t WS_GATES = 20 * MiB;
constexpr size_t WS_LIST = 24 * MiB;
constexpr size_t WS_WGU = 32 * MiB;
constexpr size_t WS_WDN = 288 * MiB;
constexpr size_t WS_H = 416 * MiB;
constexpr size_t WS_PROJ = 544 * MiB;
constexpr size_t WS_MIX = 704 * MiB;
constexpr size_t WS_ACT = 544 * MiB;
constexpr size_t WS_YBUF = 1072 * MiB;
constexpr size_t WS_END = 1584 * MiB;
static_assert(WS_ACT + (size_t)MAXTILES * 256 * 1024 * 2 <= WS_YBUF, "act fits");
constexpr int CW_BAR = 4096;
constexpr int CW_CNT = 8192;

constexpr int LDS_BYTES = 147456;

struct Params {
    const float *x, *c; const int* pos; const float *ada_w, *ada_b, *n1g, *w_in, *qg, *kg, *sinks, *pool_w, *pool_b, *pool_s, *w_out, *n2g, *rw, *rb, *wgu, *bgu, *wdn, *bdn;
    float* out; unsigned char* ws;
};

__device__ __forceinline__ unsigned cvt_pk_bf16(float lo, float hi) { unsigned r; asm("v_cvt_pk_bf16_f32 %0, %1, %2" : "=v"(r) : "v"(lo), "v"(hi)); return r; }
__device__ __forceinline__ float bf_lo(unsigned w) { return __uint_as_float(w << 16); }
__device__ __forceinline__ float bf_hi(unsigned w) { return __uint_as_float(w & 0xffff0000u); }
template <int M> __device__ __forceinline__ float swz_xor(float v) { return __int_as_float(__builtin_amdgcn_ds_swizzle(__float_as_int(v), (M << 10) | 0x1f)); }
__device__ __forceinline__ float sum_x32(float v) { const auto r = __builtin_amdgcn_permlane32_swap(__float_as_uint(v), __float_as_uint(v), false, false); return __uint_as_float(r[0]) + __uint_as_float(r[1]); }
__device__ __forceinline__ float max_x32(float v) { const auto r = __builtin_amdgcn_permlane32_swap(__float_as_uint(v), __float_as_uint(v), false, false); return fmaxf(__uint_as_float(r[0]), __uint_as_float(r[1])); }
__device__ __forceinline__ float wave_sum(float v) {
    v += swz_xor<1>(v); v += swz_xor<2>(v); v += swz_xor<4>(v); v += swz_xor<8>(v); v += swz_xor<16>(v);
    return sum_x32(v);
}
__device__ __forceinline__ int perm32(int rho) { const int n = rho >> 4, i = rho & 15; return 8 * (i >> 2) + 4 * n + (i & 3); }
__device__ __forceinline__ int opaque_tid() { int t = threadIdx.x; asm volatile("" : "+v"(t)); return t; }

__device__ __forceinline__ void tr_item_src(const Params& P, int it, const float*& src, int& ldw, bf16*& dst, int& k0, int& n0) {
    unsigned char* ws = P.ws;
    if (it < 16384) { const int m = it >> 8, r = it & 255; src = P.wgu + (size_t)m * (1024 * 2048); ldw = 2048; dst = (bf16*)(ws + WS_WGU) + (size_t)m * (2048 * 1024); k0 = 128 * (r >> 5); n0 = 64 * (r & 31); return; }
    it -= 16384;
    if (it < 8192) { const int m = it >> 7, r = it & 127; src = P.wdn + (size_t)m * (1024 * 1024); ldw = 1024; dst = (bf16*)(ws + WS_WDN) + (size_t)m * (1024 * 1024); k0 = 128 * (r >> 4); n0 = 64 * (r & 15); return; }
    it -= 8192;
    if (it < 192) { const int l = it / 96, r = it % 96; src = P.w_in + (size_t)l * (1024 * 1280); ldw = 1280; dst = (bf16*)(ws + WS_WIN) + (size_t)l * (1280 * 1024); k0 = 128 * (r / 12); n0 = 64 * (r % 12); return; }
    it -= 192;
    { const int l = it >> 7, r = it & 127; src = P.w_out + (size_t)l * (1024 * 1024); ldw = 1024; dst = (bf16*)(ws + WS_WOUT) + (size_t)l * (1024 * 1024); k0 = 128 * (r >> 4); n0 = 64 * (r & 15); }
}
constexpr int N_TR_ITEMS = 16384 + 8192 + 192 + 256;

__device__ __forceinline__ void p0_prologue(const Params& P, LAS unsigned char* lds, int bid, int nblk) {
    const int tid = opaque_tid(), wid = __builtin_amdgcn_readfirstlane(tid >> 6), lane = tid & 63;
    unsigned char* ws = P.ws;
    {
        LAS float* cact = (LAS float*)lds;
        LAS float* red = (LAS float*)(lds + 32768);
        if (bid < 192 || nblk < 192) {
            for (int i = tid; i < NB * D; i += NT) { const float v = P.c[i]; cact[i] = v / (1.0f + __expf(-v)); }
            __syncthreads();
            for (int it = bid; it < 192; it += nblk) {
                const int l = it / 96, n0 = 64 * (it % 96);
                float acc[NB];
#pragma unroll
                for (int b = 0; b < NB; ++b) acc[b] = 0.f;
                const float* wp = P.ada_w + (size_t)l * D * NMOD + n0 + lane;
                for (int k = 128 * wid; k < 128 * wid + 128; k += 16) {
                    float wv[16];
#pragma unroll
                    for (int q = 0; q < 16; ++q) wv[q] = wp[(size_t)(k + q) * NMOD];
#pragma unroll
                    for (int q = 0; q < 16; ++q)
#pragma unroll
                        for (int b = 0; b < NB; ++b) acc[b] += cact[b * D + k + q] * wv[q];
                }
#pragma unroll
                for (int b = 0; b < NB; ++b) red[(wid * NB + b) * 64 + lane] = acc[b];
                __syncthreads();
                { const int b = tid >> 6; float s = P.ada_b[l * NMOD + n0 + lane];
#pragma unroll
                  for (int w = 0; w < 8; ++w) s += red[(w * NB + b) * 64 + lane];
                  ((float*)(ws + WS_MOD))[(size_t)(l * NB + b) * NMOD + n0 + lane] = s; }
                __syncthreads();
            }
        }
    }
    for (int it = bid; it < 128; it += nblk) {
        const int l = it >> 6, g = (it >> 4) & 3, k0 = 64 * (it & 15);
        LAS float* At = (LAS float*)lds;
        LAS float* Pw = (LAS float*)(lds + 33024);
        __syncthreads();
        for (int j = 0; j < 16; ++j) { const int idx = tid + NT * j, k = idx >> 7, c = idx & 127; At[k * 129 + c] = P.w_in[(size_t)l * (1024 * 1280) + (size_t)(k0 + k) * 1280 + 768 + 128 * g + c]; }
        for (int j = 0; j < 32; ++j) { const int idx = tid + NT * j; Pw[idx] = P.pool_w[(size_t)(l * 4 + g) * 16384 + idx]; }
        __syncthreads();
        const int n = tid & 127, ks = tid >> 7;
        float acc[16];
#pragma unroll
        for (int i = 0; i < 16; ++i) acc[i] = 0.f;
        for (int c = 0; c < 128; ++c) { const float pw = Pw[c * 128 + n];
#pragma unroll
            for (int i = 0; i < 16; ++i) acc[i] += At[(16 * ks + i) * 129 + c] * pw; }
        bf16* dst = (bf16*)(ws + WS_WIN) + (size_t)l * (1280 * 1024) + (size_t)(768 + 128 * g + n) * 1024 + k0 + 16 * ks;
        u32x4 o0, o1;
        o0.x = cvt_pk_bf16(acc[0], acc[1]); o0.y = cvt_pk_bf16(acc[2], acc[3]); o0.z = cvt_pk_bf16(acc[4], acc[5]); o0.w = cvt_pk_bf16(acc[6], acc[7]);
        o1.x = cvt_pk_bf16(acc[8], acc[9]); o1.y = cvt_pk_bf16(acc[10], acc[11]); o1.z = cvt_pk_bf16(acc[12], acc[13]); o1.w = cvt_pk_bf16(acc[14], acc[15]);
        *(u32x4*)dst = o0; *(u32x4*)(dst + 8) = o1;
    }
    {
        const double invf[8] = {1.0, 0.19392274474868576, 0.03760603093086393, 0.007292664737217109, 0.001414213562373095, 0.0002742481756762073, 5.318295896944988e-05, 1.031338537721246e-05};
        float* rope = (float*)(ws + WS_ROPE);
        for (int idx = bid * NT + tid; idx < NTOK * 8; idx += nblk * NT) {
            const int tok = idx >> 3, i = idx & 7;
            double f = 1.0;
#pragma unroll
            for (int q = 0; q < 8; ++q) f = (i == q) ? invf[q] : f;
            const double ang = (double)P.pos[tok] * f;
            const double kq = __builtin_rint(ang * 0.6366197723675814);
            const double r = (ang - kq * 1.5707963267948966) - kq * 6.123233995736766e-17;
            const double r2 = r * r;
            double sn = r * (1.0 + r2 * (-1.0 / 6 + r2 * (1.0 / 120 + r2 * (-1.0 / 5040 + r2 * (1.0 / 362880 + r2 * (-1.0 / 39916800 + r2 * (1.0 / 6227020800.0)))))));
            double cs = 1.0 + r2 * (-0.5 + r2 * (1.0 / 24 + r2 * (-1.0 / 720 + r2 * (1.0 / 40320 + r2 * (-1.0 / 3628800 + r2 * (1.0 / 479001600.0 + r2 * (-1.0 / 87178291200.0)))))));
            const int q = ((int)(long long)kq) & 3;
            double s2 = (q & 1) ? cs : sn, c2 = (q & 1) ? sn : cs;
            if (q == 1 || q == 2) c2 = -c2;
            if (q >= 2) s2 = -s2;
            rope[tok * 16 + i] = (float)c2; rope[tok * 16 + 8 + i] = (float)s2;
        }
    }
    {
        LAS float* tile = (LAS float*)lds;
        __syncthreads();
        f32x4 r[4];
        const float* src; int ldw, k0, n0; bf16* dst;
        int it = bid;
        if (it < N_TR_ITEMS) { tr_item_src(P, it, src, ldw, dst, k0, n0);
#pragma unroll
            for (int j = 0; j < 4; ++j) { const int idx = tid + NT * j, row = idx >> 4, c4 = idx & 15; r[j] = *(const f32x4*)(src + (size_t)(k0 + row) * ldw + n0 + 4 * c4); } }
        for (; it < N_TR_ITEMS; it += nblk) {
#pragma unroll
            for (int j = 0; j < 4; ++j) { const int idx = tid + NT * j, row = idx >> 4, c4 = idx & 15; LAS float* t = tile + row * 65 + 4 * c4; t[0] = r[j].x; t[1] = r[j].y; t[2] = r[j].z; t[3] = r[j].w; }
            __syncthreads();
            bf16* cdst = dst; const int ck0 = k0, cn0 = n0;
            if (it + nblk < N_TR_ITEMS) { tr_item_src(P, it + nblk, src, ldw, dst, k0, n0);
#pragma unroll
                for (int j = 0; j < 4; ++j) { const int idx = tid + NT * j, row = idx >> 4, c4 = idx & 15; r[j] = *(const f32x4*)(src + (size_t)(k0 + row) * ldw + n0 + 4 * c4); } }
#pragma unroll
            for (int j = 0; j < 2; ++j) { const int p = tid + NT * j, n = p >> 4, c = p & 15; const LAS float* t = tile + (8 * c) * 65 + n;
                u32x4 o; o.x = cvt_pk_bf16(t[0], t[65]); o.y = cvt_pk_bf16(t[2 * 65], t[3 * 65]); o.z = cvt_pk_bf16(t[4 * 65], t[5 * 65]); o.w = cvt_pk_bf16(t[6 * 65], t[7 * 65]);
                *(u32x4*)(cdst + (size_t)(cn0 + n) * 1024 + ck0 + 8 * c) = o; }
            __syncthreads();
        }
    }
}

template <int MODE>
__device__ __forceinline__ void norm1_phase(const Params& P, int l, int bid, int nblk) {
    const int tid = opaque_tid(), wid = __builtin_amdgcn_readfirstlane(tid >> 6), lane = tid & 63;
    unsigned char* ws = P.ws;
    const float* mod = (const float*)(ws + WS_MOD);
    const float* xin = (MODE == 0) ? P.x : P.out;
    bf16* H = (bf16*)(ws + WS_H);
    const float* gates = (const float*)(ws + WS_GATES);
    const bf16* Y = (const bf16*)(ws + WS_YBUF);
    for (int ch = bid * 8 + wid; ch < NTOK / 32; ch += nblk * 8) {
        const int b = (ch * 32) >> 13;
        f32x4 ca[4], cc[4], cg[4];
#pragma unroll
        for (int j = 0; j < 4; ++j) {
            const int col = 256 * j + 4 * lane;
            if (MODE <= 1) { const f32x4 g = *(const f32x4*)(P.n1g + l * D + col); const f32x4 sc = *(const f32x4*)(mod + (size_t)(l * NB + b) * NMOD + 1 * D + col);
                ca[j] = g * (1.0f + sc); cc[j] = *(const f32x4*)(mod + (size_t)(l * NB + b) * NMOD + 0 * D + col); }
            if (MODE >= 1) { const int lp = (MODE == 2) ? (DEPTH - 1) : (l - 1); cg[j] = *(const f32x4*)(mod + (size_t)(lp * NB + b) * NMOD + 5 * D + col); }
        }
        for (int rr = 0; rr < 32; ++rr) {
            const int row = ch * 32 + rr;
            f32x4 v[4];
#pragma unroll
            for (int j = 0; j < 4; ++j) v[j] = *(const f32x4*)(xin + (size_t)row * D + 256 * j + 4 * lane);
            if (MODE >= 1) {
                const f32x4 gt = *(const f32x4*)(gates + (size_t)row * 4);
                f32x4 a[4];
#pragma unroll
                for (int j = 0; j < 4; ++j) a[j] = (f32x4){0.f, 0.f, 0.f, 0.f};
#pragma unroll
                for (int k = 0; k < 4; ++k) {
                    const float gk = gt[k];
#pragma unroll
                    for (int j = 0; j < 4; ++j) { const u32x2 y = *(const u32x2*)(Y + ((size_t)row * 4 + k) * D + 256 * j + 4 * lane);
                        a[j].x += gk * bf_lo(y.x); a[j].y += gk * bf_hi(y.x); a[j].z += gk * bf_lo(y.y); a[j].w += gk * bf_hi(y.y); }
                }
#pragma unroll
                for (int j = 0; j < 4; ++j) { v[j] += cg[j] * a[j]; *(f32x4*)(P.out + (size_t)row * D + 256 * j + 4 * lane) = v[j]; }
            }
            if (MODE <= 1) {
                float ss = 0.f;
#pragma unroll
                for (int j = 0; j < 4; ++j) ss += (v[j].x * v[j].x + v[j].y * v[j].y) + (v[j].z * v[j].z + v[j].w * v[j].w);
                const float rstd = 1.0f / sqrtf(wave_sum(ss) * (1.0f / D) + EPS);
#pragma unroll
                for (int j = 0; j < 4; ++j) { const f32x4 h = v[j] * rstd * ca[j] + cc[j]; u32x2 o; o.x = cvt_pk_bf16(h.x, h.y); o.y = cvt_pk_bf16(h.z, h.w);
                    *(u32x2*)(H + (size_t)row * D + 256 * j + 4 * lane) = o; }
            }
        }
    }
}

struct Unit { int pm, pn, e, nrows, tbase; };
typedef f32x4 Acc[2][2][4][2];

template <class Pb>
__device__ __forceinline__ void gemm_simple(LAS unsigned char* lds, const Pb& pb, int bid, int nblk) {
    const int tid = opaque_tid(), wid = __builtin_amdgcn_readfirstlane(tid >> 6), lane = tid & 63, wr = wid >> 2, wc = wid & 3, fr = lane & 15, fq = lane >> 4;
    constexpr int PITCH = 144;
    LAS unsigned char* sA = lds; LAS unsigned char* sB = lds + 256 * PITCH;
    Unit u;
    for (int i = 0; pb.next(i, bid, nblk, u); ++i) {
        Acc acc;
#pragma unroll
        for (int a = 0; a < 2; ++a)
#pragma unroll
            for (int b = 0; b < 2; ++b)
#pragma unroll
                for (int m = 0; m < 4; ++m)
#pragma unroll
                    for (int n = 0; n < 2; ++n) acc[a][b][m][n] = (f32x4){0.f, 0.f, 0.f, 0.f};
        unsigned ao[4], bo[4];
#pragma unroll
        for (int j = 0; j < 4; ++j) { const int q = tid + NT * j, row = q >> 3, c8 = q & 7;
            ao[j] = (unsigned)pb.a_row(u, row) * (unsigned)(pb.K * 2) + c8 * 16; bo[j] = (unsigned)pb.b_row(u, row) * (unsigned)(pb.K * 2) + c8 * 16; }
        for (int kt = 0; kt < pb.K / 64; ++kt) {
            u32x4 ra[4], rb[4];
#pragma unroll
            for (int j = 0; j < 4; ++j) { ra[j] = *(const u32x4*)(pb.A + ao[j] + kt * 128); rb[j] = *(const u32x4*)(pb.B + bo[j] + kt * 128); }
            __syncthreads();
#pragma unroll
            for (int j = 0; j < 4; ++j) { const int q = tid + NT * j, row = q >> 3, c8 = q & 7; *(LAS u32x4*)(sA + row * PITCH + c8 * 16) = ra[j]; *(LAS u32x4*)(sB + row * PITCH + c8 * 16) = rb[j]; }
            __syncthreads();
#pragma unroll
            for (int kk = 0; kk < 2; ++kk) {
                bf16x8 bfr[2][2];
#pragma unroll
                for (int b = 0; b < 2; ++b)
#pragma unroll
                    for (int n = 0; n < 2; ++n) bfr[b][n] = *(const LAS bf16x8*)(sB + (128 * b + 32 * wc + 16 * n + fr) * PITCH + (kk * 32 + fq * 8) * 2);
#pragma unroll
                for (int a = 0; a < 2; ++a) {
                    bf16x8 af[4];
#pragma unroll
                    for (int m = 0; m < 4; ++m) af[m] = *(const LAS bf16x8*)(sA + (128 * a + 64 * wr + 16 * m + fr) * PITCH + (kk * 32 + fq * 8) * 2);
#pragma unroll
                    for (int b = 0; b < 2; ++b)
#pragma unroll
                        for (int m = 0; m < 4; ++m)
#pragma unroll
                            for (int n = 0; n < 2; ++n) acc[a][b][m][n] = __builtin_amdgcn_mfma_f32_16x16x32_bf16(bfr[b][n], af[m], acc[a][b][m][n], 0, 0, 0);
                }
            }
        }
        pb.epi(acc, u, wr, wc, fr, fq);
    }
    __syncthreads();
}

struct PbInProj {
    const char* A; const char* B; int K;
    bf16* proj; const float* qg; const float* kg; const float* rope;
    __device__ __forceinline__ bool next(int i, int bid, int nblk, Unit& u) const { const int L = i * nblk + bid; if (L >= 256 * 5) return false; u.pm = L / 5; u.pn = L % 5; u.e = 0; u.nrows = 256; u.tbase = 0; return true; }
    __device__ __forceinline__ int a_row(const Unit& u, int r) const { return 256 * u.pm + r; }
    __device__ __forceinline__ int b_rowc(int rho) const { return 64 * ((rho >> 5) & 3) + 32 * (rho >> 7) + perm32(rho & 31); }
    __device__ __forceinline__ int b_base_row(const Unit& u) const { return 256 * u.pn; }
    __device__ __forceinline__ int b_row(const Unit& u, int rho) const { return b_base_row(u) + b_rowc(rho); }
    __device__ __forceinline__ void epi(const Acc& acc, const Unit& u, int, int, int, int) const {
        const int t_ = opaque_tid(), w_ = __builtin_amdgcn_readfirstlane(t_ >> 6), wr = w_ >> 2, wc = w_ & 3, fr = t_ & 15, fq = (t_ >> 4) & 3;
        const int hg = 4 * u.pn + wc;
        const bool nrm = hg < 10;
        const float* gsrc = (hg < 8) ? qg : kg;
        f32x4 gv[2][2];
#pragma unroll
        for (int bj = 0; bj < 2; ++bj)
#pragma unroll
            for (int n = 0; n < 2; ++n) gv[bj][n] = nrm ? *(const f32x4*)(gsrc + 32 * bj + 8 * fq + 4 * n) : (f32x4){1.f, 1.f, 1.f, 1.f};
        const float qs = (hg < 8) ? QSCALE : 1.0f;
#pragma unroll
        for (int ai = 0; ai < 2; ++ai)
#pragma unroll
            for (int m = 0; m < 4; ++m) {
                const int row = 256 * u.pm + 128 * ai + 64 * wr + 16 * m + fr;
                f32x4 v[2][2];
#pragma unroll
                for (int bj = 0; bj < 2; ++bj)
#pragma unroll
                    for (int n = 0; n < 2; ++n) v[bj][n] = acc[ai][bj][m][n];
                if (nrm) {
                    float ss = 0.f;
#pragma unroll
                    for (int bj = 0; bj < 2; ++bj)
#pragma unroll
                        for (int n = 0; n < 2; ++n) ss += (v[bj][n].x * v[bj][n].x + v[bj][n].y * v[bj][n].y) + (v[bj][n].z * v[bj][n].z + v[bj][n].w * v[bj][n].w);
                    ss += swz_xor<16>(ss); ss = sum_x32(ss);
                    const float rstd = 1.0f / sqrtf(ss * (1.0f / 64.0f) + EPS);
#pragma unroll
                    for (int bj = 0; bj < 2; ++bj)
#pragma unroll
                        for (int n = 0; n < 2; ++n) v[bj][n] = v[bj][n] * rstd * gv[bj][n];
#pragma unroll
                    for (int n = 0; n < 2; ++n) {
                        f32x4 pr;
                        pr.x = swz_xor<16>(v[0][n].x); pr.y = swz_xor<16>(v[0][n].y); pr.z = swz_xor<16>(v[0][n].z); pr.w = swz_xor<16>(v[0][n].w);
                        if (fq < 2) {
                            const f32x4 cs = *(const f32x4*)(rope + (size_t)row * 16 + 4 * n), sn = *(const f32x4*)(rope + (size_t)row * 16 + 8 + 4 * n);
                            v[0][n] = (fq == 0) ? (v[0][n] * cs - pr * sn) : (v[0][n] * cs + pr * sn);
                        }
                    }
                }
#pragma unroll
                for (int bj = 0; bj < 2; ++bj) {
                    u32x4 o; o.x = cvt_pk_bf16(v[bj][0].x * qs, v[bj][0].y * qs); o.y = cvt_pk_bf16(v[bj][0].z * qs, v[bj][0].w * qs);
                    o.z = cvt_pk_bf16(v[bj][1].x * qs, v[bj][1].y * qs); o.w = cvt_pk_bf16(v[bj][1].z * qs, v[bj][1].w * qs);
                    *(u32x4*)(proj + (size_t)row * NIN + 64 * hg + 32 * bj + 8 * fq) = o;
                }
            }
    }
};

struct PbOutProj {
    const char* A; const char* B; int K;
    const float* xin; float* xout; const float* gate1;
    __device__ __forceinline__ bool next(int i, int bid, int nblk, Unit& u) const { const int L = i * nblk + bid; if (L >= 256 * 4) return false; u.pm = L >> 2; u.pn = L & 3; u.e = 0; u.nrows = 256; u.tbase = 0; return true; }
    __device__ __forceinline__ int a_row(const Unit& u, int r) const { return 256 * u.pm + r; }
    __device__ __forceinline__ int b_rowc(int rho) const { return rho; }
    __device__ __forceinline__ int b_base_row(const Unit& u) const { return 256 * u.pn; }
    __device__ __forceinline__ int b_row(const Unit& u, int rho) const { return b_base_row(u) + b_rowc(rho); }
    __device__ __forceinline__ void epi(const Acc& acc, const Unit& u, int, int, int, int) const {
        const int t_ = opaque_tid(), w_ = __builtin_amdgcn_readfirstlane(t_ >> 6), wr = w_ >> 2, wc = w_ & 3, fr = t_ & 15, fq = (t_ >> 4) & 3;
        const int b = (256 * u.pm) >> 13;
        const int col0 = 256 * u.pn + 32 * wc + 4 * fq;
        f32x4 g[2][2];
#pragma unroll
        for (int bj = 0; bj < 2; ++bj)
#pragma unroll
            for (int n = 0; n < 2; ++n) g[bj][n] = *(const f32x4*)(gate1 + (size_t)b * NMOD + col0 + 128 * bj + 16 * n);
#pragma unroll
        for (int ai = 0; ai < 2; ++ai)
#pragma unroll
            for (int m = 0; m < 4; ++m) {
                const size_t off = (size_t)(256 * u.pm + 128 * ai + 64 * wr + 16 * m + fr) * D + col0;
#pragma unroll
                for (int bj = 0; bj < 2; ++bj)
#pragma unroll
                    for (int n = 0; n < 2; ++n) { const f32x4 xi = *(const f32x4*)(xin + off + 128 * bj + 16 * n); *(f32x4*)(xout + off + 128 * bj + 16 * n) = xi + g[bj][n] * acc[ai][bj][m][n]; }
            }
    }
};

struct MoeTab { const LAS int* cnt; const LAS int* tp; };
__device__ __forceinline__ void moe_build_tab(LAS int* tab, const unsigned* gcount) {
    if (threadIdx.x == 0) { int t = 0; for (int e = 0; e < NE; ++e) { const int c = (int)__hip_atomic_load(gcount + e * 64, __ATOMIC_RELAXED, __HIP_MEMORY_SCOPE_AGENT); tab[e] = c; tab[32 + e] = t; t += (c + 255) >> 8; } tab[64] = t; }
    __syncthreads();
}
__device__ __forceinline__ bool moe_unit(const LAS int* tab, int L, int ntn, Unit& u) {
    const int gt = L / ntn; if (gt >= tab[64]) return false;
    int e = 0;
    for (int q = 1; q < NE; ++q) e = (tab[32 + q] <= gt) ? q : e;
    u.e = e; u.pm = gt - tab[32 + e]; u.pn = L % ntn; u.tbase = gt * 256; const int rem = tab[e] - 256 * u.pm; u.nrows = rem < 256 ? rem : 256; return true;
}

struct PbGU {
    const char* A; const char* B; int K;
    const LAS int* tab; const int* list; const float* bgu; bf16* act;
    __device__ __forceinline__ bool next(int i, int bid, int nblk, Unit& u) const { return moe_unit(tab, i * nblk + bid, 8, u); }
    __device__ __forceinline__ int a_row(const Unit& u, int r) const { const int rr = r < u.nrows ? r : 0; return list[(size_t)u.e * NTOK + 256 * u.pm + rr] >> 2; }
    __device__ __forceinline__ int b_rowc(int rho) const { const int i = rho & 127; return ((rho >> 7) ? 1024 : 0) + (i & ~31) + perm32(i & 31); }
    __device__ __forceinline__ int b_base_row(const Unit& u) const { return u.e * 2048 + 128 * u.pn; }
    __device__ __forceinline__ int b_row(const Unit& u, int rho) const { return b_base_row(u) + b_rowc(rho); }
    __device__ __forceinline__ void epi(const Acc& acc, const Unit& u, int, int, int, int) const {
        const int t_ = opaque_tid(), w_ = __builtin_amdgcn_readfirstlane(t_ >> 6), wr = w_ >> 2, wc = w_ & 3, fr = t_ & 15, fq = (t_ >> 4) & 3;
        const int col0 = 128 * u.pn + 32 * wc + 8 * fq;
        f32x4 bg[2], bu[2];
#pragma unroll
        for (int n = 0; n < 2; ++n) { bg[n] = *(const f32x4*)(bgu + (size_t)u.e * 2048 + col0 + 4 * n); bu[n] = *(const f32x4*)(bgu + (size_t)u.e * 2048 + 1024 + col0 + 4 * n); }
#pragma unroll
        for (int ai = 0; ai < 2; ++ai)
#pragma unroll
            for (int m = 0; m < 4; ++m) {
                const int r = 128 * ai + 64 * wr + 16 * m + fr;
                float o[8];
#pragma unroll
                for (int n = 0; n < 2; ++n)
#pragma unroll
                    for (int j = 0; j < 4; ++j) {
                        float g = acc[ai][0][m][n][j] + bg[n][j], uu = acc[ai][1][m][n][j] + bu[n][j];
                        g = fminf(g, 7.0f); uu = fminf(fmaxf(uu, -7.0f), 7.0f);
                        const float sg = 1.0f / (1.0f + __builtin_amdgcn_exp2f(-1.702f * LOG2E * g));
                        o[4 * n + j] = g * sg * (uu + 1.0f);
                    }
                u32x4 w; w.x = cvt_pk_bf16(o[0], o[1]); w.y = cvt_pk_bf16(o[2], o[3]); w.z = cvt_pk_bf16(o[4], o[5]); w.w = cvt_pk_bf16(o[6], o[7]);
                *(u32x4*)(act + (size_t)(u.tbase + r) * 1024 + col0) = w;
            }
    }
};

struct PbDown {
    const char* A; const char* B; int K;
    const LAS int* tab; const int* list; const float* bdn; bf16* ybuf;
    __device__ __forceinline__ bool next(int i, int bid, int nblk, Unit& u) const { return moe_unit(tab, i * nblk + bid, 4, u); }
    __device__ __forceinline__ int a_row(const Unit& u, int r) const { return u.tbase + r; }
    __device__ __forceinline__ int b_rowc(int rho) const { return (rho & ~31) + perm32(rho & 31); }
    __device__ __forceinline__ int b_base_row(const Unit& u) const { return u.e * 1024 + 256 * u.pn; }
    __device__ __forceinline__ int b_row(const Unit& u, int rho) const { return b_base_row(u) + b_rowc(rho); }
    __device__ __forceinline__ void epi(const Acc& acc, const Unit& u, int, int, int, int) const {
        const int t_ = opaque_tid(), w_ = __builtin_amdgcn_readfirstlane(t_ >> 6), wr = w_ >> 2, wc = w_ & 3, fr = t_ & 15, fq = (t_ >> 4) & 3;
        const int col0 = 256 * u.pn + 32 * wc + 8 * fq;
        f32x4 bv[2][2];
#pragma unroll
        for (int bj = 0; bj < 2; ++bj)
#pragma unroll
            for (int n = 0; n < 2; ++n) bv[bj][n] = *(const f32x4*)(bdn + (size_t)u.e * 1024 + col0 + 128 * bj + 4 * n);
#pragma unroll
        for (int ai = 0; ai < 2; ++ai)
#pragma unroll
            for (int m = 0; m < 4; ++m) {
                const int r = 128 * ai + 64 * wr + 16 * m + fr;
                if (r < u.nrows) {
                    const int dest = list[(size_t)u.e * NTOK + 256 * u.pm + r];
#pragma unroll
                    for (int bj = 0; bj < 2; ++bj) {
                        const f32x4 v0 = acc[ai][bj][m][0] + bv[bj][0], v1 = acc[ai][bj][m][1] + bv[bj][1];
                        u32x4 w; w.x = cvt_pk_bf16(v0.x, v0.y); w.y = cvt_pk_bf16(v0.z, v0.w); w.z = cvt_pk_bf16(v1.x, v1.y); w.w = cvt_pk_bf16(v1.z, v1.w);
                        *(u32x4*)(ybuf + (size_t)dest * 1024 + col0 + 128 * bj) = w;
                    }
                }
            }
    }
};

__device__ __forceinline__ s16x4 lds_tr16(const LAS unsigned char* p) { return __builtin_bit_cast(s16x4, __builtin_amdgcn_ds_read_tr16_b64_v4i16((LAS s16x4*)p)); }

__device__ __forceinline__ void attn_phase(const Params& P, LAS unsigned char* lds, int l, int bid, int nblk) {
    const int tid = opaque_tid(), wid = __builtin_amdgcn_readfirstlane(tid >> 6), lane = tid & 63, r32 = lane & 31, hi = lane >> 5;
    unsigned char* ws = P.ws;
    const bf16* proj = (const bf16*)(ws + WS_PROJ);
    bf16* mix = (bf16*)(ws + WS_MIX);
    constexpr int KP = 144;
    LAS unsigned char* sK = lds; LAS unsigned char* sV = lds + 256 * KP;
    for (int unit = bid; unit < NB * 64 * 2; unit += nblk) {
        const int kvh = unit & 1, n = (unit >> 1) & 63, b = unit >> 7;
        const int tok0 = b * SEQ + n * 128 - 128;
        __syncthreads();
#pragma unroll
        for (int j = 0; j < 4; ++j) {
            const int q = tid + NT * j, key = q >> 3, c8 = q & 7;
            u32x4 kv = (u32x4){0u, 0u, 0u, 0u}, vv = (u32x4){0u, 0u, 0u, 0u};
            if (n > 0 || key >= 128) { const bf16* src = proj + (size_t)(tok0 + key) * NIN + 512 + kvh * 64 + c8 * 8; kv = *(const u32x4*)src; vv = *(const u32x4*)(src + 128); }
            *(LAS u32x4*)(sK + key * KP + c8 * 16) = kv; *(LAS u32x4*)(sV + key * KP + c8 * 16) = vv;
        }
        __syncthreads();
        const int hq = kvh * 4 + (wid >> 1);
        const float sink2 = P.sinks[l * 8 + hq] * LOG2E;
#pragma unroll 1
        for (int qt = 0; qt < 2; ++qt) {
            const int q0 = 64 * (wid & 1) + 32 * qt, qi = q0 + r32;
            const size_t qtok = (size_t)b * SEQ + n * 128 + qi;
            bf16x8 qf[4];
#pragma unroll
            for (int s = 0; s < 4; ++s) qf[s] = *(const bf16x8*)(proj + qtok * NIN + hq * 64 + 16 * s + 8 * hi);
            f32x16 st[5];
#pragma unroll
            for (int kt = 0; kt < 5; ++kt) {
#pragma unroll
                for (int r = 0; r < 16; ++r) st[kt][r] = 0.f;
#pragma unroll
                for (int s = 0; s < 4; ++s) { const bf16x8 kf = *(const LAS bf16x8*)(sK + (q0 + 32 * kt + r32) * KP + (16 * s + 8 * hi) * 2); st[kt] = __builtin_amdgcn_mfma_f32_32x32x16_bf16(kf, qf[s], st[kt], 0, 0, 0); }
            }
            float mx = sink2;
#pragma unroll
            for (int kt = 0; kt < 5; ++kt)
#pragma unroll
                for (int r = 0; r < 16; ++r) {
                    const int kj = q0 + 32 * kt + (r & 3) + 8 * (r >> 2) + 4 * hi;
                    const bool ok = (kj > qi) && (kj <= qi + 128) && (n > 0 || kj >= 128);
                    const float s = ok ? st[kt][r] : -__builtin_inff(); st[kt][r] = s; mx = fmaxf(mx, s);
                }
            mx = max_x32(mx);
            float sum = 0.f;
#pragma unroll
            for (int kt = 0; kt < 5; ++kt)
#pragma unroll
                for (int r = 0; r < 16; ++r) { const float p = __builtin_amdgcn_exp2f(st[kt][r] - mx); st[kt][r] = p; sum += p; }
            sum = sum_x32(sum);
            sum += __builtin_amdgcn_exp2f(sink2 - mx);
            f32x16 o[2];
#pragma unroll
            for (int dt = 0; dt < 2; ++dt)
#pragma unroll
                for (int r = 0; r < 16; ++r) o[dt][r] = 0.f;
#pragma unroll
            for (int kt = 0; kt < 5; ++kt)
#pragma unroll
                for (int s2 = 0; s2 < 2; ++s2) {
                    u32x4 pw; pw.x = cvt_pk_bf16(st[kt][8 * s2 + 0], st[kt][8 * s2 + 1]); pw.y = cvt_pk_bf16(st[kt][8 * s2 + 2], st[kt][8 * s2 + 3]);
                    pw.z = cvt_pk_bf16(st[kt][8 * s2 + 4], st[kt][8 * s2 + 5]); pw.w = cvt_pk_bf16(st[kt][8 * s2 + 6], st[kt][8 * s2 + 7]);
                    const bf16x8 pf = __builtin_bit_cast(bf16x8, pw);
                    const int kb = q0 + 32 * kt + 16 * s2 + 4 * hi, i16 = lane & 15;
#pragma unroll
                    for (int dt = 0; dt < 2; ++dt) {
                        const int d0 = 32 * dt + 16 * ((lane >> 4) & 1);
                        const LAS unsigned char* a0 = sV + (kb + (i16 >> 2)) * KP + (d0 + 4 * (i16 & 3)) * 2;
                        const s16x4 v0 = lds_tr16(a0), v1 = lds_tr16(a0 + 8 * KP);
                        bf16x8 vf; vf[0] = v0[0]; vf[1] = v0[1]; vf[2] = v0[2]; vf[3] = v0[3]; vf[4] = v1[0]; vf[5] = v1[1]; vf[6] = v1[2]; vf[7] = v1[3];
                        o[dt] = __builtin_amdgcn_mfma_f32_32x32x16_bf16(vf, pf, o[dt], 0, 0, 0);
                    }
                }
            const float inv = 1.0f / sum;
#pragma unroll
            for (int dt = 0; dt < 2; ++dt)
#pragma unroll
                for (int g4 = 0; g4 < 4; ++g4) {
                    u32x2 w; w.x = cvt_pk_bf16(o[dt][4 * g4 + 0] * inv, o[dt][4 * g4 + 1] * inv); w.y = cvt_pk_bf16(o[dt][4 * g4 + 2] * inv, o[dt][4 * g4 + 3] * inv);
                    *(u32x2*)(mix + qtok * D + hq * 64 + 32 * dt + 8 * g4 + 4 * hi) = w;
                }
        }
    }
    for (int ch = bid * 8 + wid; ch < NTOK / 32; ch += nblk * 8) {
        const int t0 = ch * 32, p0 = t0 & (SEQ - 1);
        const int col = 8 * lane, g = lane >> 4, w = 2 << g;
        float pb_[8], ps_[8];
#pragma unroll
        for (int i = 0; i < 8; i += 4) { const f32x4 a = *(const f32x4*)(P.pool_b + l * 512 + col + i), s = *(const f32x4*)(P.pool_s + l * 512 + col + i);
            pb_[i] = a.x; pb_[i + 1] = a.y; pb_[i + 2] = a.z; pb_[i + 3] = a.w; ps_[i] = s.x; ps_[i + 1] = s.y; ps_[i + 2] = s.z; ps_[i + 3] = s.w; }
        float sum[8];
#pragma unroll
        for (int i = 0; i < 8; ++i) sum[i] = 0.f;
        for (int j = 1; j < w; ++j) if (p0 - j >= 0) {
            const u32x4 z = *(const u32x4*)(proj + (size_t)(t0 - j) * NIN + 768 + col);
            sum[0] += bf_lo(z.x); sum[1] += bf_hi(z.x); sum[2] += bf_lo(z.y); sum[3] += bf_hi(z.y); sum[4] += bf_lo(z.z); sum[5] += bf_hi(z.z); sum[6] += bf_lo(z.w); sum[7] += bf_hi(z.w);
        }
        for (int t = 0; t < 32; ++t) {
            const u32x4 z = *(const u32x4*)(proj + (size_t)(t0 + t) * NIN + 768 + col);
            float zz[8] = {bf_lo(z.x), bf_hi(z.x), bf_lo(z.y), bf_hi(z.y), bf_lo(z.z), bf_hi(z.z), bf_lo(z.w), bf_hi(z.w)};
            const int pos = p0 + t; const float ic = 1.0f / (float)((pos + 1 < w) ? (pos + 1) : w);
            float o[8];
#pragma unroll
            for (int i = 0; i < 8; ++i) { sum[i] += zz[i]; o[i] = (sum[i] * ic - zz[i] + pb_[i]) * ps_[i]; }
            u32x4 ow; ow.x = cvt_pk_bf16(o[0], o[1]); ow.y = cvt_pk_bf16(o[2], o[3]); ow.z = cvt_pk_bf16(o[4], o[5]); ow.w = cvt_pk_bf16(o[6], o[7]);
            *(u32x4*)(mix + (size_t)(t0 + t) * D + 512 + col) = ow;
            if (pos - w + 1 >= 0) {
                const u32x4 y = *(const u32x4*)(proj + (size_t)(t0 + t - w + 1) * NIN + 768 + col);
                sum[0] -= bf_lo(y.x); sum[1] -= bf_hi(y.x); sum[2] -= bf_lo(y.y); sum[3] -= bf_hi(y.y); sum[4] -= bf_lo(y.z); sum[5] -= bf_hi(y.z); sum[6] -= bf_lo(y.w); sum[7] -= bf_hi(y.w);
            }
        }
    }
}

__device__ __forceinline__ void router_phase(const Params& P, LAS unsigned char* lds, int l, int bid, int nblk) {
    const int tid = opaque_tid(), wid = __builtin_amdgcn_readfirstlane(tid >> 6), lane = tid & 63, fr = lane & 15, fq = lane >> 4;
    unsigned char* ws = P.ws;
    const float* mod = (const float*)(ws + WS_MOD);
    bf16* H = (bf16*)(ws + WS_H);
    float* gates = (float*)(ws + WS_GATES);
    int* list = (int*)(ws + WS_LIST);
    unsigned* gcount = (unsigned*)(ws + WS_CTL) + CW_CNT + l * 32 * 64;
    constexpr int RP = 2064;
    LAS unsigned char* rwT = lds;
    LAS float* lg = (LAS float*)(lds + 66048);
    LAS int* lcnt = (LAS int*)(lds + 66048 + 33792);
    LAS int* lbase = lcnt + 32;
    LAS unsigned short* sel = (LAS unsigned short*)(lcnt + 64);
    LAS unsigned short* selr = sel + 1024;
    __syncthreads();
    for (int idx = tid; idx < 1024 * 32; idx += NT) { const int k = idx >> 5, e = idx & 31; const float v = P.rw[(size_t)l * 32768 + idx];
        *(LAS unsigned short*)(rwT + e * RP + k * 2) = (unsigned short)(cvt_pk_bf16(v, 0.f) & 0xffffu); }
    for (int tile = bid; tile < NTOK / 256; tile += nblk) {
        const int tok0 = tile * 256, b = tok0 >> 13;
        if (tid < 32) lcnt[tid] = 0;
        {
            f32x4 ca[4], cc[4];
#pragma unroll
            for (int j = 0; j < 4; ++j) { const int col = 256 * j + 4 * lane; const f32x4 g = *(const f32x4*)(P.n2g + l * D + col); const f32x4 sc = *(const f32x4*)(mod + (size_t)(l * NB + b) * NMOD + 4 * D + col);
                ca[j] = g * (1.0f + sc); cc[j] = *(const f32x4*)(mod + (size_t)(l * NB + b) * NMOD + 3 * D + col); }
            for (int rr = 0; rr < 32; ++rr) {
                const int row = tok0 + wid * 32 + rr;
                f32x4 v[4]; float ss = 0.f;
#pragma unroll
                for (int j = 0; j < 4; ++j) { v[j] = *(const f32x4*)(P.out + (size_t)row * D + 256 * j + 4 * lane); ss += (v[j].x * v[j].x + v[j].y * v[j].y) + (v[j].z * v[j].z + v[j].w * v[j].w); }
                const float rstd = 1.0f / sqrtf(wave_sum(ss) * (1.0f / D) + EPS);
#pragma unroll
                for (int j = 0; j < 4; ++j) { const f32x4 h = v[j] * rstd * ca[j] + cc[j]; u32x2 o; o.x = cvt_pk_bf16(h.x, h.y); o.y = cvt_pk_bf16(h.z, h.w); *(u32x2*)(H + (size_t)row * D + 256 * j + 4 * lane) = o; }
            }
        }
        asm volatile("s_waitcnt vmcnt(0)" ::: "memory");
        __syncthreads();
#pragma unroll 1
        for (int rg = 0; rg < 2; ++rg) {
            f32x4 a0 = (f32x4){0.f, 0.f, 0.f, 0.f}, a1 = a0;
            const bf16* hp = H + (size_t)(tok0 + 32 * wid + 16 * rg + fr) * D + 8 * fq;
            for (int s = 0; s < 32; ++s) {
                const bf16x8 af = *(const bf16x8*)(hp + 32 * s);
                const bf16x8 b0 = *(const LAS bf16x8*)(rwT + fr * RP + (32 * s + 8 * fq) * 2), b1 = *(const LAS bf16x8*)(rwT + (16 + fr) * RP + (32 * s + 8 * fq) * 2);
                a0 = __builtin_amdgcn_mfma_f32_16x16x32_bf16(af, b0, a0, 0, 0, 0); a1 = __builtin_amdgcn_mfma_f32_16x16x32_bf16(af, b1, a1, 0, 0, 0);
            }
            const float rb0 = P.rb[l * 32 + fr], rb1 = P.rb[l * 32 + 16 + fr];
#pragma unroll
            for (int r = 0; r < 4; ++r) { const int row = 32 * wid + 16 * rg + 4 * fq + r; lg[row * 33 + fr] = a0[r] + rb0; lg[row * 33 + 16 + fr] = a1[r] + rb1; }
        }
        __syncthreads();
        if (tid < 256) {
            float v[32];
#pragma unroll
            for (int e = 0; e < 32; ++e) v[e] = lg[tid * 33 + e];
            float tv[4]; int ti[4];
#pragma unroll
            for (int k = 0; k < 4; ++k) {
                float best = -__builtin_inff(); int bi = 0;
#pragma unroll
                for (int e = 0; e < 32; ++e) { const bool gt = v[e] > best; best = gt ? v[e] : best; bi = gt ? e : bi; }
                tv[k] = best; ti[k] = bi;
#pragma unroll
                for (int e = 0; e < 32; ++e) v[e] = (e == bi) ? -__builtin_inff() : v[e];
            }
            const float e1 = __expf(tv[1] - tv[0]), e2 = __expf(tv[2] - tv[0]), e3 = __expf(tv[3] - tv[0]);
            const float inv = 1.0f / (1.0f + e1 + e2 + e3);
            *(f32x4*)(gates + (size_t)(tok0 + tid) * 4) = (f32x4){inv, e1 * inv, e2 * inv, e3 * inv};
#pragma unroll
            for (int k = 0; k < 4; ++k) { const int r = __hip_atomic_fetch_add(lcnt + ti[k], 1, __ATOMIC_RELAXED, __HIP_MEMORY_SCOPE_WORKGROUP); sel[tid * 4 + k] = (unsigned short)ti[k]; selr[tid * 4 + k] = (unsigned short)r; }
        }
        __syncthreads();
        if (tid < 32) lbase[tid] = (int)__hip_atomic_fetch_add(gcount + tid * 64, (unsigned)lcnt[tid], __ATOMIC_RELAXED, __HIP_MEMORY_SCOPE_AGENT);
        __syncthreads();
        if (tid < 256) {
#pragma unroll
            for (int k = 0; k < 4; ++k) { const int e = sel[tid * 4 + k]; list[(size_t)e * NTOK + lbase[e] + selr[tid * 4 + k]] = (tok0 + tid) * 4 + k; }
        }
        __syncthreads();
    }
}


constexpr int BK = 64, HALF = 128, HTB = HALF * BK * 2;
__device__ __forceinline__ int lds_byte(int r, int c) { const int st = (r >> 4) * 2 + (c >> 5), rr = r & 15, cc = c & 31, ob = rr * 64 + cc * 2; return st * 1024 + (ob ^ (((ob >> 9) & 1) << 5)); }
__device__ __forceinline__ void stage_rc(int b, int& R, int& C) { const int st = b / 1024, sb = b % 1024, swz = sb ^ (((sb >> 9) & 1) << 5); R = (st >> 1) * 16 + swz / 64; C = (st & 1) * 32 + (swz % 64) / 2; }

template <class Pb>
__device__ __forceinline__ void gemm_phase8(LAS unsigned char* lds, const Pb& pb, int bid, int nblk) {
    const int tid = opaque_tid(), wid = __builtin_amdgcn_readfirstlane(tid >> 6), lane = tid & 63, wr = wid >> 2, wc = wid & 3, fr = lane & 15, fq = lane >> 4;
    const int K = pb.K, nt = K / BK;
    int Rp[2], Cp[2];
#pragma unroll
    for (int i = 0; i < 2; ++i) stage_rc(tid * 16 + i * 8192, Rp[i], Cp[i]);
    unsigned voB[2][2];
#pragma unroll
    for (int h = 0; h < 2; ++h)
#pragma unroll
        for (int i = 0; i < 2; ++i) voB[h][i] = (unsigned)pb.b_rowc(128 * h + Rp[i]) * (unsigned)(K * 2) + (unsigned)Cp[i] * 2u;
    const size_t kstep = (size_t)(BK * 2);
    const unsigned ldsw = (unsigned)wid * 1024u;
    const int aoff = lds_byte(wr * 64 + fr, fq * 8), boff = lds_byte(wc * 32 + fr, fq * 8);
#define PG8_SA(b, h) (((b) * 2 + (h)) * HTB)
#define PG8_SB(b, h) ((4 + (b) * 2 + (h)) * HTB)
#define PG8_STAGE(bufoff, gbase, voff) do { _Pragma("unroll") for (int _i = 0; _i < 2; ++_i) \
        __builtin_amdgcn_global_load_lds((const unsigned*)((const char*)(gbase) + (voff)[_i]), (LAS unsigned*)(lds + (bufoff) + ldsw + _i * 8192), 16, 0, 0); } while (0)
#define PG8_LDA(dst, b, h) do { _Pragma("unroll") for (int m = 0; m < 4; ++m) _Pragma("unroll") for (int k = 0; k < 2; ++k) dst[m][k] = *(const LAS bf16x8*)(lds + PG8_SA(b, h) + aoff + m * 2048 + k * 1024); } while (0)
#define PG8_LDB(dst, b, h) do { _Pragma("unroll") for (int n = 0; n < 2; ++n) _Pragma("unroll") for (int k = 0; k < 2; ++k) dst[n][k] = *(const LAS bf16x8*)(lds + PG8_SB(b, h) + boff + n * 2048 + k * 1024); } while (0)
#define PG8_MMA(ai, bj, At, Bt) do { __builtin_amdgcn_s_setprio(1); _Pragma("unroll") for (int m = 0; m < 4; ++m) _Pragma("unroll") for (int n = 0; n < 2; ++n) _Pragma("unroll") for (int k = 0; k < 2; ++k) \
        acc[ai][bj][m][n] = __builtin_amdgcn_mfma_f32_16x16x32_bf16(Bt[n][k], At[m][k], acc[ai][bj][m][n], 0, 0, 0); __builtin_amdgcn_s_setprio(0); } while (0)
#define PG8_WAIT_V(n) asm volatile("s_waitcnt vmcnt(" #n ")" ::: "memory")
#define PG8_WAIT_L(n) asm volatile("s_waitcnt lgkmcnt(" #n ")" ::: "memory")
#define PG8_BAR __builtin_amdgcn_s_barrier()
#define PG8_SCHED __builtin_amdgcn_sched_barrier(0)
#define PG8_VOA(dst, un) do { _Pragma("unroll") for (int h = 0; h < 2; ++h) _Pragma("unroll") for (int i = 0; i < 2; ++i) dst[h][i] = (unsigned)pb.a_row(un, 128 * h + Rp[i]) * (unsigned)(K * 2) + (unsigned)Cp[i] * 2u; } while (0)
    Unit cur, nxt; int ui = 0;
    if (!pb.next(0, bid, nblk, cur)) return;
    Acc acc;
#pragma unroll
    for (int a = 0; a < 2; ++a)
#pragma unroll
        for (int b = 0; b < 2; ++b)
#pragma unroll
            for (int m = 0; m < 4; ++m)
#pragma unroll
                for (int n = 0; n < 2; ++n) acc[a][b][m][n] = (f32x4){0.f, 0.f, 0.f, 0.f};
    bf16x8 At[4][2], B0[2][2], B1[2][2];
    unsigned voAc[2][2], voAn[2][2];
    PG8_VOA(voAc, cur);
    const char* cB = pb.B + (size_t)pb.b_base_row(cur) * (size_t)(K * 2);
    const char* const gA = pb.A;
    PG8_STAGE(PG8_SB(0, 0), cB, voB[0]); PG8_STAGE(PG8_SB(0, 1), cB, voB[1]); PG8_STAGE(PG8_SA(0, 0), gA, voAc[0]); PG8_STAGE(PG8_SA(0, 1), gA, voAc[1]);
    if (wr == 1) PG8_BAR;
    PG8_WAIT_V(2); PG8_BAR;
    PG8_STAGE(PG8_SB(1, 0), cB + kstep, voB[0]); PG8_STAGE(PG8_SA(1, 0), gA + kstep, voAc[0]); PG8_STAGE(PG8_SB(1, 1), cB + kstep, voB[1]);
    PG8_WAIT_V(6); PG8_BAR;
    for (;;) {
        const bool has_next = pb.next(ui + 1, bid, nblk, nxt);
        const char* nB = cB;
        if (has_next) { PG8_VOA(voAn, nxt); nB = pb.B + (size_t)pb.b_base_row(nxt) * (size_t)(K * 2); }
        else {
#pragma unroll
            for (int h = 0; h < 2; ++h)
#pragma unroll
                for (int i = 0; i < 2; ++i) voAn[h][i] = voAc[h][i]; }
        for (int t = 0; t < nt; t += 2) {
            const bool last = (t == nt - 2);
            const char* a1 = gA + (size_t)(t + 1) * kstep;
            const size_t k2 = last ? (size_t)0 : (size_t)(t + 2) * kstep;
            const char* a2 = gA + k2; const char* b2 = (last ? nB : cB) + k2;
            const char* a3 = a2 + kstep; const char* b3 = b2 + kstep;
            unsigned sa[2][2];
#pragma unroll
            for (int h = 0; h < 2; ++h)
#pragma unroll
                for (int i = 0; i < 2; ++i) sa[h][i] = last ? voAn[h][i] : voAc[h][i];
            PG8_LDB(B0, 0, 0); PG8_LDB(B1, 0, 1); PG8_SCHED; PG8_LDA(At, 0, 0); PG8_STAGE(PG8_SA(1, 1), a1, voAc[1]);
            PG8_WAIT_V(8); PG8_WAIT_L(0); PG8_BAR; PG8_MMA(0, 0, At, B0); PG8_MMA(0, 1, At, B1); PG8_BAR; PG8_SCHED;
            PG8_LDA(At, 0, 1); PG8_STAGE(PG8_SB(0, 0), b2, voB[0]); PG8_STAGE(PG8_SB(0, 1), b2, voB[1]); PG8_STAGE(PG8_SA(0, 0), a2, sa[0]);
            PG8_WAIT_V(8); PG8_WAIT_L(0); PG8_BAR; PG8_MMA(1, 0, At, B0); PG8_MMA(1, 1, At, B1); PG8_BAR; PG8_SCHED;
            PG8_LDB(B0, 1, 0); PG8_LDB(B1, 1, 1); PG8_SCHED; PG8_LDA(At, 1, 0); PG8_STAGE(PG8_SA(0, 1), a2, sa[1]);
            PG8_WAIT_V(8); PG8_WAIT_L(0); PG8_BAR; PG8_MMA(0, 0, At, B0); PG8_MMA(0, 1, At, B1); PG8_BAR; PG8_SCHED;
            PG8_LDA(At, 1, 1); PG8_STAGE(PG8_SB(1, 0), b3, voB[0]); PG8_STAGE(PG8_SB(1, 1), b3, voB[1]); PG8_STAGE(PG8_SA(1, 0), a3, sa[0]);
            PG8_WAIT_V(8); PG8_WAIT_L(0); PG8_BAR; PG8_MMA(1, 0, At, B0); PG8_MMA(1, 1, At, B1); PG8_BAR; PG8_SCHED;
        }
        if (wr == 0) PG8_BAR;
        pb.epi(acc, cur, wr, wc, fr, fq);
        if (!has_next) break;
#pragma unroll
        for (int a = 0; a < 2; ++a)
#pragma unroll
            for (int b = 0; b < 2; ++b)
#pragma unroll
                for (int m = 0; m < 4; ++m)
#pragma unroll
                    for (int n = 0; n < 2; ++n) acc[a][b][m][n] = (f32x4){0.f, 0.f, 0.f, 0.f};
        cur = nxt; cB = nB; ++ui;
#pragma unroll
        for (int h = 0; h < 2; ++h)
#pragma unroll
            for (int i = 0; i < 2; ++i) voAc[h][i] = voAn[h][i];
        if (wr == 1) PG8_BAR;
    }
    PG8_WAIT_V(0);
    PG8_BAR;
#undef PG8_SA
#undef PG8_SB
#undef PG8_STAGE
#undef PG8_LDA
#undef PG8_LDB
#undef PG8_MMA
#undef PG8_WAIT_V
#undef PG8_WAIT_L
#undef PG8_BAR
#undef PG8_SCHED
#undef PG8_VOA
}

#ifndef FAST_INPROJ
#define FAST_INPROJ 1
#endif
#ifndef FAST_OUTPROJ
#define FAST_OUTPROJ 1
#endif
#ifndef FAST_GU
#define FAST_GU 1
#endif
#ifndef FAST_DOWN
#define FAST_DOWN 1
#endif
template <bool FAST, class Pb> __device__ __forceinline__ void gemm_run(LAS unsigned char* lds, const Pb& pb, int bid, int nblk) {
    if constexpr (FAST) gemm_phase8(lds, pb, bid, nblk); else gemm_simple(lds, pb, bid, nblk);
}

__device__ __forceinline__ void inproj_phase(const Params& P, LAS unsigned char* lds, int l, int bid, int nblk) {
    unsigned char* ws = P.ws;
    PbInProj pb; pb.A = (const char*)(ws + WS_H); pb.B = (const char*)(ws + WS_WIN) + (size_t)l * (1280 * 1024 * 2); pb.K = 1024;
    pb.proj = (bf16*)(ws + WS_PROJ); pb.qg = P.qg + l * 64; pb.kg = P.kg + l * 64; pb.rope = (const float*)(ws + WS_ROPE);
    gemm_run<FAST_INPROJ>(lds, pb, bid, nblk);
}
__device__ __forceinline__ void outproj_phase(const Params& P, LAS unsigned char* lds, int l, int bid, int nblk) {
    unsigned char* ws = P.ws;
    PbOutProj pb; pb.A = (const char*)(ws + WS_MIX); pb.B = (const char*)(ws + WS_WOUT) + (size_t)l * (1024 * 1024 * 2); pb.K = 1024;
    pb.xin = (l == 0) ? P.x : P.out; pb.xout = P.out; pb.gate1 = (const float*)(ws + WS_MOD) + (size_t)l * NB * NMOD + 2 * D;
    gemm_run<FAST_OUTPROJ>(lds, pb, bid, nblk);
}
__device__ __forceinline__ void gu_phase(const Params& P, LAS unsigned char* lds, int l, int bid, int nblk) {
    unsigned char* ws = P.ws;
    LAS int* tab = (LAS int*)(lds + 131072);
    __syncthreads();
    moe_build_tab(tab, (const unsigned*)(ws + WS_CTL) + CW_CNT + l * 32 * 64);
    PbGU pb; pb.A = (const char*)(ws + WS_H); pb.B = (const char*)(ws + WS_WGU) + (size_t)l * 32 * (2048 * 1024 * 2); pb.K = 1024;
    pb.tab = tab; pb.list = (const int*)(ws + WS_LIST); pb.bgu = P.bgu + (size_t)l * 32 * 2048; pb.act = (bf16*)(ws + WS_ACT);
    gemm_run<FAST_GU>(lds, pb, bid, nblk);
}
__device__ __forceinline__ void down_phase(const Params& P, LAS unsigned char* lds, int l, int bid, int nblk) {
    unsigned char* ws = P.ws;
    LAS int* tab = (LAS int*)(lds + 131072);
    __syncthreads();
    moe_build_tab(tab, (const unsigned*)(ws + WS_CTL) + CW_CNT + l * 32 * 64);
    PbDown pb; pb.A = (const char*)(ws + WS_ACT); pb.B = (const char*)(ws + WS_WDN) + (size_t)l * 32 * (1024 * 1024 * 2); pb.K = 1024;
    pb.tab = tab; pb.list = (const int*)(ws + WS_LIST); pb.bdn = P.bdn + (size_t)l * 32 * 1024; pb.ybuf = (bf16*)(ws + WS_YBUF);
    gemm_run<FAST_DOWN>(lds, pb, bid, nblk);
}

#define XB_TMO      128
#define XB_XCNT(j)  (256  + 64 * (j))
#define XB_XSUB(j)  (1280 + 64 * (j))
#define XB_XGEN(j)  (2304 + 64 * (j))
#define XB_TOP      3328
#define XB_TOPGEN   3392
#define XCD_BAR_WORDS 3456
#define XB_SPIN_CAP (1u << 18)
__device__ __forceinline__ unsigned xb_ld(unsigned* p)              { return __hip_atomic_load(p, __ATOMIC_RELAXED, __HIP_MEMORY_SCOPE_AGENT); }
__device__ __forceinline__ unsigned xb_add(unsigned* p, unsigned v) { return __hip_atomic_fetch_add(p, v, __ATOMIC_RELAXED, __HIP_MEMORY_SCOPE_AGENT); }
__device__ __forceinline__ unsigned xb_xcc_id() { return (unsigned)__builtin_amdgcn_s_getreg((3 << 11) | 20) & 0xFu; }
#define XB_SPIN(cond, bar) do { unsigned _sp = 0; while (cond) { __builtin_amdgcn_s_sleep(1); \
    if ((++_sp & 255u) == 0u) { if (xb_ld(&(bar)[XB_TMO])) break; if (_sp > XB_SPIN_CAP) { atomicAdd(&(bar)[XB_TMO], 1u); break; } } } } while (0)
struct XcdBarrier { unsigned* bar; unsigned x; volatile LAS unsigned* st; };
__device__ __forceinline__ XcdBarrier xcd_barrier_post(unsigned* bar, volatile LAS unsigned* st) {
    XcdBarrier b; b.bar = bar; b.x = xb_xcc_id(); b.st = st;
    if (threadIdx.x == 0) (void)xb_add(&bar[XB_XCNT(b.x)], 1u);
    return b;
}
__device__ __forceinline__ void xcd_barrier_complete(unsigned* bar, unsigned x, unsigned& nloc, unsigned& nx) {
    const unsigned G = gridDim.x * gridDim.y * gridDim.z;
    unsigned sum, cnt, mine, sp = 0u;
    for (;;) {
        sum = 0u; cnt = 0u; mine = 0u;
#pragma unroll
        for (unsigned j = 0; j < 16; ++j) { const unsigned c = xb_ld(&bar[XB_XCNT(j)]); sum += c; cnt += (c > 0u) ? 1u : 0u; mine = (j == x) ? c : mine; }
        if (sum == G) break;
        __builtin_amdgcn_s_sleep(1);
        if ((++sp & 255u) == 0u) { if (xb_ld(&bar[XB_TMO])) break; if (sp > XB_SPIN_CAP) { atomicAdd(&bar[XB_TMO], 1u); break; } }
    }
    nloc = mine > 0u ? mine : 1u; nx = cnt > 0u ? cnt : 1u;
}
__device__ __forceinline__ void xcd_barrier(const XcdBarrier& b) {
    asm volatile("s_waitcnt vmcnt(0)" ::: "memory");
    __syncthreads();
    if (threadIdx.x == 0) {
        unsigned* bar = b.bar; const unsigned bx = xb_xcc_id();
        __builtin_amdgcn_s_waitcnt(0);
        unsigned nloc = b.st[0], nx = b.st[1];
        if (nloc == 0u) { xcd_barrier_complete(bar, bx, nloc, nx); b.st[0] = nloc; b.st[1] = nx; }
        const unsigned old = xb_add(&bar[XB_XSUB(bx)], 1u);
        const unsigned gen = old / nloc;
        if (old + 1u == (gen + 1u) * nloc) {
            __builtin_amdgcn_fence(__ATOMIC_RELEASE, "agent");
            asm volatile("s_waitcnt vmcnt(0)" ::: "memory");
            const unsigned og = xb_add(&bar[XB_TOP], 1u);
            const unsigned tg = og / nx;
            if (og + 1u == (tg + 1u) * nx) xb_add(&bar[XB_TOPGEN], 1u);
            else XB_SPIN(xb_ld(&bar[XB_TOPGEN]) == tg, bar);
            __builtin_amdgcn_fence(__ATOMIC_ACQUIRE, "agent");
            xb_add(&bar[XB_XGEN(bx)], 1u);
            asm volatile("s_waitcnt vmcnt(0)" ::: "memory");
        } else {
            XB_SPIN(xb_ld(&bar[XB_XGEN(bx)]) == gen, bar);
            __builtin_amdgcn_fence(__ATOMIC_ACQUIRE, "agent");
            asm volatile("s_waitcnt vmcnt(0)" ::: "memory");
        }
    }
    __syncthreads();
}


#if ONE_LAUNCH
constexpr int TAB_OFF = 131072, MISC_OFF = 131072 + 512;
__global__ void __launch_bounds__(NT, 2) mega_fwd(Params P) {
    extern __shared__ __attribute__((aligned(16))) unsigned char dyn_lds[];
    LAS unsigned char* lds = (LAS unsigned char*)dyn_lds;
    volatile LAS unsigned* MISC = (volatile LAS unsigned*)(lds + MISC_OFF);
    if (threadIdx.x < 32) MISC[threadIdx.x] = 0u;
    __syncthreads();
    XcdBarrier bar = xcd_barrier_post((unsigned*)(P.ws + WS_CTL) + CW_BAR, MISC + 8);
    const int bid = blockIdx.x, nblk = gridDim.x;
    p0_prologue(P, lds, bid, nblk);
    xcd_barrier(bar);
    for (int l = 0; l < DEPTH; ++l) {
        if (l == 0) norm1_phase<0>(P, l, bid, nblk); else norm1_phase<1>(P, l, bid, nblk);
        xcd_barrier(bar);
        inproj_phase(P, lds, l, bid, nblk);
        xcd_barrier(bar);
        attn_phase(P, lds, l, bid, nblk);
        xcd_barrier(bar);
        outproj_phase(P, lds, l, bid, nblk);
        xcd_barrier(bar);
        router_phase(P, lds, l, bid, nblk);
        xcd_barrier(bar);
        gu_phase(P, lds, l, bid, nblk);
        xcd_barrier(bar);
        down_phase(P, lds, l, bid, nblk);
        xcd_barrier(bar);
    }
    norm1_phase<2>(P, 0, bid, nblk);
}
#else
extern __shared__ __attribute__((aligned(16))) unsigned char dyn_lds[];
#define KLDS ((LAS unsigned char*)dyn_lds)
__global__ void __launch_bounds__(NT, 2) k_prologue(Params P) { p0_prologue(P, KLDS, blockIdx.x, gridDim.x); }
__global__ void __launch_bounds__(NT, 2) k_norm1_0(Params P, int l) { norm1_phase<0>(P, l, blockIdx.x, gridDim.x); }
__global__ void __launch_bounds__(NT, 2) k_norm1_1(Params P, int l) { norm1_phase<1>(P, l, blockIdx.x, gridDim.x); }
__global__ void __launch_bounds__(NT, 2) k_final(Params P) { norm1_phase<2>(P, 0, blockIdx.x, gridDim.x); }
__global__ void __launch_bounds__(NT, 2) k_inproj(Params P, int l) { inproj_phase(P, KLDS, l, blockIdx.x, gridDim.x); }
__global__ void __launch_bounds__(NT, 2) k_attn(Params P, int l) { attn_phase(P, KLDS, l, blockIdx.x, gridDim.x); }
__global__ void __launch_bounds__(NT, 2) k_outproj(Params P, int l) { outproj_phase(P, KLDS, l, blockIdx.x, gridDim.x); }
__global__ void __launch_bounds__(NT, 2) k_router(Params P, int l) { router_phase(P, KLDS, l, blockIdx.x, gridDim.x); }
__global__ void __launch_bounds__(NT, 2) k_gu(Params P, int l) { gu_phase(P, KLDS, l, blockIdx.x, gridDim.x); }
__global__ void __launch_bounds__(NT, 2) k_down(Params P, int l) { down_phase(P, KLDS, l, blockIdx.x, gridDim.x); }

#endif

extern "C" void kernel_launch(void* const* d_in, const int* in_sizes, int n_in, void* d_out, int out_size, void* d_ws, size_t ws_size, hipStream_t stream) {
    static int ready = 0;
    if (ready == 0) {
        if (n_in != 21 || out_size != NTOK * D || ws_size < WS_END) { fprintf(stderr, "kernel_launch: unexpected shapes (n_in %d out %d ws %zu)\n", n_in, out_size, ws_size); ready = -1; return; }
#if ONE_LAUNCH
        const void* ks[] = {(const void*)mega_fwd};
#else
        const void* ks[] = {(const void*)k_prologue, (const void*)k_norm1_0, (const void*)k_norm1_1, (const void*)k_final, (const void*)k_inproj, (const void*)k_attn, (const void*)k_outproj, (const void*)k_router, (const void*)k_gu, (const void*)k_down};
#endif
        for (auto k : ks) if (hipFuncSetAttribute(k, hipFuncAttributeMaxDynamicSharedMemorySize, LDS_BYTES) != hipSuccess) { fprintf(stderr, "kernel_launch: hipFuncSetAttribute failed\n"); ready = -1; return; }
        ready = 1;
    }
    if (ready < 0) return;
    (void)hipMemsetAsync((char*)d_ws + WS_CTL, 0, CTL_ZERO_BYTES, stream);
    Params P{};
    P.x = (const float*)d_in[0]; P.c = (const float*)d_in[1]; P.pos = (const int*)d_in[2]; P.ada_w = (const float*)d_in[3]; P.ada_b = (const float*)d_in[4]; P.n1g = (const float*)d_in[5];
    P.w_in = (const float*)d_in[6]; P.qg = (const float*)d_in[7]; P.kg = (const float*)d_in[8]; P.sinks = (const float*)d_in[9]; P.pool_w = (const float*)d_in[10]; P.pool_b = (const float*)d_in[11];
    P.pool_s = (const float*)d_in[12]; P.w_out = (const float*)d_in[13]; P.n2g = (const float*)d_in[14]; P.rw = (const float*)d_in[15]; P.rb = (const float*)d_in[16]; P.wgu = (const float*)d_in[17];
    P.bgu = (const float*)d_in[18]; P.wdn = (const float*)d_in[19]; P.bdn = (const float*)d_in[20]; P.out = (float*)d_out; P.ws = (unsigned char*)d_ws;
    const dim3 g(256), b(NT);
#if ONE_LAUNCH
    hipLaunchKernelGGL(mega_fwd, g, b, LDS_BYTES, stream, P);
#else
    hipLaunchKernelGGL(k_prologue, g, b, LDS_BYTES, stream, P);
    for (int l = 0; l < DEPTH; ++l) {
        if (l == 0) hipLaunchKernelGGL(k_norm1_0, g, b, LDS_BYTES, stream, P, l); else hipLaunchKernelGGL(k_norm1_1, g, b, LDS_BYTES, stream, P, l);
        hipLaunchKernelGGL(k_inproj, g, b, LDS_BYTES, stream, P, l);
        hipLaunchKernelGGL(k_attn, g, b, LDS_BYTES, stream, P, l);
        hipLaunchKernelGGL(k_outproj, g, b, LDS_BYTES, stream, P, l);
        hipLaunchKernelGGL(k_router, g, b, LDS_BYTES, stream, P, l);
        hipLaunchKernelGGL(k_gu, g, b, LDS_BYTES, stream, P, l);
        hipLaunchKernelGGL(k_down, g, b, LDS_BYTES, stream, P, l);
    }
    hipLaunchKernelGGL(k_final, g, b, LDS_BYTES, stream, P);
#endif
}
```

```cpp
#include <hip/hip_runtime.h>
#include <cstdio>
#include <cstdint>

#ifndef ONE_LAUNCH
#define ONE_LAUNCH 1
#endif

#define LAS __attribute__((address_space(3)))
typedef unsigned short bf16;
typedef short bf16x8 __attribute__((ext_vector_type(8)));
typedef short s16x4 __attribute__((ext_vector_type(4)));
typedef float f32x4 __attribute__((ext_vector_type(4)));
typedef float f32x16 __attribute__((ext_vector_type(16)));
typedef unsigned u32x4 __attribute__((ext_vector_type(4)));
typedef unsigned u32x2 __attribute__((ext_vector_type(2)));
typedef int i32x4 __attribute__((ext_vector_type(4)));
typedef int i32x8 __attribute__((ext_vector_type(8)));

constexpr int D = 1024, NB = 8, SEQ = 8192, NTOK = NB * SEQ, DEPTH = 2, NE = 32, NIN = 1280, NMOD = 6 * D;
constexpr int NT = 512;
constexpr float EPS = 1e-6f;
constexpr float LOG2E = 1.4426950408889634f;
constexpr float QSCALE = 0.18033688011112042f;
constexpr int MAXTILES = NTOK * 4 / 256 + NE;

constexpr size_t MiB = 1u << 20;
constexpr size_t WS_CTL = 0, CTL_ZERO_BYTES = 1 * MiB;
constexpr size_t WS_MOD = 1 * MiB;
constexpr size_t WS_ROPE = 2 * MiB;
constexpr size_t WS_WIN = 8 * MiB;
constexpr size_t WS_WOUT = 16 * MiB;
constexpr size_t WS_GATES = 20 * MiB;
constexpr size_t WS_SEL = 21 * MiB;
constexpr size_t WS_CNTB = 22 * MiB;
constexpr size_t WS_TOT = 23 * MiB;
constexpr size_t WS_LIST = 24 * MiB;
constexpr size_t WS_WGU = 32 * MiB;
constexpr size_t WS_WDN = 160 * MiB;
constexpr size_t WS_H = 224 * MiB;
constexpr size_t WS_H8 = 352 * MiB;
constexpr size_t WS_PROJ = 416 * MiB;
constexpr size_t WS_MIX = 576 * MiB;
constexpr size_t WS_ACT = 416 * MiB;
constexpr size_t WS_YBUF = 704 * MiB;
constexpr size_t WS_END = 1216 * MiB;
static_assert(WS_ACT + (size_t)MAXTILES * 256 * 1024 <= WS_YBUF, "act fits");
constexpr float WSCALE = 32.0f, WUNSCALE = 1.0f / 32.0f;
constexpr int CW_BAR = 4096;
constexpr int CW_CNT = 8192;

constexpr int LDS_BYTES = 147456;

struct Params {
    const float *x, *c; const int* pos; const float *ada_w, *ada_b, *n1g, *w_in, *qg, *kg, *sinks, *pool_w, *pool_b, *pool_s, *w_out, *n2g, *rw, *rb, *wgu, *bgu, *wdn, *bdn;
    float* out; unsigned char* ws;
};

__device__ __forceinline__ unsigned cvt_pk_bf16(float lo, float hi) { unsigned r; asm("v_cvt_pk_bf16_f32 %0, %1, %2" : "=v"(r) : "v"(lo), "v"(hi)); return r; }
__device__ __forceinline__ unsigned cvt_pk4_fp8(float a, float b, float c, float d) { int w = 0; w = __builtin_amdgcn_cvt_pk_fp8_f32(a, b, w, false); w = __builtin_amdgcn_cvt_pk_fp8_f32(c, d, w, true); return (unsigned)w; }
__device__ __forceinline__ float bf_lo(unsigned w) { return __uint_as_float(w << 16); }
__device__ __forceinline__ float bf_hi(unsigned w) { return __uint_as_float(w & 0xffff0000u); }
template <int M> __device__ __forceinline__ float swz_xor(float v) { return __int_as_float(__builtin_amdgcn_ds_swizzle(__float_as_int(v), (M << 10) | 0x1f)); }
__device__ __forceinline__ float sum_x32(float v) { const auto r = __builtin_amdgcn_permlane32_swap(__float_as_uint(v), __float_as_uint(v), false, false); return __uint_as_float(r[0]) + __uint_as_float(r[1]); }
__device__ __forceinline__ float max_x32(float v) { const auto r = __builtin_amdgcn_permlane32_swap(__float_as_uint(v), __float_as_uint(v), false, false); return fmaxf(__uint_as_float(r[0]), __uint_as_float(r[1])); }
__device__ __forceinline__ float wave_sum(float v) {
    v += swz_xor<1>(v); v += swz_xor<2>(v); v += swz_xor<4>(v); v += swz_xor<8>(v); v += swz_xor<16>(v);
    return sum_x32(v);
}
__device__ __forceinline__ int lperm(int r) { return (r & 63) * 4 + (r >> 6); }
__device__ __forceinline__ int perm32(int rho) { const int n = rho >> 4, i = rho & 15; return 8 * (i >> 2) + 4 * n + (i & 3); }
__device__ __forceinline__ int opaque_tid() { int t = threadIdx.x; asm volatile("" : "+v"(t)); return t; }

__device__ __forceinline__ void tr_item_src(const Params& P, int it, const float*& src, int& ldw, bf16*& dst, int& k0, int& n0, bool& f8) {
    f8 = it < 16384 + 8192;
    unsigned char* ws = P.ws;
    if (it < 16384) { const int m = it >> 8, r = it & 255; src = P.wgu + (size_t)m * (1024 * 2048); ldw = 2048; dst = (bf16*)(ws + WS_WGU + (size_t)m * (2048 * 1024)); k0 = 128 * (r >> 5); n0 = 64 * (r & 31); return; }
    it -= 16384;
    if (it < 8192) { const int m = it >> 7, r = it & 127; src = P.wdn + (size_t)m * (1024 * 1024); ldw = 1024; dst = (bf16*)(ws + WS_WDN + (size_t)m * (1024 * 1024)); k0 = 128 * (r >> 4); n0 = 64 * (r & 15); return; }
    it -= 8192;
    if (it < 192) { const int l = it / 96, r = it % 96; src = P.w_in + (size_t)l * (1024 * 1280); ldw = 1280; dst = (bf16*)(ws + WS_WIN) + (size_t)l * (1280 * 1024); k0 = 128 * (r / 12); n0 = 64 * (r % 12); return; }
    it -= 192;
    { const int l = it >> 7, r = it & 127; src = P.w_out + (size_t)l * (1024 * 1024); ldw = 1024; dst = (bf16*)(ws + WS_WOUT) + (size_t)l * (1024 * 1024); k0 = 128 * (r >> 4); n0 = 64 * (r & 15); }
}
constexpr int N_TR_ITEMS = 16384 + 8192 + 192 + 256;

__device__ __forceinline__ void p0_prologue(const Params& P, LAS unsigned char* lds, int bid, int nblk) {
    const int tid = opaque_tid(), wid = __builtin_amdgcn_readfirstlane(tid >> 6), lane = tid & 63;
    unsigned char* ws = P.ws;
    {
        LAS float* cact = (LAS float*)lds;
        LAS float* red = (LAS float*)(lds + 32768);
        if (bid < 192 || nblk < 192) {
            for (int i = tid; i < NB * D; i += NT) { const float v = P.c[i]; cact[i] = v / (1.0f + __expf(-v)); }
            __syncthreads();
            for (int it = bid; it < 192; it += nblk) {
                const int l = it / 96, n0 = 64 * (it % 96);
                float acc[NB];
#pragma unroll
                for (int b = 0; b < NB; ++b) acc[b] = 0.f;
                const float* wp = P.ada_w + (size_t)l * D * NMOD + n0 + lane;
                for (int k = 128 * wid; k < 128 * wid + 128; k += 16) {
                    float wv[16];
#pragma unroll
                    for (int q = 0; q < 16; ++q) wv[q] = wp[(size_t)(k + q) * NMOD];
#pragma unroll
                    for (int q = 0; q < 16; ++q)
#pragma unroll
                        for (int b = 0; b < NB; ++b) acc[b] += cact[b * D + k + q] * wv[q];
                }
#pragma unroll
                for (int b = 0; b < NB; ++b) red[(wid * NB + b) * 64 + lane] = acc[b];
                __syncthreads();
                { const int b = tid >> 6; float s = P.ada_b[l * NMOD + n0 + lane];
#pragma unroll
                  for (int w = 0; w < 8; ++w) s += red[(w * NB + b) * 64 + lane];
                  ((float*)(ws + WS_MOD))[(size_t)(l * NB + b) * NMOD + n0 + lane] = s; }
                __syncthreads();
            }
        }
    }
    for (int it = bid; it < 128; it += nblk) {
        const int l = it >> 6, g = (it >> 4) & 3, k0 = 64 * (it & 15);
        LAS float* At = (LAS float*)lds;
        LAS float* Pw = (LAS float*)(lds + 33024);
        __syncthreads();
        for (int j = 0; j < 16; ++j) { const int idx = tid + NT * j, k = idx >> 7, c = idx & 127; At[k * 129 + c] = P.w_in[(size_t)l * (1024 * 1280) + (size_t)(k0 + k) * 1280 + 768 + 128 * g + c]; }
        for (int j = 0; j < 32; ++j) { const int idx = tid + NT * j; Pw[idx] = P.pool_w[(size_t)(l * 4 + g) * 16384 + idx]; }
        __syncthreads();
        const int n = tid & 127, ks = tid >> 7;
        float acc[16];
#pragma unroll
        for (int i = 0; i < 16; ++i) acc[i] = 0.f;
        for (int c = 0; c < 128; ++c) { const float pw = Pw[c * 128 + n];
#pragma unroll
            for (int i = 0; i < 16; ++i) acc[i] += At[(16 * ks + i) * 129 + c] * pw; }
        bf16* dst = (bf16*)(ws + WS_WIN) + (size_t)l * (1280 * 1024) + (size_t)(768 + 128 * g + n) * 1024 + k0 + 16 * ks;
        u32x4 o0, o1;
        o0.x = cvt_pk_bf16(acc[0], acc[1]); o0.y = cvt_pk_bf16(acc[2], acc[3]); o0.z = cvt_pk_bf16(acc[4], acc[5]); o0.w = cvt_pk_bf16(acc[6], acc[7]);
        o1.x = cvt_pk_bf16(acc[8], acc[9]); o1.y = cvt_pk_bf16(acc[10], acc[11]); o1.z = cvt_pk_bf16(acc[12], acc[13]); o1.w = cvt_pk_bf16(acc[14], acc[15]);
        *(u32x4*)dst = o0; *(u32x4*)(dst + 8) = o1;
    }
    {
        const double invf[8] = {1.0, 0.19392274474868576, 0.03760603093086393, 0.007292664737217109, 0.001414213562373095, 0.0002742481756762073, 5.318295896944988e-05, 1.031338537721246e-05};
        float* rope = (float*)(ws + WS_ROPE);
        for (int idx = bid * NT + tid; idx < NTOK * 8; idx += nblk * NT) {
            const int tok = idx >> 3, i = idx & 7;
            double f = 1.0;
#pragma unroll
            for (int q = 0; q < 8; ++q) f = (i == q) ? invf[q] : f;
            const double ang = (double)P.pos[tok] * f;
            const double kq = __builtin_rint(ang * 0.6366197723675814);
            const double r = (ang - kq * 1.5707963267948966) - kq * 6.123233995736766e-17;
            const double r2 = r * r;
            double sn = r * (1.0 + r2 * (-1.0 / 6 + r2 * (1.0 / 120 + r2 * (-1.0 / 5040 + r2 * (1.0 / 362880 + r2 * (-1.0 / 39916800 + r2 * (1.0 / 6227020800.0)))))));
            double cs = 1.0 + r2 * (-0.5 + r2 * (1.0 / 24 + r2 * (-1.0 / 720 + r2 * (1.0 / 40320 + r2 * (-1.0 / 3628800 + r2 * (1.0 / 479001600.0 + r2 * (-1.0 / 87178291200.0)))))));
            const int q = ((int)(long long)kq) & 3;
            double s2 = (q & 1) ? cs : sn, c2 = (q & 1) ? sn : cs;
            if (q == 1 || q == 2) c2 = -c2;
            if (q >= 2) s2 = -s2;
            rope[tok * 16 + i] = (float)c2; rope[tok * 16 + 8 + i] = (float)s2;
        }
    }
    {
        LAS float* tile = (LAS float*)lds;
        __syncthreads();
        f32x4 r[4];
        const float* src; int ldw, k0, n0; bf16* dst; bool f8;
        int it = bid;
        if (it < N_TR_ITEMS) { tr_item_src(P, it, src, ldw, dst, k0, n0, f8);
#pragma unroll
            for (int j = 0; j < 4; ++j) { const int idx = tid + NT * j, row = idx >> 4, c4 = idx & 15; r[j] = *(const f32x4*)(src + (size_t)(k0 + row) * ldw + n0 + 4 * c4); } }
        for (; it < N_TR_ITEMS; it += nblk) {
#pragma unroll
            for (int j = 0; j < 4; ++j) { const int idx = tid + NT * j, row = idx >> 4, c4 = idx & 15; LAS float* t = tile + row * 65 + 4 * c4; t[0] = r[j].x; t[1] = r[j].y; t[2] = r[j].z; t[3] = r[j].w; }
            __syncthreads();
            bf16* cdst = dst; const int ck0 = k0, cn0 = n0; const bool cf8 = f8;
            if (it + nblk < N_TR_ITEMS) { tr_item_src(P, it + nblk, src, ldw, dst, k0, n0, f8);
#pragma unroll
                for (int j = 0; j < 4; ++j) { const int idx = tid + NT * j, row = idx >> 4, c4 = idx & 15; r[j] = *(const f32x4*)(src + (size_t)(k0 + row) * ldw + n0 + 4 * c4); } }
            if (cf8) {
                const int n = tid >> 3, c = tid & 7; const LAS float* t = tile + (16 * c) * 65 + n;
                u32x4 o; o.x = cvt_pk4_fp8(t[0] * WSCALE, t[65] * WSCALE, t[2 * 65] * WSCALE, t[3 * 65] * WSCALE); o.y = cvt_pk4_fp8(t[4 * 65] * WSCALE, t[5 * 65] * WSCALE, t[6 * 65] * WSCALE, t[7 * 65] * WSCALE);
                o.z = cvt_pk4_fp8(t[8 * 65] * WSCALE, t[9 * 65] * WSCALE, t[10 * 65] * WSCALE, t[11 * 65] * WSCALE); o.w = cvt_pk4_fp8(t[12 * 65] * WSCALE, t[13 * 65] * WSCALE, t[14 * 65] * WSCALE, t[15 * 65] * WSCALE);
                *(u32x4*)((unsigned char*)cdst + (size_t)(cn0 + n) * 1024 + ck0 + 16 * c) = o;
            } else {
#pragma unroll
            for (int j = 0; j < 2; ++j) { const int p = tid + NT * j, n = p >> 4, c = p & 15; const LAS float* t = tile + (8 * c) * 65 + n;
                u32x4 o; o.x = cvt_pk_bf16(t[0], t[65]); o.y = cvt_pk_bf16(t[2 * 65], t[3 * 65]); o.z = cvt_pk_bf16(t[4 * 65], t[5 * 65]); o.w = cvt_pk_bf16(t[6 * 65], t[7 * 65]);
                *(u32x4*)(cdst + (size_t)(cn0 + n) * 1024 + ck0 + 8 * c) = o; }
            }
            __syncthreads();
        }
    }
}

template <int MODE>
__device__ __forceinline__ void norm1_phase(const Params& P, int l, int bid, int nblk) {
    const int tid = opaque_tid(), wid = __builtin_amdgcn_readfirstlane(tid >> 6), lane = tid & 63;
    unsigned char* ws = P.ws;
    const float* mod = (const float*)(ws + WS_MOD);
    const float* xin = (MODE == 0) ? P.x : P.out;
    bf16* H = (bf16*)(ws + WS_H);
    const float* gates = (const float*)(ws + WS_GATES);
    const bf16* Y = (const bf16*)(ws + WS_YBUF);
    for (int ch = bid * 8 + wid; ch < NTOK / 32; ch += nblk * 8) {
        const int b = (ch * 32) >> 13;
        f32x4 ca[4], cc[4], cg[4];
#pragma unroll
        for (int j = 0; j < 4; ++j) {
            const int col = 256 * j + 4 * lane;
            if (MODE <= 1) { const f32x4 g = *(const f32x4*)(P.n1g + l * D + col); const f32x4 sc = *(const f32x4*)(mod + (size_t)(l * NB + b) * NMOD + 1 * D + col);
                ca[j] = g * (1.0f + sc); cc[j] = *(const f32x4*)(mod + (size_t)(l * NB + b) * NMOD + 0 * D + col); }
            if (MODE >= 1) { const int lp = (MODE == 2) ? (DEPTH - 1) : (l - 1); cg[j] = *(const f32x4*)(mod + (size_t)(lp * NB + b) * NMOD + 5 * D + col); }
        }
        for (int rr = 0; rr < 32; ++rr) {
            const int row = ch * 32 + rr;
            f32x4 v[4];
#pragma unroll
            for (int j = 0; j < 4; ++j) v[j] = *(const f32x4*)(xin + (size_t)row * D + 256 * j + 4 * lane);
            if (MODE >= 1) {
                const f32x4 gt = *(const f32x4*)(gates + (size_t)row * 4);
                f32x4 a[4];
#pragma unroll
                for (int j = 0; j < 4; ++j) a[j] = (f32x4){0.f, 0.f, 0.f, 0.f};
#pragma unroll
                for (int k = 0; k < 4; ++k) {
                    const float gk = gt[k];
#pragma unroll
                    for (int j = 0; j < 4; ++j) { const u32x2 y = *(const u32x2*)(Y + ((size_t)row * 4 + k) * D + 256 * j + 4 * lane);
                        a[j].x += gk * bf_lo(y.x); a[j].y += gk * bf_hi(y.x); a[j].z += gk * bf_lo(y.y); a[j].w += gk * bf_hi(y.y); }
                }
#pragma unroll
                for (int j = 0; j < 4; ++j) { v[j] += cg[j] * a[j]; *(f32x4*)(P.out + (size_t)row * D + 256 * j + 4 * lane) = v[j]; }
            }
            if (MODE <= 1) {
                float ss = 0.f;
#pragma unroll
                for (int j = 0; j < 4; ++j) ss += (v[j].x * v[j].x + v[j].y * v[j].y) + (v[j].z * v[j].z + v[j].w * v[j].w);
                const float rstd = 1.0f / sqrtf(wave_sum(ss) * (1.0f / D) + EPS);
#pragma unroll
                for (int j = 0; j < 4; ++j) { const f32x4 h = v[j] * rstd * ca[j] + cc[j]; u32x2 o; o.x = cvt_pk_bf16(h.x, h.y); o.y = cvt_pk_bf16(h.z, h.w);
                    *(u32x2*)(H + (size_t)row * D + 256 * j + 4 * lane) = o; }
            }
        }
    }
}

struct Unit { int pm, pn, e, nrows, tbase, ks; };
typedef f32x4 Acc[2][2][4][2];

template <class Pb>
__device__ __forceinline__ void gemm_simple(LAS unsigned char* lds, const Pb& pb, int bid, int nblk) {
    const int tid = opaque_tid(), wid = __builtin_amdgcn_readfirstlane(tid >> 6), lane = tid & 63, wr = wid >> 2, wc = wid & 3, fr = lane & 15, fq = lane >> 4;
    constexpr int PITCH = 144;
    LAS unsigned char* sA = lds; LAS unsigned char* sB = lds + 256 * PITCH;
    Unit u;
    for (int i = 0; pb.next(i, bid, nblk, u); ++i) {
        Acc acc;
#pragma unroll
        for (int a = 0; a < 2; ++a)
#pragma unroll
            for (int b = 0; b < 2; ++b)
#pragma unroll
                for (int m = 0; m < 4; ++m)
#pragma unroll
                    for (int n = 0; n < 2; ++n) acc[a][b][m][n] = (f32x4){0.f, 0.f, 0.f, 0.f};
        unsigned ao[4], bo[4];
#pragma unroll
        for (int j = 0; j < 4; ++j) { const int q = tid + NT * j, row = q >> 3, c8 = q & 7;
            ao[j] = (unsigned)pb.a_row(u, row) * (unsigned)(pb.K * 2) + c8 * 16; bo[j] = (unsigned)pb.b_row(u, row) * (unsigned)(pb.K * 2) + c8 * 16; }
        for (int kt = 0; kt < pb.K / 64; ++kt) {
            u32x4 ra[4], rb[4];
#pragma unroll
            for (int j = 0; j < 4; ++j) { ra[j] = *(const u32x4*)(pb.A + ao[j] + kt * 128); rb[j] = *(const u32x4*)(pb.B + bo[j] + kt * 128); }
            __syncthreads();
#pragma unroll
            for (int j = 0; j < 4; ++j) { const int q = tid + NT * j, row = q >> 3, c8 = q & 7; *(LAS u32x4*)(sA + row * PITCH + c8 * 16) = ra[j]; *(LAS u32x4*)(sB + row * PITCH + c8 * 16) = rb[j]; }
            __syncthreads();
#pragma unroll
            for (int kk = 0; kk < 2; ++kk) {
                bf16x8 bfr[2][2];
#pragma unroll
                for (int b = 0; b < 2; ++b)
#pragma unroll
                    for (int n = 0; n < 2; ++n) bfr[b][n] = *(const LAS bf16x8*)(sB + (128 * b + 32 * wc + 16 * n + fr) * PITCH + (kk * 32 + fq * 8) * 2);
#pragma unroll
                for (int a = 0; a < 2; ++a) {
                    bf16x8 af[4];
#pragma unroll
                    for (int m = 0; m < 4; ++m) af[m] = *(const LAS bf16x8*)(sA + (128 * a + 64 * wr + 16 * m + fr) * PITCH + (kk * 32 + fq * 8) * 2);
#pragma unroll
                    for (int b = 0; b < 2; ++b)
#pragma unroll
                        for (int m = 0; m < 4; ++m)
#pragma unroll
                            for (int n = 0; n < 2; ++n) acc[a][b][m][n] = __builtin_amdgcn_mfma_f32_16x16x32_bf16(bfr[b][n], af[m], acc[a][b][m][n], 0, 0, 0);
                }
            }
        }
        pb.epi(acc, u, wr, wc, fr, fq);
    }
    __syncthreads();
}

struct PbInProj {
    static constexpr bool F8 = false;
    const char* A; const char* B; int K;
    bf16* proj; const float* qg; const float* kg; const float* rope;
    __device__ __forceinline__ bool next(int i, int bid, int nblk, Unit& u) const { const int L = i * nblk + bid; if (L >= 256 * 5) return false; u.pm = L / 5; u.pn = L % 5; u.e = 0; u.nrows = 256; u.tbase = 0; u.ks = 3 * u.pn + 2 * (u.pm & 7); return true; }
    __device__ __forceinline__ int a_row(const Unit& u, int r) const { return 256 * u.pm + r; }
    __device__ __forceinline__ void a_rows4(const Unit& u, int r0, int (&rows)[4]) const { for (int j = 0; j < 4; ++j) rows[j] = 256 * u.pm + r0 + 64 * j; }
    __device__ __forceinline__ int b_rowc(int rho) const { return 64 * ((rho >> 5) & 3) + 32 * (rho >> 7) + perm32(rho & 31); }
    __device__ __forceinline__ int b_base_row(const Unit& u) const { return 256 * u.pn; }
    __device__ __forceinline__ int b_row(const Unit& u, int rho) const { return b_base_row(u) + b_rowc(rho); }
    __device__ __forceinline__ void epi(const Acc& acc, const Unit& u, int, int, int, int) const {
        const int t_ = opaque_tid(), w_ = __builtin_amdgcn_readfirstlane(t_ >> 6), wr = w_ >> 2, wc = w_ & 3, fr = t_ & 15, fq = (t_ >> 4) & 3;
        const int hg = 4 * u.pn + wc;
        const bool nrm = hg < 10;
        const float* gsrc = (hg < 8) ? qg : kg;
        f32x4 gv[2][2];
#pragma unroll
        for (int bj = 0; bj < 2; ++bj)
#pragma unroll
            for (int n = 0; n < 2; ++n) gv[bj][n] = nrm ? *(const f32x4*)(gsrc + 32 * bj + 8 * fq + 4 * n) : (f32x4){1.f, 1.f, 1.f, 1.f};
        const float qs = (hg < 8) ? QSCALE : 1.0f;
#pragma unroll
        for (int ai = 0; ai < 2; ++ai)
#pragma unroll
            for (int m = 0; m < 4; ++m) {
                const int row = 256 * u.pm + 128 * ai + 64 * wr + 16 * m + fr;
                f32x4 v[2][2];
#pragma unroll
                for (int bj = 0; bj < 2; ++bj)
#pragma unroll
                    for (int n = 0; n < 2; ++n) v[bj][n] = acc[ai][bj][m][n];
                if (nrm) {
                    float ss = 0.f;
#pragma unroll
                    for (int bj = 0; bj < 2; ++bj)
#pragma unroll
                        for (int n = 0; n < 2; ++n) ss += (v[bj][n].x * v[bj][n].x + v[bj][n].y * v[bj][n].y) + (v[bj][n].z * v[bj][n].z + v[bj][n].w * v[bj][n].w);
                    ss += swz_xor<16>(ss); ss = sum_x32(ss);
                    const float rstd = __builtin_amdgcn_rsqf(ss * (1.0f / 64.0f) + EPS);
#pragma unroll
                    for (int bj = 0; bj < 2; ++bj)
#pragma unroll
                        for (int n = 0; n < 2; ++n) v[bj][n] = v[bj][n] * rstd * gv[bj][n];
#pragma unroll
                    for (int n = 0; n < 2; ++n) {
                        f32x4 pr;
                        pr.x = swz_xor<16>(v[0][n].x); pr.y = swz_xor<16>(v[0][n].y); pr.z = swz_xor<16>(v[0][n].z); pr.w = swz_xor<16>(v[0][n].w);
                        if (fq < 2) {
                            const f32x4 cs = *(const f32x4*)(rope + (size_t)row * 16 + 4 * n), sn = *(const f32x4*)(rope + (size_t)row * 16 + 8 + 4 * n);
                            v[0][n] = (fq == 0) ? (v[0][n] * cs - pr * sn) : (v[0][n] * cs + pr * sn);
                        }
                    }
                }
#pragma unroll
                for (int bj = 0; bj < 2; ++bj) {
                    u32x4 o; o.x = cvt_pk_bf16(v[bj][0].x * qs, v[bj][0].y * qs); o.y = cvt_pk_bf16(v[bj][0].z * qs, v[bj][0].w * qs);
                    o.z = cvt_pk_bf16(v[bj][1].x * qs, v[bj][1].y * qs); o.w = cvt_pk_bf16(v[bj][1].z * qs, v[bj][1].w * qs);
                    *(u32x4*)(proj + (size_t)row * NIN + 64 * hg + 32 * bj + 8 * fq) = o;
                }
            }
    }
};

struct PbOutProj {
    static constexpr bool F8 = false;
    const char* A; const char* B; int K;
    const float* xin; float* xout; const float* gate1;
    __device__ __forceinline__ bool next(int i, int bid, int nblk, Unit& u) const { const int L = i * nblk + bid; if (L >= 256 * 4) return false; u.pm = L >> 2; u.pn = L & 3; u.e = 0; u.nrows = 256; u.tbase = 0; u.ks = 4 * u.pn + 2 * (u.pm & 7); return true; }
    __device__ __forceinline__ int a_row(const Unit& u, int r) const { return 256 * u.pm + r; }
    __device__ __forceinline__ void a_rows4(const Unit& u, int r0, int (&rows)[4]) const { for (int j = 0; j < 4; ++j) rows[j] = 256 * u.pm + r0 + 64 * j; }
    __device__ __forceinline__ int b_rowc(int rho) const { return rho; }
    __device__ __forceinline__ int b_base_row(const Unit& u) const { return 256 * u.pn; }
    __device__ __forceinline__ int b_row(const Unit& u, int rho) const { return b_base_row(u) + b_rowc(rho); }
    __device__ __forceinline__ void epi(const Acc& acc, const Unit& u, int, int, int, int) const {
        const int t_ = opaque_tid(), w_ = __builtin_amdgcn_readfirstlane(t_ >> 6), wr = w_ >> 2, wc = w_ & 3, fr = t_ & 15, fq = (t_ >> 4) & 3;
        const int b = (256 * u.pm) >> 13;
        const int col0 = 256 * u.pn + 32 * wc + 4 * fq;
        f32x4 g[2][2];
#pragma unroll
        for (int bj = 0; bj < 2; ++bj)
#pragma unroll
            for (int n = 0; n < 2; ++n) g[bj][n] = *(const f32x4*)(gate1 + (size_t)b * NMOD + col0 + 128 * bj + 16 * n);
#pragma unroll
        for (int ai = 0; ai < 2; ++ai)
#pragma unroll
            for (int m = 0; m < 4; ++m) {
                const size_t off = (size_t)(256 * u.pm + 128 * ai + 64 * wr + 16 * m + fr) * D + col0;
#pragma unroll
                for (int bj = 0; bj < 2; ++bj)
#pragma unroll
                    for (int n = 0; n < 2; ++n) { const f32x4 xi = *(const f32x4*)(xin + off + 128 * bj + 16 * n); *(f32x4*)(xout + off + 128 * bj + 16 * n) = xi + g[bj][n] * acc[ai][bj][m][n]; }
            }
    }
};

struct MoeTab { const LAS int* cnt; const LAS int* tp; };
__device__ __forceinline__ void moe_build_tab(LAS int* tab, const int* tot) {
    if (threadIdx.x == 0) { int t = 0; for (int e = 0; e < NE; ++e) { const int c = tot[e]; tab[e] = c; tab[32 + e] = t; t += (c + 255) >> 8; } tab[64] = t; }
    __syncthreads();
}
__device__ __forceinline__ bool moe_unit(const LAS int* tab, int L, int ntn, Unit& u) {
    const int gt = L / ntn; if (gt >= __builtin_amdgcn_readfirstlane(tab[64])) return false;
    const int ln = (int)__builtin_amdgcn_mbcnt_hi(~0u, __builtin_amdgcn_mbcnt_lo(~0u, 0u));
    const int tpv = tab[32 + (ln & 31)];
    const int e = __builtin_amdgcn_readfirstlane(__popcll(__ballot(tpv <= gt) & 0xffffffffull)) - 1;
    const int tpe = __builtin_amdgcn_readfirstlane(tab[32 + e]), cnt = __builtin_amdgcn_readfirstlane(tab[e]);
    u.e = e; u.pm = gt - tpe; u.pn = L % ntn; u.tbase = gt * 256; const int rem = cnt - 256 * u.pm; u.nrows = rem < 256 ? rem : 256; u.ks = (ntn == 8) ? (2 * u.pn + 4 * (gt & 3)) : (4 * u.pn + 2 * (gt & 7)); return true;
}

struct PbGU {
    static constexpr bool F8 = true;
    const char* A; const char* B; int K;
    const LAS int* tab; const int* list; const float* bgu; unsigned char* act;
    __device__ __forceinline__ bool next(int i, int bid, int nblk, Unit& u) const { return moe_unit(tab, i * nblk + bid, 8, u); }
    __device__ __forceinline__ int a_row(const Unit& u, int r) const { const int v = list[(size_t)u.e * NTOK + 256 * u.pm + lperm(r)]; return r < u.nrows ? (v >> 2) : 0; }
    __device__ __forceinline__ void a_rows4(const Unit& u, int r0, int (&rows)[4]) const {
        const int4 v = *(const int4*)(list + (size_t)u.e * NTOK + 256 * u.pm + 4 * r0);
        rows[0] = (r0 < u.nrows) ? (v.x >> 2) : 0; rows[1] = (r0 + 64 < u.nrows) ? (v.y >> 2) : 0; rows[2] = (r0 + 128 < u.nrows) ? (v.z >> 2) : 0; rows[3] = (r0 + 192 < u.nrows) ? (v.w >> 2) : 0; }
    __device__ __forceinline__ int b_rowc(int rho) const { const int i = rho & 127; return ((rho >> 7) ? 1024 : 0) + (i & ~31) + perm32(i & 31); }
    __device__ __forceinline__ int b_base_row(const Unit& u) const { return u.e * 2048 + 128 * u.pn; }
    __device__ __forceinline__ int b_row(const Unit& u, int rho) const { return b_base_row(u) + b_rowc(rho); }
    __device__ __forceinline__ void epi(const Acc& acc, const Unit& u, int, int, int, int) const {
        const int t_ = opaque_tid(), w_ = __builtin_amdgcn_readfirstlane(t_ >> 6), wr = w_ >> 2, wc = w_ & 3, fr = t_ & 15, fq = (t_ >> 4) & 3;
        const int col0 = 128 * u.pn + 32 * wc + 8 * fq;
        f32x4 bg[2], bu[2];
#pragma unroll
        for (int n = 0; n < 2; ++n) { bg[n] = *(const f32x4*)(bgu + (size_t)u.e * 2048 + col0 + 4 * n); bu[n] = *(const f32x4*)(bgu + (size_t)u.e * 2048 + 1024 + col0 + 4 * n); }
#pragma unroll
        for (int ai = 0; ai < 2; ++ai)
#pragma unroll
            for (int m = 0; m < 4; ++m) {
                const int r = 128 * ai + 64 * wr + 16 * m + fr;
                float o[8];
#pragma unroll
                for (int n = 0; n < 2; ++n)
#pragma unroll
                    for (int j = 0; j < 4; ++j) {
                        float g = acc[ai][0][m][n][j] * WUNSCALE + bg[n][j], uu = acc[ai][1][m][n][j] * WUNSCALE + bu[n][j];
                        g = fminf(g, 7.0f); uu = fminf(fmaxf(uu, -7.0f), 7.0f);
                        const float sg = __builtin_amdgcn_rcpf(1.0f + __builtin_amdgcn_exp2f(-1.702f * LOG2E * g));
                        o[4 * n + j] = g * sg * (uu + 1.0f);
                    }
                u32x2 w; w.x = cvt_pk4_fp8(o[0], o[1], o[2], o[3]); w.y = cvt_pk4_fp8(o[4], o[5], o[6], o[7]);
                *(u32x2*)(act + (size_t)(u.tbase + r) * 1024 + col0) = w;
            }
    }
};

struct PbDown {
    static constexpr bool F8 = true;
    const char* A; const char* B; int K;
    const LAS int* tab; const int* list; const float* bdn; bf16* ybuf;
    __device__ __forceinline__ bool next(int i, int bid, int nblk, Unit& u) const { return moe_unit(tab, i * nblk + bid, 4, u); }
    __device__ __forceinline__ int a_row(const Unit& u, int r) const { return u.tbase + r; }
    __device__ __forceinline__ void a_rows4(const Unit& u, int r0, int (&rows)[4]) const { for (int j = 0; j < 4; ++j) rows[j] = u.tbase + r0 + 64 * j; }
    __device__ __forceinline__ int b_rowc(int rho) const { return (rho & ~31) + perm32(rho & 31); }
    __device__ __forceinline__ int b_base_row(const Unit& u) const { return u.e * 1024 + 256 * u.pn; }
    __device__ __forceinline__ int b_row(const Unit& u, int rho) const { return b_base_row(u) + b_rowc(rho); }
    __device__ __forceinline__ void epi(const Acc& acc, const Unit& u, int, int, int, int) const {
        const int t_ = opaque_tid(), w_ = __builtin_amdgcn_readfirstlane(t_ >> 6), wr = w_ >> 2, wc = w_ & 3, fr = t_ & 15, fq = (t_ >> 4) & 3;
        const int col0 = 256 * u.pn + 32 * wc + 8 * fq;
        f32x4 bv[2][2];
#pragma unroll
        for (int bj = 0; bj < 2; ++bj)
#pragma unroll
            for (int n = 0; n < 2; ++n) bv[bj][n] = *(const f32x4*)(bdn + (size_t)u.e * 1024 + col0 + 128 * bj + 4 * n);
        int dst8[8];
#pragma unroll
        for (int q = 0; q < 8; ++q) dst8[q] = list[(size_t)u.e * NTOK + 256 * u.pm + lperm(128 * (q >> 2) + 64 * wr + 16 * (q & 3) + fr)];
#pragma unroll
        for (int ai = 0; ai < 2; ++ai)
#pragma unroll
            for (int m = 0; m < 4; ++m) {
                const int r = 128 * ai + 64 * wr + 16 * m + fr;
                if (r < u.nrows) {
                    const int dest = dst8[ai * 4 + m];
#pragma unroll
                    for (int bj = 0; bj < 2; ++bj) {
                        const f32x4 v0 = acc[ai][bj][m][0] * WUNSCALE + bv[bj][0], v1 = acc[ai][bj][m][1] * WUNSCALE + bv[bj][1];
                        u32x4 w; w.x = cvt_pk_bf16(v0.x, v0.y); w.y = cvt_pk_bf16(v0.z, v0.w); w.z = cvt_pk_bf16(v1.x, v1.y); w.w = cvt_pk_bf16(v1.z, v1.w);
                        *(u32x4*)(ybuf + (size_t)dest * 1024 + col0 + 128 * bj) = w;
                    }
                }
            }
    }
};

__device__ __forceinline__ s16x4 lds_tr16(const LAS unsigned char* p) { return __builtin_bit_cast(s16x4, __builtin_amdgcn_ds_read_tr16_b64_v4i16((LAS s16x4*)p)); }

__device__ __forceinline__ void attn_phase(const Params& P, LAS unsigned char* lds, int l, int bid, int nblk) {
    const int tid = opaque_tid(), wid = __builtin_amdgcn_readfirstlane(tid >> 6), lane = tid & 63, r32 = lane & 31, hi = lane >> 5;
    unsigned char* ws = P.ws;
    const bf16* proj = (const bf16*)(ws + WS_PROJ);
    bf16* mix = (bf16*)(ws + WS_MIX);
    constexpr int KP = 144;
    LAS unsigned char* sK = lds; LAS unsigned char* sV = lds + 256 * KP;
    for (int unit = bid; unit < NB * 64 * 2; unit += nblk) {
        const int kvh = unit & 1, n = (unit >> 1) & 63, b = unit >> 7;
        const int tok0 = b * SEQ + n * 128 - 128;
        __syncthreads();
#pragma unroll
        for (int j = 0; j < 4; ++j) {
            const int q = tid + NT * j, key = q >> 3, c8 = q & 7;
            u32x4 kv = (u32x4){0u, 0u, 0u, 0u}, vv = (u32x4){0u, 0u, 0u, 0u};
            if (n > 0 || key >= 128) { const bf16* src = proj + (size_t)(tok0 + key) * NIN + 512 + kvh * 64 + c8 * 8; kv = *(const u32x4*)src; vv = *(const u32x4*)(src + 128); }
            *(LAS u32x4*)(sK + key * KP + c8 * 16) = kv; *(LAS u32x4*)(sV + key * KP + c8 * 16) = vv;
        }
        __syncthreads();
        const int hq = kvh * 4 + (wid >> 1);
        const float sink2 = P.sinks[l * 8 + hq] * LOG2E;
#pragma unroll 1
        for (int qt = 0; qt < 2; ++qt) {
            const int q0 = 64 * (wid & 1) + 32 * qt, qi = q0 + r32;
            const size_t qtok = (size_t)b * SEQ + n * 128 + qi;
            bf16x8 qf[4];
#pragma unroll
            for (int s = 0; s < 4; ++s) qf[s] = *(const bf16x8*)(proj + qtok * NIN + hq * 64 + 16 * s + 8 * hi);
            f32x16 st[5];
#pragma unroll
            for (int kt = 0; kt < 5; ++kt) {
#pragma unroll
                for (int r = 0; r < 16; ++r) st[kt][r] = 0.f;
#pragma unroll
                for (int s = 0; s < 4; ++s) { const bf16x8 kf = *(const LAS bf16x8*)(sK + (q0 + 32 * kt + r32) * KP + (16 * s + 8 * hi) * 2); st[kt] = __builtin_amdgcn_mfma_f32_32x32x16_bf16(kf, qf[s], st[kt], 0, 0, 0); }
            }
            float mx = sink2;
#pragma unroll
            for (int kt = 0; kt < 5; ++kt)
#pragma unroll
                for (int r = 0; r < 16; ++r) {
                    const int kj = q0 + 32 * kt + (r & 3) + 8 * (r >> 2) + 4 * hi;
                    const bool ok = (kj > qi) && (kj <= qi + 128) && (n > 0 || kj >= 128);
                    const float s = ok ? st[kt][r] : -__builtin_inff(); st[kt][r] = s; mx = fmaxf(mx, s);
                }
            mx = max_x32(mx);
            float sum = 0.f;
#pragma unroll
            for (int kt = 0; kt < 5; ++kt)
#pragma unroll
                for (int r = 0; r < 16; ++r) { const float p = __builtin_amdgcn_exp2f(st[kt][r] - mx); st[kt][r] = p; sum += p; }
            sum = sum_x32(sum);
            sum += __builtin_amdgcn_exp2f(sink2 - mx);
            f32x16 o[2];
#pragma unroll
            for (int dt = 0; dt < 2; ++dt)
#pragma unroll
                for (int r = 0; r < 16; ++r) o[dt][r] = 0.f;
#pragma unroll
            for (int kt = 0; kt < 5; ++kt)
#pragma unroll
                for (int s2 = 0; s2 < 2; ++s2) {
                    u32x4 pw; pw.x = cvt_pk_bf16(st[kt][8 * s2 + 0], st[kt][8 * s2 + 1]); pw.y = cvt_pk_bf16(st[kt][8 * s2 + 2], st[kt][8 * s2 + 3]);
                    pw.z = cvt_pk_bf16(st[kt][8 * s2 + 4], st[kt][8 * s2 + 5]); pw.w = cvt_pk_bf16(st[kt][8 * s2 + 6], st[kt][8 * s2 + 7]);
                    const bf16x8 pf = __builtin_bit_cast(bf16x8, pw);
                    const int kb = q0 + 32 * kt + 16 * s2 + 4 * hi, i16 = lane & 15;
#pragma unroll
                    for (int dt = 0; dt < 2; ++dt) {
                        const int d0 = 32 * dt + 16 * ((lane >> 4) & 1);
                        const LAS unsigned char* a0 = sV + (kb + (i16 >> 2)) * KP + (d0 + 4 * (i16 & 3)) * 2;
                        const s16x4 v0 = lds_tr16(a0), v1 = lds_tr16(a0 + 8 * KP);
                        bf16x8 vf; vf[0] = v0[0]; vf[1] = v0[1]; vf[2] = v0[2]; vf[3] = v0[3]; vf[4] = v1[0]; vf[5] = v1[1]; vf[6] = v1[2]; vf[7] = v1[3];
                        o[dt] = __builtin_amdgcn_mfma_f32_32x32x16_bf16(vf, pf, o[dt], 0, 0, 0);
                    }
                }
            const float inv = 1.0f / sum;
#pragma unroll
            for (int dt = 0; dt < 2; ++dt)
#pragma unroll
                for (int g4 = 0; g4 < 4; ++g4) {
                    u32x2 w; w.x = cvt_pk_bf16(o[dt][4 * g4 + 0] * inv, o[dt][4 * g4 + 1] * inv); w.y = cvt_pk_bf16(o[dt][4 * g4 + 2] * inv, o[dt][4 * g4 + 3] * inv);
                    *(u32x2*)(mix + qtok * D + hq * 64 + 32 * dt + 8 * g4 + 4 * hi) = w;
                }
        }
    }
    for (int ch = bid * 8 + wid; ch < NTOK / 32; ch += nblk * 8) {
        const int t0 = ch * 32, p0 = t0 & (SEQ - 1);
        const int col = 8 * lane, g = lane >> 4, w = 2 << g;
        float pb_[8], ps_[8];
#pragma unroll
        for (int i = 0; i < 8; i += 4) { const f32x4 a = *(const f32x4*)(P.pool_b + l * 512 + col + i), s = *(const f32x4*)(P.pool_s + l * 512 + col + i);
            pb_[i] = a.x; pb_[i + 1] = a.y; pb_[i + 2] = a.z; pb_[i + 3] = a.w; ps_[i] = s.x; ps_[i + 1] = s.y; ps_[i + 2] = s.z; ps_[i + 3] = s.w; }
        float sum[8];
#pragma unroll
        for (int i = 0; i < 8; ++i) sum[i] = 0.f;
        for (int j = 1; j < w; ++j) if (p0 - j >= 0) {
            const u32x4 z = *(const u32x4*)(proj + (size_t)(t0 - j) * NIN + 768 + col);
            sum[0] += bf_lo(z.x); sum[1] += bf_hi(z.x); sum[2] += bf_lo(z.y); sum[3] += bf_hi(z.y); sum[4] += bf_lo(z.z); sum[5] += bf_hi(z.z); sum[6] += bf_lo(z.w); sum[7] += bf_hi(z.w);
        }
        for (int t = 0; t < 32; ++t) {
            const u32x4 z = *(const u32x4*)(proj + (size_t)(t0 + t) * NIN + 768 + col);
            float zz[8] = {bf_lo(z.x), bf_hi(z.x), bf_lo(z.y), bf_hi(z.y), bf_lo(z.z), bf_hi(z.z), bf_lo(z.w), bf_hi(z.w)};
            const int pos = p0 + t; const float ic = 1.0f / (float)((pos + 1 < w) ? (pos + 1) : w);
            float o[8];
#pragma unroll
            for (int i = 0; i < 8; ++i) { sum[i] += zz[i]; o[i] = (sum[i] * ic - zz[i] + pb_[i]) * ps_[i]; }
            u32x4 ow; ow.x = cvt_pk_bf16(o[0], o[1]); ow.y = cvt_pk_bf16(o[2], o[3]); ow.z = cvt_pk_bf16(o[4], o[5]); ow.w = cvt_pk_bf16(o[6], o[7]);
            *(u32x4*)(mix + (size_t)(t0 + t) * D + 512 + col) = ow;
            if (pos - w + 1 >= 0) {
                const u32x4 y = *(const u32x4*)(proj + (size_t)(t0 + t - w + 1) * NIN + 768 + col);
                sum[0] -= bf_lo(y.x); sum[1] -= bf_hi(y.x); sum[2] -= bf_lo(y.y); sum[3] -= bf_hi(y.y); sum[4] -= bf_lo(y.z); sum[5] -= bf_hi(y.z); sum[6] -= bf_lo(y.w); sum[7] -= bf_hi(y.w);
            }
        }
    }
}

__device__ __forceinline__ void router_phase(const Params& P, LAS unsigned char* lds, int l, int bid, int nblk) {
    const int tid = opaque_tid(), wid = __builtin_amdgcn_readfirstlane(tid >> 6), lane = tid & 63, fr = lane & 15, fq = lane >> 4;
    unsigned char* ws = P.ws;
    const float* mod = (const float*)(ws + WS_MOD);
    bf16* H = (bf16*)(ws + WS_H);
    float* gates = (float*)(ws + WS_GATES);
    int* list = (int*)(ws + WS_LIST);
    constexpr int RP = 2064;
    LAS unsigned char* rwT = lds;
    LAS float* lg = (LAS float*)(lds + 66048);
    LAS unsigned long long* emask = (LAS unsigned long long*)(lds + 66048 + 33792);
    LAS unsigned short* sel = (LAS unsigned short*)(emask + 128);
    __syncthreads();
    for (int idx = tid; idx < 1024 * 32; idx += NT) { const int k = idx >> 5, e = idx & 31; const float v = P.rw[(size_t)l * 32768 + idx];
        *(LAS unsigned short*)(rwT + e * RP + k * 2) = (unsigned short)(cvt_pk_bf16(v, 0.f) & 0xffffu); }
    for (int tile = bid; tile < NTOK / 256; tile += nblk) {
        const int tok0 = tile * 256, b = tok0 >> 13;
        {
            f32x4 ca[4], cc[4];
#pragma unroll
            for (int j = 0; j < 4; ++j) { const int col = 256 * j + 4 * lane; const f32x4 g = *(const f32x4*)(P.n2g + l * D + col); const f32x4 sc = *(const f32x4*)(mod + (size_t)(l * NB + b) * NMOD + 4 * D + col);
                ca[j] = g * (1.0f + sc); cc[j] = *(const f32x4*)(mod + (size_t)(l * NB + b) * NMOD + 3 * D + col); }
            for (int rr = 0; rr < 32; ++rr) {
                const int row = tok0 + wid * 32 + rr;
                f32x4 v[4]; float ss = 0.f;
#pragma unroll
                for (int j = 0; j < 4; ++j) { v[j] = *(const f32x4*)(P.out + (size_t)row * D + 256 * j + 4 * lane); ss += (v[j].x * v[j].x + v[j].y * v[j].y) + (v[j].z * v[j].z + v[j].w * v[j].w); }
                const float rstd = 1.0f / sqrtf(wave_sum(ss) * (1.0f / D) + EPS);
#pragma unroll
                for (int j = 0; j < 4; ++j) { const f32x4 h = v[j] * rstd * ca[j] + cc[j]; u32x2 o; o.x = cvt_pk_bf16(h.x, h.y); o.y = cvt_pk_bf16(h.z, h.w); *(u32x2*)(H + (size_t)row * D + 256 * j + 4 * lane) = o;
                    *(unsigned*)(ws + WS_H8 + (size_t)row * D + 256 * j + 4 * lane) = cvt_pk4_fp8(h.x, h.y, h.z, h.w); }
            }
        }
        asm volatile("s_waitcnt vmcnt(0)" ::: "memory");
        __syncthreads();
#pragma unroll 1
        for (int rg = 0; rg < 2; ++rg) {
            f32x4 a0 = (f32x4){0.f, 0.f, 0.f, 0.f}, a1 = a0;
            const bf16* hp = H + (size_t)(tok0 + 32 * wid + 16 * rg + fr) * D + 8 * fq;
            for (int s = 0; s < 32; ++s) {
                const bf16x8 af = *(const bf16x8*)(hp + 32 * s);
                const bf16x8 b0 = *(const LAS bf16x8*)(rwT + fr * RP + (32 * s + 8 * fq) * 2), b1 = *(const LAS bf16x8*)(rwT + (16 + fr) * RP + (32 * s + 8 * fq) * 2);
                a0 = __builtin_amdgcn_mfma_f32_16x16x32_bf16(af, b0, a0, 0, 0, 0); a1 = __builtin_amdgcn_mfma_f32_16x16x32_bf16(af, b1, a1, 0, 0, 0);
            }
            const float rb0 = P.rb[l * 32 + fr], rb1 = P.rb[l * 32 + 16 + fr];
#pragma unroll
            for (int r = 0; r < 4; ++r) { const int row = 32 * wid + 16 * rg + 4 * fq + r; lg[row * 33 + fr] = a0[r] + rb0; lg[row * 33 + 16 + fr] = a1[r] + rb1; }
        }
        __syncthreads();
        if (tid < 256) {
            float v[32];
#pragma unroll
            for (int e = 0; e < 32; ++e) v[e] = lg[tid * 33 + e];
            float tv[4]; int ti[4];
#pragma unroll
            for (int k = 0; k < 4; ++k) {
                float best = -__builtin_inff(); int bi = 0;
#pragma unroll
                for (int e = 0; e < 32; ++e) { const bool gt = v[e] > best; best = gt ? v[e] : best; bi = gt ? e : bi; }
                tv[k] = best; ti[k] = bi;
#pragma unroll
                for (int e = 0; e < 32; ++e) v[e] = (e == bi) ? -__builtin_inff() : v[e];
            }
            const float e1 = __expf(tv[1] - tv[0]), e2 = __expf(tv[2] - tv[0]), e3 = __expf(tv[3] - tv[0]);
            const float inv = 1.0f / (1.0f + e1 + e2 + e3);
            *(f32x4*)(gates + (size_t)(tok0 + tid) * 4) = (f32x4){inv, e1 * inv, e2 * inv, e3 * inv};
#pragma unroll
            for (int k = 0; k < 4; ++k) sel[tid * 4 + k] = (unsigned short)ti[k];
#pragma unroll
            for (int e = 0; e < 32; ++e) { const unsigned long long m = __ballot((ti[0] == e) | (ti[1] == e) | (ti[2] == e) | (ti[3] == e)); if (lane == 0) emask[e * 4 + wid] = m; }
        }
        __syncthreads();
        if (tid < 256) {
            int* selg = (int*)(ws + WS_SEL);
            const unsigned long long lt = (1ull << lane) - 1ull;
            int so[4];
#pragma unroll
            for (int k = 0; k < 4; ++k) {
                const int e = sel[tid * 4 + k]; int r = 0;
                for (int w = 0; w < 4; ++w) { const unsigned long long m = emask[e * 4 + w]; r += (w < wid) ? __popcll(m) : ((w == wid) ? __popcll(m & lt) : 0); }
                so[k] = (e << 16) | r;
            }
            *(int4*)(selg + (size_t)(tok0 + tid) * 4) = make_int4(so[0], so[1], so[2], so[3]);
        }
        if (tid < 32) { int c = 0; for (int w = 0; w < 4; ++w) c += __popcll(emask[tid * 4 + w]); ((int*)(ws + WS_CNTB))[(size_t)(l * 256 + tile) * 32 + tid] = c; }
        __syncthreads();
    }
}

__device__ __forceinline__ void place_phase(const Params& P, LAS unsigned char* lds, int l, int bid, int nblk) {
    const int tid = opaque_tid();
    unsigned char* ws = P.ws;
    const int* cntb = (const int*)(ws + WS_CNTB) + (size_t)l * 256 * 32;
    const int* selg = (const int*)(ws + WS_SEL);
    int* list = (int*)(ws + WS_LIST);
    LAS int* red = (LAS int*)lds;
    LAS int* base = red + 512;
    const int e = tid & 31, part = tid >> 5;
    __syncthreads();
    for (int tile = bid; tile < NTOK / 256 + 1; tile += nblk) {
        int s = 0;
        for (int q = 0; q < 16; ++q) { const int t = part * 16 + q; if (t < tile) s += cntb[t * 32 + e]; }
        red[part * 32 + e] = s;
        __syncthreads();
        if (tid < 32) { int b = 0; for (int p = 0; p < 16; ++p) b += red[p * 32 + tid]; base[tid] = b; if (tile == NTOK / 256) ((int*)(ws + WS_TOT))[l * 32 + tid] = b; }
        __syncthreads();
        if (tile < NTOK / 256 && tid < 256) {
            const int tok = tile * 256 + tid; const int4 v = *(const int4*)(selg + (size_t)tok * 4);
            const int vv[4] = {v.x, v.y, v.z, v.w};
#pragma unroll
            for (int k = 0; k < 4; ++k) { const int ee = vv[k] >> 16, r = vv[k] & 0xffff; { const int rk = base[ee] + r; list[(size_t)ee * NTOK + (rk & ~255) + lperm(rk & 255)] = tok * 4 + k; } }
        }
        __syncthreads();
    }
}

constexpr int BK = 64, HALF = 128, HTB = HALF * BK * 2;
__device__ __forceinline__ int lds_byte(int r, int c) { const int st = (r >> 4) * 2 + (c >> 5), rr = r & 15, cc = c & 31, ob = rr * 64 + cc * 2; return st * 1024 + (ob ^ (((ob >> 9) & 1) << 5)); }
__device__ __forceinline__ void stage_rc(int b, int& R, int& C) { const int st = b / 1024, sb = b % 1024, swz = sb ^ (((sb >> 9) & 1) << 5); R = (st >> 1) * 16 + swz / 64; C = (st & 1) * 32 + (swz % 64) / 2; }

template <bool F8> struct FragT;
template <> struct FragT<false> {
    struct A { bf16x8 k[2]; };
    static __device__ __forceinline__ void load(A& d, const LAS unsigned char* p) { d.k[0] = *(const LAS bf16x8*)p; d.k[1] = *(const LAS bf16x8*)(p + 1024); }
    static __device__ __forceinline__ f32x4 mma(const A& a, const A& b, f32x4 c) { c = __builtin_amdgcn_mfma_f32_16x16x32_bf16(a.k[0], b.k[0], c, 0, 0, 0); return __builtin_amdgcn_mfma_f32_16x16x32_bf16(a.k[1], b.k[1], c, 0, 0, 0); }
};
template <> struct FragT<true> {
    typedef i32x8 A;
    static __device__ __forceinline__ void load(A& d, const LAS unsigned char* p) { const i32x4 lo = *(const LAS i32x4*)p, hi = *(const LAS i32x4*)(p + 1024); d = __builtin_shufflevector(lo, hi, 0, 1, 2, 3, 4, 5, 6, 7); }
    static __device__ __forceinline__ f32x4 mma(const A& a, const A& b, f32x4 c) { const int one = 0x7f7f7f7f;
        asm volatile("v_mfma_scale_f32_16x16x128_f8f6f4 %0, %1, %2, %0, %3, %3 op_sel_hi:[0,0,0]" : "+v"(c) : "v"(a), "v"(b), "v"(one)); return c; }
};
template <class Pb>
__device__ __forceinline__ void gemm_phase8(LAS unsigned char* lds, const Pb& pb, int bid, int nblk) {
    const int tid = opaque_tid(), wid = __builtin_amdgcn_readfirstlane(tid >> 6), lane = tid & 63, wr = wid >> 2, wc = wid & 3, fr = lane & 15, fq = lane >> 4;
    constexpr bool F8 = Pb::F8;
    const int RB = F8 ? pb.K : pb.K * 2;
    const int nt = RB / 128;
    int Rp[2], Cp[2];
#pragma unroll
    for (int i = 0; i < 2; ++i) stage_rc(tid * 16 + i * 8192, Rp[i], Cp[i]);
    unsigned voB[2][2];
#pragma unroll
    for (int h = 0; h < 2; ++h)
#pragma unroll
        for (int i = 0; i < 2; ++i) voB[h][i] = (unsigned)pb.b_rowc(128 * h + Rp[i]) * (unsigned)RB + (unsigned)Cp[i] * 2u;
    const unsigned ldsw = (unsigned)wid * 1024u;
    const int aoff = lds_byte(wr * 64 + fr, fq * 8), boff = lds_byte(wc * 32 + fr, fq * 8);
#define PG8_SA(b, h) (((b) * 2 + (h)) * HTB)
#define PG8_SB(b, h) ((4 + (b) * 2 + (h)) * HTB)
#define PG8_STAGE(bufoff, rsrc, soff, voff) do { _Pragma("unroll") for (int _i = 0; _i < 2; ++_i) \
        __builtin_amdgcn_raw_ptr_buffer_load_lds(rsrc, (LAS unsigned*)(lds + (bufoff) + ldsw + _i * 8192), 16, (int)(voff)[_i], (int)(soff), 0, 0); } while (0)
#define PG8_LDA(dst, b, h) do { _Pragma("unroll") for (int m = 0; m < 4; ++m) FragT<F8>::load(dst[m], lds + PG8_SA(b, h) + aoff + m * 2048); } while (0)
#define PG8_LDB(dst, b, h) do { _Pragma("unroll") for (int n = 0; n < 2; ++n) FragT<F8>::load(dst[n], lds + PG8_SB(b, h) + boff + n * 2048); } while (0)
#define PG8_MMA(ai, bj, At, Bt) do { __builtin_amdgcn_s_setprio(1); _Pragma("unroll") for (int m = 0; m < 4; ++m) _Pragma("unroll") for (int n = 0; n < 2; ++n) \
        acc[ai][bj][m][n] = FragT<F8>::mma(Bt[n], At[m], acc[ai][bj][m][n]); __builtin_amdgcn_s_setprio(0); } while (0)
#define PG8_WAIT_V(n) asm volatile("s_waitcnt vmcnt(" #n ")" ::: "memory")
#define PG8_WAIT_L(n) asm volatile("s_waitcnt lgkmcnt(" #n ")" ::: "memory")
#define PG8_BAR __builtin_amdgcn_s_barrier()
#define PG8_SCHED __builtin_amdgcn_sched_barrier(0)
#define PG8_VOA(dst, un) do { int _r[4]; pb.a_rows4(un, Rp[0], _r); _Pragma("unroll") for (int h = 0; h < 2; ++h) _Pragma("unroll") for (int i = 0; i < 2; ++i) dst[h][i] = (unsigned)_r[2 * h + i] * (unsigned)RB + (unsigned)Cp[i] * 2u; } while (0)
    Unit cur, nxt; int ui = 0;
    if (!pb.next(0, bid, nblk, cur)) return;
    Acc acc;
#pragma unroll
    for (int a = 0; a < 2; ++a)
#pragma unroll
        for (int b = 0; b < 2; ++b)
#pragma unroll
            for (int m = 0; m < 4; ++m)
#pragma unroll
                for (int n = 0; n < 2; ++n) acc[a][b][m][n] = (f32x4){0.f, 0.f, 0.f, 0.f};
    typename FragT<F8>::A At[4]; typename FragT<F8>::A B0[2], B1[2];
    unsigned voAc[2][2], voAn[2][2];
    PG8_VOA(voAc, cur);
    const __amdgpu_buffer_rsrc_t rA = __builtin_amdgcn_make_buffer_rsrc((void*)pb.A, 0, 0x7fffffff, 0x00020000), rB = __builtin_amdgcn_make_buffer_rsrc((void*)pb.B, 0, 0x7fffffff, 0x00020000);
    unsigned cB = (unsigned)pb.b_base_row(cur) * (unsigned)RB;
    { const unsigned k0 = (unsigned)(cur.ks & (nt - 1)) * 128u, k1 = (unsigned)((cur.ks + 1) & (nt - 1)) * 128u;
    PG8_STAGE(PG8_SB(0, 0), rB, cB + k0, voB[0]); PG8_STAGE(PG8_SB(0, 1), rB, cB + k0, voB[1]); PG8_STAGE(PG8_SA(0, 0), rA, k0, voAc[0]); PG8_STAGE(PG8_SA(0, 1), rA, k0, voAc[1]);
    if (wr == 1) PG8_BAR;
    PG8_WAIT_V(2); PG8_BAR;
    PG8_STAGE(PG8_SB(1, 0), rB, cB + k1, voB[0]); PG8_STAGE(PG8_SA(1, 0), rA, k1, voAc[0]); PG8_STAGE(PG8_SB(1, 1), rB, cB + k1, voB[1]); }
    PG8_WAIT_V(6); PG8_BAR;
    for (;;) {
        const bool has_next = pb.next(ui + 1, bid, nblk, nxt);
        unsigned nB = cB; int nks = cur.ks;
        if (has_next) { PG8_VOA(voAn, nxt); nB = (unsigned)pb.b_base_row(nxt) * (unsigned)RB; nks = nxt.ks; }
        else {
#pragma unroll
            for (int h = 0; h < 2; ++h)
#pragma unroll
                for (int i = 0; i < 2; ++i) voAn[h][i] = voAc[h][i]; }
        for (int t = 0; t < nt; t += 2) {
            const bool last = (t == nt - 2);
            const unsigned a1 = (unsigned)((t + 1 + cur.ks) & (nt - 1)) * 128u;
            const int ks2 = last ? nks : (t + 2 + cur.ks);
            const unsigned a2 = (unsigned)(ks2 & (nt - 1)) * 128u, a3 = (unsigned)((ks2 + 1) & (nt - 1)) * 128u;
            const unsigned bb = last ? nB : cB;
            const unsigned b2 = bb + a2, b3 = bb + a3;
            unsigned sa[2][2];
#pragma unroll
            for (int h = 0; h < 2; ++h)
#pragma unroll
                for (int i = 0; i < 2; ++i) sa[h][i] = last ? voAn[h][i] : voAc[h][i];
            PG8_LDB(B0, 0, 0); PG8_LDB(B1, 0, 1); PG8_SCHED; PG8_LDA(At, 0, 0); PG8_STAGE(PG8_SA(1, 1), rA, a1, voAc[1]);
            PG8_WAIT_V(8); PG8_WAIT_L(0); PG8_BAR; PG8_MMA(0, 0, At, B0); PG8_MMA(0, 1, At, B1); PG8_BAR; PG8_SCHED;
            PG8_LDA(At, 0, 1); PG8_STAGE(PG8_SB(0, 0), rB, b2, voB[0]); PG8_STAGE(PG8_SB(0, 1), rB, b2, voB[1]); PG8_STAGE(PG8_SA(0, 0), rA, a2, sa[0]);
            PG8_WAIT_V(8); PG8_WAIT_L(0); PG8_BAR; PG8_MMA(1, 0, At, B0); PG8_MMA(1, 1, At, B1); PG8_BAR; PG8_SCHED;
            PG8_LDB(B0, 1, 0); PG8_LDB(B1, 1, 1); PG8_SCHED; PG8_LDA(At, 1, 0); PG8_STAGE(PG8_SA(0, 1), rA, a2, sa[1]);
            PG8_WAIT_V(8); PG8_WAIT_L(0); PG8_BAR; PG8_MMA(0, 0, At, B0); PG8_MMA(0, 1, At, B1); PG8_BAR; PG8_SCHED;
            PG8_LDA(At, 1, 1); PG8_STAGE(PG8_SB(1, 0), rB, b3, voB[0]); PG8_STAGE(PG8_SB(1, 1), rB, b3, voB[1]); PG8_STAGE(PG8_SA(1, 0), rA, a3, sa[0]);
            PG8_WAIT_V(8); PG8_WAIT_L(0); PG8_BAR; PG8_MMA(1, 0, At, B0); PG8_MMA(1, 1, At, B1); PG8_BAR; PG8_SCHED;
        }
        if (wr == 0) PG8_BAR;
        if constexpr (F8) asm volatile("s_nop 15\n\ts_nop 15" ::: "memory");
        pb.epi(acc, cur, wr, wc, fr, fq);
        if (!has_next) break;
#pragma unroll
        for (int a = 0; a < 2; ++a)
#pragma unroll
            for (int b = 0; b < 2; ++b)
#pragma unroll
                for (int m = 0; m < 4; ++m)
#pragma unroll
                    for (int n = 0; n < 2; ++n) acc[a][b][m][n] = (f32x4){0.f, 0.f, 0.f, 0.f};
        cur = nxt; cB = nB; ++ui;
#pragma unroll
        for (int h = 0; h < 2; ++h)
#pragma unroll
            for (int i = 0; i < 2; ++i) voAc[h][i] = voAn[h][i];
        if (wr == 1) PG8_BAR;
    }
    PG8_WAIT_V(0);
    PG8_BAR;
#undef PG8_SA
#undef PG8_SB
#undef PG8_STAGE
#undef PG8_LDA
#undef PG8_LDB
#undef PG8_MMA
#undef PG8_WAIT_V
#undef PG8_WAIT_L
#undef PG8_BAR
#undef PG8_SCHED
#undef PG8_VOA
}

#ifndef FAST_INPROJ
#define FAST_INPROJ 1
#endif
#ifndef FAST_OUTPROJ
#define FAST_OUTPROJ 1
#endif
#ifndef FAST_GU
#define FAST_GU 1
#endif
#ifndef FAST_DOWN
#define FAST_DOWN 1
#endif
template <bool FAST, class Pb> __device__ __forceinline__ void gemm_run(LAS unsigned char* lds, const Pb& pb, int bid, int nblk) {
    if constexpr (FAST) gemm_phase8(lds, pb, bid, nblk); else gemm_simple(lds, pb, bid, nblk);
}

__device__ __forceinline__ void inproj_phase(const Params& P, LAS unsigned char* lds, int l, int bid, int nblk) {
    unsigned char* ws = P.ws;
    PbInProj pb; pb.A = (const char*)(ws + WS_H); pb.B = (const char*)(ws + WS_WIN) + (size_t)l * (1280 * 1024 * 2); pb.K = 1024;
    pb.proj = (bf16*)(ws + WS_PROJ); pb.qg = P.qg + l * 64; pb.kg = P.kg + l * 64; pb.rope = (const float*)(ws + WS_ROPE);
    gemm_run<FAST_INPROJ>(lds, pb, bid, nblk);
}
__device__ __forceinline__ void outproj_phase(const Params& P, LAS unsigned char* lds, int l, int bid, int nblk) {
    unsigned char* ws = P.ws;
    PbOutProj pb; pb.A = (const char*)(ws + WS_MIX); pb.B = (const char*)(ws + WS_WOUT) + (size_t)l * (1024 * 1024 * 2); pb.K = 1024;
    pb.xin = (l == 0) ? P.x : P.out; pb.xout = P.out; pb.gate1 = (const float*)(ws + WS_MOD) + (size_t)l * NB * NMOD + 2 * D;
    gemm_run<FAST_OUTPROJ>(lds, pb, bid, nblk);
}
__device__ __forceinline__ void gu_phase(const Params& P, LAS unsigned char* lds, int l, int bid, int nblk) {
    unsigned char* ws = P.ws;
    LAS int* tab = (LAS int*)(lds + 131072);
    __syncthreads();
    moe_build_tab(tab, (const int*)(ws + WS_TOT) + l * 32);
    PbGU pb; pb.A = (const char*)(ws + WS_H8); pb.B = (const char*)(ws + WS_WGU) + (size_t)l * 32 * (2048 * 1024); pb.K = 1024;
    pb.tab = tab; pb.list = (const int*)(ws + WS_LIST); pb.bgu = P.bgu + (size_t)l * 32 * 2048; pb.act = ws + WS_ACT;
    gemm_phase8(lds, pb, bid, nblk);
}
__device__ __forceinline__ void down_phase(const Params& P, LAS unsigned char* lds, int l, int bid, int nblk) {
    unsigned char* ws = P.ws;
    LAS int* tab = (LAS int*)(lds + 131072);
    __syncthreads();
    moe_build_tab(tab, (const int*)(ws + WS_TOT) + l * 32);
    PbDown pb; pb.A = (const char*)(ws + WS_ACT); pb.B = (const char*)(ws + WS_WDN) + (size_t)l * 32 * (1024 * 1024); pb.K = 1024;
    pb.tab = tab; pb.list = (const int*)(ws + WS_LIST); pb.bdn = P.bdn + (size_t)l * 32 * 1024; pb.ybuf = (bf16*)(ws + WS_YBUF);
    gemm_phase8(lds, pb, bid, nblk);
}

#define XB_TMO      128
#define XB_XCNT(j)  (256  + 64 * (j))
#define XB_XSUB(j)  (1280 + 64 * (j))
#define XB_XGEN(j)  (2304 + 64 * (j))
#define XB_TOP      3328
#define XB_TOPGEN   3392
#define XCD_BAR_WORDS 3456
#define XB_SPIN_CAP (1u << 18)
__device__ __forceinline__ unsigned xb_ld(unsigned* p)              { return __hip_atomic_load(p, __ATOMIC_RELAXED, __HIP_MEMORY_SCOPE_AGENT); }
__device__ __forceinline__ unsigned xb_add(unsigned* p, unsigned v) { return __hip_atomic_fetch_add(p, v, __ATOMIC_RELAXED, __HIP_MEMORY_SCOPE_AGENT); }
__device__ __forceinline__ unsigned xb_xcc_id() { return (unsigned)__builtin_amdgcn_s_getreg((3 << 11) | 20) & 0xFu; }
#define XB_SPIN(cond, bar) do { unsigned _sp = 0; while (cond) { __builtin_amdgcn_s_sleep(1); \
    if ((++_sp & 255u) == 0u) { if (xb_ld(&(bar)[XB_TMO])) break; if (_sp > XB_SPIN_CAP) { atomicAdd(&(bar)[XB_TMO], 1u); break; } } } } while (0)
struct XcdBarrier { unsigned* bar; unsigned x; volatile LAS unsigned* st; };
__device__ __forceinline__ XcdBarrier xcd_barrier_post(unsigned* bar, volatile LAS unsigned* st) {
    XcdBarrier b; b.bar = bar; b.x = xb_xcc_id(); b.st = st;
    if (threadIdx.x == 0) (void)xb_add(&bar[XB_XCNT(b.x)], 1u);
    return b;
}
__device__ __forceinline__ void xcd_barrier_complete(unsigned* bar, unsigned x, unsigned& nloc, unsigned& nx) {
    const unsigned G = gridDim.x * gridDim.y * gridDim.z;
    unsigned sum, cnt, mine, sp = 0u;
    for (;;) {
        sum = 0u; cnt = 0u; mine = 0u;
#pragma unroll
        for (unsigned j = 0; j < 16; ++j) { const unsigned c = xb_ld(&bar[XB_XCNT(j)]); sum += c; cnt += (c > 0u) ? 1u : 0u; mine = (j == x) ? c : mine; }
        if (sum == G) break;
        __builtin_amdgcn_s_sleep(1);
        if ((++sp & 255u) == 0u) { if (xb_ld(&bar[XB_TMO])) break; if (sp > XB_SPIN_CAP) { atomicAdd(&bar[XB_TMO], 1u); break; } }
    }
    nloc = mine > 0u ? mine : 1u; nx = cnt > 0u ? cnt : 1u;
}
__device__ __forceinline__ void xcd_barrier(const XcdBarrier& b) {
    asm volatile("s_waitcnt vmcnt(0)" ::: "memory");
    __syncthreads();
    if (threadIdx.x == 0) {
        unsigned* bar = b.bar; const unsigned bx = xb_xcc_id();
        __builtin_amdgcn_s_waitcnt(0);
        unsigned nloc = b.st[0], nx = b.st[1];
        if (nloc == 0u) { xcd_barrier_complete(bar, bx, nloc, nx); b.st[0] = nloc; b.st[1] = nx; }
        const unsigned old = xb_add(&bar[XB_XSUB(bx)], 1u);
        const unsigned gen = old / nloc;
        if (old + 1u == (gen + 1u) * nloc) {
            __builtin_amdgcn_fence(__ATOMIC_RELEASE, "agent");
            asm volatile("s_waitcnt vmcnt(0)" ::: "memory");
            const unsigned og = xb_add(&bar[XB_TOP], 1u);
            const unsigned tg = og / nx;
            if (og + 1u == (tg + 1u) * nx) xb_add(&bar[XB_TOPGEN], 1u);
            else XB_SPIN(xb_ld(&bar[XB_TOPGEN]) == tg, bar);
            __builtin_amdgcn_fence(__ATOMIC_ACQUIRE, "agent");
            xb_add(&bar[XB_XGEN(bx)], 1u);
            asm volatile("s_waitcnt vmcnt(0)" ::: "memory");
        } else {
            XB_SPIN(xb_ld(&bar[XB_XGEN(bx)]) == gen, bar);
            __builtin_amdgcn_fence(__ATOMIC_ACQUIRE, "agent");
            asm volatile("s_waitcnt vmcnt(0)" ::: "memory");
        }
    }
    __syncthreads();
}


#if ONE_LAUNCH
constexpr int TAB_OFF = 131072, MISC_OFF = 131072 + 512;
__global__ void __launch_bounds__(NT, 2) mega_fwd(Params P) {
    extern __shared__ __attribute__((aligned(16))) unsigned char dyn_lds[];
    LAS unsigned char* lds = (LAS unsigned char*)dyn_lds;
    volatile LAS unsigned* MISC = (volatile LAS unsigned*)(lds + MISC_OFF);
    if (threadIdx.x < 32) MISC[threadIdx.x] = 0u;
    __syncthreads();
    XcdBarrier bar = xcd_barrier_post((unsigned*)(P.ws + WS_CTL) + CW_BAR, MISC + 8);
    const int bid = blockIdx.x, nblk = gridDim.x;
    const int vb = (nblk % 8 == 0) ? (bid % 8) * (nblk / 8) + bid / 8 : bid;
#ifndef REP_P0
#define REP_P0 1
#endif
#ifndef REP_INPROJ
#define REP_INPROJ 1
#endif
#ifndef REP_ATTN
#define REP_ATTN 1
#endif
#ifndef REP_GU
#define REP_GU 1
#endif
#ifndef REP_DOWN
#define REP_DOWN 1
#endif
    for (int r = 0; r < REP_P0; ++r) { p0_prologue(P, lds, bid, nblk); xcd_barrier(bar); }
    for (int l = 0; l < DEPTH; ++l) {
        if (l == 0) norm1_phase<0>(P, l, bid, nblk); else norm1_phase<1>(P, l, bid, nblk);
        xcd_barrier(bar);
        for (int r = 0; r < REP_INPROJ; ++r) { inproj_phase(P, lds, l, vb, nblk); xcd_barrier(bar); }
        for (int r = 0; r < REP_ATTN; ++r) { attn_phase(P, lds, l, bid, nblk); xcd_barrier(bar); }
        outproj_phase(P, lds, l, vb, nblk);
        xcd_barrier(bar);
        router_phase(P, lds, l, bid, nblk);
        xcd_barrier(bar);
        place_phase(P, lds, l, bid, nblk);
        xcd_barrier(bar);
        for (int r = 0; r < REP_GU; ++r) { gu_phase(P, lds, l, vb, nblk); xcd_barrier(bar); }
        for (int r = 0; r < REP_DOWN; ++r) { down_phase(P, lds, l, vb, nblk); xcd_barrier(bar); }
    }
    norm1_phase<2>(P, 0, bid, nblk);
}
#else
extern __shared__ __attribute__((aligned(16))) unsigned char dyn_lds[];
#define KLDS ((LAS unsigned char*)dyn_lds)
__global__ void __launch_bounds__(NT, 2) k_prologue(Params P) { p0_prologue(P, KLDS, blockIdx.x, gridDim.x); }
__global__ void __launch_bounds__(NT, 2) k_norm1_0(Params P, int l) { norm1_phase<0>(P, l, blockIdx.x, gridDim.x); }
__global__ void __launch_bounds__(NT, 2) k_norm1_1(Params P, int l) { norm1_phase<1>(P, l, blockIdx.x, gridDim.x); }
__global__ void __launch_bounds__(NT, 2) k_final(Params P) { norm1_phase<2>(P, 0, blockIdx.x, gridDim.x); }
__global__ void __launch_bounds__(NT, 2) k_inproj(Params P, int l) { inproj_phase(P, KLDS, l, blockIdx.x, gridDim.x); }
__global__ void __launch_bounds__(NT, 2) k_attn(Params P, int l) { attn_phase(P, KLDS, l, blockIdx.x, gridDim.x); }
__global__ void __launch_bounds__(NT, 2) k_outproj(Params P, int l) { outproj_phase(P, KLDS, l, blockIdx.x, gridDim.x); }
__global__ void __launch_bounds__(NT, 2) k_router(Params P, int l) { router_phase(P, KLDS, l, blockIdx.x, gridDim.x); }
__global__ void __launch_bounds__(NT, 2) k_place(Params P, int l) { place_phase(P, KLDS, l, blockIdx.x, gridDim.x); }
__global__ void __launch_bounds__(NT, 2) k_gu(Params P, int l) { gu_phase(P, KLDS, l, blockIdx.x, gridDim.x); }
__global__ void __launch_bounds__(NT, 2) k_down(Params P, int l) { down_phase(P, KLDS, l, blockIdx.x, gridDim.x); }

#endif

extern "C" void kernel_launch(void* const* d_in, const int* in_sizes, int n_in, void* d_out, int out_size, void* d_ws, size_t ws_size, hipStream_t stream) {
    static int ready = 0;
    if (ready == 0) {
        if (n_in != 21 || out_size != NTOK * D || ws_size < WS_END) { fprintf(stderr, "kernel_launch: unexpected shapes (n_in %d out %d ws %zu)\n", n_in, out_size, ws_size); ready = -1; return; }
#if ONE_LAUNCH
        const void* ks[] = {(const void*)mega_fwd};
#else
        const void* ks[] = {(const void*)k_prologue, (const void*)k_norm1_0, (const void*)k_norm1_1, (const void*)k_final, (const void*)k_inproj, (const void*)k_attn, (const void*)k_outproj, (const void*)k_router, (const void*)k_gu, (const void*)k_down, (const void*)k_place};
#endif
        for (auto k : ks) if (hipFuncSetAttribute(k, hipFuncAttributeMaxDynamicSharedMemorySize, LDS_BYTES) != hipSuccess) { fprintf(stderr, "kernel_launch: hipFuncSetAttribute failed\n"); ready = -1; return; }
        ready = 1;
    }
    if (ready < 0) return;
    (void)hipMemsetAsync((char*)d_ws + WS_CTL, 0, CTL_ZERO_BYTES, stream);
    Params P{};
    P.x = (const float*)d_in[0]; P.c = (const float*)d_in[1]; P.pos = (const int*)d_in[2]; P.ada_w = (const float*)d_in[3]; P.ada_b = (const float*)d_in[4]; P.n1g = (const float*)d_in[5];
    P.w_in = (const float*)d_in[6]; P.qg = (const float*)d_in[7]; P.kg = (const float*)d_in[8]; P.sinks = (const float*)d_in[9]; P.pool_w = (const float*)d_in[10]; P.pool_b = (const float*)d_in[11];
    P.pool_s = (const float*)d_in[12]; P.w_out = (const float*)d_in[13]; P.n2g = (const float*)d_in[14]; P.rw = (const float*)d_in[15]; P.rb = (const float*)d_in[16]; P.wgu = (const float*)d_in[17];
    P.bgu = (const float*)d_in[18]; P.wdn = (const float*)d_in[19]; P.bdn = (const float*)d_in[20]; P.out = (float*)d_out; P.ws = (unsigned char*)d_ws;
    const dim3 g(256), b(NT);
#if ONE_LAUNCH
    hipLaunchKernelGGL(mega_fwd, g, b, LDS_BYTES, stream, P);
#else
    hipLaunchKernelGGL(k_prologue, g, b, LDS_BYTES, stream, P);
    for (int l = 0; l < DEPTH; ++l) {
        if (l == 0) hipLaunchKernelGGL(k_norm1_0, g, b, LDS_BYTES, stream, P, l); else hipLaunchKernelGGL(k_norm1_1, g, b, LDS_BYTES, stream, P, l);
        hipLaunchKernelGGL(k_inproj, g, b, LDS_BYTES, stream, P, l);
        hipLaunchKernelGGL(k_attn, g, b, LDS_BYTES, stream, P, l);
        hipLaunchKernelGGL(k_outproj, g, b, LDS_BYTES, stream, P, l);
        hipLaunchKernelGGL(k_router, g, b, LDS_BYTES, stream, P, l);
        hipLaunchKernelGGL(k_place, g, b, LDS_BYTES, stream, P, l);
        hipLaunchKernelGGL(k_gu, g, b, LDS_BYTES, stream, P, l);
        hipLaunchKernelGGL(k_down, g, b, LDS_BYTES, stream, P, l);
    }
    hipLaunchKernelGGL(k_final, g, b, LDS_BYTES, stream, P);
#endif
}
```

```cpp
#include <hip/hip_runtime.h>
#include <cstdio>
#include <cstdint>

#ifndef ONE_LAUNCH
#define ONE_LAUNCH 1
#endif

#define LAS __attribute__((address_space(3)))
typedef unsigned short bf16;
typedef short bf16x8 __attribute__((ext_vector_type(8)));
typedef short s16x4 __attribute__((ext_vector_type(4)));
typedef float f32x4 __attribute__((ext_vector_type(4)));
typedef float f32x16 __attribute__((ext_vector_type(16)));
typedef unsigned u32x4 __attribute__((ext_vector_type(4)));
typedef unsigned u32x2 __attribute__((ext_vector_type(2)));
typedef int i32x4 __attribute__((ext_vector_type(4)));
typedef int i32x8 __attribute__((ext_vector_type(8)));

constexpr int D = 1024, NB = 8, SEQ = 8192, NTOK = NB * SEQ, DEPTH = 2, NE = 32, NIN = 1280, NMOD = 6 * D;
constexpr int NT = 512;
constexpr float EPS = 1e-6f;
constexpr float LOG2E = 1.4426950408889634f;
constexpr float QSCALE = 0.18033688011112042f;
constexpr int MAXTILES = NTOK * 4 / 256 + NE;

constexpr size_t MiB = 1u << 20;
constexpr size_t WS_CTL = 0, CTL_ZERO_BYTES = 1 * MiB;
constexpr size_t WS_MOD = 1 * MiB;
constexpr size_t WS_ROPE = 2 * MiB;
constexpr size_t WS_WIN = 8 * MiB;
constexpr size_t WS_WOUT = 16 * MiB;
constexpr size_t WS_GATES = 20 * MiB;
constexpr size_t WS_SEL = 21 * MiB;
constexpr size_t WS_CNTB = 22 * MiB;
constexpr size_t WS_TOT = 23 * MiB;
constexpr size_t WS_LIST = 24 * MiB;
constexpr size_t WS_WGU = 32 * MiB;
constexpr size_t WS_WDN = 160 * MiB;
constexpr size_t WS_H = 224 * MiB;
constexpr size_t WS_H8 = 352 * MiB;
constexpr size_t WS_PROJ = 416 * MiB;
constexpr size_t WS_MIX = 576 * MiB;
constexpr size_t WS_ACT = 416 * MiB;
constexpr size_t WS_YBUF = 704 * MiB;
constexpr size_t WS_END = 1216 * MiB;
static_assert(WS_ACT + (size_t)MAXTILES * 256 * 1024 <= WS_YBUF, "act fits");
constexpr float WSCALE = 32.0f, WUNSCALE = 1.0f / 32.0f;
constexpr int CW_BAR = 4096;
constexpr int CW_CNT = 8192;

constexpr int LDS_BYTES = 147456;

struct Params {
    const float *x, *c; const int* pos; const float *ada_w, *ada_b, *n1g, *w_in, *qg, *kg, *sinks, *pool_w, *pool_b, *pool_s, *w_out, *n2g, *rw, *rb, *wgu, *bgu, *wdn, *bdn;
    float* out; unsigned char* ws;
};

__device__ __forceinline__ unsigned cvt_pk_bf16(float lo, float hi) { unsigned r; asm("v_cvt_pk_bf16_f32 %0, %1, %2" : "=v"(r) : "v"(lo), "v"(hi)); return r; }
__device__ __forceinline__ unsigned cvt_pk4_fp8(float a, float b, float c, float d) { int w = 0; w = __builtin_amdgcn_cvt_pk_fp8_f32(a, b, w, false); w = __builtin_amdgcn_cvt_pk_fp8_f32(c, d, w, true); return (unsigned)w; }
__device__ __forceinline__ float bf_lo(unsigned w) { return __uint_as_float(w << 16); }
__device__ __forceinline__ float bf_hi(unsigned w) { return __uint_as_float(w & 0xffff0000u); }
template <int M> __device__ __forceinline__ float swz_xor(float v) { return __int_as_float(__builtin_amdgcn_ds_swizzle(__float_as_int(v), (M << 10) | 0x1f)); }
__device__ __forceinline__ float sum_x32(float v) { const auto r = __builtin_amdgcn_permlane32_swap(__float_as_uint(v), __float_as_uint(v), false, false); return __uint_as_float(r[0]) + __uint_as_float(r[1]); }
__device__ __forceinline__ float max_x32(float v) { const auto r = __builtin_amdgcn_permlane32_swap(__float_as_uint(v), __float_as_uint(v), false, false); return fmaxf(__uint_as_float(r[0]), __uint_as_float(r[1])); }
__device__ __forceinline__ float wave_sum(float v) {
    v += swz_xor<1>(v); v += swz_xor<2>(v); v += swz_xor<4>(v); v += swz_xor<8>(v); v += swz_xor<16>(v);
    return sum_x32(v);
}
__device__ __forceinline__ int dpp_swap1(int v) { return __builtin_amdgcn_update_dpp(0, v, 0xB1, 0xF, 0xF, true); }
__device__ __forceinline__ u32x4 dpp_swap1(u32x4 v) { u32x4 r; r.x = (unsigned)dpp_swap1((int)v.x); r.y = (unsigned)dpp_swap1((int)v.y); r.z = (unsigned)dpp_swap1((int)v.z); r.w = (unsigned)dpp_swap1((int)v.w); return r; }
__device__ __forceinline__ void store_line_pair(unsigned char* own_line, unsigned char* nb_line, bool own_valid, bool nb_valid, u32x4 lo, u32x4 hi, int fq, bool odd) {
    const u32x4 got = dpp_swap1(odd ? lo : hi);
    const int off = (odd ? 64 : 0) + 16 * fq;
    if (odd ? nb_valid : own_valid) *(u32x4*)((odd ? nb_line : own_line) + off) = odd ? got : lo;
    if (odd ? own_valid : nb_valid) *(u32x4*)((odd ? own_line : nb_line) + off) = odd ? hi : got;
}
__device__ __forceinline__ void load_line_pair(const unsigned char* own_line, const unsigned char* nb_line, int fq, bool odd, u32x4& lo, u32x4& hi) {
    const int off = (odd ? 64 : 0) + 16 * fq;
    const u32x4 a = *(const u32x4*)((odd ? nb_line : own_line) + off), b = *(const u32x4*)((odd ? own_line : nb_line) + off);
    const u32x4 got = dpp_swap1(odd ? a : b);
    lo = odd ? got : a; hi = odd ? b : got;
}
__device__ __forceinline__ int lperm(int r) { return (r & 63) * 4 + (r >> 6); }
__device__ __forceinline__ int perm32(int rho) { const int n = rho >> 4, i = rho & 15; return 8 * (i >> 2) + 4 * n + (i & 3); }
__device__ __forceinline__ int opaque_tid() { int t = threadIdx.x; asm volatile("" : "+v"(t)); return t; }

__device__ __forceinline__ void tr_item_src(const Params& P, int it, const float*& src, int& ldw, bf16*& dst, int& k0, int& n0, bool& f8) {
    f8 = it < 16384 + 8192;
    unsigned char* ws = P.ws;
    if (it < 16384) { const int m = it >> 8, r = it & 255; src = P.wgu + (size_t)m * (1024 * 2048); ldw = 2048; dst = (bf16*)(ws + WS_WGU + (size_t)m * (2048 * 1024)); k0 = 128 * (r >> 5); n0 = 64 * (r & 31); return; }
    it -= 16384;
    if (it < 8192) { const int m = it >> 7, r = it & 127; src = P.wdn + (size_t)m * (1024 * 1024); ldw = 1024; dst = (bf16*)(ws + WS_WDN + (size_t)m * (1024 * 1024)); k0 = 128 * (r >> 4); n0 = 64 * (r & 15); return; }
    it -= 8192;
    if (it < 192) { const int l = it / 96, r = it % 96; src = P.w_in + (size_t)l * (1024 * 1280); ldw = 1280; dst = (bf16*)(ws + WS_WIN) + (size_t)l * (1280 * 1024); k0 = 128 * (r / 12); n0 = 64 * (r % 12); return; }
    it -= 192;
    { const int l = it >> 7, r = it & 127; src = P.w_out + (size_t)l * (1024 * 1024); ldw = 1024; dst = (bf16*)(ws + WS_WOUT) + (size_t)l * (1024 * 1024); k0 = 128 * (r >> 4); n0 = 64 * (r & 15); }
}
constexpr int N_TR_ITEMS = 16384 + 8192 + 192 + 256;

__device__ __forceinline__ void p0_prologue(const Params& P, LAS unsigned char* lds, int bid, int nblk) {
    const int tid = opaque_tid(), wid = __builtin_amdgcn_readfirstlane(tid >> 6), lane = tid & 63;
    unsigned char* ws = P.ws;
    {
        LAS float* cact = (LAS float*)lds;
        LAS float* red = (LAS float*)(lds + 32768);
        if (bid < 192 || nblk < 192) {
            for (int i = tid; i < NB * D; i += NT) { const float v = P.c[i]; cact[i] = v / (1.0f + __expf(-v)); }
            __syncthreads();
            for (int it = bid; it < 192; it += nblk) {
                const int l = it / 96, n0 = 64 * (it % 96);
                float acc[NB];
#pragma unroll
                for (int b = 0; b < NB; ++b) acc[b] = 0.f;
                const float* wp = P.ada_w + (size_t)l * D * NMOD + n0 + lane;
                for (int k = 128 * wid; k < 128 * wid + 128; k += 16) {
                    float wv[16];
#pragma unroll
                    for (int q = 0; q < 16; ++q) wv[q] = wp[(size_t)(k + q) * NMOD];
#pragma unroll
                    for (int q = 0; q < 16; ++q)
#pragma unroll
                        for (int b = 0; b < NB; ++b) acc[b] += cact[b * D + k + q] * wv[q];
                }
#pragma unroll
                for (int b = 0; b < NB; ++b) red[(wid * NB + b) * 64 + lane] = acc[b];
                __syncthreads();
                { const int b = tid >> 6; float s = P.ada_b[l * NMOD + n0 + lane];
#pragma unroll
                  for (int w = 0; w < 8; ++w) s += red[(w * NB + b) * 64 + lane];
                  ((float*)(ws + WS_MOD))[(size_t)(l * NB + b) * NMOD + n0 + lane] = s; }
                __syncthreads();
            }
        }
    }
    for (int it = bid; it < 128; it += nblk) {
        const int l = it >> 6, g = (it >> 4) & 3, k0 = 64 * (it & 15);
        LAS float* At = (LAS float*)lds;
        LAS float* Pw = (LAS float*)(lds + 33024);
        __syncthreads();
        for (int j = 0; j < 16; ++j) { const int idx = tid + NT * j, k = idx >> 7, c = idx & 127; At[k * 129 + c] = P.w_in[(size_t)l * (1024 * 1280) + (size_t)(k0 + k) * 1280 + 768 + 128 * g + c]; }
        for (int j = 0; j < 32; ++j) { const int idx = tid + NT * j; Pw[idx] = P.pool_w[(size_t)(l * 4 + g) * 16384 + idx]; }
        __syncthreads();
        const int n = tid & 127, ks = tid >> 7;
        float acc[16];
#pragma unroll
        for (int i = 0; i < 16; ++i) acc[i] = 0.f;
        for (int c = 0; c < 128; ++c) { const float pw = Pw[c * 128 + n];
#pragma unroll
            for (int i = 0; i < 16; ++i) acc[i] += At[(16 * ks + i) * 129 + c] * pw; }
        bf16* dst = (bf16*)(ws + WS_WIN) + (size_t)l * (1280 * 1024) + (size_t)(768 + 128 * g + n) * 1024 + k0 + 16 * ks;
        u32x4 o0, o1;
        o0.x = cvt_pk_bf16(acc[0], acc[1]); o0.y = cvt_pk_bf16(acc[2], acc[3]); o0.z = cvt_pk_bf16(acc[4], acc[5]); o0.w = cvt_pk_bf16(acc[6], acc[7]);
        o1.x = cvt_pk_bf16(acc[8], acc[9]); o1.y = cvt_pk_bf16(acc[10], acc[11]); o1.z = cvt_pk_bf16(acc[12], acc[13]); o1.w = cvt_pk_bf16(acc[14], acc[15]);
        *(u32x4*)dst = o0; *(u32x4*)(dst + 8) = o1;
    }
    {
        const double invf[8] = {1.0, 0.19392274474868576, 0.03760603093086393, 0.007292664737217109, 0.001414213562373095, 0.0002742481756762073, 5.318295896944988e-05, 1.031338537721246e-05};
        float* rope = (float*)(ws + WS_ROPE);
        for (int idx = bid * NT + tid; idx < NTOK * 8; idx += nblk * NT) {
            const int tok = idx >> 3, i = idx & 7;
            double f = 1.0;
#pragma unroll
            for (int q = 0; q < 8; ++q) f = (i == q) ? invf[q] : f;
            const double ang = (double)P.pos[tok] * f;
            const double kq = __builtin_rint(ang * 0.6366197723675814);
            const double r = (ang - kq * 1.5707963267948966) - kq * 6.123233995736766e-17;
            const double r2 = r * r;
            double sn = r * (1.0 + r2 * (-1.0 / 6 + r2 * (1.0 / 120 + r2 * (-1.0 / 5040 + r2 * (1.0 / 362880 + r2 * (-1.0 / 39916800 + r2 * (1.0 / 6227020800.0)))))));
            double cs = 1.0 + r2 * (-0.5 + r2 * (1.0 / 24 + r2 * (-1.0 / 720 + r2 * (1.0 / 40320 + r2 * (-1.0 / 3628800 + r2 * (1.0 / 479001600.0 + r2 * (-1.0 / 87178291200.0)))))));
            const int q = ((int)(long long)kq) & 3;
            double s2 = (q & 1) ? cs : sn, c2 = (q & 1) ? sn : cs;
            if (q == 1 || q == 2) c2 = -c2;
            if (q >= 2) s2 = -s2;
            rope[tok * 16 + i] = (float)c2; rope[tok * 16 + 8 + i] = (float)s2;
        }
    }
    {
        LAS float* tile = (LAS float*)lds;
        __syncthreads();
        f32x4 r[4];
        const float* src; int ldw, k0, n0; bf16* dst; bool f8;
        int it = bid;
        if (it < N_TR_ITEMS) { tr_item_src(P, it, src, ldw, dst, k0, n0, f8);
#pragma unroll
            for (int j = 0; j < 4; ++j) { const int idx = tid + NT * j, row = idx >> 4, c4 = idx & 15; r[j] = *(const f32x4*)(src + (size_t)(k0 + row) * ldw + n0 + 4 * c4); } }
        for (; it < N_TR_ITEMS; it += nblk) {
#pragma unroll
            for (int j = 0; j < 4; ++j) { const int idx = tid + NT * j, row = idx >> 4, c4 = idx & 15; LAS float* t = tile + row * 65 + 4 * c4; t[0] = r[j].x; t[1] = r[j].y; t[2] = r[j].z; t[3] = r[j].w; }
            __syncthreads();
            bf16* cdst = dst; const int ck0 = k0, cn0 = n0; const bool cf8 = f8;
            if (it + nblk < N_TR_ITEMS) { tr_item_src(P, it + nblk, src, ldw, dst, k0, n0, f8);
#pragma unroll
                for (int j = 0; j < 4; ++j) { const int idx = tid + NT * j, row = idx >> 4, c4 = idx & 15; r[j] = *(const f32x4*)(src + (size_t)(k0 + row) * ldw + n0 + 4 * c4); } }
            if (cf8) {
                const int n = tid >> 3, c = tid & 7; const LAS float* t = tile + (16 * c) * 65 + n;
                u32x4 o; o.x = cvt_pk4_fp8(t[0] * WSCALE, t[65] * WSCALE, t[2 * 65] * WSCALE, t[3 * 65] * WSCALE); o.y = cvt_pk4_fp8(t[4 * 65] * WSCALE, t[5 * 65] * WSCALE, t[6 * 65] * WSCALE, t[7 * 65] * WSCALE);
                o.z = cvt_pk4_fp8(t[8 * 65] * WSCALE, t[9 * 65] * WSCALE, t[10 * 65] * WSCALE, t[11 * 65] * WSCALE); o.w = cvt_pk4_fp8(t[12 * 65] * WSCALE, t[13 * 65] * WSCALE, t[14 * 65] * WSCALE, t[15 * 65] * WSCALE);
                *(u32x4*)((unsigned char*)cdst + (size_t)(cn0 + n) * 1024 + ck0 + 16 * c) = o;
            } else {
#pragma unroll
            for (int j = 0; j < 2; ++j) { const int p = tid + NT * j, n = p >> 4, c = p & 15; const LAS float* t = tile + (8 * c) * 65 + n;
                u32x4 o; o.x = cvt_pk_bf16(t[0], t[65]); o.y = cvt_pk_bf16(t[2 * 65], t[3 * 65]); o.z = cvt_pk_bf16(t[4 * 65], t[5 * 65]); o.w = cvt_pk_bf16(t[6 * 65], t[7 * 65]);
                *(u32x4*)(cdst + (size_t)(cn0 + n) * 1024 + ck0 + 8 * c) = o; }
            }
            __syncthreads();
        }
    }
}

template <int MODE>
__device__ __forceinline__ void norm1_phase(const Params& P, int l, int bid, int nblk) {
    const int tid = opaque_tid(), wid = __builtin_amdgcn_readfirstlane(tid >> 6), lane = tid & 63;
    unsigned char* ws = P.ws;
    const float* mod = (const float*)(ws + WS_MOD);
    const float* xin = (MODE == 0) ? P.x : P.out;
    bf16* H = (bf16*)(ws + WS_H);
    const float* gates = (const float*)(ws + WS_GATES);
    const bf16* Y = (const bf16*)(ws + WS_YBUF);
    for (int ch = bid * 8 + wid; ch < NTOK / 32; ch += nblk * 8) {
        const int b = (ch * 32) >> 13;
        f32x4 ca[4], cc[4], cg[4];
#pragma unroll
        for (int j = 0; j < 4; ++j) {
            const int col = 256 * j + 4 * lane;
            if (MODE <= 1) { const f32x4 g = *(const f32x4*)(P.n1g + l * D + col); const f32x4 sc = *(const f32x4*)(mod + (size_t)(l * NB + b) * NMOD + 1 * D + col);
                ca[j] = g * (1.0f + sc); cc[j] = *(const f32x4*)(mod + (size_t)(l * NB + b) * NMOD + 0 * D + col); }
            if (MODE >= 1) { const int lp = (MODE == 2) ? (DEPTH - 1) : (l - 1); cg[j] = *(const f32x4*)(mod + (size_t)(lp * NB + b) * NMOD + 5 * D + col); }
        }
        for (int rr = 0; rr < 32; ++rr) {
            const int row = ch * 32 + rr;
            f32x4 v[4];
#pragma unroll
            for (int j = 0; j < 4; ++j) v[j] = *(const f32x4*)(xin + (size_t)row * D + 256 * j + 4 * lane);
            if (MODE >= 1) {
                const f32x4 gt = *(const f32x4*)(gates + (size_t)row * 4);
                f32x4 a[4];
#pragma unroll
                for (int j = 0; j < 4; ++j) a[j] = (f32x4){0.f, 0.f, 0.f, 0.f};
#pragma unroll
                for (int k = 0; k < 4; ++k) {
                    const float gk = gt[k];
#pragma unroll
                    for (int j = 0; j < 4; ++j) { const u32x2 y = *(const u32x2*)(Y + ((size_t)row * 4 + k) * D + 256 * j + 4 * lane);
                        a[j].x += gk * bf_lo(y.x); a[j].y += gk * bf_hi(y.x); a[j].z += gk * bf_lo(y.y); a[j].w += gk * bf_hi(y.y); }
                }
#pragma unroll
                for (int j = 0; j < 4; ++j) { v[j] += cg[j] * a[j]; *(f32x4*)(P.out + (size_t)row * D + 256 * j + 4 * lane) = v[j]; }
            }
            if (MODE <= 1) {
                float ss = 0.f;
#pragma unroll
                for (int j = 0; j < 4; ++j) ss += (v[j].x * v[j].x + v[j].y * v[j].y) + (v[j].z * v[j].z + v[j].w * v[j].w);
                const float rstd = 1.0f / sqrtf(wave_sum(ss) * (1.0f / D) + EPS);
#pragma unroll
                for (int j = 0; j < 4; ++j) { const f32x4 h = v[j] * rstd * ca[j] + cc[j]; u32x2 o; o.x = cvt_pk_bf16(h.x, h.y); o.y = cvt_pk_bf16(h.z, h.w);
                    *(u32x2*)(H + (size_t)row * D + 256 * j + 4 * lane) = o; }
            }
        }
    }
}

struct Unit { int pm, pn, e, nrows, tbase, ks; };
typedef f32x4 Acc[2][2][4][2];

template <class Pb>
__device__ __forceinline__ void gemm_simple(LAS unsigned char* lds, const Pb& pb, int bid, int nblk) {
    const int tid = opaque_tid(), wid = __builtin_amdgcn_readfirstlane(tid >> 6), lane = tid & 63, wr = wid >> 2, wc = wid & 3, fr = lane & 15, fq = lane >> 4;
    constexpr int PITCH = 144;
    LAS unsigned char* sA = lds; LAS unsigned char* sB = lds + 256 * PITCH;
    Unit u;
    for (int i = 0; pb.next(i, bid, nblk, u); ++i) {
        Acc acc;
#pragma unroll
        for (int a = 0; a < 2; ++a)
#pragma unroll
            for (int b = 0; b < 2; ++b)
#pragma unroll
                for (int m = 0; m < 4; ++m)
#pragma unroll
                    for (int n = 0; n < 2; ++n) acc[a][b][m][n] = (f32x4){0.f, 0.f, 0.f, 0.f};
        unsigned ao[4], bo[4];
#pragma unroll
        for (int j = 0; j < 4; ++j) { const int q = tid + NT * j, row = q >> 3, c8 = q & 7;
            ao[j] = (unsigned)pb.a_row(u, row) * (unsigned)(pb.K * 2) + c8 * 16; bo[j] = (unsigned)pb.b_row(u, row) * (unsigned)(pb.K * 2) + c8 * 16; }
        for (int kt = 0; kt < pb.K / 64; ++kt) {
            u32x4 ra[4], rb[4];
#pragma unroll
            for (int j = 0; j < 4; ++j) { ra[j] = *(const u32x4*)(pb.A + ao[j] + kt * 128); rb[j] = *(const u32x4*)(pb.B + bo[j] + kt * 128); }
            __syncthreads();
#pragma unroll
            for (int j = 0; j < 4; ++j) { const int q = tid + NT * j, row = q >> 3, c8 = q & 7; *(LAS u32x4*)(sA + row * PITCH + c8 * 16) = ra[j]; *(LAS u32x4*)(sB + row * PITCH + c8 * 16) = rb[j]; }
            __syncthreads();
#pragma unroll
            for (int kk = 0; kk < 2; ++kk) {
                bf16x8 bfr[2][2];
#pragma unroll
                for (int b = 0; b < 2; ++b)
#pragma unroll
                    for (int n = 0; n < 2; ++n) bfr[b][n] = *(const LAS bf16x8*)(sB + (128 * b + 32 * wc + 16 * n + fr) * PITCH + (kk * 32 + fq * 8) * 2);
#pragma unroll
                for (int a = 0; a < 2; ++a) {
                    bf16x8 af[4];
#pragma unroll
                    for (int m = 0; m < 4; ++m) af[m] = *(const LAS bf16x8*)(sA + (128 * a + 64 * wr + 16 * m + fr) * PITCH + (kk * 32 + fq * 8) * 2);
#pragma unroll
                    for (int b = 0; b < 2; ++b)
#pragma unroll
                        for (int m = 0; m < 4; ++m)
#pragma unroll
                            for (int n = 0; n < 2; ++n) acc[a][b][m][n] = __builtin_amdgcn_mfma_f32_16x16x32_bf16(bfr[b][n], af[m], acc[a][b][m][n], 0, 0, 0);
                }
            }
        }
        pb.epi(acc, u, wr, wc, fr, fq);
    }
    __syncthreads();
}

struct PbInProj {
    static constexpr bool F8 = false;
    const char* A; const char* B; int K;
    bf16* proj; const float* qg; const float* kg; const float* rope;
    __device__ __forceinline__ bool next(int i, int bid, int nblk, Unit& u) const { const int L = i * nblk + bid; if (L >= 256 * 5) return false; u.pm = L / 5; u.pn = L % 5; u.e = 0; u.nrows = 256; u.tbase = 0; u.ks = 3 * u.pn + 2 * (u.pm & 7); return true; }
    __device__ __forceinline__ int a_row(const Unit& u, int r) const { return 256 * u.pm + r; }
    __device__ __forceinline__ void a_rows4(const Unit& u, int r0, int (&rows)[4]) const { for (int j = 0; j < 4; ++j) rows[j] = 256 * u.pm + r0 + 64 * j; }
    __device__ __forceinline__ int b_rowc(int rho) const { return 64 * ((rho >> 5) & 3) + 32 * (rho >> 7) + perm32(rho & 31); }
    __device__ __forceinline__ int b_base_row(const Unit& u) const { return 256 * u.pn; }
    __device__ __forceinline__ int b_row(const Unit& u, int rho) const { return b_base_row(u) + b_rowc(rho); }
    __device__ __forceinline__ void epi(const Acc& acc, const Unit& u, int, int, int, int) const {
        const int t_ = opaque_tid(), w_ = __builtin_amdgcn_readfirstlane(t_ >> 6), wr = w_ >> 2, wc = w_ & 3, fr = t_ & 15, fq = (t_ >> 4) & 3;
        const int hg = 4 * u.pn + wc;
        const bool nrm = hg < 10;
        const float* gsrc = (hg < 8) ? qg : kg;
        f32x4 gv[2][2];
#pragma unroll
        for (int bj = 0; bj < 2; ++bj)
#pragma unroll
            for (int n = 0; n < 2; ++n) gv[bj][n] = nrm ? *(const f32x4*)(gsrc + 32 * bj + 8 * fq + 4 * n) : (f32x4){1.f, 1.f, 1.f, 1.f};
        const float qs = (hg < 8) ? QSCALE : 1.0f;
#pragma unroll
        for (int q = 0; q < 4; ++q) {
            const int ai = q >> 1, m0 = 2 * (q & 1);
            f32x4 rcs[2][2], rsn[2][2];
            if (nrm && fq < 2) {
#pragma unroll
                for (int mm = 0; mm < 2; ++mm) { const float* rp = rope + (size_t)(256 * u.pm + 128 * ai + 64 * wr + 16 * (m0 + mm) + fr) * 16;
#pragma unroll
                    for (int n = 0; n < 2; ++n) { rcs[mm][n] = *(const f32x4*)(rp + 4 * n); rsn[mm][n] = *(const f32x4*)(rp + 8 + 4 * n); } }
            }
#pragma unroll
            for (int mm = 0; mm < 2; ++mm) {
                const int m = m0 + mm;
                const int row = 256 * u.pm + 128 * ai + 64 * wr + 16 * m + fr;
                f32x4 v[2][2];
#pragma unroll
                for (int bj = 0; bj < 2; ++bj)
#pragma unroll
                    for (int n = 0; n < 2; ++n) v[bj][n] = acc[ai][bj][m][n];
                if (nrm) {
                    float ss = 0.f;
#pragma unroll
                    for (int bj = 0; bj < 2; ++bj)
#pragma unroll
                        for (int n = 0; n < 2; ++n) ss += (v[bj][n].x * v[bj][n].x + v[bj][n].y * v[bj][n].y) + (v[bj][n].z * v[bj][n].z + v[bj][n].w * v[bj][n].w);
                    ss += swz_xor<16>(ss); ss = sum_x32(ss);
                    const float rstd = __builtin_amdgcn_rsqf(ss * (1.0f / 64.0f) + EPS);
#pragma unroll
                    for (int bj = 0; bj < 2; ++bj)
#pragma unroll
                        for (int n = 0; n < 2; ++n) v[bj][n] = v[bj][n] * rstd * gv[bj][n];
#pragma unroll
                    for (int n = 0; n < 2; ++n) {
                        f32x4 pr;
                        pr.x = swz_xor<16>(v[0][n].x); pr.y = swz_xor<16>(v[0][n].y); pr.z = swz_xor<16>(v[0][n].z); pr.w = swz_xor<16>(v[0][n].w);
                        if (fq < 2) v[0][n] = (fq == 0) ? (v[0][n] * rcs[mm][n] - pr * rsn[mm][n]) : (v[0][n] * rcs[mm][n] + pr * rsn[mm][n]);
                    }
                }
                u32x4 o[2];
#pragma unroll
                for (int bj = 0; bj < 2; ++bj) {
                    o[bj].x = cvt_pk_bf16(v[bj][0].x * qs, v[bj][0].y * qs); o[bj].y = cvt_pk_bf16(v[bj][0].z * qs, v[bj][0].w * qs);
                    o[bj].z = cvt_pk_bf16(v[bj][1].x * qs, v[bj][1].y * qs); o[bj].w = cvt_pk_bf16(v[bj][1].z * qs, v[bj][1].w * qs);
                }
                { unsigned char* own = (unsigned char*)(proj + (size_t)row * NIN + 64 * hg); const bool odd = fr & 1;
                  store_line_pair(own, odd ? own - NIN * 2 : own + NIN * 2, true, true, o[0], o[1], fq, odd); }
            }
        }
    }
};

struct PbOutProj {
    static constexpr bool F8 = false;
    const char* A; const char* B; int K;
    const float* xin; float* xout; const float* gate1;
    __device__ __forceinline__ bool next(int i, int bid, int nblk, Unit& u) const { const int L = i * nblk + bid; if (L >= 256 * 4) return false; u.pm = L >> 2; u.pn = L & 3; u.e = 0; u.nrows = 256; u.tbase = 0; u.ks = 4 * u.pn + 2 * (u.pm & 7); return true; }
    __device__ __forceinline__ int a_row(const Unit& u, int r) const { return 256 * u.pm + r; }
    __device__ __forceinline__ void a_rows4(const Unit& u, int r0, int (&rows)[4]) const { for (int j = 0; j < 4; ++j) rows[j] = 256 * u.pm + r0 + 64 * j; }
    __device__ __forceinline__ int b_rowc(int rho) const { return rho; }
    __device__ __forceinline__ int b_base_row(const Unit& u) const { return 256 * u.pn; }
    __device__ __forceinline__ int b_row(const Unit& u, int rho) const { return b_base_row(u) + b_rowc(rho); }
    __device__ __forceinline__ void epi(const Acc& acc, const Unit& u, int, int, int, int) const {
        const int t_ = opaque_tid(), w_ = __builtin_amdgcn_readfirstlane(t_ >> 6), wr = w_ >> 2, wc = w_ & 3, fr = t_ & 15, fq = (t_ >> 4) & 3;
        const int b = (256 * u.pm) >> 13;
        const int col0 = 256 * u.pn + 32 * wc + 4 * fq;
        const bool odd = fr & 1;
        f32x4 g[2][2];
#pragma unroll
        for (int bj = 0; bj < 2; ++bj)
#pragma unroll
            for (int n = 0; n < 2; ++n) g[bj][n] = *(const f32x4*)(gate1 + (size_t)b * NMOD + col0 + 128 * bj + 16 * n);
#pragma unroll
        for (int q = 0; q < 4; ++q) {
            const int ai = q >> 1, m0 = 2 * (q & 1);
            u32x4 lo[2][2], hi[2][2];
#pragma unroll
            for (int mm = 0; mm < 2; ++mm)
#pragma unroll
                for (int bj = 0; bj < 2; ++bj) { const unsigned char* xi = (const unsigned char*)(xin + (size_t)(256 * u.pm + 128 * ai + 64 * wr + 16 * (m0 + mm) + fr) * D + 256 * u.pn + 32 * wc + 128 * bj);
                    load_line_pair(xi, odd ? xi - D * 4 : xi + D * 4, fq, odd, lo[mm][bj], hi[mm][bj]); }
#pragma unroll
            for (int mm = 0; mm < 2; ++mm)
#pragma unroll
                for (int bj = 0; bj < 2; ++bj) { unsigned char* xo = (unsigned char*)(xout + (size_t)(256 * u.pm + 128 * ai + 64 * wr + 16 * (m0 + mm) + fr) * D + 256 * u.pn + 32 * wc + 128 * bj);
                    const f32x4 r0 = __builtin_bit_cast(f32x4, lo[mm][bj]) + g[bj][0] * acc[ai][bj][m0 + mm][0], r1 = __builtin_bit_cast(f32x4, hi[mm][bj]) + g[bj][1] * acc[ai][bj][m0 + mm][1];
                    store_line_pair(xo, odd ? xo - D * 4 : xo + D * 4, true, true, __builtin_bit_cast(u32x4, r0), __builtin_bit_cast(u32x4, r1), fq, odd); }
            asm volatile("" ::: "memory");
        }
    }
};

struct MoeTab { const LAS int* cnt; const LAS int* tp; };
__device__ __forceinline__ void moe_build_tab(LAS int* tab, const int* tot) {
    if (threadIdx.x == 0) { int t = 0; for (int e = 0; e < NE; ++e) { const int c = tot[e]; tab[e] = c; tab[32 + e] = t; t += (c + 255) >> 8; } tab[64] = t; }
    __syncthreads();
}
__device__ __forceinline__ bool moe_unit(const LAS int* tab, int L, int ntn, Unit& u) {
    const int gt = L / ntn; if (gt >= __builtin_amdgcn_readfirstlane(tab[64])) return false;
    const int ln = (int)__builtin_amdgcn_mbcnt_hi(~0u, __builtin_amdgcn_mbcnt_lo(~0u, 0u));
    const int tpv = tab[32 + (ln & 31)];
    const int e = __builtin_amdgcn_readfirstlane(__popcll(__ballot(tpv <= gt) & 0xffffffffull)) - 1;
    const int tpe = __builtin_amdgcn_readfirstlane(tab[32 + e]), cnt = __builtin_amdgcn_readfirstlane(tab[e]);
    u.e = e; u.pm = gt - tpe; u.pn = L % ntn; u.tbase = gt * 256; const int rem = cnt - 256 * u.pm; u.nrows = rem < 256 ? rem : 256; u.ks = (ntn == 8) ? (2 * u.pn + 4 * (gt & 3)) : (4 * u.pn + 2 * (gt & 7)); return true;
}

struct PbGU {
    static constexpr bool F8 = true;
    const char* A; const char* B; int K;
    const LAS int* tab; const int* list; const float* bgu; unsigned char* act;
    __device__ __forceinline__ bool next(int i, int bid, int nblk, Unit& u) const { return moe_unit(tab, i * nblk + bid, 8, u); }
    __device__ __forceinline__ int a_row(const Unit& u, int r) const { const int v = list[(size_t)u.e * NTOK + 256 * u.pm + lperm(r)]; return r < u.nrows ? (v >> 2) : 0; }
    __device__ __forceinline__ void a_rows4(const Unit& u, int r0, int (&rows)[4]) const {
        const int4 v = *(const int4*)(list + (size_t)u.e * NTOK + 256 * u.pm + 4 * r0);
        rows[0] = (r0 < u.nrows) ? (v.x >> 2) : 0; rows[1] = (r0 + 64 < u.nrows) ? (v.y >> 2) : 0; rows[2] = (r0 + 128 < u.nrows) ? (v.z >> 2) : 0; rows[3] = (r0 + 192 < u.nrows) ? (v.w >> 2) : 0; }
    __device__ __forceinline__ int b_rowc(int rho) const { const int i = rho & 127; return ((rho >> 7) ? 1024 : 0) + (i & ~31) + perm32(i & 31); }
    __device__ __forceinline__ int b_base_row(const Unit& u) const { return u.e * 2048 + 128 * u.pn; }
    __device__ __forceinline__ int b_row(const Unit& u, int rho) const { return b_base_row(u) + b_rowc(rho); }
    __device__ __forceinline__ void epi(const Acc& acc, const Unit& u, int, int, int, int) const {
        const int t_ = opaque_tid(), w_ = __builtin_amdgcn_readfirstlane(t_ >> 6), wr = w_ >> 2, wc = w_ & 3, fr = t_ & 15, fq = (t_ >> 4) & 3;
        const int col0 = 128 * u.pn + 32 * wc + 8 * fq;
        f32x4 bg[2], bu[2];
#pragma unroll
        for (int n = 0; n < 2; ++n) { bg[n] = *(const f32x4*)(bgu + (size_t)u.e * 2048 + col0 + 4 * n); bu[n] = *(const f32x4*)(bgu + (size_t)u.e * 2048 + 1024 + col0 + 4 * n); }
#pragma unroll
        for (int ai = 0; ai < 2; ++ai)
#pragma unroll
            for (int m = 0; m < 4; ++m) {
                const int r = 128 * ai + 64 * wr + 16 * m + fr;
                float o[8];
#pragma unroll
                for (int n = 0; n < 2; ++n)
#pragma unroll
                    for (int j = 0; j < 4; ++j) {
                        float g = acc[ai][0][m][n][j] * WUNSCALE + bg[n][j], uu = acc[ai][1][m][n][j] * WUNSCALE + bu[n][j];
                        g = fminf(g, 7.0f); uu = fminf(fmaxf(uu, -7.0f), 7.0f);
                        const float sg = __builtin_amdgcn_rcpf(1.0f + __builtin_amdgcn_exp2f(-1.702f * LOG2E * g));
                        o[4 * n + j] = g * sg * (uu + 1.0f);
                    }
                u32x2 w; w.x = cvt_pk4_fp8(o[0], o[1], o[2], o[3]); w.y = cvt_pk4_fp8(o[4], o[5], o[6], o[7]);
                *(u32x2*)(act + (size_t)(u.tbase + r) * 1024 + col0) = w;
            }
    }
};

struct PbDown {
    static constexpr bool F8 = true;
    const char* A; const char* B; int K;
    const LAS int* tab; const int* list; const float* bdn; bf16* ybuf;
    __device__ __forceinline__ bool next(int i, int bid, int nblk, Unit& u) const { return moe_unit(tab, i * nblk + bid, 4, u); }
    __device__ __forceinline__ int a_row(const Unit& u, int r) const { return u.tbase + r; }
    __device__ __forceinline__ void a_rows4(const Unit& u, int r0, int (&rows)[4]) const { for (int j = 0; j < 4; ++j) rows[j] = u.tbase + r0 + 64 * j; }
    __device__ __forceinline__ int b_rowc(int rho) const { return 64 * ((rho >> 5) & 3) + 32 * (rho >> 7) + perm32(rho & 31); }
    __device__ __forceinline__ int b_base_row(const Unit& u) const { return u.e * 1024 + 256 * u.pn; }
    __device__ __forceinline__ int b_row(const Unit& u, int rho) const { return b_base_row(u) + b_rowc(rho); }
    __device__ __forceinline__ void epi(const Acc& acc, const Unit& u, int, int, int, int) const {
        const int t_ = opaque_tid(), w_ = __builtin_amdgcn_readfirstlane(t_ >> 6), wr = w_ >> 2, wc = w_ & 3, fr = t_ & 15, fq = (t_ >> 4) & 3;
        const int colw = 256 * u.pn + 64 * wc;
        f32x4 bv[2][2];
#pragma unroll
        for (int bj = 0; bj < 2; ++bj)
#pragma unroll
            for (int n = 0; n < 2; ++n) bv[bj][n] = *(const f32x4*)(bdn + (size_t)u.e * 1024 + colw + 32 * bj + 8 * fq + 4 * n);
        int dst8[8];
#pragma unroll
        for (int q = 0; q < 8; ++q) dst8[q] = list[(size_t)u.e * NTOK + 256 * u.pm + lperm(128 * (q >> 2) + 64 * wr + 16 * (q & 3) + fr)];
        const bool odd = fr & 1;
#pragma unroll
        for (int ai = 0; ai < 2; ++ai)
#pragma unroll
            for (int m = 0; m < 4; ++m) {
                const int r = 128 * ai + 64 * wr + 16 * m + fr;
                const int dest = dst8[ai * 4 + m], dnb = dpp_swap1(dest);
                u32x4 w[2];
#pragma unroll
                for (int bj = 0; bj < 2; ++bj) {
                    const f32x4 v0 = acc[ai][bj][m][0] * WUNSCALE + bv[bj][0], v1 = acc[ai][bj][m][1] * WUNSCALE + bv[bj][1];
                    w[bj].x = cvt_pk_bf16(v0.x, v0.y); w[bj].y = cvt_pk_bf16(v0.z, v0.w); w[bj].z = cvt_pk_bf16(v1.x, v1.y); w[bj].w = cvt_pk_bf16(v1.z, v1.w);
                }
                store_line_pair((unsigned char*)(ybuf + (size_t)dest * 1024 + colw), (unsigned char*)(ybuf + (size_t)dnb * 1024 + colw), r < u.nrows, (r ^ 1) < u.nrows, w[0], w[1], fq, odd);
            }
    }
};

__device__ __forceinline__ s16x4 lds_tr16(const LAS unsigned char* p) { return __builtin_bit_cast(s16x4, __builtin_amdgcn_ds_read_tr16_b64_v4i16((LAS s16x4*)p)); }

__device__ __forceinline__ void attn_phase(const Params& P, LAS unsigned char* lds, int l, int bid, int nblk) {
    const int tid = opaque_tid(), wid = __builtin_amdgcn_readfirstlane(tid >> 6), lane = tid & 63, r32 = lane & 31, hi = lane >> 5;
    unsigned char* ws = P.ws;
    const bf16* proj = (const bf16*)(ws + WS_PROJ);
    bf16* mix = (bf16*)(ws + WS_MIX);
    constexpr int KP = 144;
    LAS unsigned char* sK = lds; LAS unsigned char* sV = lds + 256 * KP;
    for (int unit = bid; unit < NB * 64 * 2; unit += nblk) {
        const int kvh = unit & 1, n = (unit >> 1) & 63, b = unit >> 7;
        const int tok0 = b * SEQ + n * 128 - 128;
        __syncthreads();
#pragma unroll
        for (int j = 0; j < 4; ++j) {
            const int q = tid + NT * j, key = q >> 3, c8 = q & 7;
            u32x4 kv = (u32x4){0u, 0u, 0u, 0u}, vv = (u32x4){0u, 0u, 0u, 0u};
            if (n > 0 || key >= 128) { const bf16* src = proj + (size_t)(tok0 + key) * NIN + 512 + kvh * 64 + c8 * 8; kv = *(const u32x4*)src; vv = *(const u32x4*)(src + 128); }
            *(LAS u32x4*)(sK + key * KP + c8 * 16) = kv; *(LAS u32x4*)(sV + key * KP + c8 * 16) = vv;
        }
        __syncthreads();
        const int hq = kvh * 4 + (wid >> 1);
        const float sink2 = P.sinks[l * 8 + hq] * LOG2E;
#pragma unroll 1
        for (int qt = 0; qt < 2; ++qt) {
            const int q0 = 64 * (wid & 1) + 32 * qt, qi = q0 + r32;
            const size_t qtok = (size_t)b * SEQ + n * 128 + qi;
            bf16x8 qf[4];
#pragma unroll
            for (int s = 0; s < 4; ++s) qf[s] = *(const bf16x8*)(proj + qtok * NIN + hq * 64 + 16 * s + 8 * hi);
            f32x16 st[5];
#pragma unroll
            for (int kt = 0; kt < 5; ++kt) {
#pragma unroll
                for (int r = 0; r < 16; ++r) st[kt][r] = 0.f;
#pragma unroll
                for (int s = 0; s < 4; ++s) { const bf16x8 kf = *(const LAS bf16x8*)(sK + (q0 + 32 * kt + r32) * KP + (16 * s + 8 * hi) * 2); st[kt] = __builtin_amdgcn_mfma_f32_32x32x16_bf16(kf, qf[s], st[kt], 0, 0, 0); }
            }
            float mx = sink2;
#pragma unroll
            for (int kt = 0; kt < 5; ++kt)
#pragma unroll
                for (int r = 0; r < 16; ++r) {
                    const int kj = q0 + 32 * kt + (r & 3) + 8 * (r >> 2) + 4 * hi;
                    const bool ok = (kj > qi) && (kj <= qi + 128) && (n > 0 || kj >= 128);
                    const float s = ok ? st[kt][r] : -__builtin_inff(); st[kt][r] = s; mx = fmaxf(mx, s);
                }
            mx = max_x32(mx);
            float sum = 0.f;
#pragma unroll
            for (int kt = 0; kt < 5; ++kt)
#pragma unroll
                for (int r = 0; r < 16; ++r) { const float p = __builtin_amdgcn_exp2f(st[kt][r] - mx); st[kt][r] = p; sum += p; }
            sum = sum_x32(sum);
            sum += __builtin_amdgcn_exp2f(sink2 - mx);
            f32x16 o[2];
#pragma unroll
            for (int dt = 0; dt < 2; ++dt)
#pragma unroll
                for (int r = 0; r < 16; ++r) o[dt][r] = 0.f;
#pragma unroll
            for (int kt = 0; kt < 5; ++kt)
#pragma unroll
                for (int s2 = 0; s2 < 2; ++s2) {
                    u32x4 pw; pw.x = cvt_pk_bf16(st[kt][8 * s2 + 0], st[kt][8 * s2 + 1]); pw.y = cvt_pk_bf16(st[kt][8 * s2 + 2], st[kt][8 * s2 + 3]);
                    pw.z = cvt_pk_bf16(st[kt][8 * s2 + 4], st[kt][8 * s2 + 5]); pw.w = cvt_pk_bf16(st[kt][8 * s2 + 6], st[kt][8 * s2 + 7]);
                    const bf16x8 pf = __builtin_bit_cast(bf16x8, pw);
                    const int kb = q0 + 32 * kt + 16 * s2 + 4 * hi, i16 = lane & 15;
#pragma unroll
                    for (int dt = 0; dt < 2; ++dt) {
                        const int d0 = 32 * dt + 16 * ((lane >> 4) & 1);
                        const LAS unsigned char* a0 = sV + (kb + (i16 >> 2)) * KP + (d0 + 4 * (i16 & 3)) * 2;
                        const s16x4 v0 = lds_tr16(a0), v1 = lds_tr16(a0 + 8 * KP);
                        bf16x8 vf; vf[0] = v0[0]; vf[1] = v0[1]; vf[2] = v0[2]; vf[3] = v0[3]; vf[4] = v1[0]; vf[5] = v1[1]; vf[6] = v1[2]; vf[7] = v1[3];
                        o[dt] = __builtin_amdgcn_mfma_f32_32x32x16_bf16(vf, pf, o[dt], 0, 0, 0);
                    }
                }
            const float inv = 1.0f / sum;
#pragma unroll
            for (int dt = 0; dt < 2; ++dt)
#pragma unroll
                for (int g4 = 0; g4 < 4; ++g4) {
                    u32x2 w; w.x = cvt_pk_bf16(o[dt][4 * g4 + 0] * inv, o[dt][4 * g4 + 1] * inv); w.y = cvt_pk_bf16(o[dt][4 * g4 + 2] * inv, o[dt][4 * g4 + 3] * inv);
                    *(u32x2*)(mix + qtok * D + hq * 64 + 32 * dt + 8 * g4 + 4 * hi) = w;
                }
        }
    }
    for (int ch = bid * 8 + wid; ch < NTOK / 32; ch += nblk * 8) {
        const int t0 = ch * 32, p0 = t0 & (SEQ - 1);
        const int col = 8 * lane, g = lane >> 4, w = 2 << g;
        float pb_[8], ps_[8];
#pragma unroll
        for (int i = 0; i < 8; i += 4) { const f32x4 a = *(const f32x4*)(P.pool_b + l * 512 + col + i), s = *(const f32x4*)(P.pool_s + l * 512 + col + i);
            pb_[i] = a.x; pb_[i + 1] = a.y; pb_[i + 2] = a.z; pb_[i + 3] = a.w; ps_[i] = s.x; ps_[i + 1] = s.y; ps_[i + 2] = s.z; ps_[i + 3] = s.w; }
        float sum[8];
#pragma unroll
        for (int i = 0; i < 8; ++i) sum[i] = 0.f;
        for (int j = 1; j < w; ++j) if (p0 - j >= 0) {
            const u32x4 z = *(const u32x4*)(proj + (size_t)(t0 - j) * NIN + 768 + col);
            sum[0] += bf_lo(z.x); sum[1] += bf_hi(z.x); sum[2] += bf_lo(z.y); sum[3] += bf_hi(z.y); sum[4] += bf_lo(z.z); sum[5] += bf_hi(z.z); sum[6] += bf_lo(z.w); sum[7] += bf_hi(z.w);
        }
        for (int t = 0; t < 32; ++t) {
            const u32x4 z = *(const u32x4*)(proj + (size_t)(t0 + t) * NIN + 768 + col);
            float zz[8] = {bf_lo(z.x), bf_hi(z.x), bf_lo(z.y), bf_hi(z.y), bf_lo(z.z), bf_hi(z.z), bf_lo(z.w), bf_hi(z.w)};
            const int pos = p0 + t; const float ic = 1.0f / (float)((pos + 1 < w) ? (pos + 1) : w);
            float o[8];
#pragma unroll
            for (int i = 0; i < 8; ++i) { sum[i] += zz[i]; o[i] = (sum[i] * ic - zz[i] + pb_[i]) * ps_[i]; }
            u32x4 ow; ow.x = cvt_pk_bf16(o[0], o[1]); ow.y = cvt_pk_bf16(o[2], o[3]); ow.z = cvt_pk_bf16(o[4], o[5]); ow.w = cvt_pk_bf16(o[6], o[7]);
            *(u32x4*)(mix + (size_t)(t0 + t) * D + 512 + col) = ow;
            if (pos - w + 1 >= 0) {
                const u32x4 y = *(const u32x4*)(proj + (size_t)(t0 + t - w + 1) * NIN + 768 + col);
                sum[0] -= bf_lo(y.x); sum[1] -= bf_hi(y.x); sum[2] -= bf_lo(y.y); sum[3] -= bf_hi(y.y); sum[4] -= bf_lo(y.z); sum[5] -= bf_hi(y.z); sum[6] -= bf_lo(y.w); sum[7] -= bf_hi(y.w);
            }
        }
    }
}

__device__ __forceinline__ void router_phase(const Params& P, LAS unsigned char* lds, int l, int bid, int nblk) {
    const int tid = opaque_tid(), wid = __builtin_amdgcn_readfirstlane(tid >> 6), lane = tid & 63, fr = lane & 15, fq = lane >> 4;
    unsigned char* ws = P.ws;
    const float* mod = (const float*)(ws + WS_MOD);
    bf16* H = (bf16*)(ws + WS_H);
    float* gates = (float*)(ws + WS_GATES);
    int* list = (int*)(ws + WS_LIST);
    constexpr int RP = 2064;
    LAS unsigned char* rwT = lds;
    LAS float* lg = (LAS float*)(lds + 66048);
    LAS unsigned long long* emask = (LAS unsigned long long*)(lds + 66048 + 33792);
    LAS unsigned short* sel = (LAS unsigned short*)(emask + 128);
    __syncthreads();
    for (int idx = tid; idx < 1024 * 32; idx += NT) { const int k = idx >> 5, e = idx & 31; const float v = P.rw[(size_t)l * 32768 + idx];
        *(LAS unsigned short*)(rwT + e * RP + k * 2) = (unsigned short)(cvt_pk_bf16(v, 0.f) & 0xffffu); }
    for (int tile = bid; tile < NTOK / 256; tile += nblk) {
        const int tok0 = tile * 256, b = tok0 >> 13;
        {
            f32x4 ca[4], cc[4];
#pragma unroll
            for (int j = 0; j < 4; ++j) { const int col = 256 * j + 4 * lane; const f32x4 g = *(const f32x4*)(P.n2g + l * D + col); const f32x4 sc = *(const f32x4*)(mod + (size_t)(l * NB + b) * NMOD + 4 * D + col);
                ca[j] = g * (1.0f + sc); cc[j] = *(const f32x4*)(mod + (size_t)(l * NB + b) * NMOD + 3 * D + col); }
            for (int rr = 0; rr < 32; ++rr) {
                const int row = tok0 + wid * 32 + rr;
                f32x4 v[4]; float ss = 0.f;
#pragma unroll
                for (int j = 0; j < 4; ++j) { v[j] = *(const f32x4*)(P.out + (size_t)row * D + 256 * j + 4 * lane); ss += (v[j].x * v[j].x + v[j].y * v[j].y) + (v[j].z * v[j].z + v[j].w * v[j].w); }
                const float rstd = 1.0f / sqrtf(wave_sum(ss) * (1.0f / D) + EPS);
#pragma unroll
                for (int j = 0; j < 4; ++j) { const f32x4 h = v[j] * rstd * ca[j] + cc[j]; u32x2 o; o.x = cvt_pk_bf16(h.x, h.y); o.y = cvt_pk_bf16(h.z, h.w); *(u32x2*)(H + (size_t)row * D + 256 * j + 4 * lane) = o;
                    *(unsigned*)(ws + WS_H8 + (size_t)row * D + 256 * j + 4 * lane) = cvt_pk4_fp8(h.x, h.y, h.z, h.w); }
            }
        }
        asm volatile("s_waitcnt vmcnt(0)" ::: "memory");
        __syncthreads();
#pragma unroll 1
        for (int rg = 0; rg < 2; ++rg) {
            f32x4 a0 = (f32x4){0.f, 0.f, 0.f, 0.f}, a1 = a0;
            const bf16* hp = H + (size_t)(tok0 + 32 * wid + 16 * rg + fr) * D + 8 * fq;
            for (int s = 0; s < 32; ++s) {
                const bf16x8 af = *(const bf16x8*)(hp + 32 * s);
                const bf16x8 b0 = *(const LAS bf16x8*)(rwT + fr * RP + (32 * s + 8 * fq) * 2), b1 = *(const LAS bf16x8*)(rwT + (16 + fr) * RP + (32 * s + 8 * fq) * 2);
                a0 = __builtin_amdgcn_mfma_f32_16x16x32_bf16(af, b0, a0, 0, 0, 0); a1 = __builtin_amdgcn_mfma_f32_16x16x32_bf16(af, b1, a1, 0, 0, 0);
            }
            const float rb0 = P.rb[l * 32 + fr], rb1 = P.rb[l * 32 + 16 + fr];
#pragma unroll
            for (int r = 0; r < 4; ++r) { const int row = 32 * wid + 16 * rg + 4 * fq + r; lg[row * 33 + fr] = a0[r] + rb0; lg[row * 33 + 16 + fr] = a1[r] + rb1; }
        }
        __syncthreads();
        if (tid < 256) {
            float v[32];
#pragma unroll
            for (int e = 0; e < 32; ++e) v[e] = lg[tid * 33 + e];
            float tv[4]; int ti[4];
#pragma unroll
            for (int k = 0; k < 4; ++k) {
                float best = -__builtin_inff(); int bi = 0;
#pragma unroll
                for (int e = 0; e < 32; ++e) { const bool gt = v[e] > best; best = gt ? v[e] : best; bi = gt ? e : bi; }
                tv[k] = best; ti[k] = bi;
#pragma unroll
                for (int e = 0; e < 32; ++e) v[e] = (e == bi) ? -__builtin_inff() : v[e];
            }
            const float e1 = __expf(tv[1] - tv[0]), e2 = __expf(tv[2] - tv[0]), e3 = __expf(tv[3] - tv[0]);
            const float inv = 1.0f / (1.0f + e1 + e2 + e3);
            *(f32x4*)(gates + (size_t)(tok0 + tid) * 4) = (f32x4){inv, e1 * inv, e2 * inv, e3 * inv};
#pragma unroll
            for (int k = 0; k < 4; ++k) sel[tid * 4 + k] = (unsigned short)ti[k];
#pragma unroll
            for (int e = 0; e < 32; ++e) { const unsigned long long m = __ballot((ti[0] == e) | (ti[1] == e) | (ti[2] == e) | (ti[3] == e)); if (lane == 0) emask[e * 4 + wid] = m; }
        }
        __syncthreads();
        if (tid < 256) {
            int* selg = (int*)(ws + WS_SEL);
            const unsigned long long lt = (1ull << lane) - 1ull;
            int so[4];
#pragma unroll
            for (int k = 0; k < 4; ++k) {
                const int e = sel[tid * 4 + k]; int r = 0;
                for (int w = 0; w < 4; ++w) { const unsigned long long m = emask[e * 4 + w]; r += (w < wid) ? __popcll(m) : ((w == wid) ? __popcll(m & lt) : 0); }
                so[k] = (e << 16) | r;
            }
            *(int4*)(selg + (size_t)(tok0 + tid) * 4) = make_int4(so[0], so[1], so[2], so[3]);
        }
        if (tid < 32) { int c = 0; for (int w = 0; w < 4; ++w) c += __popcll(emask[tid * 4 + w]); ((int*)(ws + WS_CNTB))[(size_t)(l * 256 + tile) * 32 + tid] = c; }
        __syncthreads();
    }
}

__device__ __forceinline__ void place_phase(const Params& P, LAS unsigned char* lds, int l, int bid, int nblk) {
    const int tid = opaque_tid();
    unsigned char* ws = P.ws;
    const int* cntb = (const int*)(ws + WS_CNTB) + (size_t)l * 256 * 32;
    const int* selg = (const int*)(ws + WS_SEL);
    int* list = (int*)(ws + WS_LIST);
    LAS int* red = (LAS int*)lds;
    LAS int* base = red + 512;
    const int e = tid & 31, part = tid >> 5;
    __syncthreads();
    for (int tile = bid; tile < NTOK / 256 + 1; tile += nblk) {
        int s = 0;
        for (int q = 0; q < 16; ++q) { const int t = part * 16 + q; if (t < tile) s += cntb[t * 32 + e]; }
        red[part * 32 + e] = s;
        __syncthreads();
        if (tid < 32) { int b = 0; for (int p = 0; p < 16; ++p) b += red[p * 32 + tid]; base[tid] = b; if (tile == NTOK / 256) ((int*)(ws + WS_TOT))[l * 32 + tid] = b; }
        __syncthreads();
        if (tile < NTOK / 256 && tid < 256) {
            const int tok = tile * 256 + tid; const int4 v = *(const int4*)(selg + (size_t)tok * 4);
            const int vv[4] = {v.x, v.y, v.z, v.w};
#pragma unroll
            for (int k = 0; k < 4; ++k) { const int ee = vv[k] >> 16, r = vv[k] & 0xffff; { const int rk = base[ee] + r; list[(size_t)ee * NTOK + (rk & ~255) + lperm(rk & 255)] = tok * 4 + k; } }
        }
        __syncthreads();
    }
}

constexpr int BK = 64, HALF = 128, HTB = HALF * BK * 2;
__device__ __forceinline__ int lds_byte(int r, int c) { const int st = (r >> 4) * 2 + (c >> 5), rr = r & 15, cc = c & 31, ob = rr * 64 + cc * 2; return st * 1024 + (ob ^ (((ob >> 9) & 1) << 5)); }
__device__ __forceinline__ void stage_rc(int b, int& R, int& C) { const int st = b / 1024, sb = b % 1024, swz = sb ^ (((sb >> 9) & 1) << 5); R = (st >> 1) * 16 + swz / 64; C = (st & 1) * 32 + (swz % 64) / 2; }

template <bool F8> struct FragT;
template <> struct FragT<false> {
    struct A { bf16x8 k[2]; };
    static __device__ __forceinline__ void load(A& d, const LAS unsigned char* p) { d.k[0] = *(const LAS bf16x8*)p; d.k[1] = *(const LAS bf16x8*)(p + 1024); }
    static __device__ __forceinline__ f32x4 mma(const A& a, const A& b, f32x4 c) { c = __builtin_amdgcn_mfma_f32_16x16x32_bf16(a.k[0], b.k[0], c, 0, 0, 0); return __builtin_amdgcn_mfma_f32_16x16x32_bf16(a.k[1], b.k[1], c, 0, 0, 0); }
};
template <> struct FragT<true> {
    typedef i32x8 A;
    static __device__ __forceinline__ void load(A& d, const LAS unsigned char* p) { const i32x4 lo = *(const LAS i32x4*)p, hi = *(const LAS i32x4*)(p + 1024); d = __builtin_shufflevector(lo, hi, 0, 1, 2, 3, 4, 5, 6, 7); }
    static __device__ __forceinline__ f32x4 mma(const A& a, const A& b, f32x4 c) { const int one = 0x7f7f7f7f;
        asm volatile("v_mfma_scale_f32_16x16x128_f8f6f4 %0, %1, %2, %0, %3, %3 op_sel_hi:[0,0,0]" : "+v"(c) : "v"(a), "v"(b), "v"(one)); return c; }
};
template <class Pb>
__device__ __forceinline__ void gemm_phase8(LAS unsigned char* lds, const Pb& pb, int bid, int nblk) {
    const int tid = opaque_tid(), wid = __builtin_amdgcn_readfirstlane(tid >> 6), lane = tid & 63, wr = wid >> 2, wc = wid & 3, fr = lane & 15, fq = lane >> 4;
    constexpr bool F8 = Pb::F8;
    const int RB = F8 ? pb.K : pb.K * 2;
    const int nt = RB / 128;
    int Rp[2], Cp[2];
#pragma unroll
    for (int i = 0; i < 2; ++i) stage_rc(tid * 16 + i * 8192, Rp[i], Cp[i]);
    unsigned voB[2][2];
#pragma unroll
    for (int h = 0; h < 2; ++h)
#pragma unroll
        for (int i = 0; i < 2; ++i) voB[h][i] = (unsigned)pb.b_rowc(128 * h + Rp[i]) * (unsigned)RB + (unsigned)Cp[i] * 2u;
    const unsigned ldsw = (unsigned)wid * 1024u;
    const int aoff = lds_byte(wr * 64 + fr, fq * 8), boff = lds_byte(wc * 32 + fr, fq * 8);
#define PG8_SA(b, h) (((b) * 2 + (h)) * HTB)
#define PG8_SB(b, h) ((4 + (b) * 2 + (h)) * HTB)
#define PG8_STAGE(bufoff, rsrc, soff, voff) do { _Pragma("unroll") for (int _i = 0; _i < 2; ++_i) \
        __builtin_amdgcn_raw_ptr_buffer_load_lds(rsrc, (LAS unsigned*)(lds + (bufoff) + ldsw + _i * 8192), 16, (int)(voff)[_i], (int)(soff), 0, 0); } while (0)
#define PG8_LDA(dst, b, h) do { _Pragma("unroll") for (int m = 0; m < 4; ++m) FragT<F8>::load(dst[m], lds + PG8_SA(b, h) + aoff + m * 2048); } while (0)
#define PG8_LDB(dst, b, h) do { _Pragma("unroll") for (int n = 0; n < 2; ++n) FragT<F8>::load(dst[n], lds + PG8_SB(b, h) + boff + n * 2048); } while (0)
#define PG8_MMA(ai, bj, At, Bt) do { __builtin_amdgcn_s_setprio(1); _Pragma("unroll") for (int m = 0; m < 4; ++m) _Pragma("unroll") for (int n = 0; n < 2; ++n) \
        acc[ai][bj][m][n] = FragT<F8>::mma(Bt[n], At[m], acc[ai][bj][m][n]); __builtin_amdgcn_s_setprio(0); } while (0)
#define PG8_WAIT_V(n) asm volatile("s_waitcnt vmcnt(" #n ")" ::: "memory")
#define PG8_WAIT_L(n) asm volatile("s_waitcnt lgkmcnt(" #n ")" ::: "memory")
#define PG8_BAR __builtin_amdgcn_s_barrier()
#define PG8_SCHED __builtin_amdgcn_sched_barrier(0)
#define PG8_VOA(dst, un) do { int _r[4]; pb.a_rows4(un, Rp[0], _r); _Pragma("unroll") for (int h = 0; h < 2; ++h) _Pragma("unroll") for (int i = 0; i < 2; ++i) dst[h][i] = (unsigned)_r[2 * h + i] * (unsigned)RB + (unsigned)Cp[i] * 2u; } while (0)
    Unit cur, nxt; int ui = 0;
    if (!pb.next(0, bid, nblk, cur)) return;
    Acc acc;
#pragma unroll
    for (int a = 0; a < 2; ++a)
#pragma unroll
        for (int b = 0; b < 2; ++b)
#pragma unroll
            for (int m = 0; m < 4; ++m)
#pragma unroll
                for (int n = 0; n < 2; ++n) acc[a][b][m][n] = (f32x4){0.f, 0.f, 0.f, 0.f};
    typename FragT<F8>::A At[4]; typename FragT<F8>::A B0[2], B1[2];
    unsigned voAc[2][2], voAn[2][2];
    PG8_VOA(voAc, cur);
    const __amdgpu_buffer_rsrc_t rA = __builtin_amdgcn_make_buffer_rsrc((void*)pb.A, 0, 0x7fffffff, 0x00020000), rB = __builtin_amdgcn_make_buffer_rsrc((void*)pb.B, 0, 0x7fffffff, 0x00020000);
    unsigned cB = (unsigned)pb.b_base_row(cur) * (unsigned)RB;
    { const unsigned k0 = (unsigned)(cur.ks & (nt - 1)) * 128u, k1 = (unsigned)((cur.ks + 1) & (nt - 1)) * 128u;
    PG8_STAGE(PG8_SB(0, 0), rB, cB + k0, voB[0]); PG8_STAGE(PG8_SB(0, 1), rB, cB + k0, voB[1]); PG8_STAGE(PG8_SA(0, 0), rA, k0, voAc[0]); PG8_STAGE(PG8_SA(0, 1), rA, k0, voAc[1]);
    if (wr == 1) PG8_BAR;
    PG8_WAIT_V(2); PG8_BAR;
    PG8_STAGE(PG8_SB(1, 0), rB, cB + k1, voB[0]); PG8_STAGE(PG8_SA(1, 0), rA, k1, voAc[0]); PG8_STAGE(PG8_SB(1, 1), rB, cB + k1, voB[1]); }
    PG8_WAIT_V(6); PG8_BAR;
    for (;;) {
        const bool has_next = pb.next(ui + 1, bid, nblk, nxt);
        unsigned nB = cB; int nks = cur.ks;
        if (has_next) { PG8_VOA(voAn, nxt); nB = (unsigned)pb.b_base_row(nxt) * (unsigned)RB; nks = nxt.ks; }
        else {
#pragma unroll
            for (int h = 0; h < 2; ++h)
#pragma unroll
                for (int i = 0; i < 2; ++i) voAn[h][i] = voAc[h][i]; }
        for (int t = 0; t < nt; t += 2) {
            const bool last = (t == nt - 2);
            const unsigned a1 = (unsigned)((t + 1 + cur.ks) & (nt - 1)) * 128u;
            const int ks2 = last ? nks : (t + 2 + cur.ks);
            const unsigned a2 = (unsigned)(ks2 & (nt - 1)) * 128u, a3 = (unsigned)((ks2 + 1) & (nt - 1)) * 128u;
            const unsigned bb = last ? nB : cB;
            const unsigned b2 = bb + a2, b3 = bb + a3;
            unsigned sa[2][2];
#pragma unroll
            for (int h = 0; h < 2; ++h)
#pragma unroll
                for (int i = 0; i < 2; ++i) sa[h][i] = last ? voAn[h][i] : voAc[h][i];
            PG8_LDB(B0, 0, 0); PG8_LDB(B1, 0, 1); PG8_SCHED; PG8_LDA(At, 0, 0); PG8_STAGE(PG8_SA(1, 1), rA, a1, voAc[1]);
            PG8_WAIT_V(8); PG8_WAIT_L(0); PG8_BAR; PG8_MMA(0, 0, At, B0); PG8_MMA(0, 1, At, B1); PG8_BAR; PG8_SCHED;
            PG8_LDA(At, 0, 1); PG8_STAGE(PG8_SB(0, 0), rB, b2, voB[0]); PG8_STAGE(PG8_SB(0, 1), rB, b2, voB[1]); PG8_STAGE(PG8_SA(0, 0), rA, a2, sa[0]);
            PG8_WAIT_V(8); PG8_WAIT_L(0); PG8_BAR; PG8_MMA(1, 0, At, B0); PG8_MMA(1, 1, At, B1); PG8_BAR; PG8_SCHED;
            PG8_LDB(B0, 1, 0); PG8_LDB(B1, 1, 1); PG8_SCHED; PG8_LDA(At, 1, 0); PG8_STAGE(PG8_SA(0, 1), rA, a2, sa[1]);
            PG8_WAIT_V(8); PG8_WAIT_L(0); PG8_BAR; PG8_MMA(0, 0, At, B0); PG8_MMA(0, 1, At, B1); PG8_BAR; PG8_SCHED;
            PG8_LDA(At, 1, 1); PG8_STAGE(PG8_SB(1, 0), rB, b3, voB[0]); PG8_STAGE(PG8_SB(1, 1), rB, b3, voB[1]); PG8_STAGE(PG8_SA(1, 0), rA, a3, sa[0]);
            PG8_WAIT_V(8); PG8_WAIT_L(0); PG8_BAR; PG8_MMA(1, 0, At, B0); PG8_MMA(1, 1, At, B1); PG8_BAR; PG8_SCHED;
        }
        if (wr == 0) PG8_BAR;
        if constexpr (F8) asm volatile("s_nop 15\n\ts_nop 15" ::: "memory");
        pb.epi(acc, cur, wr, wc, fr, fq);
        if (!has_next) break;
#pragma unroll
        for (int a = 0; a < 2; ++a)
#pragma unroll
            for (int b = 0; b < 2; ++b)
#pragma unroll
                for (int m = 0; m < 4; ++m)
#pragma unroll
                    for (int n = 0; n < 2; ++n) acc[a][b][m][n] = (f32x4){0.f, 0.f, 0.f, 0.f};
        cur = nxt; cB = nB; ++ui;
#pragma unroll
        for (int h = 0; h < 2; ++h)
#pragma unroll
            for (int i = 0; i < 2; ++i) voAc[h][i] = voAn[h][i];
        if (wr == 1) PG8_BAR;
    }
    PG8_WAIT_V(0);
    PG8_BAR;
#undef PG8_SA
#undef PG8_SB
#undef PG8_STAGE
#undef PG8_LDA
#undef PG8_LDB
#undef PG8_MMA
#undef PG8_WAIT_V
#undef PG8_WAIT_L
#undef PG8_BAR
#undef PG8_SCHED
#undef PG8_VOA
}

#ifndef FAST_INPROJ
#define FAST_INPROJ 1
#endif
#ifndef FAST_OUTPROJ
#define FAST_OUTPROJ 1
#endif
#ifndef FAST_GU
#define FAST_GU 1
#endif
#ifndef FAST_DOWN
#define FAST_DOWN 1
#endif
template <bool FAST, class Pb> __device__ __forceinline__ void gemm_run(LAS unsigned char* lds, const Pb& pb, int bid, int nblk) {
    if constexpr (FAST) gemm_phase8(lds, pb, bid, nblk); else gemm_simple(lds, pb, bid, nblk);
}

__device__ __forceinline__ void inproj_phase(const Params& P, LAS unsigned char* lds, int l, int bid, int nblk) {
    unsigned char* ws = P.ws;
    PbInProj pb; pb.A = (const char*)(ws + WS_H); pb.B = (const char*)(ws + WS_WIN) + (size_t)l * (1280 * 1024 * 2); pb.K = 1024;
    pb.proj = (bf16*)(ws + WS_PROJ); pb.qg = P.qg + l * 64; pb.kg = P.kg + l * 64; pb.rope = (const float*)(ws + WS_ROPE);
    gemm_run<FAST_INPROJ>(lds, pb, bid, nblk);
}
__device__ __forceinline__ void outproj_phase(const Params& P, LAS unsigned char* lds, int l, int bid, int nblk) {
    unsigned char* ws = P.ws;
    PbOutProj pb; pb.A = (const char*)(ws + WS_MIX); pb.B = (const char*)(ws + WS_WOUT) + (size_t)l * (1024 * 1024 * 2); pb.K = 1024;
    pb.xin = (l == 0) ? P.x : P.out; pb.xout = P.out; pb.gate1 = (const float*)(ws + WS_MOD) + (size_t)l * NB * NMOD + 2 * D;
    gemm_run<FAST_OUTPROJ>(lds, pb, bid, nblk);
}
__device__ __forceinline__ void gu_phase(const Params& P, LAS unsigned char* lds, int l, int bid, int nblk) {
    unsigned char* ws = P.ws;
    LAS int* tab = (LAS int*)(lds + 131072);
    __syncthreads();
    moe_build_tab(tab, (const int*)(ws + WS_TOT) + l * 32);
    PbGU pb; pb.A = (const char*)(ws + WS_H8); pb.B = (const char*)(ws + WS_WGU) + (size_t)l * 32 * (2048 * 1024); pb.K = 1024;
    pb.tab = tab; pb.list = (const int*)(ws + WS_LIST); pb.bgu = P.bgu + (size_t)l * 32 * 2048; pb.act = ws + WS_ACT;
    gemm_phase8(lds, pb, bid, nblk);
}
__device__ __forceinline__ void down_phase(const Params& P, LAS unsigned char* lds, int l, int bid, int nblk) {
    unsigned char* ws = P.ws;
    LAS int* tab = (LAS int*)(lds + 131072);
    __syncthreads();
    moe_build_tab(tab, (const int*)(ws + WS_TOT) + l * 32);
    PbDown pb; pb.A = (const char*)(ws + WS_ACT); pb.B = (const char*)(ws + WS_WDN) + (size_t)l * 32 * (1024 * 1024); pb.K = 1024;
    pb.tab = tab; pb.list = (const int*)(ws + WS_LIST); pb.bdn = P.bdn + (size_t)l * 32 * 1024; pb.ybuf = (bf16*)(ws + WS_YBUF);
    gemm_phase8(lds, pb, bid, nblk);
}

#define XB_TMO      128
#define XB_XCNT(j)  (256  + 64 * (j))
#define XB_XSUB(j)  (1280 + 64 * (j))
#define XB_XGEN(j)  (2304 + 64 * (j))
#define XB_TOP      3328
#define XB_TOPGEN   3392
#define XCD_BAR_WORDS 3456
#define XB_SPIN_CAP (1u << 18)
__device__ __forceinline__ unsigned xb_ld(unsigned* p)              { return __hip_atomic_load(p, __ATOMIC_RELAXED, __HIP_MEMORY_SCOPE_AGENT); }
__device__ __forceinline__ unsigned xb_add(unsigned* p, unsigned v) { return __hip_atomic_fetch_add(p, v, __ATOMIC_RELAXED, __HIP_MEMORY_SCOPE_AGENT); }
__device__ __forceinline__ unsigned xb_xcc_id() { return (unsigned)__builtin_amdgcn_s_getreg((3 << 11) | 20) & 0xFu; }
#define XB_SPIN(cond, bar) do { unsigned _sp = 0; while (cond) { __builtin_amdgcn_s_sleep(1); \
    if ((++_sp & 255u) == 0u) { if (xb_ld(&(bar)[XB_TMO])) break; if (_sp > XB_SPIN_CAP) { atomicAdd(&(bar)[XB_TMO], 1u); break; } } } } while (0)
struct XcdBarrier { unsigned* bar; unsigned x; volatile LAS unsigned* st; };
__device__ __forceinline__ XcdBarrier xcd_barrier_post(unsigned* bar, volatile LAS unsigned* st) {
    XcdBarrier b; b.bar = bar; b.x = xb_xcc_id(); b.st = st;
    if (threadIdx.x == 0) (void)xb_add(&bar[XB_XCNT(b.x)], 1u);
    return b;
}
__device__ __forceinline__ void xcd_barrier_complete(unsigned* bar, unsigned x, unsigned& nloc, unsigned& nx) {
    const unsigned G = gridDim.x * gridDim.y * gridDim.z;
    unsigned sum, cnt, mine, sp = 0u;
    for (;;) {
        sum = 0u; cnt = 0u; mine = 0u;
#pragma unroll
        for (unsigned j = 0; j < 16; ++j) { const unsigned c = xb_ld(&bar[XB_XCNT(j)]); sum += c; cnt += (c > 0u) ? 1u : 0u; mine = (j == x) ? c : mine; }
        if (sum == G) break;
        __builtin_amdgcn_s_sleep(1);
        if ((++sp & 255u) == 0u) { if (xb_ld(&bar[XB_TMO])) break; if (sp > XB_SPIN_CAP) { atomicAdd(&bar[XB_TMO], 1u); break; } }
    }
    nloc = mine > 0u ? mine : 1u; nx = cnt > 0u ? cnt : 1u;
}
__device__ __forceinline__ void xcd_barrier(const XcdBarrier& b) {
    asm volatile("s_waitcnt vmcnt(0)" ::: "memory");
    __syncthreads();
    if (threadIdx.x == 0) {
        unsigned* bar = b.bar; const unsigned bx = xb_xcc_id();
        __builtin_amdgcn_s_waitcnt(0);
        unsigned nloc = b.st[0], nx = b.st[1];
        if (nloc == 0u) { xcd_barrier_complete(bar, bx, nloc, nx); b.st[0] = nloc; b.st[1] = nx; }
        const unsigned old = xb_add(&bar[XB_XSUB(bx)], 1u);
        const unsigned gen = old / nloc;
        if (old + 1u == (gen + 1u) * nloc) {
            __builtin_amdgcn_fence(__ATOMIC_RELEASE, "agent");
            asm volatile("s_waitcnt vmcnt(0)" ::: "memory");
            const unsigned og = xb_add(&bar[XB_TOP], 1u);
            const unsigned tg = og / nx;
            if (og + 1u == (tg + 1u) * nx) xb_add(&bar[XB_TOPGEN], 1u);
            else XB_SPIN(xb_ld(&bar[XB_TOPGEN]) == tg, bar);
            __builtin_amdgcn_fence(__ATOMIC_ACQUIRE, "agent");
            xb_add(&bar[XB_XGEN(bx)], 1u);
            asm volatile("s_waitcnt vmcnt(0)" ::: "memory");
        } else {
            XB_SPIN(xb_ld(&bar[XB_XGEN(bx)]) == gen, bar);
            __builtin_amdgcn_fence(__ATOMIC_ACQUIRE, "agent");
            asm volatile("s_waitcnt vmcnt(0)" ::: "memory");
        }
    }
    __syncthreads();
}


#if ONE_LAUNCH
constexpr int TAB_OFF = 131072, MISC_OFF = 131072 + 512;
__global__ void __launch_bounds__(NT, 2) mega_fwd(Params P) {
    extern __shared__ __attribute__((aligned(16))) unsigned char dyn_lds[];
    LAS unsigned char* lds = (LAS unsigned char*)dyn_lds;
    volatile LAS unsigned* MISC = (volatile LAS unsigned*)(lds + MISC_OFF);
    if (threadIdx.x < 32) MISC[threadIdx.x] = 0u;
    __syncthreads();
    XcdBarrier bar = xcd_barrier_post((unsigned*)(P.ws + WS_CTL) + CW_BAR, MISC + 8);
    const int bid = blockIdx.x, nblk = gridDim.x;
    const int vb = (nblk % 8 == 0) ? (bid % 8) * (nblk / 8) + bid / 8 : bid;
#ifndef REP_P0
#define REP_P0 1
#endif
#ifndef REP_INPROJ
#define REP_INPROJ 1
#endif
#ifndef REP_ATTN
#define REP_ATTN 1
#endif
#ifndef REP_GU
#define REP_GU 1
#endif
#ifndef REP_DOWN
#define REP_DOWN 1
#endif
    for (int r = 0; r < REP_P0; ++r) { p0_prologue(P, lds, bid, nblk); xcd_barrier(bar); }
    for (int l = 0; l < DEPTH; ++l) {
        if (l == 0) norm1_phase<0>(P, l, bid, nblk); else norm1_phase<1>(P, l, bid, nblk);
        xcd_barrier(bar);
        for (int r = 0; r < REP_INPROJ; ++r) { inproj_phase(P, lds, l, vb, nblk); xcd_barrier(bar); }
        for (int r = 0; r < REP_ATTN; ++r) { attn_phase(P, lds, l, bid, nblk); xcd_barrier(bar); }
        outproj_phase(P, lds, l, vb, nblk);
        xcd_barrier(bar);
        router_phase(P, lds, l, bid, nblk);
        xcd_barrier(bar);
        place_phase(P, lds, l, bid, nblk);
        xcd_barrier(bar);
        for (int r = 0; r < REP_GU; ++r) { gu_phase(P, lds, l, vb, nblk); xcd_barrier(bar); }
        for (int r = 0; r < REP_DOWN; ++r) { down_phase(P, lds, l, vb, nblk); xcd_barrier(bar); }
    }
    norm1_phase<2>(P, 0, bid, nblk);
}
#else
extern __shared__ __attribute__((aligned(16))) unsigned char dyn_lds[];
#define KLDS ((LAS unsigned char*)dyn_lds)
__global__ void __launch_bounds__(NT, 2) k_prologue(Params P) { p0_prologue(P, KLDS, blockIdx.x, gridDim.x); }
__global__ void __launch_bounds__(NT, 2) k_norm1_0(Params P, int l) { norm1_phase<0>(P, l, blockIdx.x, gridDim.x); }
__global__ void __launch_bounds__(NT, 2) k_norm1_1(Params P, int l) { norm1_phase<1>(P, l, blockIdx.x, gridDim.x); }
__global__ void __launch_bounds__(NT, 2) k_final(Params P) { norm1_phase<2>(P, 0, blockIdx.x, gridDim.x); }
__global__ void __launch_bounds__(NT, 2) k_inproj(Params P, int l) { inproj_phase(P, KLDS, l, blockIdx.x, gridDim.x); }
__global__ void __launch_bounds__(NT, 2) k_attn(Params P, int l) { attn_phase(P, KLDS, l, blockIdx.x, gridDim.x); }
__global__ void __launch_bounds__(NT, 2) k_outproj(Params P, int l) { outproj_phase(P, KLDS, l, blockIdx.x, gridDim.x); }
__global__ void __launch_bounds__(NT, 2) k_router(Params P, int l) { router_phase(P, KLDS, l, blockIdx.x, gridDim.x); }
__global__ void __launch_bounds__(NT, 2) k_place(Params P, int l) { place_phase(P, KLDS, l, blockIdx.x, gridDim.x); }
__global__ void __launch_bounds__(NT, 2) k_gu(Params P, int l) { gu_phase(P, KLDS, l, blockIdx.x, gridDim.x); }
__global__ void __launch_bounds__(NT, 2) k_down(Params P, int l) { down_phase(P, KLDS, l, blockIdx.x, gridDim.x); }

#endif

extern "C" void kernel_launch(void* const* d_in, const int* in_sizes, int n_in, void* d_out, int out_size, void* d_ws, size_t ws_size, hipStream_t stream) {
    static int ready = 0;
    if (ready == 0) {
        if (n_in != 21 || out_size != NTOK * D || ws_size < WS_END) { fprintf(stderr, "kernel_launch: unexpected shapes (n_in %d out %d ws %zu)\n", n_in, out_size, ws_size); ready = -1; return; }
#if ONE_LAUNCH
        const void* ks[] = {(const void*)mega_fwd};
#else
        const void* ks[] = {(const void*)k_prologue, (const void*)k_norm1_0, (const void*)k_norm1_1, (const void*)k_final, (const void*)k_inproj, (const void*)k_attn, (const void*)k_outproj, (const void*)k_router, (const void*)k_gu, (const void*)k_down, (const void*)k_place};
#endif
        for (auto k : ks) if (hipFuncSetAttribute(k, hipFuncAttributeMaxDynamicSharedMemorySize, LDS_BYTES) != hipSuccess) { fprintf(stderr, "kernel_launch: hipFuncSetAttribute failed\n"); ready = -1; return; }
        ready = 1;
    }
    if (ready < 0) return;
    (void)hipMemsetAsync((char*)d_ws + WS_CTL, 0, CTL_ZERO_BYTES, stream);
    Params P{};
    P.x = (const float*)d_in[0]; P.c = (const float*)d_in[1]; P.pos = (const int*)d_in[2]; P.ada_w = (const float*)d_in[3]; P.ada_b = (const float*)d_in[4]; P.n1g = (const float*)d_in[5];
    P.w_in = (const float*)d_in[6]; P.qg = (const float*)d_in[7]; P.kg = (const float*)d_in[8]; P.sinks = (const float*)d_in[9]; P.pool_w = (const float*)d_in[10]; P.pool_b = (const float*)d_in[11];
    P.pool_s = (const float*)d_in[12]; P.w_out = (const float*)d_in[13]; P.n2g = (const float*)d_in[14]; P.rw = (const float*)d_in[15]; P.rb = (const float*)d_in[16]; P.wgu = (const float*)d_in[17];
    P.bgu = (const float*)d_in[18]; P.wdn = (const float*)d_in[19]; P.bdn = (const float*)d_in[20]; P.out = (float*)d_out; P.ws = (unsigned char*)d_ws;
    const dim3 g(256), b(NT);
#if ONE_LAUNCH
    hipLaunchKernelGGL(mega_fwd, g, b, LDS_BYTES, stream, P);
#else
    hipLaunchKernelGGL(k_prologue, g, b, LDS_BYTES, stream, P);
    for (int l = 0; l < DEPTH; ++l) {
        if (l == 0) hipLaunchKernelGGL(k_norm1_0, g, b, LDS_BYTES, stream, P, l); else hipLaunchKernelGGL(k_norm1_1, g, b, LDS_BYTES, stream, P, l);
        hipLaunchKernelGGL(k_inproj, g, b, LDS_BYTES, stream, P, l);
        hipLaunchKernelGGL(k_attn, g, b, LDS_BYTES, stream, P, l);
        hipLaunchKernelGGL(k_outproj, g, b, LDS_BYTES, stream, P, l);
        hipLaunchKernelGGL(k_router, g, b, LDS_BYTES, stream, P, l);
        hipLaunchKernelGGL(k_place, g, b, LDS_BYTES, stream, P, l);
        hipLaunchKernelGGL(k_gu, g, b, LDS_BYTES, stream, P, l);
        hipLaunchKernelGGL(k_down, g, b, LDS_BYTES, stream, P, l);
    }
    hipLaunchKernelGGL(k_final, g, b, LDS_BYTES, stream, P);
#endif
}
```

```cpp
#include <hip/hip_runtime.h>
#include <cstdio>
#include <cstdint>

#ifndef ONE_LAUNCH
#define ONE_LAUNCH 1
#endif

#define LAS __attribute__((address_space(3)))
typedef unsigned short bf16;
typedef short bf16x8 __attribute__((ext_vector_type(8)));
typedef short s16x4 __attribute__((ext_vector_type(4)));
typedef float f32x4 __attribute__((ext_vector_type(4)));
typedef float f32x16 __attribute__((ext_vector_type(16)));
typedef unsigned u32x4 __attribute__((ext_vector_type(4)));
typedef unsigned u32x2 __attribute__((ext_vector_type(2)));
typedef float f32x2 __attribute__((ext_vector_type(2)));
typedef int i32x4 __attribute__((ext_vector_type(4)));
typedef int i32x8 __attribute__((ext_vector_type(8)));

constexpr int D = 1024, NB = 8, SEQ = 8192, NTOK = NB * SEQ, DEPTH = 2, NE = 32, NIN = 1280, NMOD = 6 * D;
constexpr int NT = 512;
constexpr float EPS = 1e-6f;
constexpr float LOG2E = 1.4426950408889634f;
constexpr float QSCALE = 0.18033688011112042f;
constexpr int MAXTILES = NTOK * 4 / 256 + NE;

constexpr size_t MiB = 1u << 20;
constexpr size_t WS_CTL = 0, CTL_ZERO_BYTES = 1 * MiB;
constexpr size_t WS_MOD = 1 * MiB;
constexpr size_t WS_ROPE = 2 * MiB;
constexpr size_t WS_WIN = 8 * MiB;
constexpr size_t WS_WOUT = 16 * MiB;
constexpr size_t WS_GATES = 20 * MiB;
constexpr size_t WS_SEL = 21 * MiB;
constexpr size_t WS_CNTB = 22 * MiB;
constexpr size_t WS_TOT = 23 * MiB;
constexpr size_t WS_LIST = 24 * MiB;
constexpr size_t WS_WGU = 32 * MiB;
constexpr size_t WS_WDN = 160 * MiB;
constexpr size_t WS_H = 224 * MiB;
constexpr size_t WS_H8 = 352 * MiB;
constexpr size_t WS_PROJ = 416 * MiB;
constexpr size_t WS_MIX = 576 * MiB;
constexpr size_t WS_ACT = 416 * MiB;
constexpr size_t WS_YBUF = 704 * MiB;
constexpr size_t WS_END = 1216 * MiB;
static_assert(WS_ACT + (size_t)MAXTILES * 256 * 1024 <= WS_YBUF, "act fits");
constexpr float WSCALE = 32.0f, WUNSCALE = 1.0f / 32.0f;
constexpr int CW_BAR = 4096;
constexpr int CW_CNT = 8192;

constexpr int LDS_BYTES = 147456;

struct Params {
    const float *x, *c; const int* pos; const float *ada_w, *ada_b, *n1g, *w_in, *qg, *kg, *sinks, *pool_w, *pool_b, *pool_s, *w_out, *n2g, *rw, *rb, *wgu, *bgu, *wdn, *bdn;
    float* out; unsigned char* ws;
};

__device__ __forceinline__ unsigned cvt_pk_bf16(float lo, float hi) { unsigned r; asm("v_cvt_pk_bf16_f32 %0, %1, %2" : "=v"(r) : "v"(lo), "v"(hi)); return r; }
__device__ __forceinline__ unsigned cvt_pk4_fp8(float a, float b, float c, float d) { int w = 0; w = __builtin_amdgcn_cvt_pk_fp8_f32(a, b, w, false); w = __builtin_amdgcn_cvt_pk_fp8_f32(c, d, w, true); return (unsigned)w; }
__device__ __forceinline__ float bf_lo(unsigned w) { return __uint_as_float(w << 16); }
__device__ __forceinline__ float bf_hi(unsigned w) { return __uint_as_float(w & 0xffff0000u); }
template <int M> __device__ __forceinline__ float swz_xor(float v) { return __int_as_float(__builtin_amdgcn_ds_swizzle(__float_as_int(v), (M << 10) | 0x1f)); }
__device__ __forceinline__ float sum_x32(float v) { const auto r = __builtin_amdgcn_permlane32_swap(__float_as_uint(v), __float_as_uint(v), false, false); return __uint_as_float(r[0]) + __uint_as_float(r[1]); }
__device__ __forceinline__ float max_x32(float v) { const auto r = __builtin_amdgcn_permlane32_swap(__float_as_uint(v), __float_as_uint(v), false, false); return fmaxf(__uint_as_float(r[0]), __uint_as_float(r[1])); }
__device__ __forceinline__ float wave_sum(float v) {
    v += swz_xor<1>(v); v += swz_xor<2>(v); v += swz_xor<4>(v); v += swz_xor<8>(v); v += swz_xor<16>(v);
    return sum_x32(v);
}
__device__ __forceinline__ int dpp_swap1(int v) { return __builtin_amdgcn_update_dpp(0, v, 0xB1, 0xF, 0xF, true); }
__device__ __forceinline__ u32x4 dpp_swap1(u32x4 v) { u32x4 r; r.x = (unsigned)dpp_swap1((int)v.x); r.y = (unsigned)dpp_swap1((int)v.y); r.z = (unsigned)dpp_swap1((int)v.z); r.w = (unsigned)dpp_swap1((int)v.w); return r; }
__device__ __forceinline__ void store_line_pair(unsigned char* own_line, unsigned char* nb_line, bool own_valid, bool nb_valid, u32x4 lo, u32x4 hi, int fq, bool odd) {
    const u32x4 got = dpp_swap1(odd ? lo : hi);
    const int off = (odd ? 64 : 0) + 16 * fq;
    if (odd ? nb_valid : own_valid) *(u32x4*)((odd ? nb_line : own_line) + off) = odd ? got : lo;
    if (odd ? own_valid : nb_valid) *(u32x4*)((odd ? own_line : nb_line) + off) = odd ? hi : got;
}
__device__ __forceinline__ void load_line_pair(const unsigned char* own_line, const unsigned char* nb_line, int fq, bool odd, u32x4& lo, u32x4& hi) {
    const int off = (odd ? 64 : 0) + 16 * fq;
    const u32x4 a = *(const u32x4*)((odd ? nb_line : own_line) + off), b = *(const u32x4*)((odd ? own_line : nb_line) + off);
    const u32x4 got = dpp_swap1(odd ? a : b);
    lo = odd ? got : a; hi = odd ? b : got;
}
__device__ __forceinline__ int lperm(int r) { return (r & 63) * 4 + (r >> 6); }
__device__ __forceinline__ int perm32(int rho) { const int n = rho >> 4, i = rho & 15; return 8 * (i >> 2) + 4 * n + (i & 3); }
__device__ __forceinline__ int opaque_tid() { int t = threadIdx.x; asm volatile("" : "+v"(t)); return t; }

__device__ __forceinline__ void tr_item_src(const Params& P, int it, const float*& src, int& ldw, bf16*& dst, int& k0, int& n0, bool& f8) {
    f8 = it < 16384 + 8192;
    unsigned char* ws = P.ws;
    if (it < 16384) { const int m = it >> 8, r = it & 255; src = P.wgu + (size_t)m * (1024 * 2048); ldw = 2048; dst = (bf16*)(ws + WS_WGU + (size_t)m * (2048 * 1024)); k0 = 128 * (r >> 5); n0 = 64 * (r & 31); return; }
    it -= 16384;
    if (it < 8192) { const int m = it >> 7, r = it & 127; src = P.wdn + (size_t)m * (1024 * 1024); ldw = 1024; dst = (bf16*)(ws + WS_WDN + (size_t)m * (1024 * 1024)); k0 = 128 * (r >> 4); n0 = 64 * (r & 15); return; }
    it -= 8192;
    if (it < 192) { const int l = it / 96, r = it % 96; src = P.w_in + (size_t)l * (1024 * 1280); ldw = 1280; dst = (bf16*)(ws + WS_WIN) + (size_t)l * (1280 * 1024); k0 = 128 * (r / 12); n0 = 64 * (r % 12); return; }
    it -= 192;
    { const int l = it >> 7, r = it & 127; src = P.w_out + (size_t)l * (1024 * 1024); ldw = 1024; dst = (bf16*)(ws + WS_WOUT) + (size_t)l * (1024 * 1024); k0 = 128 * (r >> 4); n0 = 64 * (r & 15); }
}
constexpr int N_TR_ITEMS = 16384 + 8192 + 192 + 256;

__device__ __forceinline__ void p0_prologue(const Params& P, LAS unsigned char* lds, int bid, int nblk) {
    const int tid = opaque_tid(), wid = __builtin_amdgcn_readfirstlane(tid >> 6), lane = tid & 63;
    unsigned char* ws = P.ws;
    {
        LAS float* cact = (LAS float*)lds;
        LAS float* red = (LAS float*)(lds + 32768);
        if (bid < 192 || nblk < 192) {
            for (int i = tid; i < NB * D; i += NT) { const float v = P.c[i]; cact[i] = v / (1.0f + __expf(-v)); }
            __syncthreads();
            for (int it = bid; it < 192; it += nblk) {
                const int l = it / 96, n0 = 64 * (it % 96);
                float acc[NB];
#pragma unroll
                for (int b = 0; b < NB; ++b) acc[b] = 0.f;
                const float* wp = P.ada_w + (size_t)l * D * NMOD + n0 + lane;
                for (int k = 128 * wid; k < 128 * wid + 128; k += 16) {
                    float wv[16];
#pragma unroll
                    for (int q = 0; q < 16; ++q) wv[q] = wp[(size_t)(k + q) * NMOD];
#pragma unroll
                    for (int q = 0; q < 16; ++q)
#pragma unroll
                        for (int b = 0; b < NB; ++b) acc[b] += cact[b * D + k + q] * wv[q];
                }
#pragma unroll
                for (int b = 0; b < NB; ++b) red[(wid * NB + b) * 64 + lane] = acc[b];
                __syncthreads();
                { const int b = tid >> 6; float s = P.ada_b[l * NMOD + n0 + lane];
#pragma unroll
                  for (int w = 0; w < 8; ++w) s += red[(w * NB + b) * 64 + lane];
                  ((float*)(ws + WS_MOD))[(size_t)(l * NB + b) * NMOD + n0 + lane] = s; }
                __syncthreads();
            }
        }
    }
    for (int it = bid; it < 128; it += nblk) {
        const int l = it >> 6, g = (it >> 4) & 3, k0 = 64 * (it & 15);
        LAS float* At = (LAS float*)lds;
        LAS float* Pw = (LAS float*)(lds + 33024);
        __syncthreads();
        for (int j = 0; j < 16; ++j) { const int idx = tid + NT * j, k = idx >> 7, c = idx & 127; At[k * 129 + c] = P.w_in[(size_t)l * (1024 * 1280) + (size_t)(k0 + k) * 1280 + 768 + 128 * g + c]; }
        for (int j = 0; j < 32; ++j) { const int idx = tid + NT * j; Pw[idx] = P.pool_w[(size_t)(l * 4 + g) * 16384 + idx]; }
        __syncthreads();
        const int n = tid & 127, ks = tid >> 7;
        float acc[16];
#pragma unroll
        for (int i = 0; i < 16; ++i) acc[i] = 0.f;
        for (int c = 0; c < 128; ++c) { const float pw = Pw[c * 128 + n];
#pragma unroll
            for (int i = 0; i < 16; ++i) acc[i] += At[(16 * ks + i) * 129 + c] * pw; }
        bf16* dst = (bf16*)(ws + WS_WIN) + (size_t)l * (1280 * 1024) + (size_t)(768 + 128 * g + n) * 1024 + k0 + 16 * ks;
        u32x4 o0, o1;
        o0.x = cvt_pk_bf16(acc[0], acc[1]); o0.y = cvt_pk_bf16(acc[2], acc[3]); o0.z = cvt_pk_bf16(acc[4], acc[5]); o0.w = cvt_pk_bf16(acc[6], acc[7]);
        o1.x = cvt_pk_bf16(acc[8], acc[9]); o1.y = cvt_pk_bf16(acc[10], acc[11]); o1.z = cvt_pk_bf16(acc[12], acc[13]); o1.w = cvt_pk_bf16(acc[14], acc[15]);
        *(u32x4*)dst = o0; *(u32x4*)(dst + 8) = o1;
    }
    {
        const double invf[8] = {1.0, 0.19392274474868576, 0.03760603093086393, 0.007292664737217109, 0.001414213562373095, 0.0002742481756762073, 5.318295896944988e-05, 1.031338537721246e-05};
        float* rope = (float*)(ws + WS_ROPE);
        for (int idx = bid * NT + tid; idx < NTOK * 8; idx += nblk * NT) {
            const int tok = idx >> 3, i = idx & 7;
            double f = 1.0;
#pragma unroll
            for (int q = 0; q < 8; ++q) f = (i == q) ? invf[q] : f;
            const double ang = (double)P.pos[tok] * f;
            const double kq = __builtin_rint(ang * 0.6366197723675814);
            const double r = (ang - kq * 1.5707963267948966) - kq * 6.123233995736766e-17;
            const double r2 = r * r;
            double sn = r * (1.0 + r2 * (-1.0 / 6 + r2 * (1.0 / 120 + r2 * (-1.0 / 5040 + r2 * (1.0 / 362880 + r2 * (-1.0 / 39916800 + r2 * (1.0 / 6227020800.0)))))));
            double cs = 1.0 + r2 * (-0.5 + r2 * (1.0 / 24 + r2 * (-1.0 / 720 + r2 * (1.0 / 40320 + r2 * (-1.0 / 3628800 + r2 * (1.0 / 479001600.0 + r2 * (-1.0 / 87178291200.0)))))));
            const int q = ((int)(long long)kq) & 3;
            double s2 = (q & 1) ? cs : sn, c2 = (q & 1) ? sn : cs;
            if (q == 1 || q == 2) c2 = -c2;
            if (q >= 2) s2 = -s2;
            rope[tok * 16 + i] = (float)c2; rope[tok * 16 + 8 + i] = (float)s2;
        }
    }
    {
        LAS float* tile = (LAS float*)lds;
        __syncthreads();
        f32x4 r[4];
        const float* src; int ldw, k0, n0; bf16* dst; bool f8;
        int it = bid;
        if (it < N_TR_ITEMS) { tr_item_src(P, it, src, ldw, dst, k0, n0, f8);
#pragma unroll
            for (int j = 0; j < 4; ++j) { const int idx = tid + NT * j, row = idx >> 4, c4 = idx & 15; r[j] = *(const f32x4*)(src + (size_t)(k0 + row) * ldw + n0 + 4 * c4); } }
        for (; it < N_TR_ITEMS; it += nblk) {
#pragma unroll
            for (int j = 0; j < 4; ++j) { const int idx = tid + NT * j, row = idx >> 4, c4 = idx & 15; LAS float* t = tile + row * 65 + 4 * c4; t[0] = r[j].x; t[1] = r[j].y; t[2] = r[j].z; t[3] = r[j].w; }
            __syncthreads();
            bf16* cdst = dst; const int ck0 = k0, cn0 = n0; const bool cf8 = f8;
            if (it + nblk < N_TR_ITEMS) { tr_item_src(P, it + nblk, src, ldw, dst, k0, n0, f8);
#pragma unroll
                for (int j = 0; j < 4; ++j) { const int idx = tid + NT * j, row = idx >> 4, c4 = idx & 15; r[j] = *(const f32x4*)(src + (size_t)(k0 + row) * ldw + n0 + 4 * c4); } }
            if (cf8) {
                const int n = tid >> 3, c = tid & 7; const LAS float* t = tile + (16 * c) * 65 + n;
                u32x4 o; o.x = cvt_pk4_fp8(t[0] * WSCALE, t[65] * WSCALE, t[2 * 65] * WSCALE, t[3 * 65] * WSCALE); o.y = cvt_pk4_fp8(t[4 * 65] * WSCALE, t[5 * 65] * WSCALE, t[6 * 65] * WSCALE, t[7 * 65] * WSCALE);
                o.z = cvt_pk4_fp8(t[8 * 65] * WSCALE, t[9 * 65] * WSCALE, t[10 * 65] * WSCALE, t[11 * 65] * WSCALE); o.w = cvt_pk4_fp8(t[12 * 65] * WSCALE, t[13 * 65] * WSCALE, t[14 * 65] * WSCALE, t[15 * 65] * WSCALE);
                *(u32x4*)((unsigned char*)cdst + (size_t)(cn0 + n) * 1024 + ck0 + 16 * c) = o;
            } else {
#pragma unroll
            for (int j = 0; j < 2; ++j) { const int p = tid + NT * j, n = p >> 4, c = p & 15; const LAS float* t = tile + (8 * c) * 65 + n;
                u32x4 o; o.x = cvt_pk_bf16(t[0], t[65]); o.y = cvt_pk_bf16(t[2 * 65], t[3 * 65]); o.z = cvt_pk_bf16(t[4 * 65], t[5 * 65]); o.w = cvt_pk_bf16(t[6 * 65], t[7 * 65]);
                *(u32x4*)(cdst + (size_t)(cn0 + n) * 1024 + ck0 + 8 * c) = o; }
            }
            __syncthreads();
        }
    }
}

template <int MODE>
__device__ __forceinline__ void norm1_phase(const Params& P, int l, int bid, int nblk) {
    const int tid = opaque_tid(), wid = __builtin_amdgcn_readfirstlane(tid >> 6), lane = tid & 63;
    unsigned char* ws = P.ws;
    const float* mod = (const float*)(ws + WS_MOD);
    const float* xin = (MODE == 0) ? P.x : P.out;
    bf16* H = (bf16*)(ws + WS_H);
    const float* gates = (const float*)(ws + WS_GATES);
    const unsigned char* Y = ws + WS_YBUF;
    for (int ch = bid * 8 + wid; ch < NTOK / 32; ch += nblk * 8) {
        const int b = (ch * 32) >> 13;
        f32x4 ca[4], cc[4], cg[4];
#pragma unroll
        for (int j = 0; j < 4; ++j) {
            const int col = 256 * j + 4 * lane;
            if (MODE <= 1) { const f32x4 g = *(const f32x4*)(P.n1g + l * D + col); const f32x4 sc = *(const f32x4*)(mod + (size_t)(l * NB + b) * NMOD + 1 * D + col);
                ca[j] = g * (1.0f + sc); cc[j] = *(const f32x4*)(mod + (size_t)(l * NB + b) * NMOD + 0 * D + col); }
            if (MODE >= 1) { const int lp = (MODE == 2) ? (DEPTH - 1) : (l - 1); cg[j] = *(const f32x4*)(mod + (size_t)(lp * NB + b) * NMOD + 5 * D + col); }
        }
        for (int rr = 0; rr < 32; ++rr) {
            const int row = ch * 32 + rr;
            f32x4 v[4];
#pragma unroll
            for (int j = 0; j < 4; ++j) v[j] = *(const f32x4*)(xin + (size_t)row * D + 256 * j + 4 * lane);
            if (MODE >= 1) {
                const f32x4 gt = *(const f32x4*)(gates + (size_t)row * 4);
                f32x4 a[4];
#pragma unroll
                for (int j = 0; j < 4; ++j) a[j] = (f32x4){0.f, 0.f, 0.f, 0.f};
#pragma unroll
                for (int k = 0; k < 4; ++k) {
                    const float gk = gt[k];
#pragma unroll
                    for (int j = 0; j < 4; ++j) { const unsigned y = *(const unsigned*)(Y + ((size_t)row * 4 + k) * D + 256 * j + 4 * lane);
                        const f32x2 p0 = __builtin_amdgcn_cvt_pk_f32_fp8((int)y, false), p1 = __builtin_amdgcn_cvt_pk_f32_fp8((int)y, true);
                        a[j].x += gk * p0.x; a[j].y += gk * p0.y; a[j].z += gk * p1.x; a[j].w += gk * p1.y; }
                }
#pragma unroll
                for (int j = 0; j < 4; ++j) { v[j] += cg[j] * a[j]; *(f32x4*)(P.out + (size_t)row * D + 256 * j + 4 * lane) = v[j]; }
            }
            if (MODE <= 1) {
                float ss = 0.f;
#pragma unroll
                for (int j = 0; j < 4; ++j) ss += (v[j].x * v[j].x + v[j].y * v[j].y) + (v[j].z * v[j].z + v[j].w * v[j].w);
                const float rstd = 1.0f / sqrtf(wave_sum(ss) * (1.0f / D) + EPS);
#pragma unroll
                for (int j = 0; j < 4; ++j) { const f32x4 h = v[j] * rstd * ca[j] + cc[j]; u32x2 o; o.x = cvt_pk_bf16(h.x, h.y); o.y = cvt_pk_bf16(h.z, h.w);
                    *(u32x2*)(H + (size_t)row * D + 256 * j + 4 * lane) = o; }
            }
        }
    }
}

struct Unit { int pm, pn, e, nrows, tbase, ks; };
typedef f32x4 Acc[2][2][4][2];

template <class Pb>
__device__ __forceinline__ void gemm_simple(LAS unsigned char* lds, const Pb& pb, int bid, int nblk) {
    const int tid = opaque_tid(), wid = __builtin_amdgcn_readfirstlane(tid >> 6), lane = tid & 63, wr = wid >> 2, wc = wid & 3, fr = lane & 15, fq = lane >> 4;
    constexpr int PITCH = 144;
    LAS unsigned char* sA = lds; LAS unsigned char* sB = lds + 256 * PITCH;
    Unit u;
    for (int i = 0; pb.next(i, bid, nblk, u); ++i) {
        Acc acc;
#pragma unroll
        for (int a = 0; a < 2; ++a)
#pragma unroll
            for (int b = 0; b < 2; ++b)
#pragma unroll
                for (int m = 0; m < 4; ++m)
#pragma unroll
                    for (int n = 0; n < 2; ++n) acc[a][b][m][n] = (f32x4){0.f, 0.f, 0.f, 0.f};
        unsigned ao[4], bo[4];
#pragma unroll
        for (int j = 0; j < 4; ++j) { const int q = tid + NT * j, row = q >> 3, c8 = q & 7;
            ao[j] = (unsigned)pb.a_row(u, row) * (unsigned)(pb.K * 2) + c8 * 16; bo[j] = (unsigned)pb.b_row(u, row) * (unsigned)(pb.K * 2) + c8 * 16; }
        for (int kt = 0; kt < pb.K / 64; ++kt) {
            u32x4 ra[4], rb[4];
#pragma unroll
            for (int j = 0; j < 4; ++j) { ra[j] = *(const u32x4*)(pb.A + ao[j] + kt * 128); rb[j] = *(const u32x4*)(pb.B + bo[j] + kt * 128); }
            __syncthreads();
#pragma unroll
            for (int j = 0; j < 4; ++j) { const int q = tid + NT * j, row = q >> 3, c8 = q & 7; *(LAS u32x4*)(sA + row * PITCH + c8 * 16) = ra[j]; *(LAS u32x4*)(sB + row * PITCH + c8 * 16) = rb[j]; }
            __syncthreads();
#pragma unroll
            for (int kk = 0; kk < 2; ++kk) {
                bf16x8 bfr[2][2];
#pragma unroll
                for (int b = 0; b < 2; ++b)
#pragma unroll
                    for (int n = 0; n < 2; ++n) bfr[b][n] = *(const LAS bf16x8*)(sB + (128 * b + 32 * wc + 16 * n + fr) * PITCH + (kk * 32 + fq * 8) * 2);
#pragma unroll
                for (int a = 0; a < 2; ++a) {
                    bf16x8 af[4];
#pragma unroll
                    for (int m = 0; m < 4; ++m) af[m] = *(const LAS bf16x8*)(sA + (128 * a + 64 * wr + 16 * m + fr) * PITCH + (kk * 32 + fq * 8) * 2);
#pragma unroll
                    for (int b = 0; b < 2; ++b)
#pragma unroll
                        for (int m = 0; m < 4; ++m)
#pragma unroll
                            for (int n = 0; n < 2; ++n) acc[a][b][m][n] = __builtin_amdgcn_mfma_f32_16x16x32_bf16(bfr[b][n], af[m], acc[a][b][m][n], 0, 0, 0);
                }
            }
        }
        pb.epi(acc, u, wr, wc, fr, fq);
    }
    __syncthreads();
}

struct PbInProj {
    static constexpr bool F8 = false;
    const char* A; const char* B; int K;
    bf16* proj; const float* qg; const float* kg; const float* rope;
    __device__ __forceinline__ bool next(int i, int bid, int nblk, Unit& u) const { const int L = i * nblk + bid; if (L >= 256 * 5) return false; u.pm = L / 5; u.pn = L % 5; u.e = 0; u.nrows = 256; u.tbase = 0; u.ks = 3 * u.pn + 2 * (u.pm & 7); return true; }
    __device__ __forceinline__ int a_row(const Unit& u, int r) const { return 256 * u.pm + r; }
    __device__ __forceinline__ void a_rows4(const Unit& u, int r0, int (&rows)[4]) const { for (int j = 0; j < 4; ++j) rows[j] = 256 * u.pm + r0 + 64 * j; }
    __device__ __forceinline__ int b_rowc(int rho) const { return 64 * ((rho >> 5) & 3) + 32 * (rho >> 7) + perm32(rho & 31); }
    __device__ __forceinline__ int b_base_row(const Unit& u) const { return 256 * u.pn; }
    __device__ __forceinline__ int b_row(const Unit& u, int rho) const { return b_base_row(u) + b_rowc(rho); }
    __device__ __forceinline__ void epi(const Acc& acc, const Unit& u, int, int, int, int) const {
        const int t_ = opaque_tid(), w_ = __builtin_amdgcn_readfirstlane(t_ >> 6), wr = w_ >> 2, wc = w_ & 3, fr = t_ & 15, fq = (t_ >> 4) & 3;
        const int hg = 4 * u.pn + wc;
        const bool nrm = hg < 10;
        const float* gsrc = (hg < 8) ? qg : kg;
        f32x4 gv[2][2];
#pragma unroll
        for (int bj = 0; bj < 2; ++bj)
#pragma unroll
            for (int n = 0; n < 2; ++n) gv[bj][n] = nrm ? *(const f32x4*)(gsrc + 32 * bj + 8 * fq + 4 * n) : (f32x4){1.f, 1.f, 1.f, 1.f};
        const float qs = (hg < 8) ? QSCALE : 1.0f;
#pragma unroll
        for (int q = 0; q < 4; ++q) {
            const int ai = q >> 1, m0 = 2 * (q & 1);
            f32x4 rcs[2][2], rsn[2][2];
            if (nrm && fq < 2) {
#pragma unroll
                for (int mm = 0; mm < 2; ++mm) { const float* rp = rope + (size_t)(256 * u.pm + 128 * ai + 64 * wr + 16 * (m0 + mm) + fr) * 16;
#pragma unroll
                    for (int n = 0; n < 2; ++n) { rcs[mm][n] = *(const f32x4*)(rp + 4 * n); rsn[mm][n] = *(const f32x4*)(rp + 8 + 4 * n); } }
            }
#pragma unroll
            for (int mm = 0; mm < 2; ++mm) {
                const int m = m0 + mm;
                const int row = 256 * u.pm + 128 * ai + 64 * wr + 16 * m + fr;
                f32x4 v[2][2];
#pragma unroll
                for (int bj = 0; bj < 2; ++bj)
#pragma unroll
                    for (int n = 0; n < 2; ++n) v[bj][n] = acc[ai][bj][m][n];
                if (nrm) {
                    float ss = 0.f;
#pragma unroll
                    for (int bj = 0; bj < 2; ++bj)
#pragma unroll
                        for (int n = 0; n < 2; ++n) ss += (v[bj][n].x * v[bj][n].x + v[bj][n].y * v[bj][n].y) + (v[bj][n].z * v[bj][n].z + v[bj][n].w * v[bj][n].w);
                    ss += swz_xor<16>(ss); ss = sum_x32(ss);
                    const float rstd = __builtin_amdgcn_rsqf(ss * (1.0f / 64.0f) + EPS);
#pragma unroll
                    for (int bj = 0; bj < 2; ++bj)
#pragma unroll
                        for (int n = 0; n < 2; ++n) v[bj][n] = v[bj][n] * rstd * gv[bj][n];
#pragma unroll
                    for (int n = 0; n < 2; ++n) {
                        f32x4 pr;
                        pr.x = swz_xor<16>(v[0][n].x); pr.y = swz_xor<16>(v[0][n].y); pr.z = swz_xor<16>(v[0][n].z); pr.w = swz_xor<16>(v[0][n].w);
                        if (fq < 2) v[0][n] = (fq == 0) ? (v[0][n] * rcs[mm][n] - pr * rsn[mm][n]) : (v[0][n] * rcs[mm][n] + pr * rsn[mm][n]);
                    }
                }
                u32x4 o[2];
#pragma unroll
                for (int bj = 0; bj < 2; ++bj) {
                    o[bj].x = cvt_pk_bf16(v[bj][0].x * qs, v[bj][0].y * qs); o[bj].y = cvt_pk_bf16(v[bj][0].z * qs, v[bj][0].w * qs);
                    o[bj].z = cvt_pk_bf16(v[bj][1].x * qs, v[bj][1].y * qs); o[bj].w = cvt_pk_bf16(v[bj][1].z * qs, v[bj][1].w * qs);
                }
                { unsigned char* own = (unsigned char*)(proj + (size_t)row * NIN + 64 * hg); const bool odd = fr & 1;
                  store_line_pair(own, odd ? own - NIN * 2 : own + NIN * 2, true, true, o[0], o[1], fq, odd); }
            }
        }
    }
};

struct PbOutProj {
    static constexpr bool F8 = false;
    const char* A; const char* B; int K;
    const float* xin; float* xout; const float* gate1;
    __device__ __forceinline__ bool next(int i, int bid, int nblk, Unit& u) const { const int L = i * nblk + bid; if (L >= 256 * 4) return false; u.pm = L >> 2; u.pn = L & 3; u.e = 0; u.nrows = 256; u.tbase = 0; u.ks = 4 * u.pn + 2 * (u.pm & 7); return true; }
    __device__ __forceinline__ int a_row(const Unit& u, int r) const { return 256 * u.pm + r; }
    __device__ __forceinline__ void a_rows4(const Unit& u, int r0, int (&rows)[4]) const { for (int j = 0; j < 4; ++j) rows[j] = 256 * u.pm + r0 + 64 * j; }
    __device__ __forceinline__ int b_rowc(int rho) const { return rho; }
    __device__ __forceinline__ int b_base_row(const Unit& u) const { return 256 * u.pn; }
    __device__ __forceinline__ int b_row(const Unit& u, int rho) const { return b_base_row(u) + b_rowc(rho); }
    __device__ __forceinline__ void epi(const Acc& acc, const Unit& u, int, int, int, int) const {
        const int t_ = opaque_tid(), w_ = __builtin_amdgcn_readfirstlane(t_ >> 6), wr = w_ >> 2, wc = w_ & 3, fr = t_ & 15, fq = (t_ >> 4) & 3;
        const int b = (256 * u.pm) >> 13;
        const int col0 = 256 * u.pn + 32 * wc + 4 * fq;
        const bool odd = fr & 1;
        f32x4 g[2][2];
#pragma unroll
        for (int bj = 0; bj < 2; ++bj)
#pragma unroll
            for (int n = 0; n < 2; ++n) g[bj][n] = *(const f32x4*)(gate1 + (size_t)b * NMOD + col0 + 128 * bj + 16 * n);
#pragma unroll
        for (int q = 0; q < 4; ++q) {
            const int ai = q >> 1, m0 = 2 * (q & 1);
            u32x4 lo[2][2], hi[2][2];
#pragma unroll
            for (int mm = 0; mm < 2; ++mm)
#pragma unroll
                for (int bj = 0; bj < 2; ++bj) { const unsigned char* xi = (const unsigned char*)(xin + (size_t)(256 * u.pm + 128 * ai + 64 * wr + 16 * (m0 + mm) + fr) * D + 256 * u.pn + 32 * wc + 128 * bj);
                    load_line_pair(xi, odd ? xi - D * 4 : xi + D * 4, fq, odd, lo[mm][bj], hi[mm][bj]); }
#pragma unroll
            for (int mm = 0; mm < 2; ++mm)
#pragma unroll
                for (int bj = 0; bj < 2; ++bj) { unsigned char* xo = (unsigned char*)(xout + (size_t)(256 * u.pm + 128 * ai + 64 * wr + 16 * (m0 + mm) + fr) * D + 256 * u.pn + 32 * wc + 128 * bj);
                    const f32x4 r0 = __builtin_bit_cast(f32x4, lo[mm][bj]) + g[bj][0] * acc[ai][bj][m0 + mm][0], r1 = __builtin_bit_cast(f32x4, hi[mm][bj]) + g[bj][1] * acc[ai][bj][m0 + mm][1];
                    store_line_pair(xo, odd ? xo - D * 4 : xo + D * 4, true, true, __builtin_bit_cast(u32x4, r0), __builtin_bit_cast(u32x4, r1), fq, odd); }
            asm volatile("" ::: "memory");
        }
    }
};

struct MoeTab { const LAS int* cnt; const LAS int* tp; };
__device__ __forceinline__ void moe_build_tab(LAS int* tab, const int* tot) {
    if (threadIdx.x == 0) { int t = 0; for (int e = 0; e < NE; ++e) { const int c = tot[e]; tab[e] = c; tab[32 + e] = t; t += (c + 255) >> 8; } tab[64] = t; }
    __syncthreads();
}
__device__ __forceinline__ bool moe_unit(const LAS int* tab, int L, int ntn, Unit& u) {
    const int gt = L / ntn; if (gt >= __builtin_amdgcn_readfirstlane(tab[64])) return false;
    const int ln = (int)__builtin_amdgcn_mbcnt_hi(~0u, __builtin_amdgcn_mbcnt_lo(~0u, 0u));
    const int tpv = tab[32 + (ln & 31)];
    const int e = __builtin_amdgcn_readfirstlane(__popcll(__ballot(tpv <= gt) & 0xffffffffull)) - 1;
    const int tpe = __builtin_amdgcn_readfirstlane(tab[32 + e]), cnt = __builtin_amdgcn_readfirstlane(tab[e]);
    u.e = e; u.pm = gt - tpe; u.pn = L % ntn; u.tbase = gt * 256; const int rem = cnt - 256 * u.pm; u.nrows = rem < 256 ? rem : 256; u.ks = (ntn == 8) ? (2 * u.pn + 4 * (gt & 3)) : (4 * u.pn + 2 * (gt & 7)); return true;
}

struct PbGU {
    static constexpr bool F8 = true;
    const char* A; const char* B; int K;
    const LAS int* tab; const int* list; const float* bgu; unsigned char* act;
    __device__ __forceinline__ bool next(int i, int bid, int nblk, Unit& u) const { return moe_unit(tab, i * nblk + bid, 8, u); }
    __device__ __forceinline__ int a_row(const Unit& u, int r) const { const int v = list[(size_t)u.e * NTOK + 256 * u.pm + lperm(r)]; return r < u.nrows ? (v >> 2) : 0; }
    __device__ __forceinline__ void a_rows4(const Unit& u, int r0, int (&rows)[4]) const {
        const int4 v = *(const int4*)(list + (size_t)u.e * NTOK + 256 * u.pm + 4 * r0);
        rows[0] = (r0 < u.nrows) ? (v.x >> 2) : 0; rows[1] = (r0 + 64 < u.nrows) ? (v.y >> 2) : 0; rows[2] = (r0 + 128 < u.nrows) ? (v.z >> 2) : 0; rows[3] = (r0 + 192 < u.nrows) ? (v.w >> 2) : 0; }
    __device__ __forceinline__ int b_rowc(int rho) const { const int i = rho & 127; return ((rho >> 7) ? 1024 : 0) + (i & ~31) + perm32(i & 31); }
    __device__ __forceinline__ int b_base_row(const Unit& u) const { return u.e * 2048 + 128 * u.pn; }
    __device__ __forceinline__ int b_row(const Unit& u, int rho) const { return b_base_row(u) + b_rowc(rho); }
    __device__ __forceinline__ void epi(const Acc& acc, const Unit& u, int, int, int, int) const {
        const int t_ = opaque_tid(), w_ = __builtin_amdgcn_readfirstlane(t_ >> 6), wr = w_ >> 2, wc = w_ & 3, fr = t_ & 15, fq = (t_ >> 4) & 3;
        const int col0 = 128 * u.pn + 32 * wc + 8 * fq;
        f32x4 bg[2], bu[2];
#pragma unroll
        for (int n = 0; n < 2; ++n) { bg[n] = *(const f32x4*)(bgu + (size_t)u.e * 2048 + col0 + 4 * n); bu[n] = *(const f32x4*)(bgu + (size_t)u.e * 2048 + 1024 + col0 + 4 * n); }
#pragma unroll
        for (int ai = 0; ai < 2; ++ai)
#pragma unroll
            for (int m = 0; m < 4; ++m) {
                const int r = 128 * ai + 64 * wr + 16 * m + fr;
                float o[8];
#pragma unroll
                for (int n = 0; n < 2; ++n)
#pragma unroll
                    for (int j = 0; j < 4; ++j) {
                        float g = acc[ai][0][m][n][j] * WUNSCALE + bg[n][j], uu = acc[ai][1][m][n][j] * WUNSCALE + bu[n][j];
                        g = fminf(g, 7.0f); uu = fminf(fmaxf(uu, -7.0f), 7.0f);
                        const float sg = __builtin_amdgcn_rcpf(1.0f + __builtin_amdgcn_exp2f(-1.702f * LOG2E * g));
                        o[4 * n + j] = g * sg * (uu + 1.0f);
                    }
                u32x2 w; w.x = cvt_pk4_fp8(o[0], o[1], o[2], o[3]); w.y = cvt_pk4_fp8(o[4], o[5], o[6], o[7]);
                *(u32x2*)(act + (size_t)(u.tbase + r) * 1024 + col0) = w;
            }
    }
};

struct PbDown {
    static constexpr bool F8 = true;
    const char* A; const char* B; int K;
    const LAS int* tab; const int* list; const float* bdn; unsigned char* ybuf;
    __device__ __forceinline__ bool next(int i, int bid, int nblk, Unit& u) const { return moe_unit(tab, i * nblk + bid, 4, u); }
    __device__ __forceinline__ int a_row(const Unit& u, int r) const { return u.tbase + r; }
    __device__ __forceinline__ void a_rows4(const Unit& u, int r0, int (&rows)[4]) const { for (int j = 0; j < 4; ++j) rows[j] = u.tbase + r0 + 64 * j; }
    __device__ __forceinline__ int b_rowc(int rho) const { return 64 * ((rho >> 5) & 3) + 16 * ((rho >> 2) & 3) + 8 * (rho >> 7) + 4 * ((rho >> 4) & 1) + (rho & 3); }
    __device__ __forceinline__ int b_base_row(const Unit& u) const { return u.e * 1024 + 256 * u.pn; }
    __device__ __forceinline__ int b_row(const Unit& u, int rho) const { return b_base_row(u) + b_rowc(rho); }
    __device__ __forceinline__ void epi(const Acc& acc, const Unit& u, int, int, int, int) const {
        const int t_ = opaque_tid(), w_ = __builtin_amdgcn_readfirstlane(t_ >> 6), wr = w_ >> 2, wc = w_ & 3, fr = t_ & 15, fq = (t_ >> 4) & 3;
        const int col0 = 256 * u.pn + 64 * wc + 16 * fq;
        f32x4 bv[2][2];
#pragma unroll
        for (int bj = 0; bj < 2; ++bj)
#pragma unroll
            for (int n = 0; n < 2; ++n) bv[bj][n] = *(const f32x4*)(bdn + (size_t)u.e * 1024 + col0 + 8 * bj + 4 * n);
        int dst8[8];
#pragma unroll
        for (int q = 0; q < 8; ++q) dst8[q] = list[(size_t)u.e * NTOK + 256 * u.pm + lperm(128 * (q >> 2) + 64 * wr + 16 * (q & 3) + fr)];
#pragma unroll
        for (int ai = 0; ai < 2; ++ai)
#pragma unroll
            for (int m = 0; m < 4; ++m) {
                const int r = 128 * ai + 64 * wr + 16 * m + fr;
                u32x4 w;
                { const f32x4 v00 = acc[ai][0][m][0] * WUNSCALE + bv[0][0], v01 = acc[ai][0][m][1] * WUNSCALE + bv[0][1], v10 = acc[ai][1][m][0] * WUNSCALE + bv[1][0], v11 = acc[ai][1][m][1] * WUNSCALE + bv[1][1];
                  w.x = cvt_pk4_fp8(v00.x, v00.y, v00.z, v00.w); w.y = cvt_pk4_fp8(v01.x, v01.y, v01.z, v01.w); w.z = cvt_pk4_fp8(v10.x, v10.y, v10.z, v10.w); w.w = cvt_pk4_fp8(v11.x, v11.y, v11.z, v11.w); }
                if (r < u.nrows) *(u32x4*)(ybuf + (size_t)dst8[ai * 4 + m] * 1024 + col0) = w;
            }
    }
};

__device__ __forceinline__ s16x4 lds_tr16(const LAS unsigned char* p) { return __builtin_bit_cast(s16x4, __builtin_amdgcn_ds_read_tr16_b64_v4i16((LAS s16x4*)p)); }

__device__ __forceinline__ void attn_phase(const Params& P, LAS unsigned char* lds, int l, int bid, int nblk) {
    const int tid = opaque_tid(), wid = __builtin_amdgcn_readfirstlane(tid >> 6), lane = tid & 63, r32 = lane & 31, hi = lane >> 5;
    unsigned char* ws = P.ws;
    const bf16* proj = (const bf16*)(ws + WS_PROJ);
    bf16* mix = (bf16*)(ws + WS_MIX);
    constexpr int KP = 144;
    LAS unsigned char* sK = lds; LAS unsigned char* sV = lds + 256 * KP;
    for (int unit = bid; unit < NB * 64 * 2; unit += nblk) {
        const int kvh = unit & 1, n = (unit >> 1) & 63, b = unit >> 7;
        const int tok0 = b * SEQ + n * 128 - 128;
        __syncthreads();
#pragma unroll
        for (int j = 0; j < 4; ++j) {
            const int q = tid + NT * j, key = q >> 3, c8 = q & 7;
            u32x4 kv = (u32x4){0u, 0u, 0u, 0u}, vv = (u32x4){0u, 0u, 0u, 0u};
            if (n > 0 || key >= 128) { const bf16* src = proj + (size_t)(tok0 + key) * NIN + 512 + kvh * 64 + c8 * 8; kv = *(const u32x4*)src; vv = *(const u32x4*)(src + 128); }
            *(LAS u32x4*)(sK + key * KP + c8 * 16) = kv; *(LAS u32x4*)(sV + key * KP + c8 * 16) = vv;
        }
        __syncthreads();
        const int hq = kvh * 4 + (wid >> 1);
        const float sink2 = P.sinks[l * 8 + hq] * LOG2E;
#pragma unroll 1
        for (int qt = 0; qt < 2; ++qt) {
            const int q0 = 64 * (wid & 1) + 32 * qt, qi = q0 + r32;
            const size_t qtok = (size_t)b * SEQ + n * 128 + qi;
            bf16x8 qf[4];
#pragma unroll
            for (int s = 0; s < 4; ++s) qf[s] = *(const bf16x8*)(proj + qtok * NIN + hq * 64 + 16 * s + 8 * hi);
            f32x16 st[5];
#pragma unroll
            for (int kt = 0; kt < 5; ++kt) {
#pragma unroll
                for (int r = 0; r < 16; ++r) st[kt][r] = 0.f;
#pragma unroll
                for (int s = 0; s < 4; ++s) { const bf16x8 kf = *(const LAS bf16x8*)(sK + (q0 + 32 * kt + r32) * KP + (16 * s + 8 * hi) * 2); st[kt] = __builtin_amdgcn_mfma_f32_32x32x16_bf16(kf, qf[s], st[kt], 0, 0, 0); }
            }
            float mx = sink2;
#pragma unroll
            for (int kt = 0; kt < 5; ++kt)
#pragma unroll
                for (int r = 0; r < 16; ++r) {
                    const int kj = q0 + 32 * kt + (r & 3) + 8 * (r >> 2) + 4 * hi;
                    const bool ok = (kj > qi) && (kj <= qi + 128) && (n > 0 || kj >= 128);
                    const float s = ok ? st[kt][r] : -__builtin_inff(); st[kt][r] = s; mx = fmaxf(mx, s);
                }
            mx = max_x32(mx);
            float sum = 0.f;
#pragma unroll
            for (int kt = 0; kt < 5; ++kt)
#pragma unroll
                for (int r = 0; r < 16; ++r) { const float p = __builtin_amdgcn_exp2f(st[kt][r] - mx); st[kt][r] = p; sum += p; }
            sum = sum_x32(sum);
            sum += __builtin_amdgcn_exp2f(sink2 - mx);
            f32x16 o[2];
#pragma unroll
            for (int dt = 0; dt < 2; ++dt)
#pragma unroll
                for (int r = 0; r < 16; ++r) o[dt][r] = 0.f;
#pragma unroll
            for (int kt = 0; kt < 5; ++kt)
#pragma unroll
                for (int s2 = 0; s2 < 2; ++s2) {
                    u32x4 pw; pw.x = cvt_pk_bf16(st[kt][8 * s2 + 0], st[kt][8 * s2 + 1]); pw.y = cvt_pk_bf16(st[kt][8 * s2 + 2], st[kt][8 * s2 + 3]);
                    pw.z = cvt_pk_bf16(st[kt][8 * s2 + 4], st[kt][8 * s2 + 5]); pw.w = cvt_pk_bf16(st[kt][8 * s2 + 6], st[kt][8 * s2 + 7]);
                    const bf16x8 pf = __builtin_bit_cast(bf16x8, pw);
                    const int kb = q0 + 32 * kt + 16 * s2 + 4 * hi, i16 = lane & 15;
#pragma unroll
                    for (int dt = 0; dt < 2; ++dt) {
                        const int d0 = 32 * dt + 16 * ((lane >> 4) & 1);
                        const LAS unsigned char* a0 = sV + (kb + (i16 >> 2)) * KP + (d0 + 4 * (i16 & 3)) * 2;
                        const s16x4 v0 = lds_tr16(a0), v1 = lds_tr16(a0 + 8 * KP);
                        bf16x8 vf; vf[0] = v0[0]; vf[1] = v0[1]; vf[2] = v0[2]; vf[3] = v0[3]; vf[4] = v1[0]; vf[5] = v1[1]; vf[6] = v1[2]; vf[7] = v1[3];
                        o[dt] = __builtin_amdgcn_mfma_f32_32x32x16_bf16(vf, pf, o[dt], 0, 0, 0);
                    }
                }
            const float inv = 1.0f / sum;
#pragma unroll
            for (int dt = 0; dt < 2; ++dt)
#pragma unroll
                for (int g4 = 0; g4 < 4; ++g4) {
                    u32x2 w; w.x = cvt_pk_bf16(o[dt][4 * g4 + 0] * inv, o[dt][4 * g4 + 1] * inv); w.y = cvt_pk_bf16(o[dt][4 * g4 + 2] * inv, o[dt][4 * g4 + 3] * inv);
                    *(u32x2*)(mix + qtok * D + hq * 64 + 32 * dt + 8 * g4 + 4 * hi) = w;
                }
        }
    }
    for (int ch = bid * 8 + wid; ch < NTOK / 32; ch += nblk * 8) {
        const int t0 = ch * 32, p0 = t0 & (SEQ - 1);
        const int col = 8 * lane, g = lane >> 4, w = 2 << g;
        float pb_[8], ps_[8];
#pragma unroll
        for (int i = 0; i < 8; i += 4) { const f32x4 a = *(const f32x4*)(P.pool_b + l * 512 + col + i), s = *(const f32x4*)(P.pool_s + l * 512 + col + i);
            pb_[i] = a.x; pb_[i + 1] = a.y; pb_[i + 2] = a.z; pb_[i + 3] = a.w; ps_[i] = s.x; ps_[i + 1] = s.y; ps_[i + 2] = s.z; ps_[i + 3] = s.w; }
        float sum[8];
#pragma unroll
        for (int i = 0; i < 8; ++i) sum[i] = 0.f;
        for (int j = 1; j < w; ++j) if (p0 - j >= 0) {
            const u32x4 z = *(const u32x4*)(proj + (size_t)(t0 - j) * NIN + 768 + col);
            sum[0] += bf_lo(z.x); sum[1] += bf_hi(z.x); sum[2] += bf_lo(z.y); sum[3] += bf_hi(z.y); sum[4] += bf_lo(z.z); sum[5] += bf_hi(z.z); sum[6] += bf_lo(z.w); sum[7] += bf_hi(z.w);
        }
        for (int t = 0; t < 32; ++t) {
            const u32x4 z = *(const u32x4*)(proj + (size_t)(t0 + t) * NIN + 768 + col);
            float zz[8] = {bf_lo(z.x), bf_hi(z.x), bf_lo(z.y), bf_hi(z.y), bf_lo(z.z), bf_hi(z.z), bf_lo(z.w), bf_hi(z.w)};
            const int pos = p0 + t; const float ic = 1.0f / (float)((pos + 1 < w) ? (pos + 1) : w);
            float o[8];
#pragma unroll
            for (int i = 0; i < 8; ++i) { sum[i] += zz[i]; o[i] = (sum[i] * ic - zz[i] + pb_[i]) * ps_[i]; }
            u32x4 ow; ow.x = cvt_pk_bf16(o[0], o[1]); ow.y = cvt_pk_bf16(o[2], o[3]); ow.z = cvt_pk_bf16(o[4], o[5]); ow.w = cvt_pk_bf16(o[6], o[7]);
            *(u32x4*)(mix + (size_t)(t0 + t) * D + 512 + col) = ow;
            if (pos - w + 1 >= 0) {
                const u32x4 y = *(const u32x4*)(proj + (size_t)(t0 + t - w + 1) * NIN + 768 + col);
                sum[0] -= bf_lo(y.x); sum[1] -= bf_hi(y.x); sum[2] -= bf_lo(y.y); sum[3] -= bf_hi(y.y); sum[4] -= bf_lo(y.z); sum[5] -= bf_hi(y.z); sum[6] -= bf_lo(y.w); sum[7] -= bf_hi(y.w);
            }
        }
    }
}

__device__ __forceinline__ void router_phase(const Params& P, LAS unsigned char* lds, int l, int bid, int nblk) {
    const int tid = opaque_tid(), wid = __builtin_amdgcn_readfirstlane(tid >> 6), lane = tid & 63, fr = lane & 15, fq = lane >> 4;
    unsigned char* ws = P.ws;
    const float* mod = (const float*)(ws + WS_MOD);
    bf16* H = (bf16*)(ws + WS_H);
    float* gates = (float*)(ws + WS_GATES);
    int* list = (int*)(ws + WS_LIST);
    constexpr int RP = 2064;
    LAS unsigned char* rwT = lds;
    LAS float* lg = (LAS float*)(lds + 66048);
    LAS unsigned long long* emask = (LAS unsigned long long*)(lds + 66048 + 33792);
    LAS unsigned short* sel = (LAS unsigned short*)(emask + 128);
    __syncthreads();
    for (int idx = tid; idx < 1024 * 32; idx += NT) { const int k = idx >> 5, e = idx & 31; const float v = P.rw[(size_t)l * 32768 + idx];
        *(LAS unsigned short*)(rwT + e * RP + k * 2) = (unsigned short)(cvt_pk_bf16(v, 0.f) & 0xffffu); }
    for (int tile = bid; tile < NTOK / 256; tile += nblk) {
        const int tok0 = tile * 256, b = tok0 >> 13;
        {
            f32x4 ca[4], cc[4];
#pragma unroll
            for (int j = 0; j < 4; ++j) { const int col = 256 * j + 4 * lane; const f32x4 g = *(const f32x4*)(P.n2g + l * D + col); const f32x4 sc = *(const f32x4*)(mod + (size_t)(l * NB + b) * NMOD + 4 * D + col);
                ca[j] = g * (1.0f + sc); cc[j] = *(const f32x4*)(mod + (size_t)(l * NB + b) * NMOD + 3 * D + col); }
            for (int rr = 0; rr < 32; ++rr) {
                const int row = tok0 + wid * 32 + rr;
                f32x4 v[4]; float ss = 0.f;
#pragma unroll
                for (int j = 0; j < 4; ++j) { v[j] = *(const f32x4*)(P.out + (size_t)row * D + 256 * j + 4 * lane); ss += (v[j].x * v[j].x + v[j].y * v[j].y) + (v[j].z * v[j].z + v[j].w * v[j].w); }
                const float rstd = 1.0f / sqrtf(wave_sum(ss) * (1.0f / D) + EPS);
#pragma unroll
                for (int j = 0; j < 4; ++j) { const f32x4 h = v[j] * rstd * ca[j] + cc[j]; u32x2 o; o.x = cvt_pk_bf16(h.x, h.y); o.y = cvt_pk_bf16(h.z, h.w); *(u32x2*)(H + (size_t)row * D + 256 * j + 4 * lane) = o;
                    *(unsigned*)(ws + WS_H8 + (size_t)row * D + 256 * j + 4 * lane) = cvt_pk4_fp8(h.x, h.y, h.z, h.w); }
            }
        }
        asm volatile("s_waitcnt vmcnt(0)" ::: "memory");
        __syncthreads();
#pragma unroll 1
        for (int rg = 0; rg < 2; ++rg) {
            f32x4 a0 = (f32x4){0.f, 0.f, 0.f, 0.f}, a1 = a0;
            const bf16* hp = H + (size_t)(tok0 + 32 * wid + 16 * rg + fr) * D + 8 * fq;
            for (int s = 0; s < 32; ++s) {
                const bf16x8 af = *(const bf16x8*)(hp + 32 * s);
                const bf16x8 b0 = *(const LAS bf16x8*)(rwT + fr * RP + (32 * s + 8 * fq) * 2), b1 = *(const LAS bf16x8*)(rwT + (16 + fr) * RP + (32 * s + 8 * fq) * 2);
                a0 = __builtin_amdgcn_mfma_f32_16x16x32_bf16(af, b0, a0, 0, 0, 0); a1 = __builtin_amdgcn_mfma_f32_16x16x32_bf16(af, b1, a1, 0, 0, 0);
            }
            const float rb0 = P.rb[l * 32 + fr], rb1 = P.rb[l * 32 + 16 + fr];
#pragma unroll
            for (int r = 0; r < 4; ++r) { const int row = 32 * wid + 16 * rg + 4 * fq + r; lg[row * 33 + fr] = a0[r] + rb0; lg[row * 33 + 16 + fr] = a1[r] + rb1; }
        }
        __syncthreads();
        if (tid < 256) {
            float v[32];
#pragma unroll
            for (int e = 0; e < 32; ++e) v[e] = lg[tid * 33 + e];
            float tv[4]; int ti[4];
#pragma unroll
            for (int k = 0; k < 4; ++k) {
                float best = -__builtin_inff(); int bi = 0;
#pragma unroll
                for (int e = 0; e < 32; ++e) { const bool gt = v[e] > best; best = gt ? v[e] : best; bi = gt ? e : bi; }
                tv[k] = best; ti[k] = bi;
#pragma unroll
                for (int e = 0; e < 32; ++e) v[e] = (e == bi) ? -__builtin_inff() : v[e];
            }
            const float e1 = __expf(tv[1] - tv[0]), e2 = __expf(tv[2] - tv[0]), e3 = __expf(tv[3] - tv[0]);
            const float inv = 1.0f / (1.0f + e1 + e2 + e3);
            *(f32x4*)(gates + (size_t)(tok0 + tid) * 4) = (f32x4){inv, e1 * inv, e2 * inv, e3 * inv};
#pragma unroll
            for (int k = 0; k < 4; ++k) sel[tid * 4 + k] = (unsigned short)ti[k];
#pragma unroll
            for (int e = 0; e < 32; ++e) { const unsigned long long m = __ballot((ti[0] == e) | (ti[1] == e) | (ti[2] == e) | (ti[3] == e)); if (lane == 0) emask[e * 4 + wid] = m; }
        }
        __syncthreads();
        if (tid < 256) {
            int* selg = (int*)(ws + WS_SEL);
            const unsigned long long lt = (1ull << lane) - 1ull;
            int so[4];
#pragma unroll
            for (int k = 0; k < 4; ++k) {
                const int e = sel[tid * 4 + k]; int r = 0;
                for (int w = 0; w < 4; ++w) { const unsigned long long m = emask[e * 4 + w]; r += (w < wid) ? __popcll(m) : ((w == wid) ? __popcll(m & lt) : 0); }
                so[k] = (e << 16) | r;
            }
            *(int4*)(selg + (size_t)(tok0 + tid) * 4) = make_int4(so[0], so[1], so[2], so[3]);
        }
        if (tid < 32) { int c = 0; for (int w = 0; w < 4; ++w) c += __popcll(emask[tid * 4 + w]); ((int*)(ws + WS_CNTB))[(size_t)(l * 256 + tile) * 32 + tid] = c; }
        __syncthreads();
    }
}

__device__ __forceinline__ void place_phase(const Params& P, LAS unsigned char* lds, int l, int bid, int nblk) {
    const int tid = opaque_tid();
    unsigned char* ws = P.ws;
    const int* cntb = (const int*)(ws + WS_CNTB) + (size_t)l * 256 * 32;
    const int* selg = (const int*)(ws + WS_SEL);
    int* list = (int*)(ws + WS_LIST);
    LAS int* red = (LAS int*)lds;
    LAS int* base = red + 512;
    const int e = tid & 31, part = tid >> 5;
    __syncthreads();
    for (int tile = bid; tile < NTOK / 256 + 1; tile += nblk) {
        int s = 0;
        for (int q = 0; q < 16; ++q) { const int t = part * 16 + q; if (t < tile) s += cntb[t * 32 + e]; }
        red[part * 32 + e] = s;
        __syncthreads();
        if (tid < 32) { int b = 0; for (int p = 0; p < 16; ++p) b += red[p * 32 + tid]; base[tid] = b; if (tile == NTOK / 256) ((int*)(ws + WS_TOT))[l * 32 + tid] = b; }
        __syncthreads();
        if (tile < NTOK / 256 && tid < 256) {
            const int tok = tile * 256 + tid; const int4 v = *(const int4*)(selg + (size_t)tok * 4);
            const int vv[4] = {v.x, v.y, v.z, v.w};
#pragma unroll
            for (int k = 0; k < 4; ++k) { const int ee = vv[k] >> 16, r = vv[k] & 0xffff; { const int rk = base[ee] + r; list[(size_t)ee * NTOK + (rk & ~255) + lperm(rk & 255)] = tok * 4 + k; } }
        }
        __syncthreads();
    }
}

constexpr int BK = 64, HALF = 128, HTB = HALF * BK * 2;
__device__ __forceinline__ int lds_byte(int r, int c) { const int st = (r >> 4) * 2 + (c >> 5), rr = r & 15, cc = c & 31, ob = rr * 64 + cc * 2; return st * 1024 + (ob ^ (((ob >> 9) & 1) << 5)); }
__device__ __forceinline__ void stage_rc(int b, int& R, int& C) { const int st = b / 1024, sb = b % 1024, swz = sb ^ (((sb >> 9) & 1) << 5); R = (st >> 1) * 16 + swz / 64; C = (st & 1) * 32 + (swz % 64) / 2; }

template <bool F8> struct FragT;
template <> struct FragT<false> {
    struct A { bf16x8 k[2]; };
    static __device__ __forceinline__ void load(A& d, const LAS unsigned char* p) { d.k[0] = *(const LAS bf16x8*)p; d.k[1] = *(const LAS bf16x8*)(p + 1024); }
    static __device__ __forceinline__ f32x4 mma(const A& a, const A& b, f32x4 c) { c = __builtin_amdgcn_mfma_f32_16x16x32_bf16(a.k[0], b.k[0], c, 0, 0, 0); return __builtin_amdgcn_mfma_f32_16x16x32_bf16(a.k[1], b.k[1], c, 0, 0, 0); }
};
template <> struct FragT<true> {
    typedef i32x8 A;
    static __device__ __forceinline__ void load(A& d, const LAS unsigned char* p) { const i32x4 lo = *(const LAS i32x4*)p, hi = *(const LAS i32x4*)(p + 1024); d = __builtin_shufflevector(lo, hi, 0, 1, 2, 3, 4, 5, 6, 7); }
    static __device__ __forceinline__ f32x4 mma(const A& a, const A& b, f32x4 c) { const int one = 0x7f7f7f7f;
        asm volatile("v_mfma_scale_f32_16x16x128_f8f6f4 %0, %1, %2, %0, %3, %3 op_sel_hi:[0,0,0]" : "+v"(c) : "v"(a), "v"(b), "v"(one)); return c; }
};
template <class Pb>
__device__ __forceinline__ void gemm_phase8(LAS unsigned char* lds, const Pb& pb, int bid, int nblk) {
    const int tid = opaque_tid(), wid = __builtin_amdgcn_readfirstlane(tid >> 6), lane = tid & 63, wr = wid >> 2, wc = wid & 3, fr = lane & 15, fq = lane >> 4;
    constexpr bool F8 = Pb::F8;
    const int RB = F8 ? pb.K : pb.K * 2;
    const int nt = RB / 128;
    int Rp[2], Cp[2];
#pragma unroll
    for (int i = 0; i < 2; ++i) stage_rc(tid * 16 + i * 8192, Rp[i], Cp[i]);
    unsigned voB[2][2];
#pragma unroll
    for (int h = 0; h < 2; ++h)
#pragma unroll
        for (int i = 0; i < 2; ++i) voB[h][i] = (unsigned)pb.b_rowc(128 * h + Rp[i]) * (unsigned)RB + (unsigned)Cp[i] * 2u;
    const unsigned ldsw = (unsigned)wid * 1024u;
    const int aoff = lds_byte(wr * 64 + fr, fq * 8), boff = lds_byte(wc * 32 + fr, fq * 8);
#define PG8_SA(b, h) (((b) * 2 + (h)) * HTB)
#define PG8_SB(b, h) ((4 + (b) * 2 + (h)) * HTB)
#define PG8_STAGE(bufoff, rsrc, soff, voff) do { _Pragma("unroll") for (int _i = 0; _i < 2; ++_i) \
        __builtin_amdgcn_raw_ptr_buffer_load_lds(rsrc, (LAS unsigned*)(lds + (bufoff) + ldsw + _i * 8192), 16, (int)(voff)[_i], (int)(soff), 0, 0); } while (0)
#define PG8_LDA(dst, b, h) do { _Pragma("unroll") for (int m = 0; m < 4; ++m) FragT<F8>::load(dst[m], lds + PG8_SA(b, h) + aoff + m * 2048); } while (0)
#define PG8_LDB(dst, b, h) do { _Pragma("unroll") for (int n = 0; n < 2; ++n) FragT<F8>::load(dst[n], lds + PG8_SB(b, h) + boff + n * 2048); } while (0)
#define PG8_MMA(ai, bj, At, Bt) do { __builtin_amdgcn_s_setprio(1); _Pragma("unroll") for (int m = 0; m < 4; ++m) _Pragma("unroll") for (int n = 0; n < 2; ++n) \
        acc[ai][bj][m][n] = FragT<F8>::mma(Bt[n], At[m], acc[ai][bj][m][n]); __builtin_amdgcn_s_setprio(0); } while (0)
#define PG8_WAIT_V(n) asm volatile("s_waitcnt vmcnt(" #n ")" ::: "memory")
#define PG8_WAIT_L(n) asm volatile("s_waitcnt lgkmcnt(" #n ")" ::: "memory")
#define PG8_BAR __builtin_amdgcn_s_barrier()
#define PG8_SCHED __builtin_amdgcn_sched_barrier(0)
#define PG8_VOA(dst, un) do { int _r[4]; pb.a_rows4(un, Rp[0], _r); _Pragma("unroll") for (int h = 0; h < 2; ++h) _Pragma("unroll") for (int i = 0; i < 2; ++i) dst[h][i] = (unsigned)_r[2 * h + i] * (unsigned)RB + (unsigned)Cp[i] * 2u; } while (0)
    Unit cur, nxt; int ui = 0;
    if (!pb.next(0, bid, nblk, cur)) return;
    Acc acc;
#pragma unroll
    for (int a = 0; a < 2; ++a)
#pragma unroll
        for (int b = 0; b < 2; ++b)
#pragma unroll
            for (int m = 0; m < 4; ++m)
#pragma unroll
                for (int n = 0; n < 2; ++n) acc[a][b][m][n] = (f32x4){0.f, 0.f, 0.f, 0.f};
    typename FragT<F8>::A At[4]; typename FragT<F8>::A B0[2], B1[2];
    unsigned voAc[2][2], voAn[2][2];
    PG8_VOA(voAc, cur);
    const __amdgpu_buffer_rsrc_t rA = __builtin_amdgcn_make_buffer_rsrc((void*)pb.A, 0, 0x7fffffff, 0x00020000), rB = __builtin_amdgcn_make_buffer_rsrc((void*)pb.B, 0, 0x7fffffff, 0x00020000);
    unsigned cB = (unsigned)pb.b_base_row(cur) * (unsigned)RB;
    { const unsigned k0 = (unsigned)(cur.ks & (nt - 1)) * 128u, k1 = (unsigned)((cur.ks + 1) & (nt - 1)) * 128u;
    PG8_STAGE(PG8_SB(0, 0), rB, cB + k0, voB[0]); PG8_STAGE(PG8_SB(0, 1), rB, cB + k0, voB[1]); PG8_STAGE(PG8_SA(0, 0), rA, k0, voAc[0]); PG8_STAGE(PG8_SA(0, 1), rA, k0, voAc[1]);
    if (wr == 1) PG8_BAR;
    PG8_WAIT_V(2); PG8_BAR;
    PG8_STAGE(PG8_SB(1, 0), rB, cB + k1, voB[0]); PG8_STAGE(PG8_SA(1, 0), rA, k1, voAc[0]); PG8_STAGE(PG8_SB(1, 1), rB, cB + k1, voB[1]); }
    PG8_WAIT_V(6); PG8_BAR;
    for (;;) {
        const bool has_next = pb.next(ui + 1, bid, nblk, nxt);
        unsigned nB = cB; int nks = cur.ks;
        if (has_next) { PG8_VOA(voAn, nxt); nB = (unsigned)pb.b_base_row(nxt) * (unsigned)RB; nks = nxt.ks; }
        else {
#pragma unroll
            for (int h = 0; h < 2; ++h)
#pragma unroll
                for (int i = 0; i < 2; ++i) voAn[h][i] = voAc[h][i]; }
        for (int t = 0; t < nt; t += 2) {
            const bool last = (t == nt - 2);
            const unsigned a1 = (unsigned)((t + 1 + cur.ks) & (nt - 1)) * 128u;
            const int ks2 = last ? nks : (t + 2 + cur.ks);
            const unsigned a2 = (unsigned)(ks2 & (nt - 1)) * 128u, a3 = (unsigned)((ks2 + 1) & (nt - 1)) * 128u;
            const unsigned bb = last ? nB : cB;
            const unsigned b2 = bb + a2, b3 = bb + a3;
            unsigned sa[2][2];
#pragma unroll
            for (int h = 0; h < 2; ++h)
#pragma unroll
                for (int i = 0; i < 2; ++i) sa[h][i] = last ? voAn[h][i] : voAc[h][i];
            PG8_LDB(B0, 0, 0); PG8_LDB(B1, 0, 1); PG8_SCHED; PG8_LDA(At, 0, 0); PG8_STAGE(PG8_SA(1, 1), rA, a1, voAc[1]);
            PG8_WAIT_V(8); PG8_WAIT_L(0); PG8_BAR; PG8_MMA(0, 0, At, B0); PG8_MMA(0, 1, At, B1); PG8_BAR; PG8_SCHED;
            PG8_LDA(At, 0, 1); PG8_STAGE(PG8_SB(0, 0), rB, b2, voB[0]); PG8_STAGE(PG8_SB(0, 1), rB, b2, voB[1]); PG8_STAGE(PG8_SA(0, 0), rA, a2, sa[0]);
            PG8_WAIT_V(8); PG8_WAIT_L(0); PG8_BAR; PG8_MMA(1, 0, At, B0); PG8_MMA(1, 1, At, B1); PG8_BAR; PG8_SCHED;
            PG8_LDB(B0, 1, 0); PG8_LDB(B1, 1, 1); PG8_SCHED; PG8_LDA(At, 1, 0); PG8_STAGE(PG8_SA(0, 1), rA, a2, sa[1]);
            PG8_WAIT_V(8); PG8_WAIT_L(0); PG8_BAR; PG8_MMA(0, 0, At, B0); PG8_MMA(0, 1, At, B1); PG8_BAR; PG8_SCHED;
            PG8_LDA(At, 1, 1); PG8_STAGE(PG8_SB(1, 0), rB, b3, voB[0]); PG8_STAGE(PG8_SB(1, 1), rB, b3, voB[1]); PG8_STAGE(PG8_SA(1, 0), rA, a3, sa[0]);
            PG8_WAIT_V(8); PG8_WAIT_L(0); PG8_BAR; PG8_MMA(1, 0, At, B0); PG8_MMA(1, 1, At, B1); PG8_BAR; PG8_SCHED;
        }
        if (wr == 0) PG8_BAR;
        if constexpr (F8) asm volatile("s_nop 15\n\ts_nop 15" ::: "memory");
        pb.epi(acc, cur, wr, wc, fr, fq);
        if (!has_next) break;
#pragma unroll
        for (int a = 0; a < 2; ++a)
#pragma unroll
            for (int b = 0; b < 2; ++b)
#pragma unroll
                for (int m = 0; m < 4; ++m)
#pragma unroll
                    for (int n = 0; n < 2; ++n) acc[a][b][m][n] = (f32x4){0.f, 0.f, 0.f, 0.f};
        cur = nxt; cB = nB; ++ui;
#pragma unroll
        for (int h = 0; h < 2; ++h)
#pragma unroll
            for (int i = 0; i < 2; ++i) voAc[h][i] = voAn[h][i];
        if (wr == 1) PG8_BAR;
    }
    PG8_WAIT_V(0);
    PG8_BAR;
#undef PG8_SA
#undef PG8_SB
#undef PG8_STAGE
#undef PG8_LDA
#undef PG8_LDB
#undef PG8_MMA
#undef PG8_WAIT_V
#undef PG8_WAIT_L
#undef PG8_BAR
#undef PG8_SCHED
#undef PG8_VOA
}

#ifndef FAST_INPROJ
#define FAST_INPROJ 1
#endif
#ifndef FAST_OUTPROJ
#define FAST_OUTPROJ 1
#endif
#ifndef FAST_GU
#define FAST_GU 1
#endif
#ifndef FAST_DOWN
#define FAST_DOWN 1
#endif
template <bool FAST, class Pb> __device__ __forceinline__ void gemm_run(LAS unsigned char* lds, const Pb& pb, int bid, int nblk) {
    if constexpr (FAST) gemm_phase8(lds, pb, bid, nblk); else gemm_simple(lds, pb, bid, nblk);
}

__device__ __forceinline__ void inproj_phase(const Params& P, LAS unsigned char* lds, int l, int bid, int nblk) {
    unsigned char* ws = P.ws;
    PbInProj pb; pb.A = (const char*)(ws + WS_H); pb.B = (const char*)(ws + WS_WIN) + (size_t)l * (1280 * 1024 * 2); pb.K = 1024;
    pb.proj = (bf16*)(ws + WS_PROJ); pb.qg = P.qg + l * 64; pb.kg = P.kg + l * 64; pb.rope = (const float*)(ws + WS_ROPE);
    gemm_run<FAST_INPROJ>(lds, pb, bid, nblk);
}
__device__ __forceinline__ void outproj_phase(const Params& P, LAS unsigned char* lds, int l, int bid, int nblk) {
    unsigned char* ws = P.ws;
    PbOutProj pb; pb.A = (const char*)(ws + WS_MIX); pb.B = (const char*)(ws + WS_WOUT) + (size_t)l * (1024 * 1024 * 2); pb.K = 1024;
    pb.xin = (l == 0) ? P.x : P.out; pb.xout = P.out; pb.gate1 = (const float*)(ws + WS_MOD) + (size_t)l * NB * NMOD + 2 * D;
    gemm_run<FAST_OUTPROJ>(lds, pb, bid, nblk);
}
__device__ __forceinline__ void gu_phase(const Params& P, LAS unsigned char* lds, int l, int bid, int nblk) {
    unsigned char* ws = P.ws;
    LAS int* tab = (LAS int*)(lds + 131072);
    __syncthreads();
    moe_build_tab(tab, (const int*)(ws + WS_TOT) + l * 32);
    PbGU pb; pb.A = (const char*)(ws + WS_H8); pb.B = (const char*)(ws + WS_WGU) + (size_t)l * 32 * (2048 * 1024); pb.K = 1024;
    pb.tab = tab; pb.list = (const int*)(ws + WS_LIST); pb.bgu = P.bgu + (size_t)l * 32 * 2048; pb.act = ws + WS_ACT;
    gemm_phase8(lds, pb, bid, nblk);
}
__device__ __forceinline__ void down_phase(const Params& P, LAS unsigned char* lds, int l, int bid, int nblk) {
    unsigned char* ws = P.ws;
    LAS int* tab = (LAS int*)(lds + 131072);
    __syncthreads();
    moe_build_tab(tab, (const int*)(ws + WS_TOT) + l * 32);
    PbDown pb; pb.A = (const char*)(ws + WS_ACT); pb.B = (const char*)(ws + WS_WDN) + (size_t)l * 32 * (1024 * 1024); pb.K = 1024;
    pb.tab = tab; pb.list = (const int*)(ws + WS_LIST); pb.bdn = P.bdn + (size_t)l * 32 * 1024; pb.ybuf = ws + WS_YBUF;
    gemm_phase8(lds, pb, bid, nblk);
}

#define XB_TMO      128
#define XB_XCNT(j)  (256  + 64 * (j))
#define XB_XSUB(j)  (1280 + 64 * (j))
#define XB_XGEN(j)  (2304 + 64 * (j))
#define XB_TOP      3328
#define XB_TOPGEN   3392
#define XCD_BAR_WORDS 3456
#define XB_SPIN_CAP (1u << 18)
__device__ __forceinline__ unsigned xb_ld(unsigned* p)              { return __hip_atomic_load(p, __ATOMIC_RELAXED, __HIP_MEMORY_SCOPE_AGENT); }
__device__ __forceinline__ unsigned xb_add(unsigned* p, unsigned v) { return __hip_atomic_fetch_add(p, v, __ATOMIC_RELAXED, __HIP_MEMORY_SCOPE_AGENT); }
__device__ __forceinline__ unsigned xb_xcc_id() { return (unsigned)__builtin_amdgcn_s_getreg((3 << 11) | 20) & 0xFu; }
#define XB_SPIN(cond, bar) do { unsigned _sp = 0; while (cond) { __builtin_amdgcn_s_sleep(1); \
    if ((++_sp & 255u) == 0u) { if (xb_ld(&(bar)[XB_TMO])) break; if (_sp > XB_SPIN_CAP) { atomicAdd(&(bar)[XB_TMO], 1u); break; } } } } while (0)
struct XcdBarrier { unsigned* bar; unsigned x; volatile LAS unsigned* st; };
__device__ __forceinline__ XcdBarrier xcd_barrier_post(unsigned* bar, volatile LAS unsigned* st) {
    XcdBarrier b; b.bar = bar; b.x = xb_xcc_id(); b.st = st;
    if (threadIdx.x == 0) (void)xb_add(&bar[XB_XCNT(b.x)], 1u);
    return b;
}
__device__ __forceinline__ void xcd_barrier_complete(unsigned* bar, unsigned x, unsigned& nloc, unsigned& nx) {
    const unsigned G = gridDim.x * gridDim.y * gridDim.z;
    unsigned sum, cnt, mine, sp = 0u;
    for (;;) {
        sum = 0u; cnt = 0u; mine = 0u;
#pragma unroll
        for (unsigned j = 0; j < 16; ++j) { const unsigned c = xb_ld(&bar[XB_XCNT(j)]); sum += c; cnt += (c > 0u) ? 1u : 0u; mine = (j == x) ? c : mine; }
        if (sum == G) break;
        __builtin_amdgcn_s_sleep(1);
        if ((++sp & 255u) == 0u) { if (xb_ld(&bar[XB_TMO])) break; if (sp > XB_SPIN_CAP) { atomicAdd(&bar[XB_TMO], 1u); break; } }
    }
    nloc = mine > 0u ? mine : 1u; nx = cnt > 0u ? cnt : 1u;
}
__device__ __forceinline__ void xcd_barrier(const XcdBarrier& b) {
    asm volatile("s_waitcnt vmcnt(0)" ::: "memory");
    __syncthreads();
    if (threadIdx.x == 0) {
        unsigned* bar = b.bar; const unsigned bx = xb_xcc_id();
        __builtin_amdgcn_s_waitcnt(0);
        unsigned nloc = b.st[0], nx = b.st[1];
        if (nloc == 0u) { xcd_barrier_complete(bar, bx, nloc, nx); b.st[0] = nloc; b.st[1] = nx; }
        const unsigned old = xb_add(&bar[XB_XSUB(bx)], 1u);
        const unsigned gen = old / nloc;
        if (old + 1u == (gen + 1u) * nloc) {
            __builtin_amdgcn_fence(__ATOMIC_RELEASE, "agent");
            asm volatile("s_waitcnt vmcnt(0)" ::: "memory");
            const unsigned og = xb_add(&bar[XB_TOP], 1u);
            const unsigned tg = og / nx;
            if (og + 1u == (tg + 1u) * nx) xb_add(&bar[XB_TOPGEN], 1u);
            else XB_SPIN(xb_ld(&bar[XB_TOPGEN]) == tg, bar);
            __builtin_amdgcn_fence(__ATOMIC_ACQUIRE, "agent");
            xb_add(&bar[XB_XGEN(bx)], 1u);
            asm volatile("s_waitcnt vmcnt(0)" ::: "memory");
        } else {
            XB_SPIN(xb_ld(&bar[XB_XGEN(bx)]) == gen, bar);
            __builtin_amdgcn_fence(__ATOMIC_ACQUIRE, "agent");
            asm volatile("s_waitcnt vmcnt(0)" ::: "memory");
        }
    }
    __syncthreads();
}


#if ONE_LAUNCH
constexpr int TAB_OFF = 131072, MISC_OFF = 131072 + 512;
__global__ void __launch_bounds__(NT, 2) mega_fwd(Params P) {
    extern __shared__ __attribute__((aligned(16))) unsigned char dyn_lds[];
    LAS unsigned char* lds = (LAS unsigned char*)dyn_lds;
    volatile LAS unsigned* MISC = (volatile LAS unsigned*)(lds + MISC_OFF);
    if (threadIdx.x < 32) MISC[threadIdx.x] = 0u;
    __syncthreads();
    XcdBarrier bar = xcd_barrier_post((unsigned*)(P.ws + WS_CTL) + CW_BAR, MISC + 8);
    const int bid = blockIdx.x, nblk = gridDim.x;
    const int vb = (nblk % 8 == 0) ? (bid % 8) * (nblk / 8) + bid / 8 : bid;
#ifndef REP_P0
#define REP_P0 1
#endif
#ifndef REP_INPROJ
#define REP_INPROJ 1
#endif
#ifndef REP_ATTN
#define REP_ATTN 1
#endif
#ifndef REP_GU
#define REP_GU 1
#endif
#ifndef REP_DOWN
#define REP_DOWN 1
#endif
    for (int r = 0; r < REP_P0; ++r) { p0_prologue(P, lds, bid, nblk); xcd_barrier(bar); }
    for (int l = 0; l < DEPTH; ++l) {
        if (l == 0) norm1_phase<0>(P, l, bid, nblk); else norm1_phase<1>(P, l, bid, nblk);
        xcd_barrier(bar);
        for (int r = 0; r < REP_INPROJ; ++r) { inproj_phase(P, lds, l, vb, nblk); xcd_barrier(bar); }
        for (int r = 0; r < REP_ATTN; ++r) { attn_phase(P, lds, l, bid, nblk); xcd_barrier(bar); }
        outproj_phase(P, lds, l, vb, nblk);
        xcd_barrier(bar);
        router_phase(P, lds, l, bid, nblk);
        xcd_barrier(bar);
        place_phase(P, lds, l, bid, nblk);
        xcd_barrier(bar);
        for (int r = 0; r < REP_GU; ++r) { gu_phase(P, lds, l, vb, nblk); xcd_barrier(bar); }
        for (int r = 0; r < REP_DOWN; ++r) { down_phase(P, lds, l, vb, nblk); xcd_barrier(bar); }
    }
    norm1_phase<2>(P, 0, bid, nblk);
}
#else
extern __shared__ __attribute__((aligned(16))) unsigned char dyn_lds[];
#define KLDS ((LAS unsigned char*)dyn_lds)
__global__ void __launch_bounds__(NT, 2) k_prologue(Params P) { p0_prologue(P, KLDS, blockIdx.x, gridDim.x); }
__global__ void __launch_bounds__(NT, 2) k_norm1_0(Params P, int l) { norm1_phase<0>(P, l, blockIdx.x, gridDim.x); }
__global__ void __launch_bounds__(NT, 2) k_norm1_1(Params P, int l) { norm1_phase<1>(P, l, blockIdx.x, gridDim.x); }
__global__ void __launch_bounds__(NT, 2) k_final(Params P) { norm1_phase<2>(P, 0, blockIdx.x, gridDim.x); }
__global__ void __launch_bounds__(NT, 2) k_inproj(Params P, int l) { inproj_phase(P, KLDS, l, blockIdx.x, gridDim.x); }
__global__ void __launch_bounds__(NT, 2) k_attn(Params P, int l) { attn_phase(P, KLDS, l, blockIdx.x, gridDim.x); }
__global__ void __launch_bounds__(NT, 2) k_outproj(Params P, int l) { outproj_phase(P, KLDS, l, blockIdx.x, gridDim.x); }
__global__ void __launch_bounds__(NT, 2) k_router(Params P, int l) { router_phase(P, KLDS, l, blockIdx.x, gridDim.x); }
__global__ void __launch_bounds__(NT, 2) k_place(Params P, int l) { place_phase(P, KLDS, l, blockIdx.x, gridDim.x); }
__global__ void __launch_bounds__(NT, 2) k_gu(Params P, int l) { gu_phase(P, KLDS, l, blockIdx.x, gridDim.x); }
__global__ void __launch_bounds__(NT, 2) k_down(Params P, int l) { down_phase(P, KLDS, l, blockIdx.x, gridDim.x); }

#endif

extern "C" void kernel_launch(void* const* d_in, const int* in_sizes, int n_in, void* d_out, int out_size, void* d_ws, size_t ws_size, hipStream_t stream) {
    static int ready = 0;
    if (ready == 0) {
        if (n_in != 21 || out_size != NTOK * D || ws_size < WS_END) { fprintf(stderr, "kernel_launch: unexpected shapes (n_in %d out %d ws %zu)\n", n_in, out_size, ws_size); ready = -1; return; }
#if ONE_LAUNCH
        const void* ks[] = {(const void*)mega_fwd};
#else
        const void* ks[] = {(const void*)k_prologue, (const void*)k_norm1_0, (const void*)k_norm1_1, (const void*)k_final, (const void*)k_inproj, (const void*)k_attn, (const void*)k_outproj, (const void*)k_router, (const void*)k_gu, (const void*)k_down, (const void*)k_place};
#endif
        for (auto k : ks) if (hipFuncSetAttribute(k, hipFuncAttributeMaxDynamicSharedMemorySize, LDS_BYTES) != hipSuccess) { fprintf(stderr, "kernel_launch: hipFuncSetAttribute failed\n"); ready = -1; return; }
        ready = 1;
    }
    if (ready < 0) return;
    (void)hipMemsetAsync((char*)d_ws + WS_CTL, 0, CTL_ZERO_BYTES, stream);
    Params P{};
    P.x = (const float*)d_in[0]; P.c = (const float*)d_in[1]; P.pos = (const int*)d_in[2]; P.ada_w = (const float*)d_in[3]; P.ada_b = (const float*)d_in[4]; P.n1g = (const float*)d_in[5];
    P.w_in = (const float*)d_in[6]; P.qg = (const float*)d_in[7]; P.kg = (const float*)d_in[8]; P.sinks = (const float*)d_in[9]; P.pool_w = (const float*)d_in[10]; P.pool_b = (const float*)d_in[11];
    P.pool_s = (const float*)d_in[12]; P.w_out = (const float*)d_in[13]; P.n2g = (const float*)d_in[14]; P.rw = (const float*)d_in[15]; P.rb = (const float*)d_in[16]; P.wgu = (const float*)d_in[17];
    P.bgu = (const float*)d_in[18]; P.wdn = (const float*)d_in[19]; P.bdn = (const float*)d_in[20]; P.out = (float*)d_out; P.ws = (unsigned char*)d_ws;
    const dim3 g(256), b(NT);
#if ONE_LAUNCH
    hipLaunchKernelGGL(mega_fwd, g, b, LDS_BYTES, stream, P);
#else
    hipLaunchKernelGGL(k_prologue, g, b, LDS_BYTES, stream, P);
    for (int l = 0; l < DEPTH; ++l) {
        if (l == 0) hipLaunchKernelGGL(k_norm1_0, g, b, LDS_BYTES, stream, P, l); else hipLaunchKernelGGL(k_norm1_1, g, b, LDS_BYTES, stream, P, l);
        hipLaunchKernelGGL(k_inproj, g, b, LDS_BYTES, stream, P, l);
        hipLaunchKernelGGL(k_attn, g, b, LDS_BYTES, stream, P, l);
        hipLaunchKernelGGL(k_outproj, g, b, LDS_BYTES, stream, P, l);
        hipLaunchKernelGGL(k_router, g, b, LDS_BYTES, stream, P, l);
        hipLaunchKernelGGL(k_place, g, b, LDS_BYTES, stream, P, l);
        hipLaunchKernelGGL(k_gu, g, b, LDS_BYTES, stream, P, l);
        hipLaunchKernelGGL(k_down, g, b, LDS_BYTES, stream, P, l);
    }
    hipLaunchKernelGGL(k_final, g, b, LDS_BYTES, stream, P);
#endif
}
```

```cpp
#include <hip/hip_runtime.h>
#include <cstdio>
#include <cstdint>

#ifndef ONE_LAUNCH
#define ONE_LAUNCH 1
#endif

#define LAS __attribute__((address_space(3)))
typedef unsigned short bf16;
typedef short bf16x8 __attribute__((ext_vector_type(8)));
typedef short s16x4 __attribute__((ext_vector_type(4)));
typedef float f32x4 __attribute__((ext_vector_type(4)));
typedef float f32x16 __attribute__((ext_vector_type(16)));
typedef unsigned u32x4 __attribute__((ext_vector_type(4)));
typedef unsigned u32x2 __attribute__((ext_vector_type(2)));
typedef float f32x2 __attribute__((ext_vector_type(2)));
typedef int i32x4 __attribute__((ext_vector_type(4)));
typedef int i32x8 __attribute__((ext_vector_type(8)));

constexpr int D = 1024, NB = 8, SEQ = 8192, NTOK = NB * SEQ, DEPTH = 2, NE = 32, NIN = 1280, NMOD = 6 * D;
constexpr int NT = 512;
constexpr float EPS = 1e-6f;
constexpr float LOG2E = 1.4426950408889634f;
constexpr float QSCALE = 0.18033688011112042f;
constexpr int MAXTILES = NTOK * 4 / 256 + NE;

constexpr size_t MiB = 1u << 20;
constexpr size_t WS_CTL = 0, CTL_ZERO_BYTES = 1 * MiB;
constexpr size_t WS_MOD = 1 * MiB;
constexpr size_t WS_ROPE = 2 * MiB;
constexpr size_t WS_WIN = 8 * MiB;
constexpr size_t WS_WOUT = 16 * MiB;
constexpr size_t WS_GATES = 20 * MiB;
constexpr size_t WS_SEL = 21 * MiB;
constexpr size_t WS_CNTB = 22 * MiB;
constexpr size_t WS_TOT = 23 * MiB;
constexpr size_t WS_LIST = 24 * MiB;
constexpr size_t WS_WGU = 32 * MiB;
constexpr size_t WS_WDN = 160 * MiB;
constexpr size_t WS_H = 224 * MiB;
constexpr size_t WS_H8 = 352 * MiB;
constexpr size_t WS_PROJ = 416 * MiB;
constexpr size_t WS_MIX = 576 * MiB;
constexpr size_t WS_ACT = 416 * MiB;
constexpr size_t WS_YBUF = 704 * MiB;
constexpr size_t WS_XB = 960 * MiB;
constexpr size_t WS_END = 1088 * MiB;
static_assert(WS_ACT + (size_t)MAXTILES * 256 * 1024 <= WS_YBUF, "act fits");
constexpr float WSCALE = 32.0f, WUNSCALE = 1.0f / 32.0f;
constexpr int CW_BAR = 4096;
constexpr int CW_CNT = 8192;

constexpr int LDS_BYTES = 147456;

struct Params {
    const float *x, *c; const int* pos; const float *ada_w, *ada_b, *n1g, *w_in, *qg, *kg, *sinks, *pool_w, *pool_b, *pool_s, *w_out, *n2g, *rw, *rb, *wgu, *bgu, *wdn, *bdn;
    float* out; unsigned char* ws;
};

__device__ __forceinline__ unsigned cvt_pk_bf16(float lo, float hi) { unsigned r; asm("v_cvt_pk_bf16_f32 %0, %1, %2" : "=v"(r) : "v"(lo), "v"(hi)); return r; }
__device__ __forceinline__ unsigned cvt_pk4_fp8(float a, float b, float c, float d) { int w = 0; w = __builtin_amdgcn_cvt_pk_fp8_f32(a, b, w, false); w = __builtin_amdgcn_cvt_pk_fp8_f32(c, d, w, true); return (unsigned)w; }
__device__ __forceinline__ float bf_lo(unsigned w) { return __uint_as_float(w << 16); }
__device__ __forceinline__ float bf_hi(unsigned w) { return __uint_as_float(w & 0xffff0000u); }
template <int M> __device__ __forceinline__ float swz_xor(float v) { return __int_as_float(__builtin_amdgcn_ds_swizzle(__float_as_int(v), (M << 10) | 0x1f)); }
__device__ __forceinline__ float sum_x32(float v) { const auto r = __builtin_amdgcn_permlane32_swap(__float_as_uint(v), __float_as_uint(v), false, false); return __uint_as_float(r[0]) + __uint_as_float(r[1]); }
__device__ __forceinline__ float max_x32(float v) { const auto r = __builtin_amdgcn_permlane32_swap(__float_as_uint(v), __float_as_uint(v), false, false); return fmaxf(__uint_as_float(r[0]), __uint_as_float(r[1])); }
__device__ __forceinline__ float wave_sum(float v) {
    v += swz_xor<1>(v); v += swz_xor<2>(v); v += swz_xor<4>(v); v += swz_xor<8>(v); v += swz_xor<16>(v);
    return sum_x32(v);
}
__device__ __forceinline__ int dpp_swap1(int v) { return __builtin_amdgcn_update_dpp(0, v, 0xB1, 0xF, 0xF, true); }
__device__ __forceinline__ u32x4 dpp_swap1(u32x4 v) { u32x4 r; r.x = (unsigned)dpp_swap1((int)v.x); r.y = (unsigned)dpp_swap1((int)v.y); r.z = (unsigned)dpp_swap1((int)v.z); r.w = (unsigned)dpp_swap1((int)v.w); return r; }
__device__ __forceinline__ void store_line_pair(unsigned char* own_line, unsigned char* nb_line, bool own_valid, bool nb_valid, u32x4 lo, u32x4 hi, int fq, bool odd) {
    const u32x4 got = dpp_swap1(odd ? lo : hi);
    const int off = (odd ? 64 : 0) + 16 * fq;
    if (odd ? nb_valid : own_valid) *(u32x4*)((odd ? nb_line : own_line) + off) = odd ? got : lo;
    if (odd ? own_valid : nb_valid) *(u32x4*)((odd ? own_line : nb_line) + off) = odd ? hi : got;
}
__device__ __forceinline__ void load_line_pair(const unsigned char* own_line, const unsigned char* nb_line, int fq, bool odd, u32x4& lo, u32x4& hi) {
    const int off = (odd ? 64 : 0) + 16 * fq;
    const u32x4 a = *(const u32x4*)((odd ? nb_line : own_line) + off), b = *(const u32x4*)((odd ? own_line : nb_line) + off);
    const u32x4 got = dpp_swap1(odd ? a : b);
    lo = odd ? got : a; hi = odd ? b : got;
}
__device__ __forceinline__ int lperm(int r) { return (r & 63) * 4 + (r >> 6); }
__device__ __forceinline__ int perm32(int rho) { const int n = rho >> 4, i = rho & 15; return 8 * (i >> 2) + 4 * n + (i & 3); }
__device__ __forceinline__ int opaque_tid() { int t = threadIdx.x; asm volatile("" : "+v"(t)); return t; }

__device__ __forceinline__ void tr_item_src(const Params& P, int it, const float*& src, int& ldw, bf16*& dst, int& k0, int& n0, bool& f8) {
    f8 = it < 16384 + 8192;
    unsigned char* ws = P.ws;
    if (it < 16384) { const int m = it >> 8, r = it & 255; src = P.wgu + (size_t)m * (1024 * 2048); ldw = 2048; dst = (bf16*)(ws + WS_WGU + (size_t)m * (2048 * 1024)); k0 = 128 * (r >> 5); n0 = 64 * (r & 31); return; }
    it -= 16384;
    if (it < 8192) { const int m = it >> 7, r = it & 127; src = P.wdn + (size_t)m * (1024 * 1024); ldw = 1024; dst = (bf16*)(ws + WS_WDN + (size_t)m * (1024 * 1024)); k0 = 128 * (r >> 4); n0 = 64 * (r & 15); return; }
    it -= 8192;
    if (it < 192) { const int l = it / 96, r = it % 96; src = P.w_in + (size_t)l * (1024 * 1280); ldw = 1280; dst = (bf16*)(ws + WS_WIN) + (size_t)l * (1280 * 1024); k0 = 128 * (r / 12); n0 = 64 * (r % 12); return; }
    it -= 192;
    { const int l = it >> 7, r = it & 127; src = P.w_out + (size_t)l * (1024 * 1024); ldw = 1024; dst = (bf16*)(ws + WS_WOUT) + (size_t)l * (1024 * 1024); k0 = 128 * (r >> 4); n0 = 64 * (r & 15); }
}
constexpr int N_TR_ITEMS = 16384 + 8192 + 192 + 256;

__device__ __forceinline__ void p0_prologue(const Params& P, LAS unsigned char* lds, int bid, int nblk) {
    const int tid = opaque_tid(), wid = __builtin_amdgcn_readfirstlane(tid >> 6), lane = tid & 63;
    unsigned char* ws = P.ws;
    {
        LAS float* cact = (LAS float*)lds;
        LAS float* red = (LAS float*)(lds + 32768);
        if (bid < 192 || nblk < 192) {
            for (int i = tid; i < NB * D; i += NT) { const float v = P.c[i]; cact[i] = v / (1.0f + __expf(-v)); }
            __syncthreads();
            for (int it = bid; it < 192; it += nblk) {
                const int l = it / 96, n0 = 64 * (it % 96);
                float acc[NB];
#pragma unroll
                for (int b = 0; b < NB; ++b) acc[b] = 0.f;
                const float* wp = P.ada_w + (size_t)l * D * NMOD + n0 + lane;
                for (int k = 128 * wid; k < 128 * wid + 128; k += 16) {
                    float wv[16];
#pragma unroll
                    for (int q = 0; q < 16; ++q) wv[q] = wp[(size_t)(k + q) * NMOD];
#pragma unroll
                    for (int q = 0; q < 16; ++q)
#pragma unroll
                        for (int b = 0; b < NB; ++b) acc[b] += cact[b * D + k + q] * wv[q];
                }
#pragma unroll
                for (int b = 0; b < NB; ++b) red[(wid * NB + b) * 64 + lane] = acc[b];
                __syncthreads();
                { const int b = tid >> 6; float s = P.ada_b[l * NMOD + n0 + lane];
#pragma unroll
                  for (int w = 0; w < 8; ++w) s += red[(w * NB + b) * 64 + lane];
                  ((float*)(ws + WS_MOD))[(size_t)(l * NB + b) * NMOD + n0 + lane] = s; }
                __syncthreads();
            }
        }
    }
    for (int it = bid; it < 128; it += nblk) {
        const int l = it >> 6, g = (it >> 4) & 3, k0 = 64 * (it & 15);
        LAS float* At = (LAS float*)lds;
        LAS float* Pw = (LAS float*)(lds + 33024);
        __syncthreads();
        for (int j = 0; j < 16; ++j) { const int idx = tid + NT * j, k = idx >> 7, c = idx & 127; At[k * 129 + c] = P.w_in[(size_t)l * (1024 * 1280) + (size_t)(k0 + k) * 1280 + 768 + 128 * g + c]; }
        for (int j = 0; j < 32; ++j) { const int idx = tid + NT * j; Pw[idx] = P.pool_w[(size_t)(l * 4 + g) * 16384 + idx]; }
        __syncthreads();
        const int n = tid & 127, ks = tid >> 7;
        float acc[16];
#pragma unroll
        for (int i = 0; i < 16; ++i) acc[i] = 0.f;
        for (int c = 0; c < 128; ++c) { const float pw = Pw[c * 128 + n];
#pragma unroll
            for (int i = 0; i < 16; ++i) acc[i] += At[(16 * ks + i) * 129 + c] * pw; }
        bf16* dst = (bf16*)(ws + WS_WIN) + (size_t)l * (1280 * 1024) + (size_t)(768 + 128 * g + n) * 1024 + k0 + 16 * ks;
        u32x4 o0, o1;
        o0.x = cvt_pk_bf16(acc[0], acc[1]); o0.y = cvt_pk_bf16(acc[2], acc[3]); o0.z = cvt_pk_bf16(acc[4], acc[5]); o0.w = cvt_pk_bf16(acc[6], acc[7]);
        o1.x = cvt_pk_bf16(acc[8], acc[9]); o1.y = cvt_pk_bf16(acc[10], acc[11]); o1.z = cvt_pk_bf16(acc[12], acc[13]); o1.w = cvt_pk_bf16(acc[14], acc[15]);
        *(u32x4*)dst = o0; *(u32x4*)(dst + 8) = o1;
    }
    {
        const double invf[8] = {1.0, 0.19392274474868576, 0.03760603093086393, 0.007292664737217109, 0.001414213562373095, 0.0002742481756762073, 5.318295896944988e-05, 1.031338537721246e-05};
        float* rope = (float*)(ws + WS_ROPE);
        for (int idx = bid * NT + tid; idx < NTOK * 8; idx += nblk * NT) {
            const int tok = idx >> 3, i = idx & 7;
            double f = 1.0;
#pragma unroll
            for (int q = 0; q < 8; ++q) f = (i == q) ? invf[q] : f;
            const double ang = (double)P.pos[tok] * f;
            const double kq = __builtin_rint(ang * 0.6366197723675814);
            const double r = (ang - kq * 1.5707963267948966) - kq * 6.123233995736766e-17;
            const double r2 = r * r;
            double sn = r * (1.0 + r2 * (-1.0 / 6 + r2 * (1.0 / 120 + r2 * (-1.0 / 5040 + r2 * (1.0 / 362880 + r2 * (-1.0 / 39916800 + r2 * (1.0 / 6227020800.0)))))));
            double cs = 1.0 + r2 * (-0.5 + r2 * (1.0 / 24 + r2 * (-1.0 / 720 + r2 * (1.0 / 40320 + r2 * (-1.0 / 3628800 + r2 * (1.0 / 479001600.0 + r2 * (-1.0 / 87178291200.0)))))));
            const int q = ((int)(long long)kq) & 3;
            double s2 = (q & 1) ? cs : sn, c2 = (q & 1) ? sn : cs;
            if (q == 1 || q == 2) c2 = -c2;
            if (q >= 2) s2 = -s2;
            rope[tok * 16 + i] = (float)c2; rope[tok * 16 + 8 + i] = (float)s2;
        }
    }
    {
        LAS float* tile = (LAS float*)lds;
        __syncthreads();
        f32x4 r[4];
        const float* src; int ldw, k0, n0; bf16* dst; bool f8;
        int it = bid;
        if (it < N_TR_ITEMS) { tr_item_src(P, it, src, ldw, dst, k0, n0, f8);
#pragma unroll
            for (int j = 0; j < 4; ++j) { const int idx = tid + NT * j, row = idx >> 4, c4 = idx & 15; r[j] = *(const f32x4*)(src + (size_t)(k0 + row) * ldw + n0 + 4 * c4); } }
        for (; it < N_TR_ITEMS; it += nblk) {
#pragma unroll
            for (int j = 0; j < 4; ++j) { const int idx = tid + NT * j, row = idx >> 4, c4 = idx & 15; LAS float* t = tile + row * 65 + 4 * c4; t[0] = r[j].x; t[1] = r[j].y; t[2] = r[j].z; t[3] = r[j].w; }
            __syncthreads();
            bf16* cdst = dst; const int ck0 = k0, cn0 = n0; const bool cf8 = f8;
            if (it + nblk < N_TR_ITEMS) { tr_item_src(P, it + nblk, src, ldw, dst, k0, n0, f8);
#pragma unroll
                for (int j = 0; j < 4; ++j) { const int idx = tid + NT * j, row = idx >> 4, c4 = idx & 15; r[j] = *(const f32x4*)(src + (size_t)(k0 + row) * ldw + n0 + 4 * c4); } }
            if (cf8) {
                const int n = tid >> 3, c = tid & 7; const LAS float* t = tile + (16 * c) * 65 + n;
                u32x4 o; o.x = cvt_pk4_fp8(t[0] * WSCALE, t[65] * WSCALE, t[2 * 65] * WSCALE, t[3 * 65] * WSCALE); o.y = cvt_pk4_fp8(t[4 * 65] * WSCALE, t[5 * 65] * WSCALE, t[6 * 65] * WSCALE, t[7 * 65] * WSCALE);
                o.z = cvt_pk4_fp8(t[8 * 65] * WSCALE, t[9 * 65] * WSCALE, t[10 * 65] * WSCALE, t[11 * 65] * WSCALE); o.w = cvt_pk4_fp8(t[12 * 65] * WSCALE, t[13 * 65] * WSCALE, t[14 * 65] * WSCALE, t[15 * 65] * WSCALE);
                *(u32x4*)((unsigned char*)cdst + (size_t)(cn0 + n) * 1024 + ck0 + 16 * c) = o;
            } else {
#pragma unroll
            for (int j = 0; j < 2; ++j) { const int p = tid + NT * j, n = p >> 4, c = p & 15; const LAS float* t = tile + (8 * c) * 65 + n;
                u32x4 o; o.x = cvt_pk_bf16(t[0], t[65]); o.y = cvt_pk_bf16(t[2 * 65], t[3 * 65]); o.z = cvt_pk_bf16(t[4 * 65], t[5 * 65]); o.w = cvt_pk_bf16(t[6 * 65], t[7 * 65]);
                *(u32x4*)(cdst + (size_t)(cn0 + n) * 1024 + ck0 + 8 * c) = o; }
            }
            __syncthreads();
        }
    }
}

template <int MODE>
__device__ __forceinline__ void norm1_phase(const Params& P, int l, int bid, int nblk) {
    const int tid = opaque_tid(), wid = __builtin_amdgcn_readfirstlane(tid >> 6), lane = tid & 63;
    unsigned char* ws = P.ws;
    const float* mod = (const float*)(ws + WS_MOD);
    bf16* XB = (bf16*)(ws + WS_XB);
    bf16* H = (bf16*)(ws + WS_H);
    const float* gates = (const float*)(ws + WS_GATES);
    const unsigned char* Y = ws + WS_YBUF;
    for (int ch = bid * 8 + wid; ch < NTOK / 32; ch += nblk * 8) {
        const int b = (ch * 32) >> 13;
        f32x4 ca[4], cc[4], cg[4];
#pragma unroll
        for (int j = 0; j < 4; ++j) {
            const int col = 256 * j + 4 * lane;
            if (MODE <= 1) { const f32x4 g = *(const f32x4*)(P.n1g + l * D + col); const f32x4 sc = *(const f32x4*)(mod + (size_t)(l * NB + b) * NMOD + 1 * D + col);
                ca[j] = g * (1.0f + sc); cc[j] = *(const f32x4*)(mod + (size_t)(l * NB + b) * NMOD + 0 * D + col); }
            if (MODE >= 1) { const int lp = (MODE == 2) ? (DEPTH - 1) : (l - 1); cg[j] = *(const f32x4*)(mod + (size_t)(lp * NB + b) * NMOD + 5 * D + col); }
        }
        for (int rr = 0; rr < 32; ++rr) {
            const int row = ch * 32 + rr;
            f32x4 v[4];
            if (MODE == 0) {
#pragma unroll
                for (int j = 0; j < 4; ++j) v[j] = *(const f32x4*)(P.x + (size_t)row * D + 256 * j + 4 * lane);
            } else {
#pragma unroll
                for (int j = 0; j < 4; ++j) { const u32x2 xw = *(const u32x2*)(XB + (size_t)row * D + 256 * j + 4 * lane); v[j] = (f32x4){bf_lo(xw.x), bf_hi(xw.x), bf_lo(xw.y), bf_hi(xw.y)}; }
            }
            if (MODE >= 1) {
                const f32x4 gt = *(const f32x4*)(gates + (size_t)row * 4);
                f32x4 a[4];
#pragma unroll
                for (int j = 0; j < 4; ++j) a[j] = (f32x4){0.f, 0.f, 0.f, 0.f};
#pragma unroll
                for (int k = 0; k < 4; ++k) {
                    const float gk = gt[k];
#pragma unroll
                    for (int j = 0; j < 4; ++j) { const unsigned y = *(const unsigned*)(Y + ((size_t)row * 4 + k) * D + 256 * j + 4 * lane);
                        const f32x2 p0 = __builtin_amdgcn_cvt_pk_f32_fp8((int)y, false), p1 = __builtin_amdgcn_cvt_pk_f32_fp8((int)y, true);
                        a[j].x += gk * p0.x; a[j].y += gk * p0.y; a[j].z += gk * p1.x; a[j].w += gk * p1.y; }
                }
#pragma unroll
                for (int j = 0; j < 4; ++j) { v[j] += cg[j] * a[j];
                    if (MODE == 2) *(f32x4*)(P.out + (size_t)row * D + 256 * j + 4 * lane) = v[j];
                    else { u32x2 xo; xo.x = cvt_pk_bf16(v[j].x, v[j].y); xo.y = cvt_pk_bf16(v[j].z, v[j].w); *(u32x2*)(XB + (size_t)row * D + 256 * j + 4 * lane) = xo; } }
            }
            if (MODE <= 1) {
                float ss = 0.f;
#pragma unroll
                for (int j = 0; j < 4; ++j) ss += (v[j].x * v[j].x + v[j].y * v[j].y) + (v[j].z * v[j].z + v[j].w * v[j].w);
                const float rstd = 1.0f / sqrtf(wave_sum(ss) * (1.0f / D) + EPS);
#pragma unroll
                for (int j = 0; j < 4; ++j) { const f32x4 h = v[j] * rstd * ca[j] + cc[j]; u32x2 o; o.x = cvt_pk_bf16(h.x, h.y); o.y = cvt_pk_bf16(h.z, h.w);
                    *(u32x2*)(H + (size_t)row * D + 256 * j + 4 * lane) = o; }
            }
        }
    }
}

struct Unit { int pm, pn, e, nrows, tbase, ks; };
typedef f32x4 Acc[2][2][4][2];

template <class Pb>
__device__ __forceinline__ void gemm_simple(LAS unsigned char* lds, const Pb& pb, int bid, int nblk) {
    const int tid = opaque_tid(), wid = __builtin_amdgcn_readfirstlane(tid >> 6), lane = tid & 63, wr = wid >> 2, wc = wid & 3, fr = lane & 15, fq = lane >> 4;
    constexpr int PITCH = 144;
    LAS unsigned char* sA = lds; LAS unsigned char* sB = lds + 256 * PITCH;
    Unit u;
    for (int i = 0; pb.next(i, bid, nblk, u); ++i) {
        Acc acc;
#pragma unroll
        for (int a = 0; a < 2; ++a)
#pragma unroll
            for (int b = 0; b < 2; ++b)
#pragma unroll
                for (int m = 0; m < 4; ++m)
#pragma unroll
                    for (int n = 0; n < 2; ++n) acc[a][b][m][n] = (f32x4){0.f, 0.f, 0.f, 0.f};
        unsigned ao[4], bo[4];
#pragma unroll
        for (int j = 0; j < 4; ++j) { const int q = tid + NT * j, row = q >> 3, c8 = q & 7;
            ao[j] = (unsigned)pb.a_row(u, row) * (unsigned)(pb.K * 2) + c8 * 16; bo[j] = (unsigned)pb.b_row(u, row) * (unsigned)(pb.K * 2) + c8 * 16; }
        for (int kt = 0; kt < pb.K / 64; ++kt) {
            u32x4 ra[4], rb[4];
#pragma unroll
            for (int j = 0; j < 4; ++j) { ra[j] = *(const u32x4*)(pb.A + ao[j] + kt * 128); rb[j] = *(const u32x4*)(pb.B + bo[j] + kt * 128); }
            __syncthreads();
#pragma unroll
            for (int j = 0; j < 4; ++j) { const int q = tid + NT * j, row = q >> 3, c8 = q & 7; *(LAS u32x4*)(sA + row * PITCH + c8 * 16) = ra[j]; *(LAS u32x4*)(sB + row * PITCH + c8 * 16) = rb[j]; }
            __syncthreads();
#pragma unroll
            for (int kk = 0; kk < 2; ++kk) {
                bf16x8 bfr[2][2];
#pragma unroll
                for (int b = 0; b < 2; ++b)
#pragma unroll
                    for (int n = 0; n < 2; ++n) bfr[b][n] = *(const LAS bf16x8*)(sB + (128 * b + 32 * wc + 16 * n + fr) * PITCH + (kk * 32 + fq * 8) * 2);
#pragma unroll
                for (int a = 0; a < 2; ++a) {
                    bf16x8 af[4];
#pragma unroll
                    for (int m = 0; m < 4; ++m) af[m] = *(const LAS bf16x8*)(sA + (128 * a + 64 * wr + 16 * m + fr) * PITCH + (kk * 32 + fq * 8) * 2);
#pragma unroll
                    for (int b = 0; b < 2; ++b)
#pragma unroll
                        for (int m = 0; m < 4; ++m)
#pragma unroll
                            for (int n = 0; n < 2; ++n) acc[a][b][m][n] = __builtin_amdgcn_mfma_f32_16x16x32_bf16(bfr[b][n], af[m], acc[a][b][m][n], 0, 0, 0);
                }
            }
        }
        pb.epi(acc, u, wr, wc, fr, fq);
    }
    __syncthreads();
}

struct PbInProj {
    static constexpr bool F8 = false;
    const char* A; const char* B; int K;
    bf16* proj; const float* qg; const float* kg; const float* rope;
    __device__ __forceinline__ bool next(int i, int bid, int nblk, Unit& u) const { const int L = i * nblk + bid; if (L >= 256 * 5) return false; u.pm = L / 5; u.pn = L % 5; u.e = 0; u.nrows = 256; u.tbase = 0; u.ks = 0; return true; }
    __device__ __forceinline__ int a_row(const Unit& u, int r) const { return 256 * u.pm + r; }
    __device__ __forceinline__ void a_rows4(const Unit& u, int r0, int (&rows)[4]) const { for (int j = 0; j < 4; ++j) rows[j] = 256 * u.pm + r0 + 64 * j; }
    __device__ __forceinline__ int b_rowc(int rho) const { return 64 * ((rho >> 5) & 3) + 32 * (rho >> 7) + perm32(rho & 31); }
    __device__ __forceinline__ int b_base_row(const Unit& u) const { return 256 * u.pn; }
    __device__ __forceinline__ int b_row(const Unit& u, int rho) const { return b_base_row(u) + b_rowc(rho); }
    __device__ __forceinline__ void epi(const Acc& acc, const Unit& u, int, int, int, int) const {
        const int t_ = opaque_tid(), w_ = __builtin_amdgcn_readfirstlane(t_ >> 6), wr = w_ >> 2, wc = w_ & 3, fr = t_ & 15, fq = (t_ >> 4) & 3;
        const int hg = 4 * u.pn + wc;
        const bool nrm = hg < 10;
        const float* gsrc = (hg < 8) ? qg : kg;
        f32x4 gv[2][2];
#pragma unroll
        for (int bj = 0; bj < 2; ++bj)
#pragma unroll
            for (int n = 0; n < 2; ++n) gv[bj][n] = nrm ? *(const f32x4*)(gsrc + 32 * bj + 8 * fq + 4 * n) : (f32x4){1.f, 1.f, 1.f, 1.f};
        const float qs = (hg < 8) ? QSCALE : 1.0f;
#pragma unroll
        for (int q = 0; q < 4; ++q) {
            const int ai = q >> 1, m0 = 2 * (q & 1);
            f32x4 rcs[2][2], rsn[2][2];
            if (nrm && fq < 2) {
#pragma unroll
                for (int mm = 0; mm < 2; ++mm) { const float* rp = rope + (size_t)(256 * u.pm + 128 * ai + 64 * wr + 16 * (m0 + mm) + fr) * 16;
#pragma unroll
                    for (int n = 0; n < 2; ++n) { rcs[mm][n] = *(const f32x4*)(rp + 4 * n); rsn[mm][n] = *(const f32x4*)(rp + 8 + 4 * n); } }
            }
#pragma unroll
            for (int mm = 0; mm < 2; ++mm) {
                const int m = m0 + mm;
                const int row = 256 * u.pm + 128 * ai + 64 * wr + 16 * m + fr;
                f32x4 v[2][2];
#pragma unroll
                for (int bj = 0; bj < 2; ++bj)
#pragma unroll
                    for (int n = 0; n < 2; ++n) v[bj][n] = acc[ai][bj][m][n];
                if (nrm) {
                    float ss = 0.f;
#pragma unroll
                    for (int bj = 0; bj < 2; ++bj)
#pragma unroll
                        for (int n = 0; n < 2; ++n) ss += (v[bj][n].x * v[bj][n].x + v[bj][n].y * v[bj][n].y) + (v[bj][n].z * v[bj][n].z + v[bj][n].w * v[bj][n].w);
                    ss += swz_xor<16>(ss); ss = sum_x32(ss);
                    const float rstd = __builtin_amdgcn_rsqf(ss * (1.0f / 64.0f) + EPS);
#pragma unroll
                    for (int bj = 0; bj < 2; ++bj)
#pragma unroll
                        for (int n = 0; n < 2; ++n) v[bj][n] = v[bj][n] * rstd * gv[bj][n];
#pragma unroll
                    for (int n = 0; n < 2; ++n) {
                        f32x4 pr;
                        pr.x = swz_xor<16>(v[0][n].x); pr.y = swz_xor<16>(v[0][n].y); pr.z = swz_xor<16>(v[0][n].z); pr.w = swz_xor<16>(v[0][n].w);
                        if (fq < 2) v[0][n] = (fq == 0) ? (v[0][n] * rcs[mm][n] - pr * rsn[mm][n]) : (v[0][n] * rcs[mm][n] + pr * rsn[mm][n]);
                    }
                }
                u32x4 o[2];
#pragma unroll
                for (int bj = 0; bj < 2; ++bj) {
                    o[bj].x = cvt_pk_bf16(v[bj][0].x * qs, v[bj][0].y * qs); o[bj].y = cvt_pk_bf16(v[bj][0].z * qs, v[bj][0].w * qs);
                    o[bj].z = cvt_pk_bf16(v[bj][1].x * qs, v[bj][1].y * qs); o[bj].w = cvt_pk_bf16(v[bj][1].z * qs, v[bj][1].w * qs);
                }
                { unsigned char* own = (unsigned char*)(proj + (size_t)row * NIN + 64 * hg); const bool odd = fr & 1;
                  store_line_pair(own, odd ? own - NIN * 2 : own + NIN * 2, true, true, o[0], o[1], fq, odd); }
            }
        }
    }
};

template <bool FIRST> struct PbOutProjT {
    static constexpr bool F8 = false;
    const char* A; const char* B; int K;
    const float* xin32; bf16* xb; const float* gate1;
    __device__ __forceinline__ bool next(int i, int bid, int nblk, Unit& u) const { const int L = i * nblk + bid; if (L >= 256 * 4) return false; u.pm = L >> 2; u.pn = L & 3; u.e = 0; u.nrows = 256; u.tbase = 0; u.ks = 0; return true; }
    __device__ __forceinline__ int a_row(const Unit& u, int r) const { return 256 * u.pm + r; }
    __device__ __forceinline__ void a_rows4(const Unit& u, int r0, int (&rows)[4]) const { for (int j = 0; j < 4; ++j) rows[j] = 256 * u.pm + r0 + 64 * j; }
    __device__ __forceinline__ int b_rowc(int rho) const { return 64 * ((rho >> 5) & 3) + 32 * (rho >> 7) + perm32(rho & 31); }
    __device__ __forceinline__ int b_base_row(const Unit& u) const { return 256 * u.pn; }
    __device__ __forceinline__ int b_row(const Unit& u, int rho) const { return b_base_row(u) + b_rowc(rho); }
    __device__ __forceinline__ void epi(const Acc& acc, const Unit& u, int, int, int, int) const {
        const int t_ = opaque_tid(), w_ = __builtin_amdgcn_readfirstlane(t_ >> 6), wr = w_ >> 2, wc = w_ & 3, fr = t_ & 15, fq = (t_ >> 4) & 3;
        const int b = (256 * u.pm) >> 13;
        const int colw = 256 * u.pn + 64 * wc;
        const bool odd = fr & 1;
        f32x4 g[2][2];
#pragma unroll
        for (int bj = 0; bj < 2; ++bj)
#pragma unroll
            for (int n = 0; n < 2; ++n) g[bj][n] = *(const f32x4*)(gate1 + (size_t)b * NMOD + colw + 32 * bj + 8 * fq + 4 * n);
#pragma unroll
        for (int q = 0; q < 4; ++q) {
            const int ai = q >> 1, m0 = 2 * (q & 1);
            f32x4 xr[2][2][2];
#pragma unroll
            for (int mm = 0; mm < 2; ++mm) {
                const size_t row = (size_t)(256 * u.pm + 128 * ai + 64 * wr + 16 * (m0 + mm) + fr);
                if (FIRST) {
#pragma unroll
                    for (int bj = 0; bj < 2; ++bj)
#pragma unroll
                        for (int n = 0; n < 2; ++n) xr[mm][bj][n] = *(const f32x4*)(xin32 + row * D + colw + 32 * bj + 8 * fq + 4 * n);
                } else {
                    const unsigned char* xi = (const unsigned char*)(xb + row * D + colw); u32x4 lo, hi;
                    load_line_pair(xi, odd ? xi - D * 2 : xi + D * 2, fq, odd, lo, hi);
                    xr[mm][0][0] = (f32x4){bf_lo(lo.x), bf_hi(lo.x), bf_lo(lo.y), bf_hi(lo.y)}; xr[mm][0][1] = (f32x4){bf_lo(lo.z), bf_hi(lo.z), bf_lo(lo.w), bf_hi(lo.w)};
                    xr[mm][1][0] = (f32x4){bf_lo(hi.x), bf_hi(hi.x), bf_lo(hi.y), bf_hi(hi.y)}; xr[mm][1][1] = (f32x4){bf_lo(hi.z), bf_hi(hi.z), bf_lo(hi.w), bf_hi(hi.w)};
                }
            }
#pragma unroll
            for (int mm = 0; mm < 2; ++mm) {
                const size_t row = (size_t)(256 * u.pm + 128 * ai + 64 * wr + 16 * (m0 + mm) + fr);
                u32x4 o[2];
#pragma unroll
                for (int bj = 0; bj < 2; ++bj) { const f32x4 r0 = xr[mm][bj][0] + g[bj][0] * acc[ai][bj][m0 + mm][0], r1 = xr[mm][bj][1] + g[bj][1] * acc[ai][bj][m0 + mm][1];
                    o[bj].x = cvt_pk_bf16(r0.x, r0.y); o[bj].y = cvt_pk_bf16(r0.z, r0.w); o[bj].z = cvt_pk_bf16(r1.x, r1.y); o[bj].w = cvt_pk_bf16(r1.z, r1.w); }
                unsigned char* xo = (unsigned char*)(xb + row * D + colw);
                store_line_pair(xo, odd ? xo - D * 2 : xo + D * 2, true, true, o[0], o[1], fq, odd);
            }
            asm volatile("" ::: "memory");
        }
    }
};

struct MoeTab { const LAS int* cnt; const LAS int* tp; };
__device__ __forceinline__ void moe_build_tab(LAS int* tab, const int* tot) {
    if (threadIdx.x == 0) { int t = 0; for (int e = 0; e < NE; ++e) { const int c = tot[e]; tab[e] = c; tab[32 + e] = t; t += (c + 255) >> 8; } tab[64] = t; }
    __syncthreads();
}
__device__ __forceinline__ bool moe_unit(const LAS int* tab, int L, int ntn, Unit& u) {
    const int gt = L / ntn; if (gt >= __builtin_amdgcn_readfirstlane(tab[64])) return false;
    const int ln = (int)__builtin_amdgcn_mbcnt_hi(~0u, __builtin_amdgcn_mbcnt_lo(~0u, 0u));
    const int tpv = tab[32 + (ln & 31)];
    const int e = __builtin_amdgcn_readfirstlane(__popcll(__ballot(tpv <= gt) & 0xffffffffull)) - 1;
    const int tpe = __builtin_amdgcn_readfirstlane(tab[32 + e]), cnt = __builtin_amdgcn_readfirstlane(tab[e]);
    u.e = e; u.pm = gt - tpe; u.pn = L % ntn; u.tbase = gt * 256; const int rem = cnt - 256 * u.pm; u.nrows = rem < 256 ? rem : 256; u.ks = 0; return true;
}

struct PbGU {
    static constexpr bool F8 = true;
    const char* A; const char* B; int K;
    const LAS int* tab; const int* list; const float* bgu; unsigned char* act;
    __device__ __forceinline__ bool next(int i, int bid, int nblk, Unit& u) const { return moe_unit(tab, i * nblk + bid, 8, u); }
    __device__ __forceinline__ int a_row(const Unit& u, int r) const { const int v = list[(size_t)u.e * NTOK + 256 * u.pm + lperm(r)]; return r < u.nrows ? (v >> 2) : 0; }
    __device__ __forceinline__ void a_rows4(const Unit& u, int r0, int (&rows)[4]) const {
        const int4 v = *(const int4*)(list + (size_t)u.e * NTOK + 256 * u.pm + 4 * r0);
        rows[0] = (r0 < u.nrows) ? (v.x >> 2) : 0; rows[1] = (r0 + 64 < u.nrows) ? (v.y >> 2) : 0; rows[2] = (r0 + 128 < u.nrows) ? (v.z >> 2) : 0; rows[3] = (r0 + 192 < u.nrows) ? (v.w >> 2) : 0; }
    __device__ __forceinline__ int b_rowc(int rho) const { const int i = rho & 127; return ((rho >> 7) ? 1024 : 0) + (i & ~31) + perm32(i & 31); }
    __device__ __forceinline__ int b_base_row(const Unit& u) const { return u.e * 2048 + 128 * u.pn; }
    __device__ __forceinline__ int b_row(const Unit& u, int rho) const { return b_base_row(u) + b_rowc(rho); }
    __device__ __forceinline__ void epi(const Acc& acc, const Unit& u, int, int, int, int) const {
        const int t_ = opaque_tid(), w_ = __builtin_amdgcn_readfirstlane(t_ >> 6), wr = w_ >> 2, wc = w_ & 3, fr = t_ & 15, fq = (t_ >> 4) & 3;
        const int col0 = 128 * u.pn + 32 * wc + 8 * fq;
        f32x4 bg[2], bu[2];
#pragma unroll
        for (int n = 0; n < 2; ++n) { bg[n] = *(const f32x4*)(bgu + (size_t)u.e * 2048 + col0 + 4 * n); bu[n] = *(const f32x4*)(bgu + (size_t)u.e * 2048 + 1024 + col0 + 4 * n); }
#pragma unroll
        for (int ai = 0; ai < 2; ++ai)
#pragma unroll
            for (int m = 0; m < 4; ++m) {
                const int r = 128 * ai + 64 * wr + 16 * m + fr;
                float o[8];
#pragma unroll
                for (int n = 0; n < 2; ++n)
#pragma unroll
                    for (int j = 0; j < 4; ++j) {
                        float g = acc[ai][0][m][n][j] * WUNSCALE + bg[n][j], uu = acc[ai][1][m][n][j] * WUNSCALE + bu[n][j];
                        g = fminf(g, 7.0f); uu = fminf(fmaxf(uu, -7.0f), 7.0f);
                        const float sg = __builtin_amdgcn_rcpf(1.0f + __builtin_amdgcn_exp2f(-1.702f * LOG2E * g));
                        o[4 * n + j] = g * sg * (uu + 1.0f);
                    }
                u32x2 w; w.x = cvt_pk4_fp8(o[0], o[1], o[2], o[3]); w.y = cvt_pk4_fp8(o[4], o[5], o[6], o[7]);
                *(u32x2*)(act + (size_t)(u.tbase + r) * 1024 + col0) = w;
            }
    }
};

struct PbDown {
    static constexpr bool F8 = true;
    const char* A; const char* B; int K;
    const LAS int* tab; const int* list; const float* bdn; unsigned char* ybuf;
    __device__ __forceinline__ bool next(int i, int bid, int nblk, Unit& u) const { return moe_unit(tab, i * nblk + bid, 4, u); }
    __device__ __forceinline__ int a_row(const Unit& u, int r) const { return u.tbase + r; }
    __device__ __forceinline__ void a_rows4(const Unit& u, int r0, int (&rows)[4]) const { for (int j = 0; j < 4; ++j) rows[j] = u.tbase + r0 + 64 * j; }
    __device__ __forceinline__ int b_rowc(int rho) const { return 64 * ((rho >> 5) & 3) + 16 * ((rho >> 2) & 3) + 8 * (rho >> 7) + 4 * ((rho >> 4) & 1) + (rho & 3); }
    __device__ __forceinline__ int b_base_row(const Unit& u) const { return u.e * 1024 + 256 * u.pn; }
    __device__ __forceinline__ int b_row(const Unit& u, int rho) const { return b_base_row(u) + b_rowc(rho); }
    __device__ __forceinline__ void epi(const Acc& acc, const Unit& u, int, int, int, int) const {
        const int t_ = opaque_tid(), w_ = __builtin_amdgcn_readfirstlane(t_ >> 6), wr = w_ >> 2, wc = w_ & 3, fr = t_ & 15, fq = (t_ >> 4) & 3;
        const int col0 = 256 * u.pn + 64 * wc + 16 * fq;
        f32x4 bv[2][2];
#pragma unroll
        for (int bj = 0; bj < 2; ++bj)
#pragma unroll
            for (int n = 0; n < 2; ++n) bv[bj][n] = *(const f32x4*)(bdn + (size_t)u.e * 1024 + col0 + 8 * bj + 4 * n);
        int dst8[8];
#pragma unroll
        for (int q = 0; q < 8; ++q) dst8[q] = list[(size_t)u.e * NTOK + 256 * u.pm + lperm(128 * (q >> 2) + 64 * wr + 16 * (q & 3) + fr)];
#pragma unroll
        for (int ai = 0; ai < 2; ++ai)
#pragma unroll
            for (int m = 0; m < 4; ++m) {
                const int r = 128 * ai + 64 * wr + 16 * m + fr;
                u32x4 w;
                { const f32x4 v00 = acc[ai][0][m][0] * WUNSCALE + bv[0][0], v01 = acc[ai][0][m][1] * WUNSCALE + bv[0][1], v10 = acc[ai][1][m][0] * WUNSCALE + bv[1][0], v11 = acc[ai][1][m][1] * WUNSCALE + bv[1][1];
                  w.x = cvt_pk4_fp8(v00.x, v00.y, v00.z, v00.w); w.y = cvt_pk4_fp8(v01.x, v01.y, v01.z, v01.w); w.z = cvt_pk4_fp8(v10.x, v10.y, v10.z, v10.w); w.w = cvt_pk4_fp8(v11.x, v11.y, v11.z, v11.w); }
                if (r < u.nrows) *(u32x4*)(ybuf + (size_t)dst8[ai * 4 + m] * 1024 + col0) = w;
            }
    }
};

__device__ __forceinline__ s16x4 lds_tr16(const LAS unsigned char* p) { return __builtin_bit_cast(s16x4, __builtin_amdgcn_ds_read_tr16_b64_v4i16((LAS s16x4*)p)); }

__device__ __forceinline__ void attn_phase(const Params& P, LAS unsigned char* lds, int l, int bid, int nblk) {
    const int tid = opaque_tid(), wid = __builtin_amdgcn_readfirstlane(tid >> 6), lane = tid & 63, r32 = lane & 31, hi = lane >> 5;
    unsigned char* ws = P.ws;
    const bf16* proj = (const bf16*)(ws + WS_PROJ);
    bf16* mix = (bf16*)(ws + WS_MIX);
    constexpr int KP = 144;
    LAS unsigned char* sK = lds; LAS unsigned char* sV = lds + 256 * KP;
    for (int unit = bid; unit < NB * 64 * 2; unit += nblk) {
        const int kvh = unit & 1, n = (unit >> 1) & 63, b = unit >> 7;
        const int tok0 = b * SEQ + n * 128 - 128;
        __syncthreads();
#pragma unroll
        for (int j = 0; j < 4; ++j) {
            const int q = tid + NT * j, key = q >> 3, c8 = q & 7;
            u32x4 kv = (u32x4){0u, 0u, 0u, 0u}, vv = (u32x4){0u, 0u, 0u, 0u};
            if (n > 0 || key >= 128) { const bf16* src = proj + (size_t)(tok0 + key) * NIN + 512 + kvh * 64 + c8 * 8; kv = *(const u32x4*)src; vv = *(const u32x4*)(src + 128); }
            *(LAS u32x4*)(sK + key * KP + c8 * 16) = kv; *(LAS u32x4*)(sV + key * KP + c8 * 16) = vv;
        }
        __syncthreads();
        const int hq = kvh * 4 + (wid >> 1);
        const float sink2 = P.sinks[l * 8 + hq] * LOG2E;
#pragma unroll 1
        for (int qt = 0; qt < 2; ++qt) {
            const int q0 = 64 * (wid & 1) + 32 * qt, qi = q0 + r32;
            const size_t qtok = (size_t)b * SEQ + n * 128 + qi;
            bf16x8 qf[4];
#pragma unroll
            for (int s = 0; s < 4; ++s) qf[s] = *(const bf16x8*)(proj + qtok * NIN + hq * 64 + 16 * s + 8 * hi);
            f32x16 st[5];
#pragma unroll
            for (int kt = 0; kt < 5; ++kt) {
#pragma unroll
                for (int r = 0; r < 16; ++r) st[kt][r] = 0.f;
#pragma unroll
                for (int s = 0; s < 4; ++s) { const bf16x8 kf = *(const LAS bf16x8*)(sK + (q0 + 32 * kt + r32) * KP + (16 * s + 8 * hi) * 2); st[kt] = __builtin_amdgcn_mfma_f32_32x32x16_bf16(kf, qf[s], st[kt], 0, 0, 0); }
            }
            float mx = sink2;
#pragma unroll
            for (int kt = 0; kt < 5; ++kt)
#pragma unroll
                for (int r = 0; r < 16; ++r) {
                    const int kj = q0 + 32 * kt + (r & 3) + 8 * (r >> 2) + 4 * hi;
                    const bool ok = (kj > qi) && (kj <= qi + 128) && (n > 0 || kj >= 128);
                    const float s = ok ? st[kt][r] : -__builtin_inff(); st[kt][r] = s; mx = fmaxf(mx, s);
                }
            mx = max_x32(mx);
            float sum = 0.f;
#pragma unroll
            for (int kt = 0; kt < 5; ++kt)
#pragma unroll
                for (int r = 0; r < 16; ++r) { const float p = __builtin_amdgcn_exp2f(st[kt][r] - mx); st[kt][r] = p; sum += p; }
            sum = sum_x32(sum);
            sum += __builtin_amdgcn_exp2f(sink2 - mx);
            f32x16 o[2];
#pragma unroll
            for (int dt = 0; dt < 2; ++dt)
#pragma unroll
                for (int r = 0; r < 16; ++r) o[dt][r] = 0.f;
#pragma unroll
            for (int kt = 0; kt < 5; ++kt)
#pragma unroll
                for (int s2 = 0; s2 < 2; ++s2) {
                    u32x4 pw; pw.x = cvt_pk_bf16(st[kt][8 * s2 + 0], st[kt][8 * s2 + 1]); pw.y = cvt_pk_bf16(st[kt][8 * s2 + 2], st[kt][8 * s2 + 3]);
                    pw.z = cvt_pk_bf16(st[kt][8 * s2 + 4], st[kt][8 * s2 + 5]); pw.w = cvt_pk_bf16(st[kt][8 * s2 + 6], st[kt][8 * s2 + 7]);
                    const bf16x8 pf = __builtin_bit_cast(bf16x8, pw);
                    const int kb = q0 + 32 * kt + 16 * s2 + 4 * hi, i16 = lane & 15;
#pragma unroll
                    for (int dt = 0; dt < 2; ++dt) {
                        const int d0 = 32 * dt + 16 * ((lane >> 4) & 1);
                        const LAS unsigned char* a0 = sV + (kb + (i16 >> 2)) * KP + (d0 + 4 * (i16 & 3)) * 2;
                        const s16x4 v0 = lds_tr16(a0), v1 = lds_tr16(a0 + 8 * KP);
                        bf16x8 vf; vf[0] = v0[0]; vf[1] = v0[1]; vf[2] = v0[2]; vf[3] = v0[3]; vf[4] = v1[0]; vf[5] = v1[1]; vf[6] = v1[2]; vf[7] = v1[3];
                        o[dt] = __builtin_amdgcn_mfma_f32_32x32x16_bf16(vf, pf, o[dt], 0, 0, 0);
                    }
                }
            const float inv = 1.0f / sum;
#pragma unroll
            for (int dt = 0; dt < 2; ++dt)
#pragma unroll
                for (int g4 = 0; g4 < 4; ++g4) {
                    u32x2 w; w.x = cvt_pk_bf16(o[dt][4 * g4 + 0] * inv, o[dt][4 * g4 + 1] * inv); w.y = cvt_pk_bf16(o[dt][4 * g4 + 2] * inv, o[dt][4 * g4 + 3] * inv);
                    *(u32x2*)(mix + qtok * D + hq * 64 + 32 * dt + 8 * g4 + 4 * hi) = w;
                }
        }
    }
    for (int ch = bid * 8 + wid; ch < NTOK / 32; ch += nblk * 8) {
        const int t0 = ch * 32, p0 = t0 & (SEQ - 1);
        const int col = 8 * lane, g = lane >> 4, w = 2 << g;
        float pb_[8], ps_[8];
#pragma unroll
        for (int i = 0; i < 8; i += 4) { const f32x4 a = *(const f32x4*)(P.pool_b + l * 512 + col + i), s = *(const f32x4*)(P.pool_s + l * 512 + col + i);
            pb_[i] = a.x; pb_[i + 1] = a.y; pb_[i + 2] = a.z; pb_[i + 3] = a.w; ps_[i] = s.x; ps_[i + 1] = s.y; ps_[i + 2] = s.z; ps_[i + 3] = s.w; }
        float sum[8];
#pragma unroll
        for (int i = 0; i < 8; ++i) sum[i] = 0.f;
        for (int j = 1; j < w; ++j) if (p0 - j >= 0) {
            const u32x4 z = *(const u32x4*)(proj + (size_t)(t0 - j) * NIN + 768 + col);
            sum[0] += bf_lo(z.x); sum[1] += bf_hi(z.x); sum[2] += bf_lo(z.y); sum[3] += bf_hi(z.y); sum[4] += bf_lo(z.z); sum[5] += bf_hi(z.z); sum[6] += bf_lo(z.w); sum[7] += bf_hi(z.w);
        }
        for (int t = 0; t < 32; ++t) {
            const u32x4 z = *(const u32x4*)(proj + (size_t)(t0 + t) * NIN + 768 + col);
            float zz[8] = {bf_lo(z.x), bf_hi(z.x), bf_lo(z.y), bf_hi(z.y), bf_lo(z.z), bf_hi(z.z), bf_lo(z.w), bf_hi(z.w)};
            const int pos = p0 + t; const float ic = 1.0f / (float)((pos + 1 < w) ? (pos + 1) : w);
            float o[8];
#pragma unroll
            for (int i = 0; i < 8; ++i) { sum[i] += zz[i]; o[i] = (sum[i] * ic - zz[i] + pb_[i]) * ps_[i]; }
            u32x4 ow; ow.x = cvt_pk_bf16(o[0], o[1]); ow.y = cvt_pk_bf16(o[2], o[3]); ow.z = cvt_pk_bf16(o[4], o[5]); ow.w = cvt_pk_bf16(o[6], o[7]);
            *(u32x4*)(mix + (size_t)(t0 + t) * D + 512 + col) = ow;
            if (pos - w + 1 >= 0) {
                const u32x4 y = *(const u32x4*)(proj + (size_t)(t0 + t - w + 1) * NIN + 768 + col);
                sum[0] -= bf_lo(y.x); sum[1] -= bf_hi(y.x); sum[2] -= bf_lo(y.y); sum[3] -= bf_hi(y.y); sum[4] -= bf_lo(y.z); sum[5] -= bf_hi(y.z); sum[6] -= bf_lo(y.w); sum[7] -= bf_hi(y.w);
            }
        }
    }
}

__device__ __forceinline__ void router_phase(const Params& P, LAS unsigned char* lds, int l, int bid, int nblk) {
    const int tid = opaque_tid(), wid = __builtin_amdgcn_readfirstlane(tid >> 6), lane = tid & 63, fr = lane & 15, fq = lane >> 4;
    unsigned char* ws = P.ws;
    const float* mod = (const float*)(ws + WS_MOD);
    bf16* H = (bf16*)(ws + WS_H);
    float* gates = (float*)(ws + WS_GATES);
    int* list = (int*)(ws + WS_LIST);
    constexpr int RP = 2064;
    LAS unsigned char* rwT = lds;
    LAS float* lg = (LAS float*)(lds + 66048);
    LAS unsigned long long* emask = (LAS unsigned long long*)(lds + 66048 + 33792);
    LAS unsigned short* sel = (LAS unsigned short*)(emask + 128);
    __syncthreads();
    for (int idx = tid; idx < 1024 * 32; idx += NT) { const int k = idx >> 5, e = idx & 31; const float v = P.rw[(size_t)l * 32768 + idx];
        *(LAS unsigned short*)(rwT + e * RP + k * 2) = (unsigned short)(cvt_pk_bf16(v, 0.f) & 0xffffu); }
    for (int tile = bid; tile < NTOK / 256; tile += nblk) {
        const int tok0 = tile * 256, b = tok0 >> 13;
        {
            f32x4 ca[4], cc[4];
#pragma unroll
            for (int j = 0; j < 4; ++j) { const int col = 256 * j + 4 * lane; const f32x4 g = *(const f32x4*)(P.n2g + l * D + col); const f32x4 sc = *(const f32x4*)(mod + (size_t)(l * NB + b) * NMOD + 4 * D + col);
                ca[j] = g * (1.0f + sc); cc[j] = *(const f32x4*)(mod + (size_t)(l * NB + b) * NMOD + 3 * D + col); }
            for (int rr = 0; rr < 32; ++rr) {
                const int row = tok0 + wid * 32 + rr;
                f32x4 v[4]; float ss = 0.f;
#pragma unroll
                for (int j = 0; j < 4; ++j) { const u32x2 xw = *(const u32x2*)((const bf16*)(ws + WS_XB) + (size_t)row * D + 256 * j + 4 * lane); v[j] = (f32x4){bf_lo(xw.x), bf_hi(xw.x), bf_lo(xw.y), bf_hi(xw.y)};
                    ss += (v[j].x * v[j].x + v[j].y * v[j].y) + (v[j].z * v[j].z + v[j].w * v[j].w); }
                const float rstd = 1.0f / sqrtf(wave_sum(ss) * (1.0f / D) + EPS);
#pragma unroll
                for (int j = 0; j < 4; ++j) { const f32x4 h = v[j] * rstd * ca[j] + cc[j]; u32x2 o; o.x = cvt_pk_bf16(h.x, h.y); o.y = cvt_pk_bf16(h.z, h.w); *(u32x2*)(H + (size_t)row * D + 256 * j + 4 * lane) = o;
                    *(unsigned*)(ws + WS_H8 + (size_t)row * D + 256 * j + 4 * lane) = cvt_pk4_fp8(h.x, h.y, h.z, h.w); }
            }
        }
        asm volatile("s_waitcnt vmcnt(0)" ::: "memory");
        __syncthreads();
#pragma unroll 1
        for (int rg = 0; rg < 2; ++rg) {
            f32x4 a0 = (f32x4){0.f, 0.f, 0.f, 0.f}, a1 = a0;
            const bf16* hp = H + (size_t)(tok0 + 32 * wid + 16 * rg + fr) * D + 8 * fq;
            for (int s = 0; s < 32; ++s) {
                const bf16x8 af = *(const bf16x8*)(hp + 32 * s);
                const bf16x8 b0 = *(const LAS bf16x8*)(rwT + fr * RP + (32 * s + 8 * fq) * 2), b1 = *(const LAS bf16x8*)(rwT + (16 + fr) * RP + (32 * s + 8 * fq) * 2);
                a0 = __builtin_amdgcn_mfma_f32_16x16x32_bf16(af, b0, a0, 0, 0, 0); a1 = __builtin_amdgcn_mfma_f32_16x16x32_bf16(af, b1, a1, 0, 0, 0);
            }
            const float rb0 = P.rb[l * 32 + fr], rb1 = P.rb[l * 32 + 16 + fr];
#pragma unroll
            for (int r = 0; r < 4; ++r) { const int row = 32 * wid + 16 * rg + 4 * fq + r; lg[row * 33 + fr] = a0[r] + rb0; lg[row * 33 + 16 + fr] = a1[r] + rb1; }
        }
        __syncthreads();
        if (tid < 256) {
            float v[32];
#pragma unroll
            for (int e = 0; e < 32; ++e) v[e] = lg[tid * 33 + e];
            float tv[4]; int ti[4];
#pragma unroll
            for (int k = 0; k < 4; ++k) {
                float best = -__builtin_inff(); int bi = 0;
#pragma unroll
                for (int e = 0; e < 32; ++e) { const bool gt = v[e] > best; best = gt ? v[e] : best; bi = gt ? e : bi; }
                tv[k] = best; ti[k] = bi;
#pragma unroll
                for (int e = 0; e < 32; ++e) v[e] = (e == bi) ? -__builtin_inff() : v[e];
            }
            const float e1 = __expf(tv[1] - tv[0]), e2 = __expf(tv[2] - tv[0]), e3 = __expf(tv[3] - tv[0]);
            const float inv = 1.0f / (1.0f + e1 + e2 + e3);
            *(f32x4*)(gates + (size_t)(tok0 + tid) * 4) = (f32x4){inv, e1 * inv, e2 * inv, e3 * inv};
#pragma unroll
            for (int k = 0; k < 4; ++k) sel[tid * 4 + k] = (unsigned short)ti[k];
#pragma unroll
            for (int e = 0; e < 32; ++e) { const unsigned long long m = __ballot((ti[0] == e) | (ti[1] == e) | (ti[2] == e) | (ti[3] == e)); if (lane == 0) emask[e * 4 + wid] = m; }
        }
        __syncthreads();
        if (tid < 256) {
            int* selg = (int*)(ws + WS_SEL);
            const unsigned long long lt = (1ull << lane) - 1ull;
            int so[4];
#pragma unroll
            for (int k = 0; k < 4; ++k) {
                const int e = sel[tid * 4 + k]; int r = 0;
                for (int w = 0; w < 4; ++w) { const unsigned long long m = emask[e * 4 + w]; r += (w < wid) ? __popcll(m) : ((w == wid) ? __popcll(m & lt) : 0); }
                so[k] = (e << 16) | r;
            }
            *(int4*)(selg + (size_t)(tok0 + tid) * 4) = make_int4(so[0], so[1], so[2], so[3]);
        }
        if (tid < 32) { int c = 0; for (int w = 0; w < 4; ++w) c += __popcll(emask[tid * 4 + w]); ((int*)(ws + WS_CNTB))[(size_t)(l * 256 + tile) * 32 + tid] = c; }
        __syncthreads();
    }
}

__device__ __forceinline__ void place_phase(const Params& P, LAS unsigned char* lds, int l, int bid, int nblk) {
    const int tid = opaque_tid();
    unsigned char* ws = P.ws;
    const int* cntb = (const int*)(ws + WS_CNTB) + (size_t)l * 256 * 32;
    const int* selg = (const int*)(ws + WS_SEL);
    int* list = (int*)(ws + WS_LIST);
    LAS int* red = (LAS int*)lds;
    LAS int* base = red + 512;
    const int e = tid & 31, part = tid >> 5;
    __syncthreads();
    for (int tile = bid; tile < NTOK / 256 + 1; tile += nblk) {
        int s = 0;
        for (int q = 0; q < 16; ++q) { const int t = part * 16 + q; if (t < tile) s += cntb[t * 32 + e]; }
        red[part * 32 + e] = s;
        __syncthreads();
        if (tid < 32) { int b = 0; for (int p = 0; p < 16; ++p) b += red[p * 32 + tid]; base[tid] = b; if (tile == NTOK / 256) ((int*)(ws + WS_TOT))[l * 32 + tid] = b; }
        __syncthreads();
        if (tile < NTOK / 256 && tid < 256) {
            const int tok = tile * 256 + tid; const int4 v = *(const int4*)(selg + (size_t)tok * 4);
            const int vv[4] = {v.x, v.y, v.z, v.w};
#pragma unroll
            for (int k = 0; k < 4; ++k) { const int ee = vv[k] >> 16, r = vv[k] & 0xffff; { const int rk = base[ee] + r; list[(size_t)ee * NTOK + (rk & ~255) + lperm(rk & 255)] = tok * 4 + k; } }
        }
        __syncthreads();
    }
}

constexpr int BK = 64, HALF = 128, HTB = HALF * BK * 2;
__device__ __forceinline__ int lds_byte(int r, int c) { const int st = (r >> 4) * 2 + (c >> 5), rr = r & 15, cc = c & 31, ob = rr * 64 + cc * 2; return st * 1024 + (ob ^ (((ob >> 9) & 1) << 5)); }
__device__ __forceinline__ void stage_rc(int b, int& R, int& C) { const int st = b / 1024, sb = b % 1024, swz = sb ^ (((sb >> 9) & 1) << 5); R = (st >> 1) * 16 + swz / 64; C = (st & 1) * 32 + (swz % 64) / 2; }

template <bool F8> struct FragT;
template <> struct FragT<false> {
    struct A { bf16x8 k[2]; };
    static __device__ __forceinline__ void load(A& d, const LAS unsigned char* p) { d.k[0] = *(const LAS bf16x8*)p; d.k[1] = *(const LAS bf16x8*)(p + 1024); }
    static __device__ __forceinline__ f32x4 mma(const A& a, const A& b, f32x4 c) { c = __builtin_amdgcn_mfma_f32_16x16x32_bf16(a.k[0], b.k[0], c, 0, 0, 0); return __builtin_amdgcn_mfma_f32_16x16x32_bf16(a.k[1], b.k[1], c, 0, 0, 0); }
};
template <> struct FragT<true> {
    typedef i32x8 A;
    static __device__ __forceinline__ void load(A& d, const LAS unsigned char* p) { const i32x4 lo = *(const LAS i32x4*)p, hi = *(const LAS i32x4*)(p + 1024); d = __builtin_shufflevector(lo, hi, 0, 1, 2, 3, 4, 5, 6, 7); }
    static __device__ __forceinline__ f32x4 mma(const A& a, const A& b, f32x4 c) { const int one = 0x7f7f7f7f;
        asm volatile("v_mfma_scale_f32_16x16x128_f8f6f4 %0, %1, %2, %0, %3, %3 op_sel_hi:[0,0,0]" : "+v"(c) : "v"(a), "v"(b), "v"(one)); return c; }
};
template <class Pb>
__device__ __forceinline__ void gemm_phase8(LAS unsigned char* lds, const Pb& pb, int bid, int nblk) {
    const int tid = opaque_tid(), wid = __builtin_amdgcn_readfirstlane(tid >> 6), lane = tid & 63, wr = wid >> 2, wc = wid & 3, fr = lane & 15, fq = lane >> 4;
    constexpr bool F8 = Pb::F8;
    const int RB = F8 ? pb.K : pb.K * 2;
    const int nt = RB / 128;
    int Rp[2], Cp[2];
#pragma unroll
    for (int i = 0; i < 2; ++i) stage_rc(tid * 16 + i * 8192, Rp[i], Cp[i]);
    unsigned voB[2][2];
#pragma unroll
    for (int h = 0; h < 2; ++h)
#pragma unroll
        for (int i = 0; i < 2; ++i) voB[h][i] = (unsigned)pb.b_rowc(128 * h + Rp[i]) * (unsigned)RB + (unsigned)Cp[i] * 2u;
    const unsigned ldsw = (unsigned)wid * 1024u;
    const int aoff = lds_byte(wr * 64 + fr, fq * 8), boff = lds_byte(wc * 32 + fr, fq * 8);
#define PG8_SA(b, h) (((b) * 2 + (h)) * HTB)
#define PG8_SB(b, h) ((4 + (b) * 2 + (h)) * HTB)
#define PG8_STAGE(bufoff, rsrc, soff, voff) do { _Pragma("unroll") for (int _i = 0; _i < 2; ++_i) \
        __builtin_amdgcn_raw_ptr_buffer_load_lds(rsrc, (LAS unsigned*)(lds + (bufoff) + ldsw + _i * 8192), 16, (int)(voff)[_i], (int)(soff), 0, 0); } while (0)
#define PG8_LDA(dst, b, h) do { _Pragma("unroll") for (int m = 0; m < 4; ++m) FragT<F8>::load(dst[m], lds + PG8_SA(b, h) + aoff + m * 2048); } while (0)
#define PG8_LDB(dst, b, h) do { _Pragma("unroll") for (int n = 0; n < 2; ++n) FragT<F8>::load(dst[n], lds + PG8_SB(b, h) + boff + n * 2048); } while (0)
#define PG8_MMA(ai, bj, At, Bt) do { __builtin_amdgcn_s_setprio(1); _Pragma("unroll") for (int m = 0; m < 4; ++m) _Pragma("unroll") for (int n = 0; n < 2; ++n) \
        acc[ai][bj][m][n] = FragT<F8>::mma(Bt[n], At[m], acc[ai][bj][m][n]); __builtin_amdgcn_s_setprio(0); } while (0)
#define PG8_WAIT_V(n) asm volatile("s_waitcnt vmcnt(" #n ")" ::: "memory")
#define PG8_WAIT_L(n) asm volatile("s_waitcnt lgkmcnt(" #n ")" ::: "memory")
#define PG8_BAR __builtin_amdgcn_s_barrier()
#define PG8_SCHED __builtin_amdgcn_sched_barrier(0)
#define PG8_VOA(dst, un) do { int _r[4]; pb.a_rows4(un, Rp[0], _r); _Pragma("unroll") for (int h = 0; h < 2; ++h) _Pragma("unroll") for (int i = 0; i < 2; ++i) dst[h][i] = (unsigned)_r[2 * h + i] * (unsigned)RB + (unsigned)Cp[i] * 2u; } while (0)
    Unit cur, nxt; int ui = 0;
    if (!pb.next(0, bid, nblk, cur)) return;
    Acc acc;
#pragma unroll
    for (int a = 0; a < 2; ++a)
#pragma unroll
        for (int b = 0; b < 2; ++b)
#pragma unroll
            for (int m = 0; m < 4; ++m)
#pragma unroll
                for (int n = 0; n < 2; ++n) acc[a][b][m][n] = (f32x4){0.f, 0.f, 0.f, 0.f};
    typename FragT<F8>::A At[4]; typename FragT<F8>::A B0[2], B1[2];
    unsigned voAc[2][2], voAn[2][2];
    PG8_VOA(voAc, cur);
    const __amdgpu_buffer_rsrc_t rA = __builtin_amdgcn_make_buffer_rsrc((void*)pb.A, 0, 0x7fffffff, 0x00020000), rB = __builtin_amdgcn_make_buffer_rsrc((void*)pb.B, 0, 0x7fffffff, 0x00020000);
    unsigned cB = (unsigned)pb.b_base_row(cur) * (unsigned)RB;
    { const unsigned k0 = (unsigned)(cur.ks & (nt - 1)) * 128u, k1 = (unsigned)((cur.ks + 1) & (nt - 1)) * 128u;
    PG8_STAGE(PG8_SB(0, 0), rB, cB + k0, voB[0]); PG8_STAGE(PG8_SB(0, 1), rB, cB + k0, voB[1]); PG8_STAGE(PG8_SA(0, 0), rA, k0, voAc[0]); PG8_STAGE(PG8_SA(0, 1), rA, k0, voAc[1]);
    if (wr == 1) PG8_BAR;
    PG8_WAIT_V(2); PG8_BAR;
    PG8_STAGE(PG8_SB(1, 0), rB, cB + k1, voB[0]); PG8_STAGE(PG8_SA(1, 0), rA, k1, voAc[0]); PG8_STAGE(PG8_SB(1, 1), rB, cB + k1, voB[1]); }
    PG8_WAIT_V(6); PG8_BAR;
    for (;;) {
        const bool has_next = pb.next(ui + 1, bid, nblk, nxt);
        unsigned nB = cB; int nks = cur.ks;
        if (has_next) { PG8_VOA(voAn, nxt); nB = (unsigned)pb.b_base_row(nxt) * (unsigned)RB; nks = nxt.ks; }
        else {
#pragma unroll
            for (int h = 0; h < 2; ++h)
#pragma unroll
                for (int i = 0; i < 2; ++i) voAn[h][i] = voAc[h][i]; }
        for (int t = 0; t < nt; t += 2) {
            const bool last = (t == nt - 2);
            const unsigned a1 = (unsigned)((t + 1 + cur.ks) & (nt - 1)) * 128u;
            const int ks2 = last ? nks : (t + 2 + cur.ks);
            const unsigned a2 = (unsigned)(ks2 & (nt - 1)) * 128u, a3 = (unsigned)((ks2 + 1) & (nt - 1)) * 128u;
            const unsigned bb = last ? nB : cB;
            const unsigned b2 = bb + a2, b3 = bb + a3;
            unsigned sa[2][2];
#pragma unroll
            for (int h = 0; h < 2; ++h)
#pragma unroll
                for (int i = 0; i < 2; ++i) sa[h][i] = last ? voAn[h][i] : voAc[h][i];
            PG8_LDB(B0, 0, 0); PG8_LDB(B1, 0, 1); PG8_SCHED; PG8_LDA(At, 0, 0); PG8_STAGE(PG8_SA(1, 1), rA, a1, voAc[1]);
            PG8_WAIT_V(8); PG8_WAIT_L(0); PG8_BAR; PG8_MMA(0, 0, At, B0); PG8_MMA(0, 1, At, B1); PG8_BAR; PG8_SCHED;
            PG8_LDA(At, 0, 1); PG8_STAGE(PG8_SB(0, 0), rB, b2, voB[0]); PG8_STAGE(PG8_SB(0, 1), rB, b2, voB[1]); PG8_STAGE(PG8_SA(0, 0), rA, a2, sa[0]);
            PG8_WAIT_V(8); PG8_WAIT_L(0); PG8_BAR; PG8_MMA(1, 0, At, B0); PG8_MMA(1, 1, At, B1); PG8_BAR; PG8_SCHED;
            PG8_LDB(B0, 1, 0); PG8_LDB(B1, 1, 1); PG8_SCHED; PG8_LDA(At, 1, 0); PG8_STAGE(PG8_SA(0, 1), rA, a2, sa[1]);
            PG8_WAIT_V(8); PG8_WAIT_L(0); PG8_BAR; PG8_MMA(0, 0, At, B0); PG8_MMA(0, 1, At, B1); PG8_BAR; PG8_SCHED;
            PG8_LDA(At, 1, 1); PG8_STAGE(PG8_SB(1, 0), rB, b3, voB[0]); PG8_STAGE(PG8_SB(1, 1), rB, b3, voB[1]); PG8_STAGE(PG8_SA(1, 0), rA, a3, sa[0]);
            PG8_WAIT_V(8); PG8_WAIT_L(0); PG8_BAR; PG8_MMA(1, 0, At, B0); PG8_MMA(1, 1, At, B1); PG8_BAR; PG8_SCHED;
        }
        if (wr == 0) PG8_BAR;
        if constexpr (F8) asm volatile("s_nop 15\n\ts_nop 15" ::: "memory");
        pb.epi(acc, cur, wr, wc, fr, fq);
        if (!has_next) break;
#pragma unroll
        for (int a = 0; a < 2; ++a)
#pragma unroll
            for (int b = 0; b < 2; ++b)
#pragma unroll
                for (int m = 0; m < 4; ++m)
#pragma unroll
                    for (int n = 0; n < 2; ++n) acc[a][b][m][n] = (f32x4){0.f, 0.f, 0.f, 0.f};
        cur = nxt; cB = nB; ++ui;
#pragma unroll
        for (int h = 0; h < 2; ++h)
#pragma unroll
            for (int i = 0; i < 2; ++i) voAc[h][i] = voAn[h][i];
        if (wr == 1) PG8_BAR;
    }
    PG8_WAIT_V(0);
    PG8_BAR;
#undef PG8_SA
#undef PG8_SB
#undef PG8_STAGE
#undef PG8_LDA
#undef PG8_LDB
#undef PG8_MMA
#undef PG8_WAIT_V
#undef PG8_WAIT_L
#undef PG8_BAR
#undef PG8_SCHED
#undef PG8_VOA
}

#ifndef FAST_INPROJ
#define FAST_INPROJ 1
#endif
#ifndef FAST_OUTPROJ
#define FAST_OUTPROJ 1
#endif
#ifndef FAST_GU
#define FAST_GU 1
#endif
#ifndef FAST_DOWN
#define FAST_DOWN 1
#endif
template <bool FAST, class Pb> __device__ __forceinline__ void gemm_run(LAS unsigned char* lds, const Pb& pb, int bid, int nblk) {
    if constexpr (FAST) gemm_phase8(lds, pb, bid, nblk); else gemm_simple(lds, pb, bid, nblk);
}

__device__ __forceinline__ void inproj_phase(const Params& P, LAS unsigned char* lds, int l, int bid, int nblk) {
    unsigned char* ws = P.ws;
    PbInProj pb; pb.A = (const char*)(ws + WS_H); pb.B = (const char*)(ws + WS_WIN) + (size_t)l * (1280 * 1024 * 2); pb.K = 1024;
    pb.proj = (bf16*)(ws + WS_PROJ); pb.qg = P.qg + l * 64; pb.kg = P.kg + l * 64; pb.rope = (const float*)(ws + WS_ROPE);
    gemm_run<FAST_INPROJ>(lds, pb, bid, nblk);
}
__device__ __forceinline__ void outproj_phase(const Params& P, LAS unsigned char* lds, int l, int bid, int nblk) {
    unsigned char* ws = P.ws;
    if (l == 0) { PbOutProjT<true> pb; pb.A = (const char*)(ws + WS_MIX); pb.B = (const char*)(ws + WS_WOUT); pb.K = 1024;
        pb.xin32 = P.x; pb.xb = (bf16*)(ws + WS_XB); pb.gate1 = (const float*)(ws + WS_MOD) + 2 * D; gemm_phase8(lds, pb, bid, nblk); }
    else { PbOutProjT<false> pb; pb.A = (const char*)(ws + WS_MIX); pb.B = (const char*)(ws + WS_WOUT) + (size_t)l * (1024 * 1024 * 2); pb.K = 1024;
        pb.xin32 = nullptr; pb.xb = (bf16*)(ws + WS_XB); pb.gate1 = (const float*)(ws + WS_MOD) + (size_t)l * NB * NMOD + 2 * D; gemm_phase8(lds, pb, bid, nblk); }
}
__device__ __forceinline__ void gu_phase(const Params& P, LAS unsigned char* lds, int l, int bid, int nblk) {
    unsigned char* ws = P.ws;
    LAS int* tab = (LAS int*)(lds + 131072);
    __syncthreads();
    moe_build_tab(tab, (const int*)(ws + WS_TOT) + l * 32);
    PbGU pb; pb.A = (const char*)(ws + WS_H8); pb.B = (const char*)(ws + WS_WGU) + (size_t)l * 32 * (2048 * 1024); pb.K = 1024;
    pb.tab = tab; pb.list = (const int*)(ws + WS_LIST); pb.bgu = P.bgu + (size_t)l * 32 * 2048; pb.act = ws + WS_ACT;
    gemm_phase8(lds, pb, bid, nblk);
}
__device__ __forceinline__ void down_phase(const Params& P, LAS unsigned char* lds, int l, int bid, int nblk) {
    unsigned char* ws = P.ws;
    LAS int* tab = (LAS int*)(lds + 131072);
    __syncthreads();
    moe_build_tab(tab, (const int*)(ws + WS_TOT) + l * 32);
    PbDown pb; pb.A = (const char*)(ws + WS_ACT); pb.B = (const char*)(ws + WS_WDN) + (size_t)l * 32 * (1024 * 1024); pb.K = 1024;
    pb.tab = tab; pb.list = (const int*)(ws + WS_LIST); pb.bdn = P.bdn + (size_t)l * 32 * 1024; pb.ybuf = ws + WS_YBUF;
    gemm_phase8(lds, pb, bid, nblk);
}

#define XB_TMO      128
#define XB_XCNT(j)  (256  + 64 * (j))
#define XB_XSUB(j)  (1280 + 64 * (j))
#define XB_XGEN(j)  (2304 + 64 * (j))
#define XB_TOP      3328
#define XB_TOPGEN   3392
#define XCD_BAR_WORDS 3456
#define XB_SPIN_CAP (1u << 18)
__device__ __forceinline__ unsigned xb_ld(unsigned* p)              { return __hip_atomic_load(p, __ATOMIC_RELAXED, __HIP_MEMORY_SCOPE_AGENT); }
__device__ __forceinline__ unsigned xb_add(unsigned* p, unsigned v) { return __hip_atomic_fetch_add(p, v, __ATOMIC_RELAXED, __HIP_MEMORY_SCOPE_AGENT); }
__device__ __forceinline__ unsigned xb_xcc_id() { return (unsigned)__builtin_amdgcn_s_getreg((3 << 11) | 20) & 0xFu; }
#define XB_SPIN(cond, bar) do { unsigned _sp = 0; while (cond) { __builtin_amdgcn_s_sleep(1); \
    if ((++_sp & 255u) == 0u) { if (xb_ld(&(bar)[XB_TMO])) break; if (_sp > XB_SPIN_CAP) { atomicAdd(&(bar)[XB_TMO], 1u); break; } } } } while (0)
struct XcdBarrier { unsigned* bar; unsigned x; volatile LAS unsigned* st; };
__device__ __forceinline__ XcdBarrier xcd_barrier_post(unsigned* bar, volatile LAS unsigned* st) {
    XcdBarrier b; b.bar = bar; b.x = xb_xcc_id(); b.st = st;
    if (threadIdx.x == 0) (void)xb_add(&bar[XB_XCNT(b.x)], 1u);
    return b;
}
__device__ __forceinline__ void xcd_barrier_complete(unsigned* bar, unsigned x, unsigned& nloc, unsigned& nx) {
    const unsigned G = gridDim.x * gridDim.y * gridDim.z;
    unsigned sum, cnt, mine, sp = 0u;
    for (;;) {
        sum = 0u; cnt = 0u; mine = 0u;
#pragma unroll
        for (unsigned j = 0; j < 16; ++j) { const unsigned c = xb_ld(&bar[XB_XCNT(j)]); sum += c; cnt += (c > 0u) ? 1u : 0u; mine = (j == x) ? c : mine; }
        if (sum == G) break;
        __builtin_amdgcn_s_sleep(1);
        if ((++sp & 255u) == 0u) { if (xb_ld(&bar[XB_TMO])) break; if (sp > XB_SPIN_CAP) { atomicAdd(&bar[XB_TMO], 1u); break; } }
    }
    nloc = mine > 0u ? mine : 1u; nx = cnt > 0u ? cnt : 1u;
}
__device__ __forceinline__ void xcd_barrier(const XcdBarrier& b) {
    asm volatile("s_waitcnt vmcnt(0)" ::: "memory");
    __syncthreads();
    if (threadIdx.x == 0) {
        unsigned* bar = b.bar; const unsigned bx = xb_xcc_id();
        __builtin_amdgcn_s_waitcnt(0);
        unsigned nloc = b.st[0], nx = b.st[1];
        if (nloc == 0u) { xcd_barrier_complete(bar, bx, nloc, nx); b.st[0] = nloc; b.st[1] = nx; }
        const unsigned old = xb_add(&bar[XB_XSUB(bx)], 1u);
        const unsigned gen = old / nloc;
        if (old + 1u == (gen + 1u) * nloc) {
            __builtin_amdgcn_fence(__ATOMIC_RELEASE, "agent");
            asm volatile("s_waitcnt vmcnt(0)" ::: "memory");
            const unsigned og = xb_add(&bar[XB_TOP], 1u);
            const unsigned tg = og / nx;
            if (og + 1u == (tg + 1u) * nx) xb_add(&bar[XB_TOPGEN], 1u);
            else XB_SPIN(xb_ld(&bar[XB_TOPGEN]) == tg, bar);
            __builtin_amdgcn_fence(__ATOMIC_ACQUIRE, "agent");
            xb_add(&bar[XB_XGEN(bx)], 1u);
            asm volatile("s_waitcnt vmcnt(0)" ::: "memory");
        } else {
            XB_SPIN(xb_ld(&bar[XB_XGEN(bx)]) == gen, bar);
            __builtin_amdgcn_fence(__ATOMIC_ACQUIRE, "agent");
            asm volatile("s_waitcnt vmcnt(0)" ::: "memory");
        }
    }
    __syncthreads();
}


#if ONE_LAUNCH
constexpr int TAB_OFF = 131072, MISC_OFF = 131072 + 512;
__global__ void __launch_bounds__(NT, 2) mega_fwd(Params P) {
    extern __shared__ __attribute__((aligned(16))) unsigned char dyn_lds[];
    LAS unsigned char* lds = (LAS unsigned char*)dyn_lds;
    volatile LAS unsigned* MISC = (volatile LAS unsigned*)(lds + MISC_OFF);
    if (threadIdx.x < 32) MISC[threadIdx.x] = 0u;
    __syncthreads();
    XcdBarrier bar = xcd_barrier_post((unsigned*)(P.ws + WS_CTL) + CW_BAR, MISC + 8);
    const int bid = blockIdx.x, nblk = gridDim.x;
    const int vb = (nblk % 8 == 0) ? (bid % 8) * (nblk / 8) + bid / 8 : bid;
#ifndef REP_P0
#define REP_P0 1
#endif
#ifndef REP_INPROJ
#define REP_INPROJ 1
#endif
#ifndef REP_ATTN
#define REP_ATTN 1
#endif
#ifndef REP_GU
#define REP_GU 1
#endif
#ifndef REP_DOWN
#define REP_DOWN 1
#endif
    for (int r = 0; r < REP_P0; ++r) { p0_prologue(P, lds, bid, nblk); xcd_barrier(bar); }
    for (int l = 0; l < DEPTH; ++l) {
        if (l == 0) norm1_phase<0>(P, l, bid, nblk); else norm1_phase<1>(P, l, bid, nblk);
        xcd_barrier(bar);
        for (int r = 0; r < REP_INPROJ; ++r) { inproj_phase(P, lds, l, vb, nblk); xcd_barrier(bar); }
        for (int r = 0; r < REP_ATTN; ++r) { attn_phase(P, lds, l, bid, nblk); xcd_barrier(bar); }
        outproj_phase(P, lds, l, vb, nblk);
        xcd_barrier(bar);
        router_phase(P, lds, l, bid, nblk);
        xcd_barrier(bar);
        place_phase(P, lds, l, bid, nblk);
        xcd_barrier(bar);
        for (int r = 0; r < REP_GU; ++r) { gu_phase(P, lds, l, vb, nblk); xcd_barrier(bar); }
        for (int r = 0; r < REP_DOWN; ++r) { down_phase(P, lds, l, vb, nblk); xcd_barrier(bar); }
    }
    norm1_phase<2>(P, 0, bid, nblk);
}
#else
extern __shared__ __attribute__((aligned(16))) unsigned char dyn_lds[];
#define KLDS ((LAS unsigned char*)dyn_lds)
__global__ void __launch_bounds__(NT, 2) k_prologue(Params P) { p0_prologue(P, KLDS, blockIdx.x, gridDim.x); }
__global__ void __launch_bounds__(NT, 2) k_norm1_0(Params P, int l) { norm1_phase<0>(P, l, blockIdx.x, gridDim.x); }
__global__ void __launch_bounds__(NT, 2) k_norm1_1(Params P, int l) { norm1_phase<1>(P, l, blockIdx.x, gridDim.x); }
__global__ void __launch_bounds__(NT, 2) k_final(Params P) { norm1_phase<2>(P, 0, blockIdx.x, gridDim.x); }
__global__ void __launch_bounds__(NT, 2) k_inproj(Params P, int l) { inproj_phase(P, KLDS, l, blockIdx.x, gridDim.x); }
__global__ void __launch_bounds__(NT, 2) k_attn(Params P, int l) { attn_phase(P, KLDS, l, blockIdx.x, gridDim.x); }
__global__ void __launch_bounds__(NT, 2) k_outproj(Params P, int l) { outproj_phase(P, KLDS, l, blockIdx.x, gridDim.x); }
__global__ void __launch_bounds__(NT, 2) k_router(Params P, int l) { router_phase(P, KLDS, l, blockIdx.x, gridDim.x); }
__global__ void __launch_bounds__(NT, 2) k_place(Params P, int l) { place_phase(P, KLDS, l, blockIdx.x, gridDim.x); }
__global__ void __launch_bounds__(NT, 2) k_gu(Params P, int l) { gu_phase(P, KLDS, l, blockIdx.x, gridDim.x); }
__global__ void __launch_bounds__(NT, 2) k_down(Params P, int l) { down_phase(P, KLDS, l, blockIdx.x, gridDim.x); }

#endif

extern "C" void kernel_launch(void* const* d_in, const int* in_sizes, int n_in, void* d_out, int out_size, void* d_ws, size_t ws_size, hipStream_t stream) {
    static int ready = 0;
    if (ready == 0) {
        if (n_in != 21 || out_size != NTOK * D || ws_size < WS_END) { fprintf(stderr, "kernel_launch: unexpected shapes (n_in %d out %d ws %zu)\n", n_in, out_size, ws_size); ready = -1; return; }
#if ONE_LAUNCH
        const void* ks[] = {(const void*)mega_fwd};
#else
        const void* ks[] = {(const void*)k_prologue, (const void*)k_norm1_0, (const void*)k_norm1_1, (const void*)k_final, (const void*)k_inproj, (const void*)k_attn, (const void*)k_outproj, (const void*)k_router, (const void*)k_gu, (const void*)k_down, (const void*)k_place};
#endif
        for (auto k : ks) if (hipFuncSetAttribute(k, hipFuncAttributeMaxDynamicSharedMemorySize, LDS_BYTES) != hipSuccess) { fprintf(stderr, "kernel_launch: hipFuncSetAttribute failed\n"); ready = -1; return; }
        ready = 1;
    }
    if (ready < 0) return;
    (void)hipMemsetAsync((char*)d_ws + WS_CTL, 0, CTL_ZERO_BYTES, stream);
    Params P{};
    P.x = (const float*)d_in[0]; P.c = (const float*)d_in[1]; P.pos = (const int*)d_in[2]; P.ada_w = (const float*)d_in[3]; P.ada_b = (const float*)d_in[4]; P.n1g = (const float*)d_in[5];
    P.w_in = (const float*)d_in[6]; P.qg = (const float*)d_in[7]; P.kg = (const float*)d_in[8]; P.sinks = (const float*)d_in[9]; P.pool_w = (const float*)d_in[10]; P.pool_b = (const float*)d_in[11];
    P.pool_s = (const float*)d_in[12]; P.w_out = (const float*)d_in[13]; P.n2g = (const float*)d_in[14]; P.rw = (const float*)d_in[15]; P.rb = (const float*)d_in[16]; P.wgu = (const float*)d_in[17];
    P.bgu = (const float*)d_in[18]; P.wdn = (const float*)d_in[19]; P.bdn = (const float*)d_in[20]; P.out = (float*)d_out; P.ws = (unsigned char*)d_ws;
    const dim3 g(256), b(NT);
#if ONE_LAUNCH
    hipLaunchKernelGGL(mega_fwd, g, b, LDS_BYTES, stream, P);
#else
    hipLaunchKernelGGL(k_prologue, g, b, LDS_BYTES, stream, P);
    for (int l = 0; l < DEPTH; ++l) {
        if (l == 0) hipLaunchKernelGGL(k_norm1_0, g, b, LDS_BYTES, stream, P, l); else hipLaunchKernelGGL(k_norm1_1, g, b, LDS_BYTES, stream, P, l);
        hipLaunchKernelGGL(k_inproj, g, b, LDS_BYTES, stream, P, l);
        hipLaunchKernelGGL(k_attn, g, b, LDS_BYTES, stream, P, l);
        hipLaunchKernelGGL(k_outproj, g, b, LDS_BYTES, stream, P, l);
        hipLaunchKernelGGL(k_router, g, b, LDS_BYTES, stream, P, l);
        hipLaunchKernelGGL(k_place, g, b, LDS_BYTES, stream, P, l);
        hipLaunchKernelGGL(k_gu, g, b, LDS_BYTES, stream, P, l);
        hipLaunchKernelGGL(k_down, g, b, LDS_BYTES, stream, P, l);
    }
    hipLaunchKernelGGL(k_final, g, b, LDS_BYTES, stream, P);
#endif
}
```

```cpp
#include <hip/hip_runtime.h>
#include <cstdio>
#include <cstdint>

#ifndef ONE_LAUNCH
#define ONE_LAUNCH 1
#endif

#define LAS __attribute__((address_space(3)))
typedef unsigned short bf16;
typedef short bf16x8 __attribute__((ext_vector_type(8)));
typedef short s16x4 __attribute__((ext_vector_type(4)));
typedef float f32x4 __attribute__((ext_vector_type(4)));
typedef float f32x16 __attribute__((ext_vector_type(16)));
typedef unsigned u32x4 __attribute__((ext_vector_type(4)));
typedef unsigned u32x2 __attribute__((ext_vector_type(2)));
typedef float f32x2 __attribute__((ext_vector_type(2)));
typedef int i32x4 __attribute__((ext_vector_type(4)));
typedef int i32x8 __attribute__((ext_vector_type(8)));

constexpr int D = 1024, NB = 8, SEQ = 8192, NTOK = NB * SEQ, DEPTH = 2, NE = 32, NIN = 1280, NMOD = 6 * D;
constexpr int NT = 512;
constexpr float EPS = 1e-6f;
constexpr float LOG2E = 1.4426950408889634f;
constexpr float QSCALE = 0.18033688011112042f;
constexpr int MAXTILES = NTOK * 4 / 256 + NE;

constexpr size_t MiB = 1u << 20;
constexpr size_t WS_CTL = 0, CTL_ZERO_BYTES = 1 * MiB;
constexpr size_t WS_MOD = 1 * MiB;
constexpr size_t WS_ROPE = 2 * MiB;
constexpr size_t WS_WIN = 8 * MiB;
constexpr size_t WS_WOUT = 16 * MiB;
constexpr size_t WS_GATES = 20 * MiB;
constexpr size_t WS_SEL = 21 * MiB;
constexpr size_t WS_CNTB = 22 * MiB;
constexpr size_t WS_TOT = 23 * MiB;
constexpr size_t WS_LIST = 24 * MiB;
constexpr size_t WS_WGU = 32 * MiB;
constexpr size_t WS_WDN = 160 * MiB;
constexpr size_t WS_H = 224 * MiB;
constexpr size_t WS_H8 = 352 * MiB;
constexpr size_t WS_PROJ = 416 * MiB;
constexpr size_t WS_MIX = 576 * MiB;
constexpr size_t WS_ACT = 416 * MiB;
constexpr size_t WS_YBUF = 704 * MiB;
constexpr size_t WS_XB = 960 * MiB;
constexpr size_t WS_END = 1088 * MiB;
static_assert(WS_ACT + (size_t)MAXTILES * 256 * 1024 <= WS_YBUF, "act fits");
constexpr float WSCALE = 32.0f, WUNSCALE = 1.0f / 32.0f;
constexpr int CW_BAR = 4096;
constexpr int CW_CNT = 8192;

constexpr int LDS_BYTES = 147456;

struct Params {
    const float *x, *c; const int* pos; const float *ada_w, *ada_b, *n1g, *w_in, *qg, *kg, *sinks, *pool_w, *pool_b, *pool_s, *w_out, *n2g, *rw, *rb, *wgu, *bgu, *wdn, *bdn;
    float* out; unsigned char* ws;
};

__device__ __forceinline__ unsigned cvt_pk_bf16(float lo, float hi) { unsigned r; asm("v_cvt_pk_bf16_f32 %0, %1, %2" : "=v"(r) : "v"(lo), "v"(hi)); return r; }
__device__ __forceinline__ unsigned cvt_pk4_fp8(float a, float b, float c, float d) { int w = 0; w = __builtin_amdgcn_cvt_pk_fp8_f32(a, b, w, false); w = __builtin_amdgcn_cvt_pk_fp8_f32(c, d, w, true); return (unsigned)w; }
__device__ __forceinline__ float bf_lo(unsigned w) { return __uint_as_float(w << 16); }
__device__ __forceinline__ float bf_hi(unsigned w) { return __uint_as_float(w & 0xffff0000u); }
template <int M> __device__ __forceinline__ float swz_xor(float v) { return __int_as_float(__builtin_amdgcn_ds_swizzle(__float_as_int(v), (M << 10) | 0x1f)); }
__device__ __forceinline__ float sum_x32(float v) { const auto r = __builtin_amdgcn_permlane32_swap(__float_as_uint(v), __float_as_uint(v), false, false); return __uint_as_float(r[0]) + __uint_as_float(r[1]); }
__device__ __forceinline__ float max_x32(float v) { const auto r = __builtin_amdgcn_permlane32_swap(__float_as_uint(v), __float_as_uint(v), false, false); return fmaxf(__uint_as_float(r[0]), __uint_as_float(r[1])); }
__device__ __forceinline__ float wave_sum(float v) {
    v += swz_xor<1>(v); v += swz_xor<2>(v); v += swz_xor<4>(v); v += swz_xor<8>(v); v += swz_xor<16>(v);
    return sum_x32(v);
}
__device__ __forceinline__ int dpp_swap1(int v) { return __builtin_amdgcn_update_dpp(0, v, 0xB1, 0xF, 0xF, true); }
__device__ __forceinline__ u32x4 dpp_swap1(u32x4 v) { u32x4 r; r.x = (unsigned)dpp_swap1((int)v.x); r.y = (unsigned)dpp_swap1((int)v.y); r.z = (unsigned)dpp_swap1((int)v.z); r.w = (unsigned)dpp_swap1((int)v.w); return r; }
__device__ __forceinline__ void store_line_pair(unsigned char* own_line, unsigned char* nb_line, bool own_valid, bool nb_valid, u32x4 lo, u32x4 hi, int fq, bool odd) {
    const u32x4 got = dpp_swap1(odd ? lo : hi);
    const int off = (odd ? 64 : 0) + 16 * fq;
    if (odd ? nb_valid : own_valid) *(u32x4*)((odd ? nb_line : own_line) + off) = odd ? got : lo;
    if (odd ? own_valid : nb_valid) *(u32x4*)((odd ? own_line : nb_line) + off) = odd ? hi : got;
}
__device__ __forceinline__ void load_line_pair(const unsigned char* own_line, const unsigned char* nb_line, int fq, bool odd, u32x4& lo, u32x4& hi) {
    const int off = (odd ? 64 : 0) + 16 * fq;
    const u32x4 a = *(const u32x4*)((odd ? nb_line : own_line) + off), b = *(const u32x4*)((odd ? own_line : nb_line) + off);
    const u32x4 got = dpp_swap1(odd ? a : b);
    lo = odd ? got : a; hi = odd ? b : got;
}
__device__ __forceinline__ int lperm(int r) { return (r & 63) * 4 + (r >> 6); }
__device__ __forceinline__ int perm32(int rho) { const int n = rho >> 4, i = rho & 15; return 8 * (i >> 2) + 4 * n + (i & 3); }
__device__ __forceinline__ int opaque_tid() { int t = threadIdx.x; asm volatile("" : "+v"(t)); return t; }

__device__ __forceinline__ void tr_item_src(const Params& P, int it, const float*& src, int& ldw, bf16*& dst, int& k0, int& n0, bool& f8) {
    f8 = it < 16384 + 8192;
    unsigned char* ws = P.ws;
    if (it < 16384) { const int m = it >> 8, r = it & 255; src = P.wgu + (size_t)m * (1024 * 2048); ldw = 2048; dst = (bf16*)(ws + WS_WGU + (size_t)m * (2048 * 1024)); k0 = 128 * (r >> 5); n0 = 64 * (r & 31); return; }
    it -= 16384;
    if (it < 8192) { const int m = it >> 7, r = it & 127; src = P.wdn + (size_t)m * (1024 * 1024); ldw = 1024; dst = (bf16*)(ws + WS_WDN + (size_t)m * (1024 * 1024)); k0 = 128 * (r >> 4); n0 = 64 * (r & 15); return; }
    it -= 8192;
    if (it < 192) { const int l = it / 96, r = it % 96; src = P.w_in + (size_t)l * (1024 * 1280); ldw = 1280; dst = (bf16*)(ws + WS_WIN) + (size_t)l * (1280 * 1024); k0 = 128 * (r / 12); n0 = 64 * (r % 12); return; }
    it -= 192;
    { const int l = it >> 7, r = it & 127; src = P.w_out + (size_t)l * (1024 * 1024); ldw = 1024; dst = (bf16*)(ws + WS_WOUT) + (size_t)l * (1024 * 1024); k0 = 128 * (r >> 4); n0 = 64 * (r & 15); }
}
constexpr int N_TR_ITEMS = 16384 + 8192 + 192 + 256;

__device__ __forceinline__ void p0_prologue(const Params& P, LAS unsigned char* lds, int bid, int nblk) {
    const int tid = opaque_tid(), wid = __builtin_amdgcn_readfirstlane(tid >> 6), lane = tid & 63;
    unsigned char* ws = P.ws;
    {
        LAS float* cact = (LAS float*)lds;
        LAS float* red = (LAS float*)(lds + 32768);
        if (bid < 192 || nblk < 192) {
            for (int i = tid; i < NB * D; i += NT) { const float v = P.c[i]; cact[i] = v / (1.0f + __expf(-v)); }
            __syncthreads();
            for (int it = bid; it < 192; it += nblk) {
                const int l = it / 96, n0 = 64 * (it % 96);
                float acc[NB];
#pragma unroll
                for (int b = 0; b < NB; ++b) acc[b] = 0.f;
                const float* wp = P.ada_w + (size_t)l * D * NMOD + n0 + lane;
                for (int k = 128 * wid; k < 128 * wid + 128; k += 16) {
                    float wv[16];
#pragma unroll
                    for (int q = 0; q < 16; ++q) wv[q] = wp[(size_t)(k + q) * NMOD];
#pragma unroll
                    for (int q = 0; q < 16; ++q)
#pragma unroll
                        for (int b = 0; b < NB; ++b) acc[b] += cact[b * D + k + q] * wv[q];
                }
#pragma unroll
                for (int b = 0; b < NB; ++b) red[(wid * NB + b) * 64 + lane] = acc[b];
                __syncthreads();
                { const int b = tid >> 6; float s = P.ada_b[l * NMOD + n0 + lane];
#pragma unroll
                  for (int w = 0; w < 8; ++w) s += red[(w * NB + b) * 64 + lane];
                  ((float*)(ws + WS_MOD))[(size_t)(l * NB + b) * NMOD + n0 + lane] = s; }
                __syncthreads();
            }
        }
    }
    for (int it = bid; it < 128; it += nblk) {
        const int l = it >> 6, g = (it >> 4) & 3, k0 = 64 * (it & 15);
        LAS float* At = (LAS float*)lds;
        LAS float* Pw = (LAS float*)(lds + 33024);
        __syncthreads();
        for (int j = 0; j < 16; ++j) { const int idx = tid + NT * j, k = idx >> 7, c = idx & 127; At[k * 129 + c] = P.w_in[(size_t)l * (1024 * 1280) + (size_t)(k0 + k) * 1280 + 768 + 128 * g + c]; }
        for (int j = 0; j < 32; ++j) { const int idx = tid + NT * j; Pw[idx] = P.pool_w[(size_t)(l * 4 + g) * 16384 + idx]; }
        __syncthreads();
        const int n = tid & 127, ks = tid >> 7;
        float acc[16];
#pragma unroll
        for (int i = 0; i < 16; ++i) acc[i] = 0.f;
        for (int c = 0; c < 128; ++c) { const float pw = Pw[c * 128 + n];
#pragma unroll
            for (int i = 0; i < 16; ++i) acc[i] += At[(16 * ks + i) * 129 + c] * pw; }
        bf16* dst = (bf16*)(ws + WS_WIN) + (size_t)l * (1280 * 1024) + (size_t)(768 + 128 * g + n) * 1024 + k0 + 16 * ks;
        u32x4 o0, o1;
        o0.x = cvt_pk_bf16(acc[0], acc[1]); o0.y = cvt_pk_bf16(acc[2], acc[3]); o0.z = cvt_pk_bf16(acc[4], acc[5]); o0.w = cvt_pk_bf16(acc[6], acc[7]);
        o1.x = cvt_pk_bf16(acc[8], acc[9]); o1.y = cvt_pk_bf16(acc[10], acc[11]); o1.z = cvt_pk_bf16(acc[12], acc[13]); o1.w = cvt_pk_bf16(acc[14], acc[15]);
        *(u32x4*)dst = o0; *(u32x4*)(dst + 8) = o1;
    }
    {
        const double invf[8] = {1.0, 0.19392274474868576, 0.03760603093086393, 0.007292664737217109, 0.001414213562373095, 0.0002742481756762073, 5.318295896944988e-05, 1.031338537721246e-05};
        float* rope = (float*)(ws + WS_ROPE);
        for (int idx = bid * NT + tid; idx < NTOK * 8; idx += nblk * NT) {
            const int tok = idx >> 3, i = idx & 7;
            double f = 1.0;
#pragma unroll
            for (int q = 0; q < 8; ++q) f = (i == q) ? invf[q] : f;
            const double ang = (double)P.pos[tok] * f;
            const double kq = __builtin_rint(ang * 0.6366197723675814);
            const double r = (ang - kq * 1.5707963267948966) - kq * 6.123233995736766e-17;
            const double r2 = r * r;
            double sn = r * (1.0 + r2 * (-1.0 / 6 + r2 * (1.0 / 120 + r2 * (-1.0 / 5040 + r2 * (1.0 / 362880 + r2 * (-1.0 / 39916800 + r2 * (1.0 / 6227020800.0)))))));
            double cs = 1.0 + r2 * (-0.5 + r2 * (1.0 / 24 + r2 * (-1.0 / 720 + r2 * (1.0 / 40320 + r2 * (-1.0 / 3628800 + r2 * (1.0 / 479001600.0 + r2 * (-1.0 / 87178291200.0)))))));
            const int q = ((int)(long long)kq) & 3;
            double s2 = (q & 1) ? cs : sn, c2 = (q & 1) ? sn : cs;
            if (q == 1 || q == 2) c2 = -c2;
            if (q >= 2) s2 = -s2;
            rope[tok * 16 + i] = (float)c2; rope[tok * 16 + 8 + i] = (float)s2;
        }
    }
    {
        LAS float* tile = (LAS float*)lds;
        __syncthreads();
        f32x4 r[4];
        const float* src; int ldw, k0, n0; bf16* dst; bool f8;
        int it = bid;
        if (it < N_TR_ITEMS) { tr_item_src(P, it, src, ldw, dst, k0, n0, f8);
#pragma unroll
            for (int j = 0; j < 4; ++j) { const int idx = tid + NT * j, row = idx >> 4, c4 = idx & 15; r[j] = *(const f32x4*)(src + (size_t)(k0 + row) * ldw + n0 + 4 * c4); } }
        for (; it < N_TR_ITEMS; it += nblk) {
#pragma unroll
            for (int j = 0; j < 4; ++j) { const int idx = tid + NT * j, row = idx >> 4, c4 = idx & 15; LAS float* t = tile + row * 65 + 4 * c4; t[0] = r[j].x; t[1] = r[j].y; t[2] = r[j].z; t[3] = r[j].w; }
            __syncthreads();
            bf16* cdst = dst; const int ck0 = k0, cn0 = n0; const bool cf8 = f8;
            if (it + nblk < N_TR_ITEMS) { tr_item_src(P, it + nblk, src, ldw, dst, k0, n0, f8);
#pragma unroll
                for (int j = 0; j < 4; ++j) { const int idx = tid + NT * j, row = idx >> 4, c4 = idx & 15; r[j] = *(const f32x4*)(src + (size_t)(k0 + row) * ldw + n0 + 4 * c4); } }
            if (cf8) {
                const int n = tid >> 3, c = tid & 7; const LAS float* t = tile + (16 * c) * 65 + n;
                u32x4 o; o.x = cvt_pk4_fp8(t[0] * WSCALE, t[65] * WSCALE, t[2 * 65] * WSCALE, t[3 * 65] * WSCALE); o.y = cvt_pk4_fp8(t[4 * 65] * WSCALE, t[5 * 65] * WSCALE, t[6 * 65] * WSCALE, t[7 * 65] * WSCALE);
                o.z = cvt_pk4_fp8(t[8 * 65] * WSCALE, t[9 * 65] * WSCALE, t[10 * 65] * WSCALE, t[11 * 65] * WSCALE); o.w = cvt_pk4_fp8(t[12 * 65] * WSCALE, t[13 * 65] * WSCALE, t[14 * 65] * WSCALE, t[15 * 65] * WSCALE);
                *(u32x4*)((unsigned char*)cdst + (size_t)(cn0 + n) * 1024 + ck0 + 16 * c) = o;
            } else {
#pragma unroll
            for (int j = 0; j < 2; ++j) { const int p = tid + NT * j, n = p >> 4, c = p & 15; const LAS float* t = tile + (8 * c) * 65 + n;
                u32x4 o; o.x = cvt_pk_bf16(t[0], t[65]); o.y = cvt_pk_bf16(t[2 * 65], t[3 * 65]); o.z = cvt_pk_bf16(t[4 * 65], t[5 * 65]); o.w = cvt_pk_bf16(t[6 * 65], t[7 * 65]);
                *(u32x4*)(cdst + (size_t)(cn0 + n) * 1024 + ck0 + 8 * c) = o; }
            }
            __syncthreads();
        }
    }
}

template <int MODE>
__device__ __forceinline__ void norm1_phase(const Params& P, int l, int bid, int nblk) {
    const int tid = opaque_tid(), wid = __builtin_amdgcn_readfirstlane(tid >> 6), lane = tid & 63;
    unsigned char* ws = P.ws;
    const float* mod = (const float*)(ws + WS_MOD);
    bf16* XB = (bf16*)(ws + WS_XB);
    bf16* H = (bf16*)(ws + WS_H);
    const float* gates = (const float*)(ws + WS_GATES);
    const unsigned char* Y = ws + WS_YBUF;
    for (int ch = bid * 8 + wid; ch < NTOK / 32; ch += nblk * 8) {
        const int b = (ch * 32) >> 13;
        f32x4 ca[4], cc[4], cg[4];
#pragma unroll
        for (int j = 0; j < 4; ++j) {
            const int col = 256 * j + 4 * lane;
            if (MODE <= 1) { const f32x4 g = *(const f32x4*)(P.n1g + l * D + col); const f32x4 sc = *(const f32x4*)(mod + (size_t)(l * NB + b) * NMOD + 1 * D + col);
                ca[j] = g * (1.0f + sc); cc[j] = *(const f32x4*)(mod + (size_t)(l * NB + b) * NMOD + 0 * D + col); }
            if (MODE >= 1) { const int lp = (MODE == 2) ? (DEPTH - 1) : (l - 1); cg[j] = *(const f32x4*)(mod + (size_t)(lp * NB + b) * NMOD + 5 * D + col); }
        }
        for (int rr = 0; rr < 32; ++rr) {
            const int row = ch * 32 + rr;
            f32x4 v[4];
            if (MODE == 0) {
#pragma unroll
                for (int j = 0; j < 4; ++j) v[j] = *(const f32x4*)(P.x + (size_t)row * D + 256 * j + 4 * lane);
            } else {
#pragma unroll
                for (int j = 0; j < 4; ++j) { const u32x2 xw = *(const u32x2*)(XB + (size_t)row * D + 256 * j + 4 * lane); v[j] = (f32x4){bf_lo(xw.x), bf_hi(xw.x), bf_lo(xw.y), bf_hi(xw.y)}; }
            }
            if (MODE >= 1) {
                const f32x4 gt = *(const f32x4*)(gates + (size_t)row * 4);
                f32x4 a[4];
#pragma unroll
                for (int j = 0; j < 4; ++j) a[j] = (f32x4){0.f, 0.f, 0.f, 0.f};
#pragma unroll
                for (int k = 0; k < 4; ++k) {
                    const float gk = gt[k];
#pragma unroll
                    for (int j = 0; j < 4; ++j) { const unsigned y = *(const unsigned*)(Y + ((size_t)row * 4 + k) * D + 256 * j + 4 * lane);
                        const f32x2 p0 = __builtin_amdgcn_cvt_pk_f32_fp8((int)y, false), p1 = __builtin_amdgcn_cvt_pk_f32_fp8((int)y, true);
                        a[j].x += gk * p0.x; a[j].y += gk * p0.y; a[j].z += gk * p1.x; a[j].w += gk * p1.y; }
                }
#pragma unroll
                for (int j = 0; j < 4; ++j) { v[j] += cg[j] * a[j];
                    if (MODE == 2) *(f32x4*)(P.out + (size_t)row * D + 256 * j + 4 * lane) = v[j];
                    else { u32x2 xo; xo.x = cvt_pk_bf16(v[j].x, v[j].y); xo.y = cvt_pk_bf16(v[j].z, v[j].w); *(u32x2*)(XB + (size_t)row * D + 256 * j + 4 * lane) = xo; } }
            }
            if (MODE <= 1) {
                float ss = 0.f;
#pragma unroll
                for (int j = 0; j < 4; ++j) ss += (v[j].x * v[j].x + v[j].y * v[j].y) + (v[j].z * v[j].z + v[j].w * v[j].w);
                const float rstd = 1.0f / sqrtf(wave_sum(ss) * (1.0f / D) + EPS);
#pragma unroll
                for (int j = 0; j < 4; ++j) { const f32x4 h = v[j] * rstd * ca[j] + cc[j]; u32x2 o; o.x = cvt_pk_bf16(h.x, h.y); o.y = cvt_pk_bf16(h.z, h.w);
                    *(u32x2*)(H + (size_t)row * D + 256 * j + 4 * lane) = o; }
            }
        }
    }
}

struct Unit { int pm, pn, e, nrows, tbase, ks; };
typedef f32x4 Acc[2][2][4][2];

template <class Pb>
__device__ __forceinline__ void gemm_simple(LAS unsigned char* lds, const Pb& pb, int bid, int nblk) {
    const int tid = opaque_tid(), wid = __builtin_amdgcn_readfirstlane(tid >> 6), lane = tid & 63, wr = wid >> 2, wc = wid & 3, fr = lane & 15, fq = lane >> 4;
    constexpr int PITCH = 144;
    LAS unsigned char* sA = lds; LAS unsigned char* sB = lds + 256 * PITCH;
    Unit u;
    for (int i = 0; pb.next(i, bid, nblk, u); ++i) {
        Acc acc;
#pragma unroll
        for (int a = 0; a < 2; ++a)
#pragma unroll
            for (int b = 0; b < 2; ++b)
#pragma unroll
                for (int m = 0; m < 4; ++m)
#pragma unroll
                    for (int n = 0; n < 2; ++n) acc[a][b][m][n] = (f32x4){0.f, 0.f, 0.f, 0.f};
        unsigned ao[4], bo[4];
#pragma unroll
        for (int j = 0; j < 4; ++j) { const int q = tid + NT * j, row = q >> 3, c8 = q & 7;
            ao[j] = (unsigned)pb.a_row(u, row) * (unsigned)(pb.K * 2) + c8 * 16; bo[j] = (unsigned)pb.b_row(u, row) * (unsigned)(pb.K * 2) + c8 * 16; }
        for (int kt = 0; kt < pb.K / 64; ++kt) {
            u32x4 ra[4], rb[4];
#pragma unroll
            for (int j = 0; j < 4; ++j) { ra[j] = *(const u32x4*)(pb.A + ao[j] + kt * 128); rb[j] = *(const u32x4*)(pb.B + bo[j] + kt * 128); }
            __syncthreads();
#pragma unroll
            for (int j = 0; j < 4; ++j) { const int q = tid + NT * j, row = q >> 3, c8 = q & 7; *(LAS u32x4*)(sA + row * PITCH + c8 * 16) = ra[j]; *(LAS u32x4*)(sB + row * PITCH + c8 * 16) = rb[j]; }
            __syncthreads();
#pragma unroll
            for (int kk = 0; kk < 2; ++kk) {
                bf16x8 bfr[2][2];
#pragma unroll
                for (int b = 0; b < 2; ++b)
#pragma unroll
                    for (int n = 0; n < 2; ++n) bfr[b][n] = *(const LAS bf16x8*)(sB + (128 * b + 32 * wc + 16 * n + fr) * PITCH + (kk * 32 + fq * 8) * 2);
#pragma unroll
                for (int a = 0; a < 2; ++a) {
                    bf16x8 af[4];
#pragma unroll
                    for (int m = 0; m < 4; ++m) af[m] = *(const LAS bf16x8*)(sA + (128 * a + 64 * wr + 16 * m + fr) * PITCH + (kk * 32 + fq * 8) * 2);
#pragma unroll
                    for (int b = 0; b < 2; ++b)
#pragma unroll
                        for (int m = 0; m < 4; ++m)
#pragma unroll
                            for (int n = 0; n < 2; ++n) acc[a][b][m][n] = __builtin_amdgcn_mfma_f32_16x16x32_bf16(bfr[b][n], af[m], acc[a][b][m][n], 0, 0, 0);
                }
            }
        }
        pb.epi(acc, u, wr, wc, fr, fq);
    }
    __syncthreads();
}

struct PbInProj {
    static constexpr bool F8 = false;
    const char* A; const char* B; int K;
    bf16* proj; const float* qg; const float* kg; const float* rope;
    __device__ __forceinline__ bool next(int i, int bid, int nblk, Unit& u) const { const int L = i * nblk + bid; if (L >= 256 * 5) return false; u.pm = L / 5; u.pn = L % 5; u.e = 0; u.nrows = 256; u.tbase = 0; u.ks = 0; return true; }
    __device__ __forceinline__ int a_row(const Unit& u, int r) const { return 256 * u.pm + r; }
    __device__ __forceinline__ void a_rows4(const Unit& u, int r0, int (&rows)[4]) const { for (int j = 0; j < 4; ++j) rows[j] = 256 * u.pm + r0 + 64 * j; }
    __device__ __forceinline__ int b_rowc(int rho) const { return 64 * ((rho >> 5) & 3) + 32 * (rho >> 7) + perm32(rho & 31); }
    __device__ __forceinline__ int b_base_row(const Unit& u) const { return 256 * u.pn; }
    __device__ __forceinline__ int b_row(const Unit& u, int rho) const { return b_base_row(u) + b_rowc(rho); }
    __device__ __forceinline__ void epi(const Acc& acc, const Unit& u, int, int, int, int) const {
        const int t_ = opaque_tid(), w_ = __builtin_amdgcn_readfirstlane(t_ >> 6), wr = w_ >> 2, wc = w_ & 3, fr = t_ & 15, fq = (t_ >> 4) & 3;
        const int hg = 4 * u.pn + wc;
        const bool nrm = hg < 10;
        const float* gsrc = (hg < 8) ? qg : kg;
        f32x4 gv[2][2];
#pragma unroll
        for (int bj = 0; bj < 2; ++bj)
#pragma unroll
            for (int n = 0; n < 2; ++n) gv[bj][n] = nrm ? *(const f32x4*)(gsrc + 32 * bj + 8 * fq + 4 * n) : (f32x4){1.f, 1.f, 1.f, 1.f};
        const float qs = (hg < 8) ? QSCALE : 1.0f;
#pragma unroll
        for (int q = 0; q < 4; ++q) {
            const int ai = q >> 1, m0 = 2 * (q & 1);
            f32x4 rcs[2][2], rsn[2][2];
            if (nrm && fq < 2) {
#pragma unroll
                for (int mm = 0; mm < 2; ++mm) { const float* rp = rope + (size_t)(256 * u.pm + 128 * ai + 64 * wr + 16 * (m0 + mm) + fr) * 16;
#pragma unroll
                    for (int n = 0; n < 2; ++n) { rcs[mm][n] = *(const f32x4*)(rp + 4 * n); rsn[mm][n] = *(const f32x4*)(rp + 8 + 4 * n); } }
            }
#pragma unroll
            for (int mm = 0; mm < 2; ++mm) {
                const int m = m0 + mm;
                const int row = 256 * u.pm + 128 * ai + 64 * wr + 16 * m + fr;
                f32x4 v[2][2];
#pragma unroll
                for (int bj = 0; bj < 2; ++bj)
#pragma unroll
                    for (int n = 0; n < 2; ++n) v[bj][n] = acc[ai][bj][m][n];
                if (nrm) {
                    float ss = 0.f;
#pragma unroll
                    for (int bj = 0; bj < 2; ++bj)
#pragma unroll
                        for (int n = 0; n < 2; ++n) ss += (v[bj][n].x * v[bj][n].x + v[bj][n].y * v[bj][n].y) + (v[bj][n].z * v[bj][n].z + v[bj][n].w * v[bj][n].w);
                    ss += swz_xor<16>(ss); ss = sum_x32(ss);
                    const float rstd = __builtin_amdgcn_rsqf(ss * (1.0f / 64.0f) + EPS);
#pragma unroll
                    for (int bj = 0; bj < 2; ++bj)
#pragma unroll
                        for (int n = 0; n < 2; ++n) v[bj][n] = v[bj][n] * rstd * gv[bj][n];
#pragma unroll
                    for (int n = 0; n < 2; ++n) {
                        f32x4 pr;
                        pr.x = swz_xor<16>(v[0][n].x); pr.y = swz_xor<16>(v[0][n].y); pr.z = swz_xor<16>(v[0][n].z); pr.w = swz_xor<16>(v[0][n].w);
                        if (fq < 2) v[0][n] = (fq == 0) ? (v[0][n] * rcs[mm][n] - pr * rsn[mm][n]) : (v[0][n] * rcs[mm][n] + pr * rsn[mm][n]);
                    }
                }
                u32x4 o[2];
#pragma unroll
                for (int bj = 0; bj < 2; ++bj) {
                    o[bj].x = cvt_pk_bf16(v[bj][0].x * qs, v[bj][0].y * qs); o[bj].y = cvt_pk_bf16(v[bj][0].z * qs, v[bj][0].w * qs);
                    o[bj].z = cvt_pk_bf16(v[bj][1].x * qs, v[bj][1].y * qs); o[bj].w = cvt_pk_bf16(v[bj][1].z * qs, v[bj][1].w * qs);
                }
                { unsigned char* own = (unsigned char*)(proj + (size_t)row * NIN + 64 * hg); const bool odd = fr & 1;
                  store_line_pair(own, odd ? own - NIN * 2 : own + NIN * 2, true, true, o[0], o[1], fq, odd); }
            }
        }
    }
};

template <bool FIRST> struct PbOutProjT {
    static constexpr bool F8 = false;
    const char* A; const char* B; int K;
    const float* xin32; bf16* xb; const float* gate1;
    __device__ __forceinline__ bool next(int i, int bid, int nblk, Unit& u) const { const int L = i * nblk + bid; if (L >= 256 * 4) return false; u.pm = L >> 2; u.pn = L & 3; u.e = 0; u.nrows = 256; u.tbase = 0; u.ks = 0; return true; }
    __device__ __forceinline__ int a_row(const Unit& u, int r) const { return 256 * u.pm + r; }
    __device__ __forceinline__ void a_rows4(const Unit& u, int r0, int (&rows)[4]) const { for (int j = 0; j < 4; ++j) rows[j] = 256 * u.pm + r0 + 64 * j; }
    __device__ __forceinline__ int b_rowc(int rho) const { return 64 * ((rho >> 5) & 3) + 32 * (rho >> 7) + perm32(rho & 31); }
    __device__ __forceinline__ int b_base_row(const Unit& u) const { return 256 * u.pn; }
    __device__ __forceinline__ int b_row(const Unit& u, int rho) const { return b_base_row(u) + b_rowc(rho); }
    __device__ __forceinline__ void epi(const Acc& acc, const Unit& u, int, int, int, int) const {
        const int t_ = opaque_tid(), w_ = __builtin_amdgcn_readfirstlane(t_ >> 6), wr = w_ >> 2, wc = w_ & 3, fr = t_ & 15, fq = (t_ >> 4) & 3;
        const int b = (256 * u.pm) >> 13;
        const int colw = 256 * u.pn + 64 * wc;
        const bool odd = fr & 1;
        f32x4 g[2][2];
#pragma unroll
        for (int bj = 0; bj < 2; ++bj)
#pragma unroll
            for (int n = 0; n < 2; ++n) g[bj][n] = *(const f32x4*)(gate1 + (size_t)b * NMOD + colw + 32 * bj + 8 * fq + 4 * n);
#pragma unroll
        for (int q = 0; q < 4; ++q) {
            const int ai = q >> 1, m0 = 2 * (q & 1);
            f32x4 xr[2][2][2];
#pragma unroll
            for (int mm = 0; mm < 2; ++mm) {
                const size_t row = (size_t)(256 * u.pm + 128 * ai + 64 * wr + 16 * (m0 + mm) + fr);
                if (FIRST) {
#pragma unroll
                    for (int bj = 0; bj < 2; ++bj)
#pragma unroll
                        for (int n = 0; n < 2; ++n) xr[mm][bj][n] = *(const f32x4*)(xin32 + row * D + colw + 32 * bj + 8 * fq + 4 * n);
                } else {
                    const unsigned char* xi = (const unsigned char*)(xb + row * D + colw); u32x4 lo, hi;
                    load_line_pair(xi, odd ? xi - D * 2 : xi + D * 2, fq, odd, lo, hi);
                    xr[mm][0][0] = (f32x4){bf_lo(lo.x), bf_hi(lo.x), bf_lo(lo.y), bf_hi(lo.y)}; xr[mm][0][1] = (f32x4){bf_lo(lo.z), bf_hi(lo.z), bf_lo(lo.w), bf_hi(lo.w)};
                    xr[mm][1][0] = (f32x4){bf_lo(hi.x), bf_hi(hi.x), bf_lo(hi.y), bf_hi(hi.y)}; xr[mm][1][1] = (f32x4){bf_lo(hi.z), bf_hi(hi.z), bf_lo(hi.w), bf_hi(hi.w)};
                }
            }
#pragma unroll
            for (int mm = 0; mm < 2; ++mm) {
                const size_t row = (size_t)(256 * u.pm + 128 * ai + 64 * wr + 16 * (m0 + mm) + fr);
                u32x4 o[2];
#pragma unroll
                for (int bj = 0; bj < 2; ++bj) { const f32x4 r0 = xr[mm][bj][0] + g[bj][0] * acc[ai][bj][m0 + mm][0], r1 = xr[mm][bj][1] + g[bj][1] * acc[ai][bj][m0 + mm][1];
                    o[bj].x = cvt_pk_bf16(r0.x, r0.y); o[bj].y = cvt_pk_bf16(r0.z, r0.w); o[bj].z = cvt_pk_bf16(r1.x, r1.y); o[bj].w = cvt_pk_bf16(r1.z, r1.w); }
                unsigned char* xo = (unsigned char*)(xb + row * D + colw);
                store_line_pair(xo, odd ? xo - D * 2 : xo + D * 2, true, true, o[0], o[1], fq, odd);
            }
            asm volatile("" ::: "memory");
        }
    }
};

struct MoeTab { const LAS int* cnt; const LAS int* tp; };
__device__ __forceinline__ void moe_build_tab(LAS int* tab, const int* tot) {
    if (threadIdx.x == 0) { int t = 0; for (int e = 0; e < NE; ++e) { const int c = tot[e]; tab[e] = c; tab[32 + e] = t; t += (c + 255) >> 8; } tab[64] = t; }
    __syncthreads();
}
__device__ __forceinline__ bool moe_unit(const LAS int* tab, int L, int ntn, Unit& u) {
    const int gt = L / ntn; if (gt >= __builtin_amdgcn_readfirstlane(tab[64])) return false;
    const int ln = (int)__builtin_amdgcn_mbcnt_hi(~0u, __builtin_amdgcn_mbcnt_lo(~0u, 0u));
    const int tpv = tab[32 + (ln & 31)];
    const int e = __builtin_amdgcn_readfirstlane(__popcll(__ballot(tpv <= gt) & 0xffffffffull)) - 1;
    const int tpe = __builtin_amdgcn_readfirstlane(tab[32 + e]), cnt = __builtin_amdgcn_readfirstlane(tab[e]);
    u.e = e; u.pm = gt - tpe; u.pn = L % ntn; u.tbase = gt * 256; const int rem = cnt - 256 * u.pm; u.nrows = rem < 256 ? rem : 256; u.ks = 0; return true;
}

struct PbGU {
    static constexpr bool F8 = true;
    const char* A; const char* B; int K;
    const LAS int* tab; const int* list; const float* bgu; unsigned char* act;
    __device__ __forceinline__ bool next(int i, int bid, int nblk, Unit& u) const { return moe_unit(tab, i * nblk + bid, 8, u); }
    __device__ __forceinline__ int a_row(const Unit& u, int r) const { const int v = list[(size_t)u.e * NTOK + 256 * u.pm + lperm(r)]; return r < u.nrows ? (v >> 2) : 0; }
    __device__ __forceinline__ void a_rows4(const Unit& u, int r0, int (&rows)[4]) const {
        const int4 v = *(const int4*)(list + (size_t)u.e * NTOK + 256 * u.pm + 4 * r0);
        rows[0] = (r0 < u.nrows) ? (v.x >> 2) : 0; rows[1] = (r0 + 64 < u.nrows) ? (v.y >> 2) : 0; rows[2] = (r0 + 128 < u.nrows) ? (v.z >> 2) : 0; rows[3] = (r0 + 192 < u.nrows) ? (v.w >> 2) : 0; }
    __device__ __forceinline__ int b_rowc(int rho) const { const int i = rho & 127; return ((rho >> 7) ? 1024 : 0) + (i & ~31) + perm32(i & 31); }
    __device__ __forceinline__ int b_base_row(const Unit& u) const { return u.e * 2048 + 128 * u.pn; }
    __device__ __forceinline__ int b_row(const Unit& u, int rho) const { return b_base_row(u) + b_rowc(rho); }
    __device__ __forceinline__ void epi(const Acc& acc, const Unit& u, int, int, int, int) const {
        const int t_ = opaque_tid(), w_ = __builtin_amdgcn_readfirstlane(t_ >> 6), wr = w_ >> 2, wc = w_ & 3, fr = t_ & 15, fq = (t_ >> 4) & 3;
        const int col0 = 128 * u.pn + 32 * wc + 8 * fq;
        f32x4 bg[2], bu[2];
#pragma unroll
        for (int n = 0; n < 2; ++n) { bg[n] = *(const f32x4*)(bgu + (size_t)u.e * 2048 + col0 + 4 * n); bu[n] = *(const f32x4*)(bgu + (size_t)u.e * 2048 + 1024 + col0 + 4 * n); }
#pragma unroll
        for (int ai = 0; ai < 2; ++ai)
#pragma unroll
            for (int m = 0; m < 4; ++m) {
                const int r = 128 * ai + 64 * wr + 16 * m + fr;
                float o[8];
#pragma unroll
                for (int n = 0; n < 2; ++n)
#pragma unroll
                    for (int j = 0; j < 4; ++j) {
                        float g = acc[ai][0][m][n][j] * WUNSCALE + bg[n][j], uu = acc[ai][1][m][n][j] * WUNSCALE + bu[n][j];
                        g = fminf(g, 7.0f); uu = fminf(fmaxf(uu, -7.0f), 7.0f);
                        const float sg = __builtin_amdgcn_rcpf(1.0f + __builtin_amdgcn_exp2f(-1.702f * LOG2E * g));
                        o[4 * n + j] = g * sg * (uu + 1.0f);
                    }
                u32x2 w; w.x = cvt_pk4_fp8(o[0], o[1], o[2], o[3]); w.y = cvt_pk4_fp8(o[4], o[5], o[6], o[7]);
                *(u32x2*)(act + (size_t)(u.tbase + r) * 1024 + col0) = w;
            }
    }
};

struct PbDown {
    static constexpr bool F8 = true;
    const char* A; const char* B; int K;
    const LAS int* tab; const int* list; const float* bdn; unsigned char* ybuf;
    __device__ __forceinline__ bool next(int i, int bid, int nblk, Unit& u) const { return moe_unit(tab, i * nblk + bid, 4, u); }
    __device__ __forceinline__ int a_row(const Unit& u, int r) const { return u.tbase + r; }
    __device__ __forceinline__ void a_rows4(const Unit& u, int r0, int (&rows)[4]) const { for (int j = 0; j < 4; ++j) rows[j] = u.tbase + r0 + 64 * j; }
    __device__ __forceinline__ int b_rowc(int rho) const { return 64 * ((rho >> 5) & 3) + 16 * ((rho >> 2) & 3) + 8 * (rho >> 7) + 4 * ((rho >> 4) & 1) + (rho & 3); }
    __device__ __forceinline__ int b_base_row(const Unit& u) const { return u.e * 1024 + 256 * u.pn; }
    __device__ __forceinline__ int b_row(const Unit& u, int rho) const { return b_base_row(u) + b_rowc(rho); }
    __device__ __forceinline__ void epi(const Acc& acc, const Unit& u, int, int, int, int) const {
        const int t_ = opaque_tid(), w_ = __builtin_amdgcn_readfirstlane(t_ >> 6), wr = w_ >> 2, wc = w_ & 3, fr = t_ & 15, fq = (t_ >> 4) & 3;
        const int col0 = 256 * u.pn + 64 * wc + 16 * fq;
        f32x4 bv[2][2];
#pragma unroll
        for (int bj = 0; bj < 2; ++bj)
#pragma unroll
            for (int n = 0; n < 2; ++n) bv[bj][n] = *(const f32x4*)(bdn + (size_t)u.e * 1024 + col0 + 8 * bj + 4 * n);
        int dst8[8];
#pragma unroll
        for (int q = 0; q < 8; ++q) dst8[q] = list[(size_t)u.e * NTOK + 256 * u.pm + lperm(128 * (q >> 2) + 64 * wr + 16 * (q & 3) + fr)];
#pragma unroll
        for (int ai = 0; ai < 2; ++ai)
#pragma unroll
            for (int m = 0; m < 4; ++m) {
                const int r = 128 * ai + 64 * wr + 16 * m + fr;
                u32x4 w;
                { const f32x4 v00 = acc[ai][0][m][0] * WUNSCALE + bv[0][0], v01 = acc[ai][0][m][1] * WUNSCALE + bv[0][1], v10 = acc[ai][1][m][0] * WUNSCALE + bv[1][0], v11 = acc[ai][1][m][1] * WUNSCALE + bv[1][1];
                  w.x = cvt_pk4_fp8(v00.x, v00.y, v00.z, v00.w); w.y = cvt_pk4_fp8(v01.x, v01.y, v01.z, v01.w); w.z = cvt_pk4_fp8(v10.x, v10.y, v10.z, v10.w); w.w = cvt_pk4_fp8(v11.x, v11.y, v11.z, v11.w); }
                if (r < u.nrows) *(u32x4*)(ybuf + (size_t)dst8[ai * 4 + m] * 1024 + col0) = w;
            }
    }
};

__device__ __forceinline__ s16x4 lds_tr16(const LAS unsigned char* p) { return __builtin_bit_cast(s16x4, __builtin_amdgcn_ds_read_tr16_b64_v4i16((LAS s16x4*)p)); }

__device__ __forceinline__ void attn_phase(const Params& P, LAS unsigned char* lds, int l, int bid, int nblk) {
    const int tid = opaque_tid(), wid = __builtin_amdgcn_readfirstlane(tid >> 6), lane = tid & 63, r32 = lane & 31, hi = lane >> 5;
    unsigned char* ws = P.ws;
    const bf16* proj = (const bf16*)(ws + WS_PROJ);
    bf16* mix = (bf16*)(ws + WS_MIX);
    constexpr int KP = 144;
    LAS unsigned char* sK = lds; LAS unsigned char* sV = lds + 256 * KP;
    u32x4 kreg[4], vreg[4];
#define ATT_FETCH(un) do { const int _kvh = (un) & 1, _n = ((un) >> 1) & 63, _b = (un) >> 7; const int _tok0 = _b * SEQ + _n * 128 - 128; \
        _Pragma("unroll") for (int j = 0; j < 4; ++j) { const int q = tid + NT * j, key = q >> 3, c8 = q & 7; \
            kreg[j] = (u32x4){0u, 0u, 0u, 0u}; vreg[j] = (u32x4){0u, 0u, 0u, 0u}; \
            if (_n > 0 || key >= 128) { const bf16* src_ = proj + (size_t)(_tok0 + key) * NIN + 512 + _kvh * 64 + c8 * 8; kreg[j] = *(const u32x4*)src_; vreg[j] = *(const u32x4*)(src_ + 128); } } } while (0)
    if (bid < NB * 64 * 2) ATT_FETCH(bid);
    for (int unit = bid; unit < NB * 64 * 2; unit += nblk) {
        const int kvh = unit & 1, n = (unit >> 1) & 63, b = unit >> 7;
        __syncthreads();
#pragma unroll
        for (int j = 0; j < 4; ++j) { const int q = tid + NT * j, key = q >> 3, c8 = q & 7; *(LAS u32x4*)(sK + key * KP + c8 * 16) = kreg[j]; *(LAS u32x4*)(sV + key * KP + c8 * 16) = vreg[j]; }
        const int hq = kvh * 4 + (wid >> 1);
        const float sink2 = P.sinks[l * 8 + hq] * LOG2E;
        bf16x8 qfa[2][4];
#pragma unroll
        for (int qt = 0; qt < 2; ++qt)
#pragma unroll
            for (int s = 0; s < 4; ++s) qfa[qt][s] = *(const bf16x8*)(proj + ((size_t)b * SEQ + n * 128 + 64 * (wid & 1) + 32 * qt + r32) * NIN + hq * 64 + 16 * s + 8 * hi);
        __syncthreads();
        if (unit + nblk < NB * 64 * 2) ATT_FETCH(unit + nblk);
#pragma unroll
        for (int qt = 0; qt < 2; ++qt) {
            const int q0 = 64 * (wid & 1) + 32 * qt, qi = q0 + r32;
            const size_t qtok = (size_t)b * SEQ + n * 128 + qi;
            bf16x8 qf[4];
#pragma unroll
            for (int s = 0; s < 4; ++s) qf[s] = qfa[qt][s];
            f32x16 st[5];
#pragma unroll
            for (int kt = 0; kt < 5; ++kt) {
#pragma unroll
                for (int r = 0; r < 16; ++r) st[kt][r] = 0.f;
#pragma unroll
                for (int s = 0; s < 4; ++s) { const bf16x8 kf = *(const LAS bf16x8*)(sK + (q0 + 32 * kt + r32) * KP + (16 * s + 8 * hi) * 2); st[kt] = __builtin_amdgcn_mfma_f32_32x32x16_bf16(kf, qf[s], st[kt], 0, 0, 0); }
            }
            float mx = sink2;
#pragma unroll
            for (int kt = 0; kt < 5; ++kt)
#pragma unroll
                for (int r = 0; r < 16; ++r) {
                    const int kj = q0 + 32 * kt + (r & 3) + 8 * (r >> 2) + 4 * hi;
                    const bool ok = (kj > qi) && (kj <= qi + 128) && (n > 0 || kj >= 128);
                    const float s = ok ? st[kt][r] : -__builtin_inff(); st[kt][r] = s; mx = fmaxf(mx, s);
                }
            mx = max_x32(mx);
            float sum = 0.f;
#pragma unroll
            for (int kt = 0; kt < 5; ++kt)
#pragma unroll
                for (int r = 0; r < 16; ++r) { const float p = __builtin_amdgcn_exp2f(st[kt][r] - mx); st[kt][r] = p; sum += p; }
            sum = sum_x32(sum);
            sum += __builtin_amdgcn_exp2f(sink2 - mx);
            f32x16 o[2];
#pragma unroll
            for (int dt = 0; dt < 2; ++dt)
#pragma unroll
                for (int r = 0; r < 16; ++r) o[dt][r] = 0.f;
#pragma unroll
            for (int kt = 0; kt < 5; ++kt)
#pragma unroll
                for (int s2 = 0; s2 < 2; ++s2) {
                    u32x4 pw; pw.x = cvt_pk_bf16(st[kt][8 * s2 + 0], st[kt][8 * s2 + 1]); pw.y = cvt_pk_bf16(st[kt][8 * s2 + 2], st[kt][8 * s2 + 3]);
                    pw.z = cvt_pk_bf16(st[kt][8 * s2 + 4], st[kt][8 * s2 + 5]); pw.w = cvt_pk_bf16(st[kt][8 * s2 + 6], st[kt][8 * s2 + 7]);
                    const bf16x8 pf = __builtin_bit_cast(bf16x8, pw);
                    const int kb = q0 + 32 * kt + 16 * s2 + 4 * hi, i16 = lane & 15;
#pragma unroll
                    for (int dt = 0; dt < 2; ++dt) {
                        const int d0 = 32 * dt + 16 * ((lane >> 4) & 1);
                        const LAS unsigned char* a0 = sV + (kb + (i16 >> 2)) * KP + (d0 + 4 * (i16 & 3)) * 2;
                        const s16x4 v0 = lds_tr16(a0), v1 = lds_tr16(a0 + 8 * KP);
                        bf16x8 vf; vf[0] = v0[0]; vf[1] = v0[1]; vf[2] = v0[2]; vf[3] = v0[3]; vf[4] = v1[0]; vf[5] = v1[1]; vf[6] = v1[2]; vf[7] = v1[3];
                        o[dt] = __builtin_amdgcn_mfma_f32_32x32x16_bf16(vf, pf, o[dt], 0, 0, 0);
                    }
                }
            const float inv = 1.0f / sum;
#pragma unroll
            for (int dt = 0; dt < 2; ++dt)
#pragma unroll
                for (int g4 = 0; g4 < 4; ++g4) {
                    u32x2 w; w.x = cvt_pk_bf16(o[dt][4 * g4 + 0] * inv, o[dt][4 * g4 + 1] * inv); w.y = cvt_pk_bf16(o[dt][4 * g4 + 2] * inv, o[dt][4 * g4 + 3] * inv);
                    *(u32x2*)(mix + qtok * D + hq * 64 + 32 * dt + 8 * g4 + 4 * hi) = w;
                }
        }
    }
    for (int ch = bid * 8 + wid; ch < NTOK / 16; ch += nblk * 8) {
        const int t0 = ch * 16, p0 = t0 & (SEQ - 1);
        const int col = 8 * lane, g = lane >> 4, w = 2 << g;
        u32x4 zr[31];
#pragma unroll
        for (int t = 0; t < 31; ++t) zr[t] = (t >= 15 || p0 > 0) ? *(const u32x4*)(proj + (size_t)(t0 + t - 15) * NIN + 768 + col) : (u32x4){0u, 0u, 0u, 0u};
        float pb_[8], ps_[8];
#pragma unroll
        for (int i = 0; i < 8; i += 4) { const f32x4 a = *(const f32x4*)(P.pool_b + l * 512 + col + i), s = *(const f32x4*)(P.pool_s + l * 512 + col + i);
            pb_[i] = a.x; pb_[i + 1] = a.y; pb_[i + 2] = a.z; pb_[i + 3] = a.w; ps_[i] = s.x; ps_[i + 1] = s.y; ps_[i + 2] = s.z; ps_[i + 3] = s.w; }
        float sum[8];
#pragma unroll
        for (int i = 0; i < 8; ++i) sum[i] = 0.f;
#pragma unroll
        for (int j = 1; j < 16; ++j) {
            const u32x4 z = zr[15 - j]; const float m = (j < w) ? 1.0f : 0.0f;
            sum[0] += m * bf_lo(z.x); sum[1] += m * bf_hi(z.x); sum[2] += m * bf_lo(z.y); sum[3] += m * bf_hi(z.y); sum[4] += m * bf_lo(z.z); sum[5] += m * bf_hi(z.z); sum[6] += m * bf_lo(z.w); sum[7] += m * bf_hi(z.w);
        }
#pragma unroll
        for (int t = 0; t < 16; ++t) {
            const u32x4 z = zr[15 + t];
            const float zz[8] = {bf_lo(z.x), bf_hi(z.x), bf_lo(z.y), bf_hi(z.y), bf_lo(z.z), bf_hi(z.z), bf_lo(z.w), bf_hi(z.w)};
            const int pos = p0 + t; const float ic = 1.0f / (float)((pos + 1 < w) ? (pos + 1) : w);
            float o[8];
#pragma unroll
            for (int i = 0; i < 8; ++i) { sum[i] += zz[i]; o[i] = (sum[i] * ic - zz[i] + pb_[i]) * ps_[i]; }
            u32x4 ow; ow.x = cvt_pk_bf16(o[0], o[1]); ow.y = cvt_pk_bf16(o[2], o[3]); ow.z = cvt_pk_bf16(o[4], o[5]); ow.w = cvt_pk_bf16(o[6], o[7]);
            *(u32x4*)(mix + (size_t)(t0 + t) * D + 512 + col) = ow;
            const u32x4 y = (g == 0) ? zr[15 + t - 1] : (g == 1) ? zr[15 + t - 3] : (g == 2) ? zr[15 + t - 7] : zr[15 + t - 15];
            sum[0] -= bf_lo(y.x); sum[1] -= bf_hi(y.x); sum[2] -= bf_lo(y.y); sum[3] -= bf_hi(y.y); sum[4] -= bf_lo(y.z); sum[5] -= bf_hi(y.z); sum[6] -= bf_lo(y.w); sum[7] -= bf_hi(y.w);
        }
    }
}

__device__ __forceinline__ void router_phase(const Params& P, LAS unsigned char* lds, int l, int bid, int nblk) {
    const int tid = opaque_tid(), wid = __builtin_amdgcn_readfirstlane(tid >> 6), lane = tid & 63, fr = lane & 15, fq = lane >> 4;
    unsigned char* ws = P.ws;
    const float* mod = (const float*)(ws + WS_MOD);
    bf16* H = (bf16*)(ws + WS_H);
    float* gates = (float*)(ws + WS_GATES);
    int* list = (int*)(ws + WS_LIST);
    constexpr int RP = 2064;
    LAS unsigned char* rwT = lds;
    LAS float* lg = (LAS float*)(lds + 66048);
    LAS unsigned long long* emask = (LAS unsigned long long*)(lds + 66048 + 33792);
    LAS unsigned short* sel = (LAS unsigned short*)(emask + 128);
    __syncthreads();
    for (int idx = tid; idx < 1024 * 32; idx += NT) { const int k = idx >> 5, e = idx & 31; const float v = P.rw[(size_t)l * 32768 + idx];
        *(LAS unsigned short*)(rwT + e * RP + k * 2) = (unsigned short)(cvt_pk_bf16(v, 0.f) & 0xffffu); }
    for (int tile = bid; tile < NTOK / 256; tile += nblk) {
        const int tok0 = tile * 256, b = tok0 >> 13;
        {
            f32x4 ca[4], cc[4];
#pragma unroll
            for (int j = 0; j < 4; ++j) { const int col = 256 * j + 4 * lane; const f32x4 g = *(const f32x4*)(P.n2g + l * D + col); const f32x4 sc = *(const f32x4*)(mod + (size_t)(l * NB + b) * NMOD + 4 * D + col);
                ca[j] = g * (1.0f + sc); cc[j] = *(const f32x4*)(mod + (size_t)(l * NB + b) * NMOD + 3 * D + col); }
            for (int rr = 0; rr < 32; ++rr) {
                const int row = tok0 + wid * 32 + rr;
                f32x4 v[4]; float ss = 0.f;
#pragma unroll
                for (int j = 0; j < 4; ++j) { const u32x2 xw = *(const u32x2*)((const bf16*)(ws + WS_XB) + (size_t)row * D + 256 * j + 4 * lane); v[j] = (f32x4){bf_lo(xw.x), bf_hi(xw.x), bf_lo(xw.y), bf_hi(xw.y)};
                    ss += (v[j].x * v[j].x + v[j].y * v[j].y) + (v[j].z * v[j].z + v[j].w * v[j].w); }
                const float rstd = 1.0f / sqrtf(wave_sum(ss) * (1.0f / D) + EPS);
#pragma unroll
                for (int j = 0; j < 4; ++j) { const f32x4 h = v[j] * rstd * ca[j] + cc[j]; u32x2 o; o.x = cvt_pk_bf16(h.x, h.y); o.y = cvt_pk_bf16(h.z, h.w); *(u32x2*)(H + (size_t)row * D + 256 * j + 4 * lane) = o;
                    *(unsigned*)(ws + WS_H8 + (size_t)row * D + 256 * j + 4 * lane) = cvt_pk4_fp8(h.x, h.y, h.z, h.w); }
            }
        }
        asm volatile("s_waitcnt vmcnt(0)" ::: "memory");
        __syncthreads();
#pragma unroll 1
        for (int rg = 0; rg < 2; ++rg) {
            f32x4 a0 = (f32x4){0.f, 0.f, 0.f, 0.f}, a1 = a0;
            const bf16* hp = H + (size_t)(tok0 + 32 * wid + 16 * rg + fr) * D + 8 * fq;
            for (int s = 0; s < 32; ++s) {
                const bf16x8 af = *(const bf16x8*)(hp + 32 * s);
                const bf16x8 b0 = *(const LAS bf16x8*)(rwT + fr * RP + (32 * s + 8 * fq) * 2), b1 = *(const LAS bf16x8*)(rwT + (16 + fr) * RP + (32 * s + 8 * fq) * 2);
                a0 = __builtin_amdgcn_mfma_f32_16x16x32_bf16(af, b0, a0, 0, 0, 0); a1 = __builtin_amdgcn_mfma_f32_16x16x32_bf16(af, b1, a1, 0, 0, 0);
            }
            const float rb0 = P.rb[l * 32 + fr], rb1 = P.rb[l * 32 + 16 + fr];
#pragma unroll
            for (int r = 0; r < 4; ++r) { const int row = 32 * wid + 16 * rg + 4 * fq + r; lg[row * 33 + fr] = a0[r] + rb0; lg[row * 33 + 16 + fr] = a1[r] + rb1; }
        }
        __syncthreads();
        if (tid < 256) {
            float v[32];
#pragma unroll
            for (int e = 0; e < 32; ++e) v[e] = lg[tid * 33 + e];
            float tv[4]; int ti[4];
#pragma unroll
            for (int k = 0; k < 4; ++k) {
                float best = -__builtin_inff(); int bi = 0;
#pragma unroll
                for (int e = 0; e < 32; ++e) { const bool gt = v[e] > best; best = gt ? v[e] : best; bi = gt ? e : bi; }
                tv[k] = best; ti[k] = bi;
#pragma unroll
                for (int e = 0; e < 32; ++e) v[e] = (e == bi) ? -__builtin_inff() : v[e];
            }
            const float e1 = __expf(tv[1] - tv[0]), e2 = __expf(tv[2] - tv[0]), e3 = __expf(tv[3] - tv[0]);
            const float inv = 1.0f / (1.0f + e1 + e2 + e3);
            *(f32x4*)(gates + (size_t)(tok0 + tid) * 4) = (f32x4){inv, e1 * inv, e2 * inv, e3 * inv};
#pragma unroll
            for (int k = 0; k < 4; ++k) sel[tid * 4 + k] = (unsigned short)ti[k];
#pragma unroll
            for (int e = 0; e < 32; ++e) { const unsigned long long m = __ballot((ti[0] == e) | (ti[1] == e) | (ti[2] == e) | (ti[3] == e)); if (lane == 0) emask[e * 4 + wid] = m; }
        }
        __syncthreads();
        if (tid < 256) {
            int* selg = (int*)(ws + WS_SEL);
            const unsigned long long lt = (1ull << lane) - 1ull;
            int so[4];
#pragma unroll
            for (int k = 0; k < 4; ++k) {
                const int e = sel[tid * 4 + k]; int r = 0;
                for (int w = 0; w < 4; ++w) { const unsigned long long m = emask[e * 4 + w]; r += (w < wid) ? __popcll(m) : ((w == wid) ? __popcll(m & lt) : 0); }
                so[k] = (e << 16) | r;
            }
            *(int4*)(selg + (size_t)(tok0 + tid) * 4) = make_int4(so[0], so[1], so[2], so[3]);
        }
        if (tid < 32) { int c = 0; for (int w = 0; w < 4; ++w) c += __popcll(emask[tid * 4 + w]); ((int*)(ws + WS_CNTB))[(size_t)(l * 256 + tile) * 32 + tid] = c; }
        __syncthreads();
    }
}

__device__ __forceinline__ void place_phase(const Params& P, LAS unsigned char* lds, int l, int bid, int nblk) {
    const int tid = opaque_tid();
    unsigned char* ws = P.ws;
    const int* cntb = (const int*)(ws + WS_CNTB) + (size_t)l * 256 * 32;
    const int* selg = (const int*)(ws + WS_SEL);
    int* list = (int*)(ws + WS_LIST);
    LAS int* red = (LAS int*)lds;
    LAS int* base = red + 512;
    const int e = tid & 31, part = tid >> 5;
    __syncthreads();
    for (int tile = bid; tile < NTOK / 256 + 1; tile += nblk) {
        int s = 0;
        for (int q = 0; q < 16; ++q) { const int t = part * 16 + q; if (t < tile) s += cntb[t * 32 + e]; }
        red[part * 32 + e] = s;
        __syncthreads();
        if (tid < 32) { int b = 0; for (int p = 0; p < 16; ++p) b += red[p * 32 + tid]; base[tid] = b; if (tile == NTOK / 256) ((int*)(ws + WS_TOT))[l * 32 + tid] = b; }
        __syncthreads();
        if (tile < NTOK / 256 && tid < 256) {
            const int tok = tile * 256 + tid; const int4 v = *(const int4*)(selg + (size_t)tok * 4);
            const int vv[4] = {v.x, v.y, v.z, v.w};
#pragma unroll
            for (int k = 0; k < 4; ++k) { const int ee = vv[k] >> 16, r = vv[k] & 0xffff; { const int rk = base[ee] + r; list[(size_t)ee * NTOK + (rk & ~255) + lperm(rk & 255)] = tok * 4 + k; } }
        }
        __syncthreads();
    }
}

constexpr int BK = 64, HALF = 128, HTB = HALF * BK * 2;
__device__ __forceinline__ int lds_byte(int r, int c) { const int st = (r >> 4) * 2 + (c >> 5), rr = r & 15, cc = c & 31, ob = rr * 64 + cc * 2; return st * 1024 + (ob ^ (((ob >> 9) & 1) << 5)); }
__device__ __forceinline__ void stage_rc(int b, int& R, int& C) { const int st = b / 1024, sb = b % 1024, swz = sb ^ (((sb >> 9) & 1) << 5); R = (st >> 1) * 16 + swz / 64; C = (st & 1) * 32 + (swz % 64) / 2; }

template <bool F8> struct FragT;
template <> struct FragT<false> {
    struct A { bf16x8 k[2]; };
    static __device__ __forceinline__ void load(A& d, const LAS unsigned char* p) { d.k[0] = *(const LAS bf16x8*)p; d.k[1] = *(const LAS bf16x8*)(p + 1024); }
    static __device__ __forceinline__ f32x4 mma(const A& a, const A& b, f32x4 c) { c = __builtin_amdgcn_mfma_f32_16x16x32_bf16(a.k[0], b.k[0], c, 0, 0, 0); return __builtin_amdgcn_mfma_f32_16x16x32_bf16(a.k[1], b.k[1], c, 0, 0, 0); }
};
template <> struct FragT<true> {
    typedef i32x8 A;
    static __device__ __forceinline__ void load(A& d, const LAS unsigned char* p) { const i32x4 lo = *(const LAS i32x4*)p, hi = *(const LAS i32x4*)(p + 1024); d = __builtin_shufflevector(lo, hi, 0, 1, 2, 3, 4, 5, 6, 7); }
    static __device__ __forceinline__ f32x4 mma(const A& a, const A& b, f32x4 c) { const int one = 0x7f7f7f7f;
        asm volatile("v_mfma_scale_f32_16x16x128_f8f6f4 %0, %1, %2, %0, %3, %3 op_sel_hi:[0,0,0]" : "+v"(c) : "v"(a), "v"(b), "v"(one)); return c; }
};
template <class Pb>
__device__ __forceinline__ void gemm_phase8(LAS unsigned char* lds, const Pb& pb, int bid, int nblk) {
    const int tid = opaque_tid(), wid = __builtin_amdgcn_readfirstlane(tid >> 6), lane = tid & 63, wr = wid >> 2, wc = wid & 3, fr = lane & 15, fq = lane >> 4;
    constexpr bool F8 = Pb::F8;
    const int RB = F8 ? pb.K : pb.K * 2;
    const int nt = RB / 128;
    int Rp[2], Cp[2];
#pragma unroll
    for (int i = 0; i < 2; ++i) stage_rc(tid * 16 + i * 8192, Rp[i], Cp[i]);
    unsigned voB[2][2];
#pragma unroll
    for (int h = 0; h < 2; ++h)
#pragma unroll
        for (int i = 0; i < 2; ++i) voB[h][i] = (unsigned)pb.b_rowc(128 * h + Rp[i]) * (unsigned)RB + (unsigned)Cp[i] * 2u;
    const unsigned ldsw = (unsigned)wid * 1024u;
    const int aoff = lds_byte(wr * 64 + fr, fq * 8), boff = lds_byte(wc * 32 + fr, fq * 8);
#define PG8_SA(b, h) (((b) * 2 + (h)) * HTB)
#define PG8_SB(b, h) ((4 + (b) * 2 + (h)) * HTB)
#define PG8_STAGE(bufoff, rsrc, soff, voff) do { _Pragma("unroll") for (int _i = 0; _i < 2; ++_i) \
        __builtin_amdgcn_raw_ptr_buffer_load_lds(rsrc, (LAS unsigned*)(lds + (bufoff) + ldsw + _i * 8192), 16, (int)(voff)[_i], (int)(soff), 0, 0); } while (0)
#define PG8_LDA(dst, b, h) do { _Pragma("unroll") for (int m = 0; m < 4; ++m) FragT<F8>::load(dst[m], lds + PG8_SA(b, h) + aoff + m * 2048); } while (0)
#define PG8_LDB(dst, b, h) do { _Pragma("unroll") for (int n = 0; n < 2; ++n) FragT<F8>::load(dst[n], lds + PG8_SB(b, h) + boff + n * 2048); } while (0)
#define PG8_MMA(ai, bj, At, Bt) do { __builtin_amdgcn_s_setprio(1); _Pragma("unroll") for (int m = 0; m < 4; ++m) _Pragma("unroll") for (int n = 0; n < 2; ++n) \
        acc[ai][bj][m][n] = FragT<F8>::mma(Bt[n], At[m], acc[ai][bj][m][n]); __builtin_amdgcn_s_setprio(0); } while (0)
#define PG8_WAIT_V(n) asm volatile("s_waitcnt vmcnt(" #n ")" ::: "memory")
#define PG8_WAIT_L(n) asm volatile("s_waitcnt lgkmcnt(" #n ")" ::: "memory")
#define PG8_BAR __builtin_amdgcn_s_barrier()
#define PG8_SCHED __builtin_amdgcn_sched_barrier(0)
#define PG8_VOA(dst, un) do { int _r[4]; pb.a_rows4(un, Rp[0], _r); _Pragma("unroll") for (int h = 0; h < 2; ++h) _Pragma("unroll") for (int i = 0; i < 2; ++i) dst[h][i] = (unsigned)_r[2 * h + i] * (unsigned)RB + (unsigned)Cp[i] * 2u; } while (0)
    Unit cur, nxt; int ui = 0;
    if (!pb.next(0, bid, nblk, cur)) return;
    Acc acc;
#pragma unroll
    for (int a = 0; a < 2; ++a)
#pragma unroll
        for (int b = 0; b < 2; ++b)
#pragma unroll
            for (int m = 0; m < 4; ++m)
#pragma unroll
                for (int n = 0; n < 2; ++n) acc[a][b][m][n] = (f32x4){0.f, 0.f, 0.f, 0.f};
    typename FragT<F8>::A At[4]; typename FragT<F8>::A B0[2], B1[2];
    unsigned voAc[2][2], voAn[2][2];
    PG8_VOA(voAc, cur);
    const __amdgpu_buffer_rsrc_t rA = __builtin_amdgcn_make_buffer_rsrc((void*)pb.A, 0, 0x7fffffff, 0x00020000), rB = __builtin_amdgcn_make_buffer_rsrc((void*)pb.B, 0, 0x7fffffff, 0x00020000);
    unsigned cB = (unsigned)pb.b_base_row(cur) * (unsigned)RB;
    { const unsigned k0 = (unsigned)(cur.ks & (nt - 1)) * 128u, k1 = (unsigned)((cur.ks + 1) & (nt - 1)) * 128u;
    PG8_STAGE(PG8_SB(0, 0), rB, cB + k0, voB[0]); PG8_STAGE(PG8_SB(0, 1), rB, cB + k0, voB[1]); PG8_STAGE(PG8_SA(0, 0), rA, k0, voAc[0]); PG8_STAGE(PG8_SA(0, 1), rA, k0, voAc[1]);
    if (wr == 1) PG8_BAR;
    PG8_WAIT_V(2); PG8_BAR;
    PG8_STAGE(PG8_SB(1, 0), rB, cB + k1, voB[0]); PG8_STAGE(PG8_SA(1, 0), rA, k1, voAc[0]); PG8_STAGE(PG8_SB(1, 1), rB, cB + k1, voB[1]); }
    PG8_WAIT_V(6); PG8_BAR;
    for (;;) {
        const bool has_next = pb.next(ui + 1, bid, nblk, nxt);
        unsigned nB = cB; int nks = cur.ks;
        if (has_next) { PG8_VOA(voAn, nxt); nB = (unsigned)pb.b_base_row(nxt) * (unsigned)RB; nks = nxt.ks; }
        else {
#pragma unroll
            for (int h = 0; h < 2; ++h)
#pragma unroll
                for (int i = 0; i < 2; ++i) voAn[h][i] = voAc[h][i]; }
        for (int t = 0; t < nt; t += 2) {
            const bool last = (t == nt - 2);
            const unsigned a1 = (unsigned)((t + 1 + cur.ks) & (nt - 1)) * 128u;
            const int ks2 = last ? nks : (t + 2 + cur.ks);
            const unsigned a2 = (unsigned)(ks2 & (nt - 1)) * 128u, a3 = (unsigned)((ks2 + 1) & (nt - 1)) * 128u;
            const unsigned bb = last ? nB : cB;
            const unsigned b2 = bb + a2, b3 = bb + a3;
            unsigned sa[2][2];
#pragma unroll
            for (int h = 0; h < 2; ++h)
#pragma unroll
                for (int i = 0; i < 2; ++i) sa[h][i] = last ? voAn[h][i] : voAc[h][i];
            PG8_LDB(B0, 0, 0); PG8_LDB(B1, 0, 1); PG8_SCHED; PG8_LDA(At, 0, 0); PG8_STAGE(PG8_SA(1, 1), rA, a1, voAc[1]);
            PG8_WAIT_V(8); PG8_WAIT_L(0); PG8_BAR; PG8_MMA(0, 0, At, B0); PG8_MMA(0, 1, At, B1); PG8_BAR; PG8_SCHED;
            PG8_LDA(At, 0, 1); PG8_STAGE(PG8_SB(0, 0), rB, b2, voB[0]); PG8_STAGE(PG8_SB(0, 1), rB, b2, voB[1]); PG8_STAGE(PG8_SA(0, 0), rA, a2, sa[0]);
            PG8_WAIT_V(8); PG8_WAIT_L(0); PG8_BAR; PG8_MMA(1, 0, At, B0); PG8_MMA(1, 1, At, B1); PG8_BAR; PG8_SCHED;
            PG8_LDB(B0, 1, 0); PG8_LDB(B1, 1, 1); PG8_SCHED; PG8_LDA(At, 1, 0); PG8_STAGE(PG8_SA(0, 1), rA, a2, sa[1]);
            PG8_WAIT_V(8); PG8_WAIT_L(0); PG8_BAR; PG8_MMA(0, 0, At, B0); PG8_MMA(0, 1, At, B1); PG8_BAR; PG8_SCHED;
            PG8_LDA(At, 1, 1); PG8_STAGE(PG8_SB(1, 0), rB, b3, voB[0]); PG8_STAGE(PG8_SB(1, 1), rB, b3, voB[1]); PG8_STAGE(PG8_SA(1, 0), rA, a3, sa[0]);
            PG8_WAIT_V(8); PG8_WAIT_L(0); PG8_BAR; PG8_MMA(1, 0, At, B0); PG8_MMA(1, 1, At, B1); PG8_BAR; PG8_SCHED;
        }
        if (wr == 0) PG8_BAR;
        if constexpr (F8) asm volatile("s_nop 15\n\ts_nop 15" ::: "memory");
        pb.epi(acc, cur, wr, wc, fr, fq);
        if (!has_next) break;
#pragma unroll
        for (int a = 0; a < 2; ++a)
#pragma unroll
            for (int b = 0; b < 2; ++b)
#pragma unroll
                for (int m = 0; m < 4; ++m)
#pragma unroll
                    for (int n = 0; n < 2; ++n) acc[a][b][m][n] = (f32x4){0.f, 0.f, 0.f, 0.f};
        cur = nxt; cB = nB; ++ui;
#pragma unroll
        for (int h = 0; h < 2; ++h)
#pragma unroll
            for (int i = 0; i < 2; ++i) voAc[h][i] = voAn[h][i];
        if (wr == 1) PG8_BAR;
    }
    PG8_WAIT_V(0);
    PG8_BAR;
#undef PG8_SA
#undef PG8_SB
#undef PG8_STAGE
#undef PG8_LDA
#undef PG8_LDB
#undef PG8_MMA
#undef PG8_WAIT_V
#undef PG8_WAIT_L
#undef PG8_BAR
#undef PG8_SCHED
#undef PG8_VOA
}

#ifndef FAST_INPROJ
#define FAST_INPROJ 1
#endif
#ifndef FAST_OUTPROJ
#define FAST_OUTPROJ 1
#endif
#ifndef FAST_GU
#define FAST_GU 1
#endif
#ifndef FAST_DOWN
#define FAST_DOWN 1
#endif
template <bool FAST, class Pb> __device__ __forceinline__ void gemm_run(LAS unsigned char* lds, const Pb& pb, int bid, int nblk) {
    if constexpr (FAST) gemm_phase8(lds, pb, bid, nblk); else gemm_simple(lds, pb, bid, nblk);
}

__device__ __forceinline__ void inproj_phase(const Params& P, LAS unsigned char* lds, int l, int bid, int nblk) {
    unsigned char* ws = P.ws;
    PbInProj pb; pb.A = (const char*)(ws + WS_H); pb.B = (const char*)(ws + WS_WIN) + (size_t)l * (1280 * 1024 * 2); pb.K = 1024;
    pb.proj = (bf16*)(ws + WS_PROJ); pb.qg = P.qg + l * 64; pb.kg = P.kg + l * 64; pb.rope = (const float*)(ws + WS_ROPE);
    gemm_run<FAST_INPROJ>(lds, pb, bid, nblk);
}
__device__ __forceinline__ void outproj_phase(const Params& P, LAS unsigned char* lds, int l, int bid, int nblk) {
    unsigned char* ws = P.ws;
    if (l == 0) { PbOutProjT<true> pb; pb.A = (const char*)(ws + WS_MIX); pb.B = (const char*)(ws + WS_WOUT); pb.K = 1024;
        pb.xin32 = P.x; pb.xb = (bf16*)(ws + WS_XB); pb.gate1 = (const float*)(ws + WS_MOD) + 2 * D; gemm_phase8(lds, pb, bid, nblk); }
    else { PbOutProjT<false> pb; pb.A = (const char*)(ws + WS_MIX); pb.B = (const char*)(ws + WS_WOUT) + (size_t)l * (1024 * 1024 * 2); pb.K = 1024;
        pb.xin32 = nullptr; pb.xb = (bf16*)(ws + WS_XB); pb.gate1 = (const float*)(ws + WS_MOD) + (size_t)l * NB * NMOD + 2 * D; gemm_phase8(lds, pb, bid, nblk); }
}
__device__ __forceinline__ void gu_phase(const Params& P, LAS unsigned char* lds, int l, int bid, int nblk) {
    unsigned char* ws = P.ws;
    LAS int* tab = (LAS int*)(lds + 131072);
    __syncthreads();
    moe_build_tab(tab, (const int*)(ws + WS_TOT) + l * 32);
    PbGU pb; pb.A = (const char*)(ws + WS_H8); pb.B = (const char*)(ws + WS_WGU) + (size_t)l * 32 * (2048 * 1024); pb.K = 1024;
    pb.tab = tab; pb.list = (const int*)(ws + WS_LIST); pb.bgu = P.bgu + (size_t)l * 32 * 2048; pb.act = ws + WS_ACT;
    gemm_phase8(lds, pb, bid, nblk);
}
__device__ __forceinline__ void down_phase(const Params& P, LAS unsigned char* lds, int l, int bid, int nblk) {
    unsigned char* ws = P.ws;
    LAS int* tab = (LAS int*)(lds + 131072);
    __syncthreads();
    moe_build_tab(tab, (const int*)(ws + WS_TOT) + l * 32);
    PbDown pb; pb.A = (const char*)(ws + WS_ACT); pb.B = (const char*)(ws + WS_WDN) + (size_t)l * 32 * (1024 * 1024); pb.K = 1024;
    pb.tab = tab; pb.list = (const int*)(ws + WS_LIST); pb.bdn = P.bdn + (size_t)l * 32 * 1024; pb.ybuf = ws + WS_YBUF;
    gemm_phase8(lds, pb, bid, nblk);
}

#define XB_TMO      128
#define XB_XCNT(j)  (256  + 64 * (j))
#define XB_XSUB(j)  (1280 + 64 * (j))
#define XB_XGEN(j)  (2304 + 64 * (j))
#define XB_TOP      3328
#define XB_TOPGEN   3392
#define XCD_BAR_WORDS 3456
#define XB_SPIN_CAP (1u << 18)
__device__ __forceinline__ unsigned xb_ld(unsigned* p)              { return __hip_atomic_load(p, __ATOMIC_RELAXED, __HIP_MEMORY_SCOPE_AGENT); }
__device__ __forceinline__ unsigned xb_add(unsigned* p, unsigned v) { return __hip_atomic_fetch_add(p, v, __ATOMIC_RELAXED, __HIP_MEMORY_SCOPE_AGENT); }
__device__ __forceinline__ unsigned xb_xcc_id() { return (unsigned)__builtin_amdgcn_s_getreg((3 << 11) | 20) & 0xFu; }
#define XB_SPIN(cond, bar) do { unsigned _sp = 0; while (cond) { __builtin_amdgcn_s_sleep(1); \
    if ((++_sp & 255u) == 0u) { if (xb_ld(&(bar)[XB_TMO])) break; if (_sp > XB_SPIN_CAP) { atomicAdd(&(bar)[XB_TMO], 1u); break; } } } } while (0)
struct XcdBarrier { unsigned* bar; unsigned x; volatile LAS unsigned* st; };
__device__ __forceinline__ XcdBarrier xcd_barrier_post(unsigned* bar, volatile LAS unsigned* st) {
    XcdBarrier b; b.bar = bar; b.x = xb_xcc_id(); b.st = st;
    if (threadIdx.x == 0) (void)xb_add(&bar[XB_XCNT(b.x)], 1u);
    return b;
}
__device__ __forceinline__ void xcd_barrier_complete(unsigned* bar, unsigned x, unsigned& nloc, unsigned& nx) {
    const unsigned G = gridDim.x * gridDim.y * gridDim.z;
    unsigned sum, cnt, mine, sp = 0u;
    for (;;) {
        sum = 0u; cnt = 0u; mine = 0u;
#pragma unroll
        for (unsigned j = 0; j < 16; ++j) { const unsigned c = xb_ld(&bar[XB_XCNT(j)]); sum += c; cnt += (c > 0u) ? 1u : 0u; mine = (j == x) ? c : mine; }
        if (sum == G) break;
        __builtin_amdgcn_s_sleep(1);
        if ((++sp & 255u) == 0u) { if (xb_ld(&bar[XB_TMO])) break; if (sp > XB_SPIN_CAP) { atomicAdd(&bar[XB_TMO], 1u); break; } }
    }
    nloc = mine > 0u ? mine : 1u; nx = cnt > 0u ? cnt : 1u;
}
__device__ __forceinline__ void xcd_barrier(const XcdBarrier& b) {
    asm volatile("s_waitcnt vmcnt(0)" ::: "memory");
    __syncthreads();
    if (threadIdx.x == 0) {
        unsigned* bar = b.bar; const unsigned bx = xb_xcc_id();
        __builtin_amdgcn_s_waitcnt(0);
        unsigned nloc = b.st[0], nx = b.st[1];
        if (nloc == 0u) { xcd_barrier_complete(bar, bx, nloc, nx); b.st[0] = nloc; b.st[1] = nx; }
        const unsigned old = xb_add(&bar[XB_XSUB(bx)], 1u);
        const unsigned gen = old / nloc;
        if (old + 1u == (gen + 1u) * nloc) {
            __builtin_amdgcn_fence(__ATOMIC_RELEASE, "agent");
            asm volatile("s_waitcnt vmcnt(0)" ::: "memory");
            const unsigned og = xb_add(&bar[XB_TOP], 1u);
            const unsigned tg = og / nx;
            if (og + 1u == (tg + 1u) * nx) xb_add(&bar[XB_TOPGEN], 1u);
            else XB_SPIN(xb_ld(&bar[XB_TOPGEN]) == tg, bar);
            __builtin_amdgcn_fence(__ATOMIC_ACQUIRE, "agent");
            xb_add(&bar[XB_XGEN(bx)], 1u);
            asm volatile("s_waitcnt vmcnt(0)" ::: "memory");
        } else {
            XB_SPIN(xb_ld(&bar[XB_XGEN(bx)]) == gen, bar);
            __builtin_amdgcn_fence(__ATOMIC_ACQUIRE, "agent");
            asm volatile("s_waitcnt vmcnt(0)" ::: "memory");
        }
    }
    __syncthreads();
}


#if ONE_LAUNCH
constexpr int TAB_OFF = 131072, MISC_OFF = 131072 + 512;
__global__ void __launch_bounds__(NT, 2) mega_fwd(Params P) {
    extern __shared__ __attribute__((aligned(16))) unsigned char dyn_lds[];
    LAS unsigned char* lds = (LAS unsigned char*)dyn_lds;
    volatile LAS unsigned* MISC = (volatile LAS unsigned*)(lds + MISC_OFF);
    if (threadIdx.x < 32) MISC[threadIdx.x] = 0u;
    __syncthreads();
    XcdBarrier bar = xcd_barrier_post((unsigned*)(P.ws + WS_CTL) + CW_BAR, MISC + 8);
    const int bid = blockIdx.x, nblk = gridDim.x;
    const int vb = (nblk % 8 == 0) ? (bid % 8) * (nblk / 8) + bid / 8 : bid;
#ifndef REP_P0
#define REP_P0 1
#endif
#ifndef REP_INPROJ
#define REP_INPROJ 1
#endif
#ifndef REP_ATTN
#define REP_ATTN 1
#endif
#ifndef REP_GU
#define REP_GU 1
#endif
#ifndef REP_DOWN
#define REP_DOWN 1
#endif
    for (int r = 0; r < REP_P0; ++r) { p0_prologue(P, lds, bid, nblk); xcd_barrier(bar); }
    for (int l = 0; l < DEPTH; ++l) {
        if (l == 0) norm1_phase<0>(P, l, bid, nblk); else norm1_phase<1>(P, l, bid, nblk);
        xcd_barrier(bar);
        for (int r = 0; r < REP_INPROJ; ++r) { inproj_phase(P, lds, l, vb, nblk); xcd_barrier(bar); }
        for (int r = 0; r < REP_ATTN; ++r) { attn_phase(P, lds, l, bid, nblk); xcd_barrier(bar); }
        outproj_phase(P, lds, l, vb, nblk);
        xcd_barrier(bar);
        router_phase(P, lds, l, bid, nblk);
        xcd_barrier(bar);
        place_phase(P, lds, l, bid, nblk);
        xcd_barrier(bar);
        for (int r = 0; r < REP_GU; ++r) { gu_phase(P, lds, l, vb, nblk); xcd_barrier(bar); }
        for (int r = 0; r < REP_DOWN; ++r) { down_phase(P, lds, l, vb, nblk); xcd_barrier(bar); }
    }
    norm1_phase<2>(P, 0, bid, nblk);
}
#else
extern __shared__ __attribute__((aligned(16))) unsigned char dyn_lds[];
#define KLDS ((LAS unsigned char*)dyn_lds)
__global__ void __launch_bounds__(NT, 2) k_prologue(Params P) { p0_prologue(P, KLDS, blockIdx.x, gridDim.x); }
__global__ void __launch_bounds__(NT, 2) k_norm1_0(Params P, int l) { norm1_phase<0>(P, l, blockIdx.x, gridDim.x); }
__global__ void __launch_bounds__(NT, 2) k_norm1_1(Params P, int l) { norm1_phase<1>(P, l, blockIdx.x, gridDim.x); }
__global__ void __launch_bounds__(NT, 2) k_final(Params P) { norm1_phase<2>(P, 0, blockIdx.x, gridDim.x); }
__global__ void __launch_bounds__(NT, 2) k_inproj(Params P, int l) { inproj_phase(P, KLDS, l, blockIdx.x, gridDim.x); }
__global__ void __launch_bounds__(NT, 2) k_attn(Params P, int l) { attn_phase(P, KLDS, l, blockIdx.x, gridDim.x); }
__global__ void __launch_bounds__(NT, 2) k_outproj(Params P, int l) { outproj_phase(P, KLDS, l, blockIdx.x, gridDim.x); }
__global__ void __launch_bounds__(NT, 2) k_router(Params P, int l) { router_phase(P, KLDS, l, blockIdx.x, gridDim.x); }
__global__ void __launch_bounds__(NT, 2) k_place(Params P, int l) { place_phase(P, KLDS, l, blockIdx.x, gridDim.x); }
__global__ void __launch_bounds__(NT, 2) k_gu(Params P, int l) { gu_phase(P, KLDS, l, blockIdx.x, gridDim.x); }
__global__ void __launch_bounds__(NT, 2) k_down(Params P, int l) { down_phase(P, KLDS, l, blockIdx.x, gridDim.x); }

#endif

extern "C" void kernel_launch(void* const* d_in, const int* in_sizes, int n_in, void* d_out, int out_size, void* d_ws, size_t ws_size, hipStream_t stream) {
    static int ready = 0;
    if (ready == 0) {
        if (n_in != 21 || out_size != NTOK * D || ws_size < WS_END) { fprintf(stderr, "kernel_launch: unexpected shapes (n_in %d out %d ws %zu)\n", n_in, out_size, ws_size); ready = -1; return; }
#if ONE_LAUNCH
        const void* ks[] = {(const void*)mega_fwd};
#else
        const void* ks[] = {(const void*)k_prologue, (const void*)k_norm1_0, (const void*)k_norm1_1, (const void*)k_final, (const void*)k_inproj, (const void*)k_attn, (const void*)k_outproj, (const void*)k_router, (const void*)k_gu, (const void*)k_down, (const void*)k_place};
#endif
        for (auto k : ks) if (hipFuncSetAttribute(k, hipFuncAttributeMaxDynamicSharedMemorySize, LDS_BYTES) != hipSuccess) { fprintf(stderr, "kernel_launch: hipFuncSetAttribute failed\n"); ready = -1; return; }
        ready = 1;
    }
    if (ready < 0) return;
    (void)hipMemsetAsync((char*)d_ws + WS_CTL, 0, CTL_ZERO_BYTES, stream);
    Params P{};
    P.x = (const float*)d_in[0]; P.c = (const float*)d_in[1]; P.pos = (const int*)d_in[2]; P.ada_w = (const float*)d_in[3]; P.ada_b = (const float*)d_in[4]; P.n1g = (const float*)d_in[5];
    P.w_in = (const float*)d_in[6]; P.qg = (const float*)d_in[7]; P.kg = (const float*)d_in[8]; P.sinks = (const float*)d_in[9]; P.pool_w = (const float*)d_in[10]; P.pool_b = (const float*)d_in[11];
    P.pool_s = (const float*)d_in[12]; P.w_out = (const float*)d_in[13]; P.n2g = (const float*)d_in[14]; P.rw = (const float*)d_in[15]; P.rb = (const float*)d_in[16]; P.wgu = (const float*)d_in[17];
    P.bgu = (const float*)d_in[18]; P.wdn = (const float*)d_in[19]; P.bdn = (const float*)d_in[20]; P.out = (float*)d_out; P.ws = (unsigned char*)d_ws;
    const dim3 g(256), b(NT);
#if ONE_LAUNCH
    hipLaunchKernelGGL(mega_fwd, g, b, LDS_BYTES, stream, P);
#else
    hipLaunchKernelGGL(k_prologue, g, b, LDS_BYTES, stream, P);
    for (int l = 0; l < DEPTH; ++l) {
        if (l == 0) hipLaunchKernelGGL(k_norm1_0, g, b, LDS_BYTES, stream, P, l); else hipLaunchKernelGGL(k_norm1_1, g, b, LDS_BYTES, stream, P, l);
        hipLaunchKernelGGL(k_inproj, g, b, LDS_BYTES, stream, P, l);
        hipLaunchKernelGGL(k_attn, g, b, LDS_BYTES, stream, P, l);
        hipLaunchKernelGGL(k_outproj, g, b, LDS_BYTES, stream, P, l);
        hipLaunchKernelGGL(k_router, g, b, LDS_BYTES, stream, P, l);
        hipLaunchKernelGGL(k_place, g, b, LDS_BYTES, stream, P, l);
        hipLaunchKernelGGL(k_gu, g, b, LDS_BYTES, stream, P, l);
        hipLaunchKernelGGL(k_down, g, b, LDS_BYTES, stream, P, l);
    }
    hipLaunchKernelGGL(k_final, g, b, LDS_BYTES, stream, P);
#endif
}
```

```cpp
#include <hip/hip_runtime.h>
#include <cstdio>
#include <cstdint>

#ifndef ONE_LAUNCH
#define ONE_LAUNCH 1
#endif

#define LAS __attribute__((address_space(3)))
typedef unsigned short bf16;
typedef short bf16x8 __attribute__((ext_vector_type(8)));
typedef short s16x4 __attribute__((ext_vector_type(4)));
typedef float f32x4 __attribute__((ext_vector_type(4)));
typedef float f32x16 __attribute__((ext_vector_type(16)));
typedef unsigned u32x4 __attribute__((ext_vector_type(4)));
typedef unsigned u32x2 __attribute__((ext_vector_type(2)));
typedef float f32x2 __attribute__((ext_vector_type(2)));
typedef int i32x4 __attribute__((ext_vector_type(4)));
typedef int i32x8 __attribute__((ext_vector_type(8)));

constexpr int D = 1024, NB = 8, SEQ = 8192, NTOK = NB * SEQ, DEPTH = 2, NE = 32, NIN = 1280, NMOD = 6 * D;
constexpr int NT = 512;
constexpr float EPS = 1e-6f;
constexpr float LOG2E = 1.4426950408889634f;
constexpr float QSCALE = 0.18033688011112042f;
constexpr int MAXTILES = NTOK * 4 / 256 + NE;

constexpr size_t MiB = 1u << 20;
constexpr size_t WS_CTL = 0, CTL_ZERO_BYTES = 1 * MiB;
constexpr size_t WS_MOD = 1 * MiB;
constexpr size_t WS_ROPE = 2 * MiB;
constexpr size_t WS_WIN = 8 * MiB;
constexpr size_t WS_WIN8 = 14 * MiB;
constexpr size_t WS_WOUT = 16 * MiB;
constexpr size_t WS_GATES = 20 * MiB;
constexpr size_t WS_SEL = 21 * MiB;
constexpr size_t WS_CNTB = 22 * MiB;
constexpr size_t WS_TOT = 23 * MiB;
constexpr size_t WS_LIST = 24 * MiB;
constexpr size_t WS_WGU = 32 * MiB;
constexpr size_t WS_WDN = 160 * MiB;
constexpr size_t WS_H = 224 * MiB;
constexpr size_t WS_H8 = 352 * MiB;
constexpr size_t WS_PROJ = 416 * MiB;
constexpr size_t WS_MIX = 576 * MiB;
constexpr size_t WS_ACT = 416 * MiB;
constexpr size_t WS_YBUF = 704 * MiB;
constexpr size_t WS_XB = 960 * MiB;
constexpr size_t WS_END = 1088 * MiB;
static_assert(WS_ACT + (size_t)MAXTILES * 256 * 1024 <= WS_YBUF, "act fits");
constexpr float MIXSCALE = 8.0f;
constexpr float WSCALE = 32.0f, WUNSCALE = 1.0f / 32.0f;
constexpr int CW_BAR = 4096;
constexpr int CW_CNT = 8192;

constexpr int LDS_BYTES = 147456;
constexpr int AUX_OFF = 131072 + 2048;
constexpr int LSTAGE_OFF = 131072 + 1024;

struct Params {
    const float *x, *c; const int* pos; const float *ada_w, *ada_b, *n1g, *w_in, *qg, *kg, *sinks, *pool_w, *pool_b, *pool_s, *w_out, *n2g, *rw, *rb, *wgu, *bgu, *wdn, *bdn;
    float* out; unsigned char* ws;
};

__device__ __forceinline__ unsigned cvt_pk_bf16(float lo, float hi) { unsigned r; asm("v_cvt_pk_bf16_f32 %0, %1, %2" : "=v"(r) : "v"(lo), "v"(hi)); return r; }
__device__ __forceinline__ unsigned cvt_pk4_fp8(float a, float b, float c, float d) { int w = 0; w = __builtin_amdgcn_cvt_pk_fp8_f32(a, b, w, false); w = __builtin_amdgcn_cvt_pk_fp8_f32(c, d, w, true); return (unsigned)w; }
__device__ __forceinline__ float bf_lo(unsigned w) { return __uint_as_float(w << 16); }
__device__ __forceinline__ float bf_hi(unsigned w) { return __uint_as_float(w & 0xffff0000u); }
template <int M> __device__ __forceinline__ float swz_xor(float v) { return __int_as_float(__builtin_amdgcn_ds_swizzle(__float_as_int(v), (M << 10) | 0x1f)); }
__device__ __forceinline__ float sum_x32(float v) { const auto r = __builtin_amdgcn_permlane32_swap(__float_as_uint(v), __float_as_uint(v), false, false); return __uint_as_float(r[0]) + __uint_as_float(r[1]); }
__device__ __forceinline__ float max_x32(float v) { const auto r = __builtin_amdgcn_permlane32_swap(__float_as_uint(v), __float_as_uint(v), false, false); return fmaxf(__uint_as_float(r[0]), __uint_as_float(r[1])); }
__device__ __forceinline__ float sum_x16(float v) { const auto r = __builtin_amdgcn_permlane16_swap(__float_as_uint(v), __float_as_uint(v), false, false); return __uint_as_float(r[0]) + __uint_as_float(r[1]); }
__device__ __forceinline__ float get_x16(float v, bool rowodd) { const auto r = __builtin_amdgcn_permlane16_swap(__float_as_uint(v), __float_as_uint(v), false, false); return __uint_as_float(rowodd ? r[0] : r[1]); }
template <int CTRL> __device__ __forceinline__ float dpp_f(float v) { return __int_as_float(__builtin_amdgcn_update_dpp(0, __float_as_int(v), CTRL, 0xF, 0xF, true)); }
__device__ __forceinline__ float wave_sum(float v) {
    v += dpp_f<0xB1>(v); v += dpp_f<0x4E>(v); v += dpp_f<0x141>(v); v += dpp_f<0x140>(v); v = sum_x16(v);
    return sum_x32(v);
}
__device__ __forceinline__ int dpp_swap1(int v) { return __builtin_amdgcn_update_dpp(0, v, 0xB1, 0xF, 0xF, true); }
__device__ __forceinline__ u32x4 dpp_swap1(u32x4 v) { u32x4 r; r.x = (unsigned)dpp_swap1((int)v.x); r.y = (unsigned)dpp_swap1((int)v.y); r.z = (unsigned)dpp_swap1((int)v.z); r.w = (unsigned)dpp_swap1((int)v.w); return r; }
__device__ __forceinline__ void store_line_pair(unsigned char* own_line, unsigned char* nb_line, bool own_valid, bool nb_valid, u32x4 lo, u32x4 hi, int fq, bool odd) {
    const u32x4 got = dpp_swap1(odd ? lo : hi);
    const int off = (odd ? 64 : 0) + 16 * fq;
    if (odd ? nb_valid : own_valid) *(u32x4*)((odd ? nb_line : own_line) + off) = odd ? got : lo;
    if (odd ? own_valid : nb_valid) *(u32x4*)((odd ? own_line : nb_line) + off) = odd ? hi : got;
}
__device__ __forceinline__ void load_line_pair(const unsigned char* own_line, const unsigned char* nb_line, int fq, bool odd, u32x4& lo, u32x4& hi) {
    const int off = (odd ? 64 : 0) + 16 * fq;
    const u32x4 a = *(const u32x4*)((odd ? nb_line : own_line) + off), b = *(const u32x4*)((odd ? own_line : nb_line) + off);
    const u32x4 got = dpp_swap1(odd ? a : b);
    lo = odd ? got : a; hi = odd ? b : got;
}
__device__ __forceinline__ int lperm(int r) { return (r & 63) * 4 + (r >> 6); }
__device__ __forceinline__ int perm32(int rho) { const int n = rho >> 4, i = rho & 15; return 8 * (i >> 2) + 4 * n + (i & 3); }
__device__ __forceinline__ int opaque_tid() { int t = threadIdx.x; asm volatile("" : "+v"(t)); return t; }

__device__ __forceinline__ void tr_item_src(const Params& P, int it, const float*& src, int& ldw, bf16*& dst, int& k0, int& n0, bool& f8) {
    f8 = true;
    unsigned char* ws = P.ws;
    if (it < 8192) { const int m = it >> 7, r = it & 127; src = P.wgu + (size_t)m * (1024 * 2048); ldw = 2048; dst = (bf16*)(ws + WS_WGU + (size_t)m * (2048 * 1024)); k0 = 128 * (r >> 4); n0 = 128 * (r & 15); return; }
    it -= 8192;
    if (it < 4096) { const int m = it >> 6, r = it & 63; src = P.wdn + (size_t)m * (1024 * 1024); ldw = 1024; dst = (bf16*)(ws + WS_WDN + (size_t)m * (1024 * 1024)); k0 = 128 * (r >> 3); n0 = 128 * (r & 7); return; }
    it -= 4096;
    if (it < 96) { const int l = it / 48, r = it % 48; src = P.w_in + (size_t)l * (1024 * 1280); ldw = 1280; dst = (bf16*)(ws + WS_WIN8 + (size_t)l * (768 * 1024)); k0 = 128 * (r / 6); n0 = 128 * (r % 6); return; }
    it -= 96;
    { const int l = it >> 6, r = it & 63; src = P.w_out + (size_t)l * (1024 * 1024); ldw = 1024; dst = (bf16*)(ws + WS_WOUT + (size_t)l * (1024 * 1024)); k0 = 128 * (r >> 3); n0 = 128 * (r & 7); }
}
constexpr int N_TR_ITEMS = 8192 + 4096 + 96 + 128;

__device__ __forceinline__ void p0_prologue(const Params& P, LAS unsigned char* lds, int bid, int nblk) {
    const int tid = opaque_tid(), wid = __builtin_amdgcn_readfirstlane(tid >> 6), lane = tid & 63;
    unsigned char* ws = P.ws;
    {
        LAS float* cact = (LAS float*)lds;
        LAS float* red = (LAS float*)(lds + 32768);
        if (bid < 192 || nblk < 192) {
            for (int i = tid; i < NB * D; i += NT) { const float v = P.c[i]; cact[i] = v / (1.0f + __expf(-v)); }
            __syncthreads();
            for (int it = bid; it < 192; it += nblk) {
                const int l = it / 96, n0 = 64 * (it % 96);
                float acc[NB];
#pragma unroll
                for (int b = 0; b < NB; ++b) acc[b] = 0.f;
                const float* wp = P.ada_w + (size_t)l * D * NMOD + n0 + lane;
                for (int k = 128 * wid; k < 128 * wid + 128; k += 16) {
                    float wv[16];
#pragma unroll
                    for (int q = 0; q < 16; ++q) wv[q] = wp[(size_t)(k + q) * NMOD];
#pragma unroll
                    for (int q = 0; q < 16; ++q)
#pragma unroll
                        for (int b = 0; b < NB; ++b) acc[b] += cact[b * D + k + q] * wv[q];
                }
#pragma unroll
                for (int b = 0; b < NB; ++b) red[(wid * NB + b) * 64 + lane] = acc[b];
                __syncthreads();
                { const int b = tid >> 6; float s = P.ada_b[l * NMOD + n0 + lane];
#pragma unroll
                  for (int w = 0; w < 8; ++w) s += red[(w * NB + b) * 64 + lane];
                  ((float*)(ws + WS_MOD))[(size_t)(l * NB + b) * NMOD + n0 + lane] = s; }
                __syncthreads();
            }
        }
    }
    for (int it = bid; it < 128; it += nblk) {
        const int l = it >> 6, g = (it >> 4) & 3, k0 = 64 * (it & 15);
        LAS float* At = (LAS float*)lds;
        LAS float* Pw = (LAS float*)(lds + 33024);
        __syncthreads();
        for (int j = 0; j < 16; ++j) { const int idx = tid + NT * j, k = idx >> 7, c = idx & 127; At[k * 129 + c] = P.w_in[(size_t)l * (1024 * 1280) + (size_t)(k0 + k) * 1280 + 768 + 128 * g + c]; }
        for (int j = 0; j < 32; ++j) { const int idx = tid + NT * j; Pw[idx] = P.pool_w[(size_t)(l * 4 + g) * 16384 + idx]; }
        __syncthreads();
        const int n = tid & 127, ks = tid >> 7;
        float acc[16];
#pragma unroll
        for (int i = 0; i < 16; ++i) acc[i] = 0.f;
        for (int c = 0; c < 128; ++c) { const float pw = Pw[c * 128 + n];
#pragma unroll
            for (int i = 0; i < 16; ++i) acc[i] += At[(16 * ks + i) * 129 + c] * pw; }
        bf16* dst = (bf16*)(ws + WS_WIN) + (size_t)l * (1280 * 1024) + (size_t)(768 + 128 * g + n) * 1024 + k0 + 16 * ks;
        u32x4 o0, o1;
        o0.x = cvt_pk_bf16(acc[0], acc[1]); o0.y = cvt_pk_bf16(acc[2], acc[3]); o0.z = cvt_pk_bf16(acc[4], acc[5]); o0.w = cvt_pk_bf16(acc[6], acc[7]);
        o1.x = cvt_pk_bf16(acc[8], acc[9]); o1.y = cvt_pk_bf16(acc[10], acc[11]); o1.z = cvt_pk_bf16(acc[12], acc[13]); o1.w = cvt_pk_bf16(acc[14], acc[15]);
        *(u32x4*)dst = o0; *(u32x4*)(dst + 8) = o1;
    }
    {
        const double invf[8] = {1.0, 0.19392274474868576, 0.03760603093086393, 0.007292664737217109, 0.001414213562373095, 0.0002742481756762073, 5.318295896944988e-05, 1.031338537721246e-05};
        float* rope = (float*)(ws + WS_ROPE);
        for (int idx = bid * NT + tid; idx < NTOK * 8; idx += nblk * NT) {
            const int tok = idx >> 3, i = idx & 7;
            double f = 1.0;
#pragma unroll
            for (int q = 0; q < 8; ++q) f = (i == q) ? invf[q] : f;
            const double ang = (double)P.pos[tok] * f;
            const double kq = __builtin_rint(ang * 0.6366197723675814);
            const double r = (ang - kq * 1.5707963267948966) - kq * 6.123233995736766e-17;
            const double r2 = r * r;
            double sn = r * (1.0 + r2 * (-1.0 / 6 + r2 * (1.0 / 120 + r2 * (-1.0 / 5040 + r2 * (1.0 / 362880 + r2 * (-1.0 / 39916800 + r2 * (1.0 / 6227020800.0)))))));
            double cs = 1.0 + r2 * (-0.5 + r2 * (1.0 / 24 + r2 * (-1.0 / 720 + r2 * (1.0 / 40320 + r2 * (-1.0 / 3628800 + r2 * (1.0 / 479001600.0 + r2 * (-1.0 / 87178291200.0)))))));
            const int q = ((int)(long long)kq) & 3;
            double s2 = (q & 1) ? cs : sn, c2 = (q & 1) ? sn : cs;
            if (q == 1 || q == 2) c2 = -c2;
            if (q >= 2) s2 = -s2;
            rope[tok * 16 + i] = (float)c2; rope[tok * 16 + 8 + i] = (float)s2;
        }
    }
    {
        LAS float* tile = (LAS float*)lds;
        __syncthreads();
        f32x4 r[8];
        const float* src; int ldw, k0, n0; bf16* dst; bool f8;
        int it = bid;
        if (it < N_TR_ITEMS) { tr_item_src(P, it, src, ldw, dst, k0, n0, f8);
#pragma unroll
            for (int j = 0; j < 8; ++j) { const int idx = tid + NT * j, row = idx >> 5, c4 = idx & 31; r[j] = *(const f32x4*)(src + (size_t)(k0 + row) * ldw + n0 + 4 * c4); } }
        for (; it < N_TR_ITEMS; it += nblk) {
#pragma unroll
            for (int j = 0; j < 8; ++j) { const int idx = tid + NT * j, row = idx >> 5, c4 = idx & 31; LAS float* t = tile + row * 129 + (row >> 5) * 8 + 4 * c4; t[0] = r[j].x; t[1] = r[j].y; t[2] = r[j].z; t[3] = r[j].w; }
            __syncthreads();
            bf16* cdst = dst; const int ck0 = k0, cn0 = n0;
            if (it + nblk < N_TR_ITEMS) { tr_item_src(P, it + nblk, src, ldw, dst, k0, n0, f8);
#pragma unroll
                for (int j = 0; j < 8; ++j) { const int idx = tid + NT * j, row = idx >> 5, c4 = idx & 31; r[j] = *(const f32x4*)(src + (size_t)(k0 + row) * ldw + n0 + 4 * c4); } }
            const int n = tid >> 2, c = tid & 3;
            const LAS float* t = tile + (32 * c) * 129 + c * 8 + n;
            {
                u32x4 o[2];
#pragma unroll
                for (int h = 0; h < 2; ++h) {
                    float v[16];
#pragma unroll
                    for (int i = 0; i < 16; ++i) v[i] = t[(16 * h + i) * 129] * WSCALE;
                    o[h].x = cvt_pk4_fp8(v[0], v[1], v[2], v[3]); o[h].y = cvt_pk4_fp8(v[4], v[5], v[6], v[7]); o[h].z = cvt_pk4_fp8(v[8], v[9], v[10], v[11]); o[h].w = cvt_pk4_fp8(v[12], v[13], v[14], v[15]);
                }
                unsigned char* op = (unsigned char*)cdst + (size_t)(cn0 + n) * 1024 + ck0 + 32 * c;
                *(u32x4*)op = o[0]; *(u32x4*)(op + 16) = o[1];
            }
            __syncthreads();
        }
    }
}

template <int MODE>
__device__ __forceinline__ void norm1_phase(const Params& P, int l, int bid, int nblk) {
    const int tid = opaque_tid(), wid = __builtin_amdgcn_readfirstlane(tid >> 6), lane = tid & 63;
    unsigned char* ws = P.ws;
    const float* mod = (const float*)(ws + WS_MOD);
    bf16* XB = (bf16*)(ws + WS_XB);
    bf16* H = (bf16*)(ws + WS_H);
    unsigned char* H8 = ws + WS_H8;
    const float* gates = (const float*)(ws + WS_GATES);
    const unsigned char* Y = ws + WS_YBUF;
    for (int ch = bid * 8 + wid; ch < NTOK / 32; ch += nblk * 8) {
        const int b = (ch * 32) >> 13;
        f32x4 ca[4], cc[4], cg[4];
#pragma unroll
        for (int j = 0; j < 4; ++j) {
            const int col = 256 * j + 4 * lane;
            if (MODE <= 1) { const f32x4 g = *(const f32x4*)(P.n1g + l * D + col); const f32x4 sc = *(const f32x4*)(mod + (size_t)(l * NB + b) * NMOD + 1 * D + col);
                ca[j] = g * (1.0f + sc); cc[j] = *(const f32x4*)(mod + (size_t)(l * NB + b) * NMOD + 0 * D + col); }
            if (MODE >= 1) { const int lp = (MODE == 2) ? (DEPTH - 1) : (l - 1); cg[j] = *(const f32x4*)(mod + (size_t)(lp * NB + b) * NMOD + 5 * D + col); }
        }
        for (int rr = 0; rr < 32; ++rr) {
            const int row = ch * 32 + rr;
            f32x4 v[4];
            if (MODE == 0) {
#pragma unroll
                for (int j = 0; j < 4; ++j) v[j] = *(const f32x4*)(P.x + (size_t)row * D + 256 * j + 4 * lane);
            } else {
#pragma unroll
                for (int j = 0; j < 4; ++j) { const u32x2 xw = *(const u32x2*)(XB + (size_t)row * D + 256 * j + 4 * lane); v[j] = (f32x4){bf_lo(xw.x), bf_hi(xw.x), bf_lo(xw.y), bf_hi(xw.y)}; }
            }
            if (MODE >= 1) {
                const f32x4 gt = *(const f32x4*)(gates + (size_t)row * 4);
                f32x4 a[4];
#pragma unroll
                for (int j = 0; j < 4; ++j) a[j] = (f32x4){0.f, 0.f, 0.f, 0.f};
#pragma unroll
                for (int k = 0; k < 4; ++k) {
                    const float gk = gt[k];
#pragma unroll
                    for (int j = 0; j < 4; ++j) { const unsigned y = *(const unsigned*)(Y + ((size_t)row * 4 + k) * D + 256 * j + 4 * lane);
                        const f32x2 p0 = __builtin_amdgcn_cvt_pk_f32_fp8((int)y, false), p1 = __builtin_amdgcn_cvt_pk_f32_fp8((int)y, true);
                        a[j].x += gk * p0.x; a[j].y += gk * p0.y; a[j].z += gk * p1.x; a[j].w += gk * p1.y; }
                }
#pragma unroll
                for (int j = 0; j < 4; ++j) { v[j] += cg[j] * a[j];
                    if (MODE == 2) *(f32x4*)(P.out + (size_t)row * D + 256 * j + 4 * lane) = v[j];
                    else { u32x2 xo; xo.x = cvt_pk_bf16(v[j].x, v[j].y); xo.y = cvt_pk_bf16(v[j].z, v[j].w); *(u32x2*)(XB + (size_t)row * D + 256 * j + 4 * lane) = xo; } }
            }
            if (MODE <= 1) {
                float ss = 0.f;
#pragma unroll
                for (int j = 0; j < 4; ++j) ss += (v[j].x * v[j].x + v[j].y * v[j].y) + (v[j].z * v[j].z + v[j].w * v[j].w);
                const float rstd = 1.0f / sqrtf(wave_sum(ss) * (1.0f / D) + EPS);
#pragma unroll
                for (int j = 0; j < 4; ++j) { const f32x4 h = v[j] * rstd * ca[j] + cc[j]; u32x2 o; o.x = cvt_pk_bf16(h.x, h.y); o.y = cvt_pk_bf16(h.z, h.w);
                    *(u32x2*)(H + (size_t)row * D + 256 * j + 4 * lane) = o; *(unsigned*)(H8 + (size_t)row * D + 256 * j + 4 * lane) = cvt_pk4_fp8(h.x, h.y, h.z, h.w); }
            }
        }
    }
}

struct Unit { int pm, pn, e, nrows, tbase, ks; };
typedef f32x4 Acc[2][2][4][2];

template <class Pb>
__device__ __forceinline__ void gemm_simple(LAS unsigned char* lds, const Pb& pb, int bid, int nblk) {
    const int tid = opaque_tid(), wid = __builtin_amdgcn_readfirstlane(tid >> 6), lane = tid & 63, wr = wid >> 2, wc = wid & 3, fr = lane & 15, fq = lane >> 4;
    constexpr int PITCH = 144;
    LAS unsigned char* sA = lds; LAS unsigned char* sB = lds + 256 * PITCH;
    Unit u;
    for (int i = 0; pb.next(i, bid, nblk, u); ++i) {
        Acc acc;
#pragma unroll
        for (int a = 0; a < 2; ++a)
#pragma unroll
            for (int b = 0; b < 2; ++b)
#pragma unroll
                for (int m = 0; m < 4; ++m)
#pragma unroll
                    for (int n = 0; n < 2; ++n) acc[a][b][m][n] = (f32x4){0.f, 0.f, 0.f, 0.f};
        unsigned ao[4], bo[4];
#pragma unroll
        for (int j = 0; j < 4; ++j) { const int q = tid + NT * j, row = q >> 3, c8 = q & 7;
            ao[j] = (unsigned)pb.a_row(u, row) * (unsigned)(pb.K * 2) + c8 * 16; bo[j] = (unsigned)pb.b_row(u, row) * (unsigned)(pb.K * 2) + c8 * 16; }
        for (int kt = 0; kt < pb.K / 64; ++kt) {
            u32x4 ra[4], rb[4];
#pragma unroll
            for (int j = 0; j < 4; ++j) { ra[j] = *(const u32x4*)(pb.A + ao[j] + kt * 128); rb[j] = *(const u32x4*)(pb.B + bo[j] + kt * 128); }
            __syncthreads();
#pragma unroll
            for (int j = 0; j < 4; ++j) { const int q = tid + NT * j, row = q >> 3, c8 = q & 7; *(LAS u32x4*)(sA + row * PITCH + c8 * 16) = ra[j]; *(LAS u32x4*)(sB + row * PITCH + c8 * 16) = rb[j]; }
            __syncthreads();
#pragma unroll
            for (int kk = 0; kk < 2; ++kk) {
                bf16x8 bfr[2][2];
#pragma unroll
                for (int b = 0; b < 2; ++b)
#pragma unroll
                    for (int n = 0; n < 2; ++n) bfr[b][n] = *(const LAS bf16x8*)(sB + (128 * b + 32 * wc + 16 * n + fr) * PITCH + (kk * 32 + fq * 8) * 2);
#pragma unroll
                for (int a = 0; a < 2; ++a) {
                    bf16x8 af[4];
#pragma unroll
                    for (int m = 0; m < 4; ++m) af[m] = *(const LAS bf16x8*)(sA + (128 * a + 64 * wr + 16 * m + fr) * PITCH + (kk * 32 + fq * 8) * 2);
#pragma unroll
                    for (int b = 0; b < 2; ++b)
#pragma unroll
                        for (int m = 0; m < 4; ++m)
#pragma unroll
                            for (int n = 0; n < 2; ++n) acc[a][b][m][n] = __builtin_amdgcn_mfma_f32_16x16x32_bf16(bfr[b][n], af[m], acc[a][b][m][n], 0, 0, 0);
                }
            }
        }
        pb.epi(acc, u, lds + AUX_OFF);
    }
    __syncthreads();
}

template <bool F8_> struct PbInProjT {
    static constexpr bool GATHER = false; __device__ __forceinline__ const int* list_block(const Unit&) const { return nullptr; }
    static constexpr bool F8 = F8_, AUX = false;
    const char* A; const char* B; int K;
    bf16* proj; const float* qg; const float* kg; const float* rope;
    __device__ __forceinline__ bool next(int i, int bid, int nblk, Unit& u) const { const int L = i * nblk + bid; u.e = 0; u.nrows = 256; u.tbase = 0; u.ks = 0;
        if (F8_) { if (L >= 256 * 3) return false; u.pm = L / 3; u.pn = L % 3; } else { if (L >= 256 * 2) return false; u.pm = L >> 1; u.pn = 3 + (L & 1); }
        return true; }
    __device__ __forceinline__ int a_row(const Unit& u, int r) const { return 256 * u.pm + r; }
    __device__ __forceinline__ void a_rows4(const Unit& u, int r0, int (&rows)[4]) const { for (int j = 0; j < 4; ++j) rows[j] = 256 * u.pm + r0 + 64 * j; }
    __device__ __forceinline__ int4 a_rows_raw(const Unit&, int) const { return make_int4(0, 0, 0, 0); }
    __device__ __forceinline__ void a_rows_fin(const Unit& u, int r0, const int4&, int (&rows)[4]) const { a_rows4(u, r0, rows); }
    __device__ __forceinline__ int b_rowc(int rho) const { return 64 * ((rho >> 5) & 3) + 32 * (rho >> 7) + perm32(rho & 31); }
    __device__ __forceinline__ int b_base_row(const Unit& u) const { return 256 * u.pn; }
    __device__ __forceinline__ int b_row(const Unit& u, int rho) const { return b_base_row(u) + b_rowc(rho); }
    __device__ __forceinline__ void epi(const Acc& acc, const Unit& u, const LAS unsigned char* aux) const {
        const int t_ = opaque_tid(), w_ = __builtin_amdgcn_readfirstlane(t_ >> 6), wr = w_ >> 2, wc = w_ & 3, fr = t_ & 15, fq = (t_ >> 4) & 3;
        const int hg = 4 * u.pn + wc;
        const bool nrm = F8_ && hg < 10;
        constexpr float US = F8_ ? WUNSCALE : 1.0f;
        const float* gsrc = (hg < 8) ? qg : kg;
        f32x4 gv[2][2];
#pragma unroll
        for (int bj = 0; bj < 2; ++bj)
#pragma unroll
            for (int n = 0; n < 2; ++n) gv[bj][n] = nrm ? *(const f32x4*)(gsrc + 32 * bj + 8 * fq + 4 * n) * US : (f32x4){1.f, 1.f, 1.f, 1.f};
        const float qs = (hg < 8) ? QSCALE : (nrm ? 1.0f : US);
#pragma unroll
        for (int q = 0; q < 4; ++q) {
            const int ai = q >> 1, m0 = 2 * (q & 1);
            f32x4 rcs[2][2], rsn[2][2];
            if (nrm && fq < 2) {
#pragma unroll
                for (int mm = 0; mm < 2; ++mm) { const float* rp = rope + (size_t)(256 * u.pm + 128 * ai + 64 * wr + 16 * (m0 + mm) + fr) * 16;
#pragma unroll
                    for (int n = 0; n < 2; ++n) { rcs[mm][n] = *(const f32x4*)(rp + 4 * n); rsn[mm][n] = *(const f32x4*)(rp + 8 + 4 * n); } }
            }
#pragma unroll
            for (int mm = 0; mm < 2; ++mm) {
                const int m = m0 + mm;
                const int row = 256 * u.pm + 128 * ai + 64 * wr + 16 * m + fr;
                f32x4 v[2][2];
#pragma unroll
                for (int bj = 0; bj < 2; ++bj)
#pragma unroll
                    for (int n = 0; n < 2; ++n) v[bj][n] = acc[ai][bj][m][n];
                if (nrm) {
                    float ss = 0.f;
#pragma unroll
                    for (int bj = 0; bj < 2; ++bj)
#pragma unroll
                        for (int n = 0; n < 2; ++n) ss += (v[bj][n].x * v[bj][n].x + v[bj][n].y * v[bj][n].y) + (v[bj][n].z * v[bj][n].z + v[bj][n].w * v[bj][n].w);
                    ss = sum_x16(ss); ss = sum_x32(ss);
                    const float rstd = __builtin_amdgcn_rsqf(ss * (US * US / 64.0f) + EPS);
#pragma unroll
                    for (int bj = 0; bj < 2; ++bj)
#pragma unroll
                        for (int n = 0; n < 2; ++n) v[bj][n] = v[bj][n] * rstd * gv[bj][n];
#pragma unroll
                    for (int n = 0; n < 2; ++n) {
                        f32x4 pr;
                        pr.x = get_x16(v[0][n].x, fq & 1); pr.y = get_x16(v[0][n].y, fq & 1); pr.z = get_x16(v[0][n].z, fq & 1); pr.w = get_x16(v[0][n].w, fq & 1);
                        if (fq < 2) v[0][n] = (fq == 0) ? (v[0][n] * rcs[mm][n] - pr * rsn[mm][n]) : (v[0][n] * rcs[mm][n] + pr * rsn[mm][n]);
                    }
                }
                u32x4 o[2];
#pragma unroll
                for (int bj = 0; bj < 2; ++bj) {
                    o[bj].x = cvt_pk_bf16(v[bj][0].x * qs, v[bj][0].y * qs); o[bj].y = cvt_pk_bf16(v[bj][0].z * qs, v[bj][0].w * qs);
                    o[bj].z = cvt_pk_bf16(v[bj][1].x * qs, v[bj][1].y * qs); o[bj].w = cvt_pk_bf16(v[bj][1].z * qs, v[bj][1].w * qs);
                }
                { unsigned char* own = (unsigned char*)(proj + (size_t)row * NIN + 64 * hg); const bool odd = fr & 1;
                  store_line_pair(own, odd ? own - NIN * 2 : own + NIN * 2, true, true, o[0], o[1], fq, odd); }
            }
        }
    }
};

template <bool FIRST> struct PbOutProjT {
    static constexpr bool GATHER = false; __device__ __forceinline__ const int* list_block(const Unit&) const { return nullptr; }
    static constexpr bool F8 = true, AUX = true;
    const char* A; const char* B; int K;
    const float* xin32; bf16* xb; const float* gate1;
    __device__ __forceinline__ bool next(int i, int bid, int nblk, Unit& u) const { const int L = i * nblk + bid; if (L >= 256 * 4) return false; u.pm = L >> 2; u.pn = L & 3; u.e = 0; u.nrows = 256; u.tbase = 0; u.ks = 0; return true; }
    __device__ __forceinline__ int a_row(const Unit& u, int r) const { return 256 * u.pm + r; }
    __device__ __forceinline__ void a_rows4(const Unit& u, int r0, int (&rows)[4]) const { for (int j = 0; j < 4; ++j) rows[j] = 256 * u.pm + r0 + 64 * j; }
    __device__ __forceinline__ int4 a_rows_raw(const Unit&, int) const { return make_int4(0, 0, 0, 0); }
    __device__ __forceinline__ void a_rows_fin(const Unit& u, int r0, const int4&, int (&rows)[4]) const { a_rows4(u, r0, rows); }
    __device__ __forceinline__ int b_rowc(int rho) const { return 64 * ((rho >> 5) & 3) + 32 * (rho >> 7) + perm32(rho & 31); }
    __device__ __forceinline__ int b_base_row(const Unit& u) const { return 256 * u.pn; }
    __device__ __forceinline__ int b_row(const Unit& u, int rho) const { return b_base_row(u) + b_rowc(rho); }
    __device__ __forceinline__ void stage_aux(const Unit& u, LAS unsigned char* aux, int wid, int lane) const {
        if (lane < 8) __builtin_amdgcn_raw_ptr_buffer_load_lds(__builtin_amdgcn_make_buffer_rsrc((void*)(gate1 + (size_t)((256 * u.pm) >> 13) * NMOD + 256 * u.pn), 0, 1024, 0x00020000), (LAS unsigned*)(aux + wid * 128), 16, (wid * 8 + lane) * 16, 0, 0, 0); }
    __device__ __forceinline__ void epi(const Acc& acc, const Unit& u, const LAS unsigned char* aux) const {
        const int t_ = opaque_tid(), w_ = __builtin_amdgcn_readfirstlane(t_ >> 6), wr = w_ >> 2, wc = w_ & 3, fr = t_ & 15, fq = (t_ >> 4) & 3;
        const int colw = 256 * u.pn + 64 * wc;
        const bool odd = fr & 1;
        f32x4 g[2][2];
#pragma unroll
        for (int bj = 0; bj < 2; ++bj)
#pragma unroll
            for (int n = 0; n < 2; ++n) g[bj][n] = *(const LAS f32x4*)(aux + (64 * wc + 32 * bj + 8 * fq + 4 * n) * 4) * (WUNSCALE / MIXSCALE);
        u32x4 raw[2][2][FIRST ? 4 : 2];
#define OP_LOAD(q_) do { _Pragma("unroll") for (int mm = 0; mm < 2; ++mm) { \
            const size_t row = (size_t)(256 * u.pm + 128 * ((q_) >> 1) + 64 * wr + 16 * (2 * ((q_) & 1) + mm) + fr); \
            if (FIRST) { _Pragma("unroll") for (int c = 0; c < 4; ++c) raw[(q_) & 1][mm][c] = *(const u32x4*)(xin32 + row * D + colw + 32 * (c >> 1) + 8 * fq + 4 * (c & 1)); } \
            else { const unsigned char* xi = (const unsigned char*)(xb + row * D + colw); const unsigned char* nb = odd ? xi - D * 2 : xi + D * 2; const int off = (odd ? 64 : 0) + 16 * fq; \
                raw[(q_) & 1][mm][0] = *(const u32x4*)((odd ? nb : xi) + off); raw[(q_) & 1][mm][1] = *(const u32x4*)((odd ? xi : nb) + off); } } } while (0)
        OP_LOAD(0);
#pragma unroll
        for (int q = 0; q < 4; ++q) {
            const int ai = q >> 1, m0 = 2 * (q & 1);
            if (q < 3) OP_LOAD(q + 1);
#pragma unroll
            for (int mm = 0; mm < 2; ++mm) {
                const size_t row = (size_t)(256 * u.pm + 128 * ai + 64 * wr + 16 * (m0 + mm) + fr);
                f32x4 xr[2][2];
                if (FIRST) {
#pragma unroll
                    for (int c = 0; c < 4; ++c) xr[c >> 1][c & 1] = __builtin_bit_cast(f32x4, raw[q & 1][mm][c]);
                } else {
                    const u32x4 a = raw[q & 1][mm][0], bq = raw[q & 1][mm][1];
                    const u32x4 got = dpp_swap1(odd ? a : bq);
                    const u32x4 lo = odd ? got : a, hi = odd ? bq : got;
                    xr[0][0] = (f32x4){bf_lo(lo.x), bf_hi(lo.x), bf_lo(lo.y), bf_hi(lo.y)}; xr[0][1] = (f32x4){bf_lo(lo.z), bf_hi(lo.z), bf_lo(lo.w), bf_hi(lo.w)};
                    xr[1][0] = (f32x4){bf_lo(hi.x), bf_hi(hi.x), bf_lo(hi.y), bf_hi(hi.y)}; xr[1][1] = (f32x4){bf_lo(hi.z), bf_hi(hi.z), bf_lo(hi.w), bf_hi(hi.w)};
                }
                u32x4 o[2];
#pragma unroll
                for (int bj = 0; bj < 2; ++bj) { const f32x4 r0 = xr[bj][0] + g[bj][0] * acc[ai][bj][m0 + mm][0], r1 = xr[bj][1] + g[bj][1] * acc[ai][bj][m0 + mm][1];
                    o[bj].x = cvt_pk_bf16(r0.x, r0.y); o[bj].y = cvt_pk_bf16(r0.z, r0.w); o[bj].z = cvt_pk_bf16(r1.x, r1.y); o[bj].w = cvt_pk_bf16(r1.z, r1.w); }
                unsigned char* xo = (unsigned char*)(xb + row * D + colw);
                store_line_pair(xo, odd ? xo - D * 2 : xo + D * 2, true, true, o[0], o[1], fq, odd);
            }
            asm volatile("" ::: "memory");
        }
#undef OP_LOAD
    }
};

struct MoeTab { const LAS int* cnt; const LAS int* tp; };
__device__ __forceinline__ void moe_build_tab(LAS int* tab, const int* tot) {
    if (threadIdx.x == 0) { int t = 0; for (int e = 0; e < NE; ++e) { const int c = tot[e]; tab[e] = c; tab[32 + e] = t; t += (c + 255) >> 8; } tab[64] = t; }
    __syncthreads();
}
__device__ __forceinline__ bool moe_unit(const LAS int* tab, int L, int ntn, Unit& u) {
    const int gt = L / ntn; if (gt >= __builtin_amdgcn_readfirstlane(tab[64])) return false;
    const int ln = (int)__builtin_amdgcn_mbcnt_hi(~0u, __builtin_amdgcn_mbcnt_lo(~0u, 0u));
    const int tpv = tab[32 + (ln & 31)];
    const int e = __builtin_amdgcn_readfirstlane(__popcll(__ballot(tpv <= gt) & 0xffffffffull)) - 1;
    const int tpe = __builtin_amdgcn_readfirstlane(tab[32 + e]), cnt = __builtin_amdgcn_readfirstlane(tab[e]);
    u.e = e; u.pm = gt - tpe; u.pn = L % ntn; u.tbase = gt * 256; const int rem = cnt - 256 * u.pm; u.nrows = rem < 256 ? rem : 256; u.ks = 0; return true;
}

struct PbGU {
    static constexpr bool GATHER = true; __device__ __forceinline__ const int* list_block(const Unit& u) const { return list + (size_t)u.e * NTOK + 256 * u.pm; }
    static constexpr bool F8 = true, AUX = true;
    const char* A; const char* B; int K;
    const LAS int* tab; const int* list; const float* bgu; unsigned char* act;
    __device__ __forceinline__ void stage_aux(const Unit& u, LAS unsigned char* aux, int wid, int lane) const {
        if (lane < 8) __builtin_amdgcn_raw_ptr_buffer_load_lds(__builtin_amdgcn_make_buffer_rsrc((void*)(bgu + (size_t)u.e * 2048 + 128 * u.pn), 0, 4096 + 512, 0x00020000), (LAS unsigned*)(aux + wid * 128), 16, (wid >> 2) * 4096 + (wid & 3) * 128 + lane * 16, 0, 0, 0); }
    __device__ __forceinline__ bool next(int i, int bid, int nblk, Unit& u) const { return moe_unit(tab, i * nblk + bid, 8, u); }
    __device__ __forceinline__ int a_row(const Unit& u, int r) const { const int v = list[(size_t)u.e * NTOK + 256 * u.pm + lperm(r)]; return r < u.nrows ? (v >> 2) : 0; }
    __device__ __forceinline__ void a_rows4(const Unit& u, int r0, int (&rows)[4]) const {
        a_rows_fin(u, r0, a_rows_raw(u, r0), rows); }
    __device__ __forceinline__ int4 a_rows_raw(const Unit& u, int r0) const { return *(const int4*)(list + (size_t)u.e * NTOK + 256 * u.pm + 4 * r0); }
    __device__ __forceinline__ void a_rows_fin(const Unit& u, int r0, const int4& v, int (&rows)[4]) const {
        rows[0] = (r0 < u.nrows) ? (v.x >> 2) : 0; rows[1] = (r0 + 64 < u.nrows) ? (v.y >> 2) : 0; rows[2] = (r0 + 128 < u.nrows) ? (v.z >> 2) : 0; rows[3] = (r0 + 192 < u.nrows) ? (v.w >> 2) : 0; }
    __device__ __forceinline__ int b_rowc(int rho) const { const int i = rho & 127; return ((rho >> 7) ? 1024 : 0) + (i & ~31) + perm32(i & 31); }
    __device__ __forceinline__ int b_base_row(const Unit& u) const { return u.e * 2048 + 128 * u.pn; }
    __device__ __forceinline__ int b_row(const Unit& u, int rho) const { return b_base_row(u) + b_rowc(rho); }
    __device__ __forceinline__ void epi(const Acc& acc, const Unit& u, const LAS unsigned char* aux) const {
        const int t_ = opaque_tid(), w_ = __builtin_amdgcn_readfirstlane(t_ >> 6), wr = w_ >> 2, wc = w_ & 3, fr = t_ & 15, fq = (t_ >> 4) & 3;
        const int col0 = 128 * u.pn + 32 * wc + 8 * fq;
        f32x4 bg[2], bu[2];
#pragma unroll
        for (int n = 0; n < 2; ++n) { bg[n] = *(const LAS f32x4*)(aux + (32 * wc + 8 * fq + 4 * n) * 4); bu[n] = *(const LAS f32x4*)(aux + 512 + (32 * wc + 8 * fq + 4 * n) * 4) + 1.0f; }
#pragma unroll
        for (int ai = 0; ai < 2; ++ai)
#pragma unroll
            for (int m = 0; m < 4; ++m) {
                const int r = 128 * ai + 64 * wr + 16 * m + fr;
                f32x2 o[4];
#pragma unroll
                for (int n = 0; n < 2; ++n)
#pragma unroll
                    for (int h = 0; h < 2; ++h) {
                        const f32x2 ag = {acc[ai][0][m][n][2 * h], acc[ai][0][m][n][2 * h + 1]}, au = {acc[ai][1][m][n][2 * h], acc[ai][1][m][n][2 * h + 1]};
                        const f32x2 bgv = {bg[n][2 * h], bg[n][2 * h + 1]}, buv = {bu[n][2 * h], bu[n][2 * h + 1]};
                        f32x2 g = ag * WUNSCALE + bgv, uu = au * WUNSCALE + buv;
                        g.x = fminf(g.x, 7.0f); g.y = fminf(g.y, 7.0f);
                        uu.x = __builtin_amdgcn_fmed3f(uu.x, -6.0f, 8.0f); uu.y = __builtin_amdgcn_fmed3f(uu.y, -6.0f, 8.0f);
                        const f32x2 t = g * (-1.702f * LOG2E);
                        f32x2 e; e.x = __builtin_amdgcn_exp2f(t.x); e.y = __builtin_amdgcn_exp2f(t.y);
                        const f32x2 d = e + 1.0f;
                        f32x2 rc; rc.x = __builtin_amdgcn_rcpf(d.x); rc.y = __builtin_amdgcn_rcpf(d.y);
                        o[2 * n + h] = (g * rc) * uu;
                    }
                u32x2 w; w.x = cvt_pk4_fp8(o[0].x, o[0].y, o[1].x, o[1].y); w.y = cvt_pk4_fp8(o[2].x, o[2].y, o[3].x, o[3].y);
                *(u32x2*)(act + (size_t)(u.tbase + r) * 1024 + col0) = w;
            }
    }
};

struct PbDown {
    static constexpr bool GATHER = false; __device__ __forceinline__ const int* list_block(const Unit&) const { return nullptr; }
    static constexpr bool F8 = true, AUX = true;
    const char* A; const char* B; int K;
    const LAS int* tab; const int* list; const float* bdn; unsigned char* ybuf;
    __device__ __forceinline__ void stage_aux(const Unit& u, LAS unsigned char* aux, int wid, int lane) const {
        if (lane < 8) { __builtin_amdgcn_raw_ptr_buffer_load_lds(__builtin_amdgcn_make_buffer_rsrc((void*)(bdn + (size_t)u.e * 1024 + 256 * u.pn), 0, 1024, 0x00020000), (LAS unsigned*)(aux + wid * 128), 16, (wid * 8 + lane) * 16, 0, 0, 0);
            __builtin_amdgcn_raw_ptr_buffer_load_lds(__builtin_amdgcn_make_buffer_rsrc((void*)(list + (size_t)u.e * NTOK + 256 * u.pm), 0, 1024, 0x00020000), (LAS unsigned*)(aux + 1024 + wid * 128), 16, (wid * 8 + lane) * 16, 0, 0, 0); } }
    __device__ __forceinline__ bool next(int i, int bid, int nblk, Unit& u) const { return moe_unit(tab, i * nblk + bid, 4, u); }
    __device__ __forceinline__ int a_row(const Unit& u, int r) const { return u.tbase + r; }
    __device__ __forceinline__ void a_rows4(const Unit& u, int r0, int (&rows)[4]) const { for (int j = 0; j < 4; ++j) rows[j] = u.tbase + r0 + 64 * j; }
    __device__ __forceinline__ int4 a_rows_raw(const Unit&, int) const { return make_int4(0, 0, 0, 0); }
    __device__ __forceinline__ void a_rows_fin(const Unit& u, int r0, const int4&, int (&rows)[4]) const { a_rows4(u, r0, rows); }
    __device__ __forceinline__ int b_rowc(int rho) const { return 64 * ((rho >> 5) & 3) + 16 * ((rho >> 2) & 3) + 8 * (rho >> 7) + 4 * ((rho >> 4) & 1) + (rho & 3); }
    __device__ __forceinline__ int b_base_row(const Unit& u) const { return u.e * 1024 + 256 * u.pn; }
    __device__ __forceinline__ int b_row(const Unit& u, int rho) const { return b_base_row(u) + b_rowc(rho); }
    __device__ __forceinline__ void epi(const Acc& acc, const Unit& u, const LAS unsigned char* aux) const {
        const int t_ = opaque_tid(), w_ = __builtin_amdgcn_readfirstlane(t_ >> 6), wr = w_ >> 2, wc = w_ & 3, fr = t_ & 15, fq = (t_ >> 4) & 3;
        const int col0 = 256 * u.pn + 64 * wc + 16 * fq;
        f32x4 bv[2][2];
#pragma unroll
        for (int bj = 0; bj < 2; ++bj)
#pragma unroll
            for (int n = 0; n < 2; ++n) bv[bj][n] = *(const LAS f32x4*)(aux + (64 * wc + 16 * fq + 8 * bj + 4 * n) * 4);
        int dst8[8];
#pragma unroll
        for (int q = 0; q < 8; ++q) dst8[q] = ((const LAS int*)(aux + 1024))[lperm(128 * (q >> 2) + 64 * wr + 16 * (q & 3) + fr)];
#pragma unroll
        for (int ai = 0; ai < 2; ++ai)
#pragma unroll
            for (int m = 0; m < 4; ++m) {
                const int r = 128 * ai + 64 * wr + 16 * m + fr;
                u32x4 w;
                { const f32x4 v00 = acc[ai][0][m][0] * WUNSCALE + bv[0][0], v01 = acc[ai][0][m][1] * WUNSCALE + bv[0][1], v10 = acc[ai][1][m][0] * WUNSCALE + bv[1][0], v11 = acc[ai][1][m][1] * WUNSCALE + bv[1][1];
                  w.x = cvt_pk4_fp8(v00.x, v00.y, v00.z, v00.w); w.y = cvt_pk4_fp8(v01.x, v01.y, v01.z, v01.w); w.z = cvt_pk4_fp8(v10.x, v10.y, v10.z, v10.w); w.w = cvt_pk4_fp8(v11.x, v11.y, v11.z, v11.w); }
                if (r < u.nrows) *(u32x4*)(ybuf + (size_t)dst8[ai * 4 + m] * 1024 + col0) = w;
            }
    }
};

__device__ __forceinline__ s16x4 lds_tr16(const LAS unsigned char* p) { return __builtin_bit_cast(s16x4, __builtin_amdgcn_ds_read_tr16_b64_v4i16((LAS s16x4*)p)); }

__device__ __forceinline__ void attn_phase(const Params& P, LAS unsigned char* lds, int l, int bid, int nblk) {
    const int tid = opaque_tid(), wid = __builtin_amdgcn_readfirstlane(tid >> 6), lane = tid & 63, r32 = lane & 31, hi = lane >> 5;
    unsigned char* ws = P.ws;
    const bf16* proj = (const bf16*)(ws + WS_PROJ);
    unsigned char* mix = ws + WS_MIX;
    constexpr int KP = 144;
    LAS unsigned char* sK = lds; LAS unsigned char* sV = lds + 256 * KP;
    u32x4 kreg[4], vreg[4];
#define ATT_FETCH(un) do { const int _kvh = (un) & 1, _n = ((un) >> 1) & 63, _b = (un) >> 7; const int _tok0 = _b * SEQ + _n * 128 - 128; \
        _Pragma("unroll") for (int j = 0; j < 4; ++j) { const int q = tid + NT * j, key = q >> 3, c8 = q & 7; \
            kreg[j] = (u32x4){0u, 0u, 0u, 0u}; vreg[j] = (u32x4){0u, 0u, 0u, 0u}; \
            if (_n > 0 || key >= 128) { const bf16* src_ = proj + (size_t)(_tok0 + key) * NIN + 512 + _kvh * 64 + c8 * 8; kreg[j] = *(const u32x4*)src_; vreg[j] = *(const u32x4*)(src_ + 128); } } } while (0)
    if (bid < NB * 64 * 2) ATT_FETCH(bid);
    for (int unit = bid; unit < NB * 64 * 2; unit += nblk) {
        const int kvh = unit & 1, n = (unit >> 1) & 63, b = unit >> 7;
        __syncthreads();
#pragma unroll
        for (int j = 0; j < 4; ++j) { const int q = tid + NT * j, key = q >> 3, c8 = q & 7; *(LAS u32x4*)(sK + key * KP + c8 * 16) = kreg[j]; *(LAS u32x4*)(sV + key * KP + c8 * 16) = vreg[j]; }
        const int hq = kvh * 4 + (wid >> 1);
        const float sink2 = P.sinks[l * 8 + hq] * LOG2E;
        bf16x8 qfa[2][4];
#pragma unroll
        for (int qt = 0; qt < 2; ++qt)
#pragma unroll
            for (int s = 0; s < 4; ++s) qfa[qt][s] = *(const bf16x8*)(proj + ((size_t)b * SEQ + n * 128 + 64 * (wid & 1) + 32 * qt + r32) * NIN + hq * 64 + 16 * s + 8 * hi);
        __syncthreads();
        if (unit + nblk < NB * 64 * 2) ATT_FETCH(unit + nblk);
#pragma unroll
        for (int qt = 0; qt < 2; ++qt) {
            const int q0 = 64 * (wid & 1) + 32 * qt, qi = q0 + r32;
            const size_t qtok = (size_t)b * SEQ + n * 128 + qi;
            bf16x8 qf[4];
#pragma unroll
            for (int s = 0; s < 4; ++s) qf[s] = qfa[qt][s];
            f32x16 st[5];
#pragma unroll
            for (int kt = 0; kt < 5; ++kt) {
#pragma unroll
                for (int r = 0; r < 16; ++r) st[kt][r] = 0.f;
#pragma unroll
                for (int s = 0; s < 4; ++s) { const bf16x8 kf = *(const LAS bf16x8*)(sK + (q0 + 32 * kt + r32) * KP + (16 * s + 8 * hi) * 2); st[kt] = __builtin_amdgcn_mfma_f32_32x32x16_bf16(kf, qf[s], st[kt], 0, 0, 0); }
            }
            float mx = sink2;
            if (n > 0) {
#pragma unroll
                for (int r = 0; r < 16; ++r) { const int kk = (r & 3) + 8 * (r >> 2) + 4 * hi;
                    st[0][r] = (kk > r32) ? st[0][r] : -__builtin_inff(); st[4][r] = (kk <= r32) ? st[4][r] : -__builtin_inff(); }
            } else {
#pragma unroll
                for (int kt = 0; kt < 5; ++kt)
#pragma unroll
                    for (int r = 0; r < 16; ++r) {
                        const int kj = q0 + 32 * kt + (r & 3) + 8 * (r >> 2) + 4 * hi;
                        const bool ok = (kj > qi) && (kj <= qi + 128) && (kj >= 128);
                        st[kt][r] = ok ? st[kt][r] : -__builtin_inff();
                    }
            }
#pragma unroll
            for (int kt = 0; kt < 5; ++kt)
#pragma unroll
                for (int r = 0; r < 16; r += 2) mx = fmaxf(fmaxf(mx, st[kt][r]), st[kt][r + 1]);
            mx = max_x32(mx);
            float sum = 0.f;
#pragma unroll
            for (int kt = 0; kt < 5; ++kt)
#pragma unroll
                for (int r = 0; r < 16; ++r) { const float p = __builtin_amdgcn_exp2f(st[kt][r] - mx); st[kt][r] = p; sum += p; }
            sum = sum_x32(sum);
            sum += __builtin_amdgcn_exp2f(sink2 - mx);
            f32x16 o[2];
#pragma unroll
            for (int dt = 0; dt < 2; ++dt)
#pragma unroll
                for (int r = 0; r < 16; ++r) o[dt][r] = 0.f;
#pragma unroll
            for (int kt = 0; kt < 5; ++kt)
#pragma unroll
                for (int s2 = 0; s2 < 2; ++s2) {
                    u32x4 pw; pw.x = cvt_pk_bf16(st[kt][8 * s2 + 0], st[kt][8 * s2 + 1]); pw.y = cvt_pk_bf16(st[kt][8 * s2 + 2], st[kt][8 * s2 + 3]);
                    pw.z = cvt_pk_bf16(st[kt][8 * s2 + 4], st[kt][8 * s2 + 5]); pw.w = cvt_pk_bf16(st[kt][8 * s2 + 6], st[kt][8 * s2 + 7]);
                    const bf16x8 pf = __builtin_bit_cast(bf16x8, pw);
                    const int kb = q0 + 32 * kt + 16 * s2 + 4 * hi, i16 = lane & 15;
#pragma unroll
                    for (int dt = 0; dt < 2; ++dt) {
                        const int d0 = 32 * dt + 16 * ((lane >> 4) & 1);
                        const LAS unsigned char* a0 = sV + (kb + (i16 >> 2)) * KP + (d0 + 4 * (i16 & 3)) * 2;
                        const s16x4 v0 = lds_tr16(a0), v1 = lds_tr16(a0 + 8 * KP);
                        bf16x8 vf; vf[0] = v0[0]; vf[1] = v0[1]; vf[2] = v0[2]; vf[3] = v0[3]; vf[4] = v1[0]; vf[5] = v1[1]; vf[6] = v1[2]; vf[7] = v1[3];
                        o[dt] = __builtin_amdgcn_mfma_f32_32x32x16_bf16(vf, pf, o[dt], 0, 0, 0);
                    }
                }
            const float inv = MIXSCALE / sum;
#pragma unroll
            for (int dt = 0; dt < 2; ++dt)
#pragma unroll
                for (int gp = 0; gp < 2; ++gp) {
                    const unsigned wa = cvt_pk4_fp8(o[dt][8 * gp + 0] * inv, o[dt][8 * gp + 1] * inv, o[dt][8 * gp + 2] * inv, o[dt][8 * gp + 3] * inv);
                    const unsigned wb = cvt_pk4_fp8(o[dt][8 * gp + 4] * inv, o[dt][8 * gp + 5] * inv, o[dt][8 * gp + 6] * inv, o[dt][8 * gp + 7] * inv);
                    const auto sw = __builtin_amdgcn_permlane32_swap(wa, wb, false, false);
                    u32x2 w; w.x = sw[0]; w.y = sw[1];
                    *(u32x2*)(mix + qtok * D + hq * 64 + 32 * dt + 16 * gp + 8 * hi) = w;
                }
        }
    }
    for (int ch = bid * 8 + wid; ch < NTOK / 16; ch += nblk * 8) {
        const int t0 = ch * 16, p0 = t0 & (SEQ - 1);
        const int col = 8 * lane, g = lane >> 4, w = 2 << g;
        u32x4 zr[31];
#pragma unroll
        for (int t = 0; t < 31; ++t) zr[t] = (t >= 15 || p0 > 0) ? *(const u32x4*)(proj + (size_t)(t0 + t - 15) * NIN + 768 + col) : (u32x4){0u, 0u, 0u, 0u};
        float pb_[8], ps_[8];
#pragma unroll
        for (int i = 0; i < 8; i += 4) { const f32x4 a = *(const f32x4*)(P.pool_b + l * 512 + col + i), s = *(const f32x4*)(P.pool_s + l * 512 + col + i);
            pb_[i] = a.x; pb_[i + 1] = a.y; pb_[i + 2] = a.z; pb_[i + 3] = a.w; ps_[i] = s.x * MIXSCALE; ps_[i + 1] = s.y * MIXSCALE; ps_[i + 2] = s.z * MIXSCALE; ps_[i + 3] = s.w * MIXSCALE; }
        float sum[8];
#pragma unroll
        for (int i = 0; i < 8; ++i) sum[i] = 0.f;
#pragma unroll
        for (int j = 1; j < 16; ++j) {
            const u32x4 z = zr[15 - j]; const float m = (j < w) ? 1.0f : 0.0f;
            sum[0] += m * bf_lo(z.x); sum[1] += m * bf_hi(z.x); sum[2] += m * bf_lo(z.y); sum[3] += m * bf_hi(z.y); sum[4] += m * bf_lo(z.z); sum[5] += m * bf_hi(z.z); sum[6] += m * bf_lo(z.w); sum[7] += m * bf_hi(z.w);
        }
#pragma unroll
        for (int t = 0; t < 16; ++t) {
            const u32x4 z = zr[15 + t];
            const float zz[8] = {bf_lo(z.x), bf_hi(z.x), bf_lo(z.y), bf_hi(z.y), bf_lo(z.z), bf_hi(z.z), bf_lo(z.w), bf_hi(z.w)};
            const int pos = p0 + t; const float ic = 1.0f / (float)((pos + 1 < w) ? (pos + 1) : w);
            float o[8];
#pragma unroll
            for (int i = 0; i < 8; ++i) { sum[i] += zz[i]; o[i] = (sum[i] * ic - zz[i] + pb_[i]) * ps_[i]; }
            u32x2 ow; ow.x = cvt_pk4_fp8(o[0], o[1], o[2], o[3]); ow.y = cvt_pk4_fp8(o[4], o[5], o[6], o[7]);
            *(u32x2*)(mix + (size_t)(t0 + t) * D + 512 + col) = ow;
            const u32x4 y = (g == 0) ? zr[15 + t - 1] : (g == 1) ? zr[15 + t - 3] : (g == 2) ? zr[15 + t - 7] : zr[15 + t - 15];
            sum[0] -= bf_lo(y.x); sum[1] -= bf_hi(y.x); sum[2] -= bf_lo(y.y); sum[3] -= bf_hi(y.y); sum[4] -= bf_lo(y.z); sum[5] -= bf_hi(y.z); sum[6] -= bf_lo(y.w); sum[7] -= bf_hi(y.w);
        }
    }
}

__device__ __forceinline__ void router_phase(const Params& P, LAS unsigned char* lds, int l, int bid, int nblk) {
    const int tid = opaque_tid(), wid = __builtin_amdgcn_readfirstlane(tid >> 6), lane = tid & 63, fr = lane & 15, fq = lane >> 4;
    unsigned char* ws = P.ws;
    const float* mod = (const float*)(ws + WS_MOD);
    float* gates = (float*)(ws + WS_GATES);
    constexpr int RP = 2064;
    LAS unsigned char* rwT = lds;
    LAS float* lg = (LAS float*)(lds + 66048);
    LAS unsigned long long* emask = (LAS unsigned long long*)(lds + 66048 + 33792);
    LAS unsigned short* sel = (LAS unsigned short*)(emask + 128);
    __syncthreads();
    for (int idx = tid; idx < 1024 * 32; idx += NT) { const int k = idx >> 5, e = idx & 31; const float v = P.rw[(size_t)l * 32768 + idx];
        *(LAS unsigned short*)(rwT + e * RP + k * 2) = (unsigned short)(cvt_pk_bf16(v, 0.f) & 0xffffu); }
    LAS float* cav = (LAS float*)(lds + 106496);
    LAS float* ccv = cav + 1024;
    for (int tile = bid; tile < NTOK / 256; tile += nblk) {
        const int tok0 = tile * 256, b = tok0 >> 13;
        for (int c = tid; c < D; c += NT) { cav[c] = P.n2g[l * D + c] * (1.0f + mod[(size_t)(l * NB + b) * NMOD + 4 * D + c]); ccv[c] = mod[(size_t)(l * NB + b) * NMOD + 3 * D + c]; }
        __syncthreads();
#pragma unroll 1
        for (int rg = 0; rg < 2; ++rg) {
            const size_t row = (size_t)(tok0 + 32 * wid + 16 * rg + fr);
            const bf16* xp = (const bf16*)(ws + WS_XB) + row * D + 16 * fq;
            float ss = 0.f;
#pragma unroll 4
            for (int p = 0; p < 16; ++p)
#pragma unroll
                for (int t = 0; t < 2; ++t) { const u32x4 w = *(const u32x4*)(xp + 64 * p + 8 * t); const float a0_ = bf_lo(w.x), a1_ = bf_hi(w.x), a2_ = bf_lo(w.y), a3_ = bf_hi(w.y), a4_ = bf_lo(w.z), a5_ = bf_hi(w.z), a6_ = bf_lo(w.w), a7_ = bf_hi(w.w);
                    ss += (a0_ * a0_ + a1_ * a1_) + (a2_ * a2_ + a3_ * a3_) + (a4_ * a4_ + a5_ * a5_) + (a6_ * a6_ + a7_ * a7_); }
            ss = sum_x16(ss); ss = sum_x32(ss);
            const float rstd = __builtin_amdgcn_rsqf(ss * (1.0f / D) + EPS);
            f32x4 a0 = (f32x4){0.f, 0.f, 0.f, 0.f}, a1 = a0;
            u32x4 cur[2], nxt[2];
            cur[0] = *(const u32x4*)(xp); cur[1] = *(const u32x4*)(xp + 8);
#pragma unroll 2
            for (int p = 0; p < 16; ++p) {
                const int pn = (p + 1) & 15;
                nxt[0] = *(const u32x4*)(xp + 64 * pn); nxt[1] = *(const u32x4*)(xp + 64 * pn + 8);
                const int c0 = 64 * p + 16 * fq;
                unsigned hw[2][4]; float hv[16];
#pragma unroll
                for (int t = 0; t < 2; ++t) {
                    const u32x4 w = cur[t];
                    const float xv[8] = {bf_lo(w.x), bf_hi(w.x), bf_lo(w.y), bf_hi(w.y), bf_lo(w.z), bf_hi(w.z), bf_lo(w.w), bf_hi(w.w)};
                    const f32x4 g0 = *(const LAS f32x4*)(cav + c0 + 8 * t), g1 = *(const LAS f32x4*)(cav + c0 + 8 * t + 4), s0 = *(const LAS f32x4*)(ccv + c0 + 8 * t), s1 = *(const LAS f32x4*)(ccv + c0 + 8 * t + 4);
                    hv[8 * t + 0] = xv[0] * rstd * g0.x + s0.x; hv[8 * t + 1] = xv[1] * rstd * g0.y + s0.y; hv[8 * t + 2] = xv[2] * rstd * g0.z + s0.z; hv[8 * t + 3] = xv[3] * rstd * g0.w + s0.w;
                    hv[8 * t + 4] = xv[4] * rstd * g1.x + s1.x; hv[8 * t + 5] = xv[5] * rstd * g1.y + s1.y; hv[8 * t + 6] = xv[6] * rstd * g1.z + s1.z; hv[8 * t + 7] = xv[7] * rstd * g1.w + s1.w;
                    hw[t][0] = cvt_pk_bf16(hv[8 * t + 0], hv[8 * t + 1]); hw[t][1] = cvt_pk_bf16(hv[8 * t + 2], hv[8 * t + 3]); hw[t][2] = cvt_pk_bf16(hv[8 * t + 4], hv[8 * t + 5]); hw[t][3] = cvt_pk_bf16(hv[8 * t + 6], hv[8 * t + 7]);
                }
                u32x4 h8; h8.x = cvt_pk4_fp8(hv[0], hv[1], hv[2], hv[3]); h8.y = cvt_pk4_fp8(hv[4], hv[5], hv[6], hv[7]); h8.z = cvt_pk4_fp8(hv[8], hv[9], hv[10], hv[11]); h8.w = cvt_pk4_fp8(hv[12], hv[13], hv[14], hv[15]);
                *(u32x4*)(ws + WS_H8 + row * D + c0) = h8;
#pragma unroll
                for (int t = 0; t < 2; ++t) {
                    const bf16x8 af = __builtin_bit_cast(bf16x8, (u32x4){hw[t][0], hw[t][1], hw[t][2], hw[t][3]});
                    const bf16x8 b0 = *(const LAS bf16x8*)(rwT + fr * RP + (c0 + 8 * t) * 2), b1 = *(const LAS bf16x8*)(rwT + (16 + fr) * RP + (c0 + 8 * t) * 2);
                    a0 = __builtin_amdgcn_mfma_f32_16x16x32_bf16(af, b0, a0, 0, 0, 0); a1 = __builtin_amdgcn_mfma_f32_16x16x32_bf16(af, b1, a1, 0, 0, 0);
                }
                cur[0] = nxt[0]; cur[1] = nxt[1];
            }
            const float rb0 = P.rb[l * 32 + fr], rb1 = P.rb[l * 32 + 16 + fr];
#pragma unroll
            for (int r = 0; r < 4; ++r) { const int lrow = 32 * wid + 16 * rg + 4 * fq + r; lg[lrow * 33 + fr] = a0[r] + rb0; lg[lrow * 33 + 16 + fr] = a1[r] + rb1; }
        }
        __syncthreads();
        if (tid < 256) {
            float v[32];
#pragma unroll
            for (int e = 0; e < 32; ++e) v[e] = lg[tid * 33 + e];
            float tv[4]; int ti[4];
#pragma unroll
            for (int k = 0; k < 4; ++k) {
                float best = -__builtin_inff(); int bi = 0;
#pragma unroll
                for (int e = 0; e < 32; ++e) { const bool gt = v[e] > best; best = gt ? v[e] : best; bi = gt ? e : bi; }
                tv[k] = best; ti[k] = bi;
#pragma unroll
                for (int e = 0; e < 32; ++e) v[e] = (e == bi) ? -__builtin_inff() : v[e];
            }
            const float e1 = __expf(tv[1] - tv[0]), e2 = __expf(tv[2] - tv[0]), e3 = __expf(tv[3] - tv[0]);
            const float inv = 1.0f / (1.0f + e1 + e2 + e3);
            *(f32x4*)(gates + (size_t)(tok0 + tid) * 4) = (f32x4){inv, e1 * inv, e2 * inv, e3 * inv};
#pragma unroll
            for (int k = 0; k < 4; ++k) sel[tid * 4 + k] = (unsigned short)ti[k];
#pragma unroll
            for (int e = 0; e < 32; ++e) { const unsigned long long m = __ballot((ti[0] == e) | (ti[1] == e) | (ti[2] == e) | (ti[3] == e)); if (lane == 0) emask[e * 4 + wid] = m; }
        }
        __syncthreads();
        if (tid < 256) {
            int* selg = (int*)(ws + WS_SEL);
            const unsigned long long lt = (1ull << lane) - 1ull;
            int so[4];
#pragma unroll
            for (int k = 0; k < 4; ++k) {
                const int e = sel[tid * 4 + k]; int r = 0;
                for (int w = 0; w < 4; ++w) { const unsigned long long m = emask[e * 4 + w]; r += (w < wid) ? __popcll(m) : ((w == wid) ? __popcll(m & lt) : 0); }
                so[k] = (e << 16) | r;
            }
            *(int4*)(selg + (size_t)(tok0 + tid) * 4) = make_int4(so[0], so[1], so[2], so[3]);
        }
        if (tid < 32) { int c = 0; for (int w = 0; w < 4; ++w) c += __popcll(emask[tid * 4 + w]); ((int*)(ws + WS_CNTB))[(size_t)(l * 256 + tile) * 32 + tid] = c; }
        __syncthreads();
    }
}

__device__ __forceinline__ void place_phase(const Params& P, LAS unsigned char* lds, int l, int bid, int nblk) {
    const int tid = opaque_tid();
    unsigned char* ws = P.ws;
    const int* cntb = (const int*)(ws + WS_CNTB) + (size_t)l * 256 * 32;
    const int* selg = (const int*)(ws + WS_SEL);
    int* list = (int*)(ws + WS_LIST);
    LAS int* red = (LAS int*)lds;
    LAS int* base = red + 512;
    const int e = tid & 31, part = tid >> 5;
    __syncthreads();
    for (int tile = bid; tile < NTOK / 256 + 1; tile += nblk) {
        int s = 0;
        for (int q = 0; q < 16; ++q) { const int t = part * 16 + q; if (t < tile) s += cntb[t * 32 + e]; }
        red[part * 32 + e] = s;
        __syncthreads();
        if (tid < 32) { int b = 0; for (int p = 0; p < 16; ++p) b += red[p * 32 + tid]; base[tid] = b; if (tile == NTOK / 256) ((int*)(ws + WS_TOT))[l * 32 + tid] = b; }
        __syncthreads();
        if (tile < NTOK / 256 && tid < 256) {
            const int tok = tile * 256 + tid; const int4 v = *(const int4*)(selg + (size_t)tok * 4);
            const int vv[4] = {v.x, v.y, v.z, v.w};
#pragma unroll
            for (int k = 0; k < 4; ++k) { const int ee = vv[k] >> 16, r = vv[k] & 0xffff; { const int rk = base[ee] + r; list[(size_t)ee * NTOK + (rk & ~255) + lperm(rk & 255)] = tok * 4 + k; } }
        }
        __syncthreads();
    }
}

constexpr int BK = 64, HALF = 128, HTB = HALF * BK * 2;
__device__ __forceinline__ int lds_byte(int r, int c) { const int st = (r >> 4) * 2 + (c >> 5), rr = r & 15, cc = c & 31, ob = rr * 64 + cc * 2; return st * 1024 + (ob ^ (((ob >> 9) & 1) << 5)); }
__device__ __forceinline__ void stage_rc(int b, int& R, int& C) { const int st = b / 1024, sb = b % 1024, swz = sb ^ (((sb >> 9) & 1) << 5); R = (st >> 1) * 16 + swz / 64; C = (st & 1) * 32 + (swz % 64) / 2; }

template <bool F8> struct FragT;
template <> struct FragT<false> {
    struct A { bf16x8 k[2]; };
    static __device__ __forceinline__ void load(A& d, const LAS unsigned char* p) { d.k[0] = *(const LAS bf16x8*)p; d.k[1] = *(const LAS bf16x8*)(p + 1024); }
    static __device__ __forceinline__ f32x4 mma(const A& a, const A& b, f32x4 c) { c = __builtin_amdgcn_mfma_f32_16x16x32_bf16(a.k[0], b.k[0], c, 0, 0, 0); return __builtin_amdgcn_mfma_f32_16x16x32_bf16(a.k[1], b.k[1], c, 0, 0, 0); }
};
template <> struct FragT<true> {
    typedef i32x8 A;
    static __device__ __forceinline__ void load(A& d, const LAS unsigned char* p) { const i32x4 lo = *(const LAS i32x4*)p, hi = *(const LAS i32x4*)(p + 1024); d = __builtin_shufflevector(lo, hi, 0, 1, 2, 3, 4, 5, 6, 7); }
    static __device__ __forceinline__ f32x4 mma(const A& a, const A& b, f32x4 c) { const int one = 0x7f7f7f7f;
        asm volatile("v_mfma_scale_f32_16x16x128_f8f6f4 %0, %1, %2, %0, %3, %3 op_sel_hi:[0,0,0]" : "+v"(c) : "v"(a), "v"(b), "v"(one)); return c; }
};
template <class Pb>
__device__ __forceinline__ void gemm_phase8(LAS unsigned char* lds, const Pb& pb, int bid, int nblk) {
    const int tid = opaque_tid(), wid = __builtin_amdgcn_readfirstlane(tid >> 6), lane = tid & 63, wr = wid >> 2, wc = wid & 3, fr = lane & 15, fq = lane >> 4;
    constexpr bool F8 = Pb::F8;
    const int RB = F8 ? pb.K : pb.K * 2;
    const int nt = RB / 128;
    int Rp[2], Cp[2];
#pragma unroll
    for (int i = 0; i < 2; ++i) stage_rc(tid * 16 + i * 8192, Rp[i], Cp[i]);
    unsigned voB[2][2];
#pragma unroll
    for (int h = 0; h < 2; ++h)
#pragma unroll
        for (int i = 0; i < 2; ++i) voB[h][i] = (unsigned)pb.b_rowc(128 * h + Rp[i]) * (unsigned)RB + (unsigned)Cp[i] * 2u;
    const unsigned ldsw = (unsigned)wid * 1024u;
    const int aoff = lds_byte(wr * 64 + fr, fq * 8), boff = lds_byte(wc * 32 + fr, fq * 8);
#define PG8_SA(b, h) (((b) * 2 + (h)) * HTB)
#define PG8_SB(b, h) ((4 + (b) * 2 + (h)) * HTB)
#define PG8_STAGE(bufoff, rsrc, soff, voff) do { _Pragma("unroll") for (int _i = 0; _i < 2; ++_i) \
        __builtin_amdgcn_raw_ptr_buffer_load_lds(rsrc, (LAS unsigned*)(lds + (bufoff) + ldsw + _i * 8192), 16, (int)(voff)[_i], (int)(soff), 0, 0); } while (0)
#define PG8_LDA(dst, b, h) do { _Pragma("unroll") for (int m = 0; m < 4; ++m) FragT<F8>::load(dst[m], lds + PG8_SA(b, h) + aoff + m * 2048); } while (0)
#define PG8_LDB(dst, b, h) do { _Pragma("unroll") for (int n = 0; n < 2; ++n) FragT<F8>::load(dst[n], lds + PG8_SB(b, h) + boff + n * 2048); } while (0)
#define PG8_MMA(ai, bj, At, Bt) do { __builtin_amdgcn_s_setprio(1); _Pragma("unroll") for (int m = 0; m < 4; ++m) _Pragma("unroll") for (int n = 0; n < 2; ++n) \
        acc[ai][bj][m][n] = FragT<F8>::mma(Bt[n], At[m], acc[ai][bj][m][n]); __builtin_amdgcn_s_setprio(0); } while (0)
#define PG8_WAIT_V(n) asm volatile("s_waitcnt vmcnt(" #n ")" ::: "memory")
#define PG8_WAIT_L(n) asm volatile("s_waitcnt lgkmcnt(" #n ")" ::: "memory")
#define PG8_BAR __builtin_amdgcn_s_barrier()
#define PG8_SCHED __builtin_amdgcn_sched_barrier(0)
#define PG8_VOA(dst, un) do { int _r[4]; pb.a_rows4(un, Rp[0], _r); _Pragma("unroll") for (int h = 0; h < 2; ++h) _Pragma("unroll") for (int i = 0; i < 2; ++i) dst[h][i] = (unsigned)_r[2 * h + i] * (unsigned)RB + (unsigned)Cp[i] * 2u; } while (0)
    Unit cur, nxt; int ui = 0;
    if (!pb.next(0, bid, nblk, cur)) return;
    Acc acc;
#pragma unroll
    for (int a = 0; a < 2; ++a)
#pragma unroll
        for (int b = 0; b < 2; ++b)
#pragma unroll
            for (int m = 0; m < 4; ++m)
#pragma unroll
                for (int n = 0; n < 2; ++n) acc[a][b][m][n] = (f32x4){0.f, 0.f, 0.f, 0.f};
    typename FragT<F8>::A At[4]; typename FragT<F8>::A B0[2], B1[2];
    unsigned voAc[2][2], voAn[2][2];
    PG8_VOA(voAc, cur);
    const __amdgpu_buffer_rsrc_t rA = __builtin_amdgcn_make_buffer_rsrc((void*)pb.A, 0, 0x7fffffff, 0x00020000), rB = __builtin_amdgcn_make_buffer_rsrc((void*)pb.B, 0, 0x7fffffff, 0x00020000);
    unsigned cB = (unsigned)pb.b_base_row(cur) * (unsigned)RB;
    { const unsigned k0 = (unsigned)(cur.ks & (nt - 1)) * 128u, k1 = (unsigned)((cur.ks + 1) & (nt - 1)) * 128u;
    PG8_STAGE(PG8_SB(0, 0), rB, cB + k0, voB[0]); PG8_STAGE(PG8_SB(0, 1), rB, cB + k0, voB[1]); PG8_STAGE(PG8_SA(0, 0), rA, k0, voAc[0]); PG8_STAGE(PG8_SA(0, 1), rA, k0, voAc[1]);
    if (wr == 1) PG8_BAR;
    PG8_WAIT_V(2); PG8_BAR;
    PG8_STAGE(PG8_SB(1, 0), rB, cB + k1, voB[0]); PG8_STAGE(PG8_SA(1, 0), rA, k1, voAc[0]); PG8_STAGE(PG8_SB(1, 1), rB, cB + k1, voB[1]); }
    PG8_WAIT_V(6); PG8_BAR;
    for (;;) {
        const bool has_next = pb.next(ui + 1, bid, nblk, nxt);
        unsigned nB = cB; int nks = cur.ks; int4 rawn = make_int4(0, 0, 0, 0);
        if (has_next) { nB = (unsigned)pb.b_base_row(nxt) * (unsigned)RB; nks = nxt.ks;
            if constexpr (Pb::GATHER) {
                if (lane < 8) __builtin_amdgcn_raw_ptr_buffer_load_lds(__builtin_amdgcn_make_buffer_rsrc((void*)pb.list_block(nxt), 0, 1024, 0x00020000), (LAS unsigned*)(lds + LSTAGE_OFF + wid * 128), 16, (wid * 8 + lane) * 16, 0, 0, 0);
            } else rawn = pb.a_rows_raw(nxt, Rp[0]); }
        if constexpr (Pb::AUX) pb.stage_aux(cur, lds + AUX_OFF + (ui & 1) * 2048, wid, lane);
        asm volatile(".p2align 8" ::: "memory");
        for (int t = 0; t < nt; t += 2) {
            const bool last = (t == nt - 2);
            const unsigned a1 = (unsigned)((t + 1 + cur.ks) & (nt - 1)) * 128u;
            const int ks2 = last ? nks : (t + 2 + cur.ks);
            const unsigned a2 = (unsigned)(ks2 & (nt - 1)) * 128u, a3 = (unsigned)((ks2 + 1) & (nt - 1)) * 128u;
            const unsigned bb = last ? nB : cB;
            const unsigned b2 = bb + a2, b3 = bb + a3;
            unsigned sa[2][2];
            if (last) {
                if (has_next) { int _r[4]; if constexpr (Pb::GATHER) { const i32x4 t_ = *(const LAS i32x4*)(lds + LSTAGE_OFF + Rp[0] * 16); rawn = make_int4(t_.x, t_.y, t_.z, t_.w); }
                    pb.a_rows_fin(nxt, Rp[0], rawn, _r);
#pragma unroll
                    for (int h = 0; h < 2; ++h)
#pragma unroll
                        for (int i = 0; i < 2; ++i) voAn[h][i] = (unsigned)_r[2 * h + i] * (unsigned)RB + (unsigned)Cp[i] * 2u; }
                else {
#pragma unroll
                    for (int h = 0; h < 2; ++h)
#pragma unroll
                        for (int i = 0; i < 2; ++i) voAn[h][i] = voAc[h][i]; }
            }
#pragma unroll
            for (int h = 0; h < 2; ++h)
#pragma unroll
                for (int i = 0; i < 2; ++i) sa[h][i] = last ? voAn[h][i] : voAc[h][i];
            PG8_LDB(B0, 0, 0); PG8_LDB(B1, 0, 1); PG8_SCHED; PG8_LDA(At, 0, 0); PG8_STAGE(PG8_SA(1, 1), rA, a1, voAc[1]);
            PG8_WAIT_V(8); PG8_WAIT_L(0); PG8_BAR; PG8_MMA(0, 0, At, B0); PG8_MMA(0, 1, At, B1); PG8_BAR; PG8_SCHED;
            PG8_LDA(At, 0, 1); PG8_STAGE(PG8_SB(0, 0), rB, b2, voB[0]); PG8_STAGE(PG8_SB(0, 1), rB, b2, voB[1]); PG8_STAGE(PG8_SA(0, 0), rA, a2, sa[0]);
            PG8_WAIT_V(8); PG8_WAIT_L(0); PG8_BAR; PG8_MMA(1, 0, At, B0); PG8_MMA(1, 1, At, B1); PG8_BAR; PG8_SCHED;
            PG8_LDB(B0, 1, 0); PG8_LDB(B1, 1, 1); PG8_SCHED; PG8_LDA(At, 1, 0); PG8_STAGE(PG8_SA(0, 1), rA, a2, sa[1]);
            PG8_WAIT_V(8); PG8_WAIT_L(0); PG8_BAR; PG8_MMA(0, 0, At, B0); PG8_MMA(0, 1, At, B1); PG8_BAR; PG8_SCHED;
            PG8_LDA(At, 1, 1); PG8_STAGE(PG8_SB(1, 0), rB, b3, voB[0]); PG8_STAGE(PG8_SB(1, 1), rB, b3, voB[1]); PG8_STAGE(PG8_SA(1, 0), rA, a3, sa[0]);
            PG8_WAIT_V(8); PG8_WAIT_L(0); PG8_BAR; PG8_MMA(1, 0, At, B0); PG8_MMA(1, 1, At, B1); PG8_BAR; PG8_SCHED;
        }
        if (wr == 0) PG8_BAR;
        if constexpr (F8) asm volatile("s_nop 15\n\ts_nop 15" ::: "memory");
        pb.epi(acc, cur, lds + AUX_OFF + (ui & 1) * 2048);
        if (!has_next) break;
#pragma unroll
        for (int a = 0; a < 2; ++a)
#pragma unroll
            for (int b = 0; b < 2; ++b)
#pragma unroll
                for (int m = 0; m < 4; ++m)
#pragma unroll
                    for (int n = 0; n < 2; ++n) acc[a][b][m][n] = (f32x4){0.f, 0.f, 0.f, 0.f};
        cur = nxt; cB = nB; ++ui;
#pragma unroll
        for (int h = 0; h < 2; ++h)
#pragma unroll
            for (int i = 0; i < 2; ++i) voAc[h][i] = voAn[h][i];
        if (wr == 1) PG8_BAR;
    }
    PG8_WAIT_V(0);
    PG8_BAR;
#undef PG8_SA
#undef PG8_SB
#undef PG8_STAGE
#undef PG8_LDA
#undef PG8_LDB
#undef PG8_MMA
#undef PG8_WAIT_V
#undef PG8_WAIT_L
#undef PG8_BAR
#undef PG8_SCHED
#undef PG8_VOA
}

#ifndef FAST_INPROJ
#define FAST_INPROJ 1
#endif
#ifndef FAST_OUTPROJ
#define FAST_OUTPROJ 1
#endif
#ifndef FAST_GU
#define FAST_GU 1
#endif
#ifndef FAST_DOWN
#define FAST_DOWN 1
#endif
template <bool FAST, class Pb> __device__ __forceinline__ void gemm_run(LAS unsigned char* lds, const Pb& pb, int bid, int nblk) {
    if constexpr (FAST) gemm_phase8(lds, pb, bid, nblk); else gemm_simple(lds, pb, bid, nblk);
}

__device__ __forceinline__ void inproj_phase(const Params& P, LAS unsigned char* lds, int l, int bid, int nblk) {
    unsigned char* ws = P.ws;
    { PbInProjT<true> pb; pb.A = (const char*)(ws + WS_H8); pb.B = (const char*)(ws + WS_WIN8) + (size_t)l * (768 * 1024); pb.K = 1024;
      pb.proj = (bf16*)(ws + WS_PROJ); pb.qg = P.qg + l * 64; pb.kg = P.kg + l * 64; pb.rope = (const float*)(ws + WS_ROPE);
      gemm_phase8(lds, pb, bid, nblk); }
    { PbInProjT<false> pb; pb.A = (const char*)(ws + WS_H); pb.B = (const char*)(ws + WS_WIN) + (size_t)l * (1280 * 1024 * 2); pb.K = 1024;
      pb.proj = (bf16*)(ws + WS_PROJ); pb.qg = P.qg + l * 64; pb.kg = P.kg + l * 64; pb.rope = (const float*)(ws + WS_ROPE);
      gemm_phase8(lds, pb, bid, nblk); }
}
__device__ __forceinline__ void outproj_phase(const Params& P, LAS unsigned char* lds, int l, int bid, int nblk) {
    unsigned char* ws = P.ws;
    if (l == 0) { PbOutProjT<true> pb; pb.A = (const char*)(ws + WS_MIX); pb.B = (const char*)(ws + WS_WOUT); pb.K = 1024;
        pb.xin32 = P.x; pb.xb = (bf16*)(ws + WS_XB); pb.gate1 = (const float*)(ws + WS_MOD) + 2 * D; gemm_phase8(lds, pb, bid, nblk); }
    else { PbOutProjT<false> pb; pb.A = (const char*)(ws + WS_MIX); pb.B = (const char*)(ws + WS_WOUT) + (size_t)l * (1024 * 1024); pb.K = 1024;
        pb.xin32 = nullptr; pb.xb = (bf16*)(ws + WS_XB); pb.gate1 = (const float*)(ws + WS_MOD) + (size_t)l * NB * NMOD + 2 * D; gemm_phase8(lds, pb, bid, nblk); }
}
__device__ __forceinline__ void gu_phase(const Params& P, LAS unsigned char* lds, int l, int bid, int nblk) {
    unsigned char* ws = P.ws;
    LAS int* tab = (LAS int*)(lds + 131072);
    __syncthreads();
    moe_build_tab(tab, (const int*)(ws + WS_TOT) + l * 32);
    PbGU pb; pb.A = (const char*)(ws + WS_H8); pb.B = (const char*)(ws + WS_WGU) + (size_t)l * 32 * (2048 * 1024); pb.K = 1024;
    pb.tab = tab; pb.list = (const int*)(ws + WS_LIST); pb.bgu = P.bgu + (size_t)l * 32 * 2048; pb.act = ws + WS_ACT;
    gemm_phase8(lds, pb, bid, nblk);
}
__device__ __forceinline__ void down_phase(const Params& P, LAS unsigned char* lds, int l, int bid, int nblk) {
    unsigned char* ws = P.ws;
    LAS int* tab = (LAS int*)(lds + 131072);
    __syncthreads();
    moe_build_tab(tab, (const int*)(ws + WS_TOT) + l * 32);
    PbDown pb; pb.A = (const char*)(ws + WS_ACT); pb.B = (const char*)(ws + WS_WDN) + (size_t)l * 32 * (1024 * 1024); pb.K = 1024;
    pb.tab = tab; pb.list = (const int*)(ws + WS_LIST); pb.bdn = P.bdn + (size_t)l * 32 * 1024; pb.ybuf = ws + WS_YBUF;
    gemm_phase8(lds, pb, bid, nblk);
}

#define XB_TMO      128
#define XB_XCNT(j)  (256  + 64 * (j))
#define XB_XSUB(j)  (1280 + 64 * (j))
#define XB_XGEN(j)  (2304 + 64 * (j))
#define XB_TOP      3328
#define XB_TOPGEN   3392
#define XCD_BAR_WORDS 3456
#define XB_SPIN_CAP (1u << 18)
__device__ __forceinline__ unsigned xb_ld(unsigned* p)              { return __hip_atomic_load(p, __ATOMIC_RELAXED, __HIP_MEMORY_SCOPE_AGENT); }
__device__ __forceinline__ unsigned xb_add(unsigned* p, unsigned v) { return __hip_atomic_fetch_add(p, v, __ATOMIC_RELAXED, __HIP_MEMORY_SCOPE_AGENT); }
__device__ __forceinline__ unsigned xb_xcc_id() { return (unsigned)__builtin_amdgcn_s_getreg((3 << 11) | 20) & 0xFu; }
#define XB_SPIN(cond, bar) do { unsigned _sp = 0; while (cond) { __builtin_amdgcn_s_sleep(1); \
    if ((++_sp & 255u) == 0u) { if (xb_ld(&(bar)[XB_TMO])) break; if (_sp > XB_SPIN_CAP) { atomicAdd(&(bar)[XB_TMO], 1u); break; } } } } while (0)
struct XcdBarrier { unsigned* bar; unsigned x; volatile LAS unsigned* st; };
__device__ __forceinline__ XcdBarrier xcd_barrier_post(unsigned* bar, volatile LAS unsigned* st) {
    XcdBarrier b; b.bar = bar; b.x = xb_xcc_id(); b.st = st;
    if (threadIdx.x == 0) (void)xb_add(&bar[XB_XCNT(b.x)], 1u);
    return b;
}
__device__ __forceinline__ void xcd_barrier_complete(unsigned* bar, unsigned x, unsigned& nloc, unsigned& nx) {
    const unsigned G = gridDim.x * gridDim.y * gridDim.z;
    unsigned sum, cnt, mine, sp = 0u;
    for (;;) {
        sum = 0u; cnt = 0u; mine = 0u;
#pragma unroll
        for (unsigned j = 0; j < 16; ++j) { const unsigned c = xb_ld(&bar[XB_XCNT(j)]); sum += c; cnt += (c > 0u) ? 1u : 0u; mine = (j == x) ? c : mine; }
        if (sum == G) break;
        __builtin_amdgcn_s_sleep(1);
        if ((++sp & 255u) == 0u) { if (xb_ld(&bar[XB_TMO])) break; if (sp > XB_SPIN_CAP) { atomicAdd(&bar[XB_TMO], 1u); break; } }
    }
    nloc = mine > 0u ? mine : 1u; nx = cnt > 0u ? cnt : 1u;
}
__device__ __forceinline__ void xcd_barrier(const XcdBarrier& b) {
    asm volatile("s_waitcnt vmcnt(0)" ::: "memory");
    __syncthreads();
    if (threadIdx.x == 0) {
        unsigned* bar = b.bar; const unsigned bx = xb_xcc_id();
        __builtin_amdgcn_s_waitcnt(0);
        unsigned nloc = b.st[0], nx = b.st[1];
        if (nloc == 0u) { xcd_barrier_complete(bar, bx, nloc, nx); b.st[0] = nloc; b.st[1] = nx; }
        const unsigned old = xb_add(&bar[XB_XSUB(bx)], 1u);
        const unsigned gen = old / nloc;
        if (old + 1u == (gen + 1u) * nloc) {
            __builtin_amdgcn_fence(__ATOMIC_RELEASE, "agent");
            asm volatile("s_waitcnt vmcnt(0)" ::: "memory");
            const unsigned og = xb_add(&bar[XB_TOP], 1u);
            const unsigned tg = og / nx;
            if (og + 1u == (tg + 1u) * nx) xb_add(&bar[XB_TOPGEN], 1u);
            else XB_SPIN(xb_ld(&bar[XB_TOPGEN]) == tg, bar);
            __builtin_amdgcn_fence(__ATOMIC_ACQUIRE, "agent");
            xb_add(&bar[XB_XGEN(bx)], 1u);
            asm volatile("s_waitcnt vmcnt(0)" ::: "memory");
        } else {
            XB_SPIN(xb_ld(&bar[XB_XGEN(bx)]) == gen, bar);
            __builtin_amdgcn_fence(__ATOMIC_ACQUIRE, "agent");
            asm volatile("s_waitcnt vmcnt(0)" ::: "memory");
        }
    }
    __syncthreads();
}


#if ONE_LAUNCH
constexpr int TAB_OFF = 131072, MISC_OFF = 131072 + 512;
__global__ void __launch_bounds__(NT, 2) mega_fwd(Params P) {
    extern __shared__ __attribute__((aligned(16))) unsigned char dyn_lds[];
    LAS unsigned char* lds = (LAS unsigned char*)dyn_lds;
    volatile LAS unsigned* MISC = (volatile LAS unsigned*)(lds + MISC_OFF);
    if (threadIdx.x < 32) MISC[threadIdx.x] = 0u;
    __syncthreads();
    XcdBarrier bar = xcd_barrier_post((unsigned*)(P.ws + WS_CTL) + CW_BAR, MISC + 8);
    const int bid = blockIdx.x, nblk = gridDim.x;
    const int vb = (nblk % 8 == 0) ? (bid % 8) * (nblk / 8) + bid / 8 : bid;
#ifndef REP_P0
#define REP_P0 1
#endif
#ifndef REP_INPROJ
#define REP_INPROJ 1
#endif
#ifndef REP_ATTN
#define REP_ATTN 1
#endif
#ifndef REP_GU
#define REP_GU 1
#endif
#ifndef REP_DOWN
#define REP_DOWN 1
#endif
    for (int r = 0; r < REP_P0; ++r) { p0_prologue(P, lds, bid, nblk); xcd_barrier(bar); }
    for (int l = 0; l < DEPTH; ++l) {
        if (l == 0) norm1_phase<0>(P, l, bid, nblk); else norm1_phase<1>(P, l, bid, nblk);
        xcd_barrier(bar);
        for (int r = 0; r < REP_INPROJ; ++r) { inproj_phase(P, lds, l, vb, nblk); xcd_barrier(bar); }
        for (int r = 0; r < REP_ATTN; ++r) { attn_phase(P, lds, l, bid, nblk); xcd_barrier(bar); }
        outproj_phase(P, lds, l, vb, nblk);
        xcd_barrier(bar);
        router_phase(P, lds, l, bid, nblk);
        xcd_barrier(bar);
        place_phase(P, lds, l, bid, nblk);
        xcd_barrier(bar);
        for (int r = 0; r < REP_GU; ++r) { gu_phase(P, lds, l, vb, nblk); xcd_barrier(bar); }
        for (int r = 0; r < REP_DOWN; ++r) { down_phase(P, lds, l, vb, nblk); xcd_barrier(bar); }
    }
    norm1_phase<2>(P, 0, bid, nblk);
}
#else
extern __shared__ __attribute__((aligned(16))) unsigned char dyn_lds[];
#define KLDS ((LAS unsigned char*)dyn_lds)
__global__ void __launch_bounds__(NT, 2) k_prologue(Params P) { p0_prologue(P, KLDS, blockIdx.x, gridDim.x); }
__global__ void __launch_bounds__(NT, 2) k_norm1_0(Params P, int l) { norm1_phase<0>(P, l, blockIdx.x, gridDim.x); }
__global__ void __launch_bounds__(NT, 2) k_norm1_1(Params P, int l) { norm1_phase<1>(P, l, blockIdx.x, gridDim.x); }
__global__ void __launch_bounds__(NT, 2) k_final(Params P) { norm1_phase<2>(P, 0, blockIdx.x, gridDim.x); }
__global__ void __launch_bounds__(NT, 2) k_inproj(Params P, int l) { inproj_phase(P, KLDS, l, blockIdx.x, gridDim.x); }
__global__ void __launch_bounds__(NT, 2) k_attn(Params P, int l) { attn_phase(P, KLDS, l, blockIdx.x, gridDim.x); }
__global__ void __launch_bounds__(NT, 2) k_outproj(Params P, int l) { outproj_phase(P, KLDS, l, blockIdx.x, gridDim.x); }
__global__ void __launch_bounds__(NT, 2) k_router(Params P, int l) { router_phase(P, KLDS, l, blockIdx.x, gridDim.x); }
__global__ void __launch_bounds__(NT, 2) k_place(Params P, int l) { place_phase(P, KLDS, l, blockIdx.x, gridDim.x); }
__global__ void __launch_bounds__(NT, 2) k_gu(Params P, int l) { gu_phase(P, KLDS, l, blockIdx.x, gridDim.x); }
__global__ void __launch_bounds__(NT, 2) k_down(Params P, int l) { down_phase(P, KLDS, l, blockIdx.x, gridDim.x); }

#endif

extern "C" void kernel_launch(void* const* d_in, const int* in_sizes, int n_in, void* d_out, int out_size, void* d_ws, size_t ws_size, hipStream_t stream) {
    static int ready = 0;
    if (ready == 0) {
        if (n_in != 21 || out_size != NTOK * D || ws_size < WS_END) { fprintf(stderr, "kernel_launch: unexpected shapes (n_in %d out %d ws %zu)\n", n_in, out_size, ws_size); ready = -1; return; }
#if ONE_LAUNCH
        const void* ks[] = {(const void*)mega_fwd};
#else
        const void* ks[] = {(const void*)k_prologue, (const void*)k_norm1_0, (const void*)k_norm1_1, (const void*)k_final, (const void*)k_inproj, (const void*)k_attn, (const void*)k_outproj, (const void*)k_router, (const void*)k_gu, (const void*)k_down, (const void*)k_place};
#endif
        for (auto k : ks) if (hipFuncSetAttribute(k, hipFuncAttributeMaxDynamicSharedMemorySize, LDS_BYTES) != hipSuccess) { fprintf(stderr, "kernel_launch: hipFuncSetAttribute failed\n"); ready = -1; return; }
        ready = 1;
    }
    if (ready < 0) return;
    (void)hipMemsetAsync((char*)d_ws + WS_CTL, 0, CTL_ZERO_BYTES, stream);
    Params P{};
    P.x = (const float*)d_in[0]; P.c = (const float*)d_in[1]; P.pos = (const int*)d_in[2]; P.ada_w = (const float*)d_in[3]; P.ada_b = (const float*)d_in[4]; P.n1g = (const float*)d_in[5];
    P.w_in = (const float*)d_in[6]; P.qg = (const float*)d_in[7]; P.kg = (const float*)d_in[8]; P.sinks = (const float*)d_in[9]; P.pool_w = (const float*)d_in[10]; P.pool_b = (const float*)d_in[11];
    P.pool_s = (const float*)d_in[12]; P.w_out = (const float*)d_in[13]; P.n2g = (const float*)d_in[14]; P.rw = (const float*)d_in[15]; P.rb = (const float*)d_in[16]; P.wgu = (const float*)d_in[17];
    P.bgu = (const float*)d_in[18]; P.wdn = (const float*)d_in[19]; P.bdn = (const float*)d_in[20]; P.out = (float*)d_out; P.ws = (unsigned char*)d_ws;
    const dim3 g(256), b(NT);
#if ONE_LAUNCH
    hipLaunchKernelGGL(mega_fwd, g, b, LDS_BYTES, stream, P);
#else
    hipLaunchKernelGGL(k_prologue, g, b, LDS_BYTES, stream, P);
    for (int l = 0; l < DEPTH; ++l) {
        if (l == 0) hipLaunchKernelGGL(k_norm1_0, g, b, LDS_BYTES, stream, P, l); else hipLaunchKernelGGL(k_norm1_1, g, b, LDS_BYTES, stream, P, l);
        hipLaunchKernelGGL(k_inproj, g, b, LDS_BYTES, stream, P, l);
        hipLaunchKernelGGL(k_attn, g, b, LDS_BYTES, stream, P, l);
        hipLaunchKernelGGL(k_outproj, g, b, LDS_BYTES, stream, P, l);
        hipLaunchKernelGGL(k_router, g, b, LDS_BYTES, stream, P, l);
        hipLaunchKernelGGL(k_place, g, b, LDS_BYTES, stream, P, l);
        hipLaunchKernelGGL(k_gu, g, b, LDS_BYTES, stream, P, l);
        hipLaunchKernelGGL(k_down, g, b, LDS_BYTES, stream, P, l);
    }
    hipLaunchKernelGGL(k_final, g, b, LDS_BYTES, stream, P);
#endif
}
```

```cpp
#include <hip/hip_runtime.h>
#include <cstdio>
#include <cstdint>

#ifndef ONE_LAUNCH
#define ONE_LAUNCH 1
#endif

#define LAS __attribute__((address_space(3)))
typedef unsigned short bf16;
typedef short bf16x8 __attribute__((ext_vector_type(8)));
typedef short s16x4 __attribute__((ext_vector_type(4)));
typedef float f32x4 __attribute__((ext_vector_type(4)));
typedef float f32x16 __attribute__((ext_vector_type(16)));
typedef unsigned u32x4 __attribute__((ext_vector_type(4)));
typedef unsigned u32x2 __attribute__((ext_vector_type(2)));
typedef float f32x2 __attribute__((ext_vector_type(2)));
typedef int i32x4 __attribute__((ext_vector_type(4)));
typedef int i32x8 __attribute__((ext_vector_type(8)));

constexpr int D = 1024, NB = 8, SEQ = 8192, NTOK = NB * SEQ, DEPTH = 2, NE = 32, NIN = 1280, NMOD = 6 * D;
constexpr int NT = 512;
constexpr float EPS = 1e-6f;
constexpr float LOG2E = 1.4426950408889634f;
constexpr float QSCALE = 0.18033688011112042f;
constexpr int MAXTILES = NTOK * 4 / 256 + NE;

constexpr size_t MiB = 1u << 20;
constexpr size_t WS_CTL = 0, CTL_ZERO_BYTES = 1 * MiB;
constexpr size_t WS_MOD = 1 * MiB;
constexpr size_t WS_ROPE = 2 * MiB;
constexpr size_t WS_WIN = 8 * MiB;
constexpr size_t WS_WIN8 = 14 * MiB;
constexpr size_t WS_WOUT = 16 * MiB;
constexpr size_t WS_GATES = 20 * MiB;
constexpr size_t WS_SEL = 21 * MiB;
constexpr size_t WS_CNTB = 22 * MiB;
constexpr size_t WS_TOT = 23 * MiB;
constexpr size_t WS_LIST = 24 * MiB;
constexpr size_t WS_WGU = 32 * MiB;
constexpr size_t WS_WDN = 160 * MiB;
constexpr size_t WS_H = 224 * MiB;
constexpr size_t WS_H8 = 352 * MiB;
constexpr size_t WS_PROJ = 416 * MiB;
constexpr size_t WS_MIX = 576 * MiB;
constexpr size_t WS_ACT = 416 * MiB;
constexpr size_t WS_YBUF = 704 * MiB;
constexpr size_t WS_XB = 960 * MiB;
constexpr size_t WS_END = 1088 * MiB;
static_assert(WS_ACT + (size_t)MAXTILES * 256 * 1024 <= WS_YBUF, "act fits");
constexpr float MIXSCALE = 8.0f;
constexpr float WSCALE = 32.0f, WUNSCALE = 1.0f / 32.0f;
constexpr int CW_BAR = 4096;
constexpr int CW_FLAG = 16384;
constexpr int CW_CNT = 8192;

constexpr int LDS_BYTES = 147456;
constexpr int AUX_OFF = 131072 + 2048;
constexpr int LSTAGE_OFF = 131072 + 1024;

struct Params {
    const float *x, *c; const int* pos; const float *ada_w, *ada_b, *n1g, *w_in, *qg, *kg, *sinks, *pool_w, *pool_b, *pool_s, *w_out, *n2g, *rw, *rb, *wgu, *bgu, *wdn, *bdn;
    float* out; unsigned char* ws;
};

__device__ __forceinline__ unsigned cvt_pk_bf16(float lo, float hi) { unsigned r; asm("v_cvt_pk_bf16_f32 %0, %1, %2" : "=v"(r) : "v"(lo), "v"(hi)); return r; }
__device__ __forceinline__ unsigned cvt_pk4_fp8(float a, float b, float c, float d) { int w = 0; w = __builtin_amdgcn_cvt_pk_fp8_f32(a, b, w, false); w = __builtin_amdgcn_cvt_pk_fp8_f32(c, d, w, true); return (unsigned)w; }
__device__ __forceinline__ float bf_lo(unsigned w) { return __uint_as_float(w << 16); }
__device__ __forceinline__ float bf_hi(unsigned w) { return __uint_as_float(w & 0xffff0000u); }
template <int M> __device__ __forceinline__ float swz_xor(float v) { return __int_as_float(__builtin_amdgcn_ds_swizzle(__float_as_int(v), (M << 10) | 0x1f)); }
__device__ __forceinline__ float sum_x32(float v) { const auto r = __builtin_amdgcn_permlane32_swap(__float_as_uint(v), __float_as_uint(v), false, false); return __uint_as_float(r[0]) + __uint_as_float(r[1]); }
__device__ __forceinline__ float max_x32(float v) { const auto r = __builtin_amdgcn_permlane32_swap(__float_as_uint(v), __float_as_uint(v), false, false); return fmaxf(__uint_as_float(r[0]), __uint_as_float(r[1])); }
__device__ __forceinline__ float sum_x16(float v) { const auto r = __builtin_amdgcn_permlane16_swap(__float_as_uint(v), __float_as_uint(v), false, false); return __uint_as_float(r[0]) + __uint_as_float(r[1]); }
__device__ __forceinline__ float get_x16(float v, bool rowodd) { const auto r = __builtin_amdgcn_permlane16_swap(__float_as_uint(v), __float_as_uint(v), false, false); return __uint_as_float(rowodd ? r[0] : r[1]); }
template <int CTRL> __device__ __forceinline__ float dpp_f(float v) { return __int_as_float(__builtin_amdgcn_update_dpp(0, __float_as_int(v), CTRL, 0xF, 0xF, true)); }
__device__ __forceinline__ float wave_sum(float v) {
    v += dpp_f<0xB1>(v); v += dpp_f<0x4E>(v); v += dpp_f<0x141>(v); v += dpp_f<0x140>(v); v = sum_x16(v);
    return sum_x32(v);
}
__device__ __forceinline__ int dpp_swap1(int v) { return __builtin_amdgcn_update_dpp(0, v, 0xB1, 0xF, 0xF, true); }
__device__ __forceinline__ u32x4 dpp_swap1(u32x4 v) { u32x4 r; r.x = (unsigned)dpp_swap1((int)v.x); r.y = (unsigned)dpp_swap1((int)v.y); r.z = (unsigned)dpp_swap1((int)v.z); r.w = (unsigned)dpp_swap1((int)v.w); return r; }
__device__ __forceinline__ void store_line_pair(unsigned char* own_line, unsigned char* nb_line, bool own_valid, bool nb_valid, u32x4 lo, u32x4 hi, int fq, bool odd) {
    const u32x4 got = dpp_swap1(odd ? lo : hi);
    const int off = (odd ? 64 : 0) + 16 * fq;
    if (odd ? nb_valid : own_valid) *(u32x4*)((odd ? nb_line : own_line) + off) = odd ? got : lo;
    if (odd ? own_valid : nb_valid) *(u32x4*)((odd ? own_line : nb_line) + off) = odd ? hi : got;
}
__device__ __forceinline__ void load_line_pair(const unsigned char* own_line, const unsigned char* nb_line, int fq, bool odd, u32x4& lo, u32x4& hi) {
    const int off = (odd ? 64 : 0) + 16 * fq;
    const u32x4 a = *(const u32x4*)((odd ? nb_line : own_line) + off), b = *(const u32x4*)((odd ? own_line : nb_line) + off);
    const u32x4 got = dpp_swap1(odd ? a : b);
    lo = odd ? got : a; hi = odd ? b : got;
}
__device__ __forceinline__ int lperm(int r) { return (r & 63) * 4 + (r >> 6); }
__device__ __forceinline__ int perm32(int rho) { const int n = rho >> 4, i = rho & 15; return 8 * (i >> 2) + 4 * n + (i & 3); }
__device__ __forceinline__ int opaque_tid() { int t = threadIdx.x; asm volatile("" : "+v"(t)); return t; }

__device__ __forceinline__ void tr_item_src(const Params& P, int it, const float*& src, int& ldw, bf16*& dst, int& k0, int& n0, bool& f8) {
    f8 = true;
    unsigned char* ws = P.ws;
    if (it < 8192) { const int m = it >> 7, r = it & 127; src = P.wgu + (size_t)m * (1024 * 2048); ldw = 2048; dst = (bf16*)(ws + WS_WGU + (size_t)m * (2048 * 1024)); k0 = 128 * (r >> 4); n0 = 128 * (r & 15); return; }
    it -= 8192;
    if (it < 4096) { const int m = it >> 6, r = it & 63; src = P.wdn + (size_t)m * (1024 * 1024); ldw = 1024; dst = (bf16*)(ws + WS_WDN + (size_t)m * (1024 * 1024)); k0 = 128 * (r >> 3); n0 = 128 * (r & 7); return; }
    it -= 4096;
    if (it < 96) { const int l = it / 48, r = it % 48; src = P.w_in + (size_t)l * (1024 * 1280); ldw = 1280; dst = (bf16*)(ws + WS_WIN8 + (size_t)l * (768 * 1024)); k0 = 128 * (r / 6); n0 = 128 * (r % 6); return; }
    it -= 96;
    { const int l = it >> 6, r = it & 63; src = P.w_out + (size_t)l * (1024 * 1024); ldw = 1024; dst = (bf16*)(ws + WS_WOUT + (size_t)l * (1024 * 1024)); k0 = 128 * (r >> 3); n0 = 128 * (r & 7); }
}
constexpr int N_TR_ITEMS = 8192 + 4096 + 96 + 128;

__device__ __forceinline__ void p0_prologue(const Params& P, LAS unsigned char* lds, int bid, int nblk) {
    const int tid = opaque_tid(), wid = __builtin_amdgcn_readfirstlane(tid >> 6), lane = tid & 63;
    unsigned char* ws = P.ws;
    {
        LAS float* cact = (LAS float*)lds;
        LAS float* red = (LAS float*)(lds + 32768);
        if (bid < 192 || nblk < 192) {
            for (int i = tid; i < NB * D; i += NT) { const float v = P.c[i]; cact[i] = v / (1.0f + __expf(-v)); }
            __syncthreads();
            for (int it = bid; it < 192; it += nblk) {
                const int l = it / 96, n0 = 64 * (it % 96);
                float acc[NB];
#pragma unroll
                for (int b = 0; b < NB; ++b) acc[b] = 0.f;
                const float* wp = P.ada_w + (size_t)l * D * NMOD + n0 + lane;
                for (int k = 128 * wid; k < 128 * wid + 128; k += 16) {
                    float wv[16];
#pragma unroll
                    for (int q = 0; q < 16; ++q) wv[q] = wp[(size_t)(k + q) * NMOD];
#pragma unroll
                    for (int q = 0; q < 16; ++q)
#pragma unroll
                        for (int b = 0; b < NB; ++b) acc[b] += cact[b * D + k + q] * wv[q];
                }
#pragma unroll
                for (int b = 0; b < NB; ++b) red[(wid * NB + b) * 64 + lane] = acc[b];
                __syncthreads();
                { const int b = tid >> 6; float s = P.ada_b[l * NMOD + n0 + lane];
#pragma unroll
                  for (int w = 0; w < 8; ++w) s += red[(w * NB + b) * 64 + lane];
                  ((float*)(ws + WS_MOD))[(size_t)(l * NB + b) * NMOD + n0 + lane] = s; }
                __syncthreads();
            }
        }
    }
    for (int it = bid; it < 128; it += nblk) {
        const int l = it >> 6, g = (it >> 4) & 3, k0 = 64 * (it & 15);
        LAS float* At = (LAS float*)lds;
        LAS float* Pw = (LAS float*)(lds + 33024);
        __syncthreads();
        for (int j = 0; j < 16; ++j) { const int idx = tid + NT * j, k = idx >> 7, c = idx & 127; At[k * 129 + c] = P.w_in[(size_t)l * (1024 * 1280) + (size_t)(k0 + k) * 1280 + 768 + 128 * g + c]; }
        for (int j = 0; j < 32; ++j) { const int idx = tid + NT * j; Pw[idx] = P.pool_w[(size_t)(l * 4 + g) * 16384 + idx]; }
        __syncthreads();
        const int n = tid & 127, ks = tid >> 7;
        float acc[16];
#pragma unroll
        for (int i = 0; i < 16; ++i) acc[i] = 0.f;
        for (int c = 0; c < 128; ++c) { const float pw = Pw[c * 128 + n];
#pragma unroll
            for (int i = 0; i < 16; ++i) acc[i] += At[(16 * ks + i) * 129 + c] * pw; }
        bf16* dst = (bf16*)(ws + WS_WIN) + (size_t)l * (1280 * 1024) + (size_t)(768 + 128 * g + n) * 1024 + k0 + 16 * ks;
        u32x4 o0, o1;
        o0.x = cvt_pk_bf16(acc[0], acc[1]); o0.y = cvt_pk_bf16(acc[2], acc[3]); o0.z = cvt_pk_bf16(acc[4], acc[5]); o0.w = cvt_pk_bf16(acc[6], acc[7]);
        o1.x = cvt_pk_bf16(acc[8], acc[9]); o1.y = cvt_pk_bf16(acc[10], acc[11]); o1.z = cvt_pk_bf16(acc[12], acc[13]); o1.w = cvt_pk_bf16(acc[14], acc[15]);
        *(u32x4*)dst = o0; *(u32x4*)(dst + 8) = o1;
    }
    {
        const double invf[8] = {1.0, 0.19392274474868576, 0.03760603093086393, 0.007292664737217109, 0.001414213562373095, 0.0002742481756762073, 5.318295896944988e-05, 1.031338537721246e-05};
        float* rope = (float*)(ws + WS_ROPE);
        for (int idx = bid * NT + tid; idx < NTOK * 8; idx += nblk * NT) {
            const int tok = idx >> 3, i = idx & 7;
            double f = 1.0;
#pragma unroll
            for (int q = 0; q < 8; ++q) f = (i == q) ? invf[q] : f;
            const double ang = (double)P.pos[tok] * f;
            const double kq = __builtin_rint(ang * 0.6366197723675814);
            const double r = (ang - kq * 1.5707963267948966) - kq * 6.123233995736766e-17;
            const double r2 = r * r;
            double sn = r * (1.0 + r2 * (-1.0 / 6 + r2 * (1.0 / 120 + r2 * (-1.0 / 5040 + r2 * (1.0 / 362880 + r2 * (-1.0 / 39916800 + r2 * (1.0 / 6227020800.0)))))));
            double cs = 1.0 + r2 * (-0.5 + r2 * (1.0 / 24 + r2 * (-1.0 / 720 + r2 * (1.0 / 40320 + r2 * (-1.0 / 3628800 + r2 * (1.0 / 479001600.0 + r2 * (-1.0 / 87178291200.0)))))));
            const int q = ((int)(long long)kq) & 3;
            double s2 = (q & 1) ? cs : sn, c2 = (q & 1) ? sn : cs;
            if (q == 1 || q == 2) c2 = -c2;
            if (q >= 2) s2 = -s2;
            rope[tok * 16 + i] = (float)c2; rope[tok * 16 + 8 + i] = (float)s2;
        }
    }
    {
        LAS float* tile = (LAS float*)lds;
        __syncthreads();
        f32x4 r[8];
        const float* src; int ldw, k0, n0; bf16* dst; bool f8;
        int it = bid;
        if (it < N_TR_ITEMS) { tr_item_src(P, it, src, ldw, dst, k0, n0, f8);
#pragma unroll
            for (int j = 0; j < 8; ++j) { const int idx = tid + NT * j, row = idx >> 5, c4 = idx & 31; r[j] = *(const f32x4*)(src + (size_t)(k0 + row) * ldw + n0 + 4 * c4); } }
        for (; it < N_TR_ITEMS; it += nblk) {
#pragma unroll
            for (int j = 0; j < 8; ++j) { const int idx = tid + NT * j, row = idx >> 5, c4 = idx & 31; LAS float* t = tile + row * 129 + (row >> 5) * 8 + 4 * c4; t[0] = r[j].x; t[1] = r[j].y; t[2] = r[j].z; t[3] = r[j].w; }
            __syncthreads();
            bf16* cdst = dst; const int ck0 = k0, cn0 = n0;
            if (it + nblk < N_TR_ITEMS) { tr_item_src(P, it + nblk, src, ldw, dst, k0, n0, f8);
#pragma unroll
                for (int j = 0; j < 8; ++j) { const int idx = tid + NT * j, row = idx >> 5, c4 = idx & 31; r[j] = *(const f32x4*)(src + (size_t)(k0 + row) * ldw + n0 + 4 * c4); } }
            const int n = tid >> 2, c = tid & 3;
            const LAS float* t = tile + (32 * c) * 129 + c * 8 + n;
            {
                u32x4 o[2];
#pragma unroll
                for (int h = 0; h < 2; ++h) {
                    float v[16];
#pragma unroll
                    for (int i = 0; i < 16; ++i) v[i] = t[(16 * h + i) * 129] * WSCALE;
                    o[h].x = cvt_pk4_fp8(v[0], v[1], v[2], v[3]); o[h].y = cvt_pk4_fp8(v[4], v[5], v[6], v[7]); o[h].z = cvt_pk4_fp8(v[8], v[9], v[10], v[11]); o[h].w = cvt_pk4_fp8(v[12], v[13], v[14], v[15]);
                }
                unsigned char* op = (unsigned char*)cdst + (size_t)(cn0 + n) * 1024 + ck0 + 32 * c;
                *(u32x4*)op = o[0]; *(u32x4*)(op + 16) = o[1];
            }
            __syncthreads();
        }
    }
}

template <int MODE>
__device__ __forceinline__ void norm1_phase(const Params& P, int l, int bid, int nblk) {
    const int tid = opaque_tid(), wid = __builtin_amdgcn_readfirstlane(tid >> 6), lane = tid & 63;
    unsigned char* ws = P.ws;
    const float* mod = (const float*)(ws + WS_MOD);
    bf16* XB = (bf16*)(ws + WS_XB);
    bf16* H = (bf16*)(ws + WS_H);
    unsigned char* H8 = ws + WS_H8;
    const float* gates = (const float*)(ws + WS_GATES);
    const unsigned char* Y = ws + WS_YBUF;
    for (int ch = bid * 8 + wid; ch < NTOK / 32; ch += nblk * 8) {
        const int b = (ch * 32) >> 13;
        f32x4 ca[4], cc[4], cg[4];
#pragma unroll
        for (int j = 0; j < 4; ++j) {
            const int col = 256 * j + 4 * lane;
            if (MODE <= 1) { const f32x4 g = *(const f32x4*)(P.n1g + l * D + col); const f32x4 sc = *(const f32x4*)(mod + (size_t)(l * NB + b) * NMOD + 1 * D + col);
                ca[j] = g * (1.0f + sc); cc[j] = *(const f32x4*)(mod + (size_t)(l * NB + b) * NMOD + 0 * D + col); }
            if (MODE >= 1) { const int lp = (MODE == 2) ? (DEPTH - 1) : (l - 1); cg[j] = *(const f32x4*)(mod + (size_t)(lp * NB + b) * NMOD + 5 * D + col); }
        }
        for (int rr = 0; rr < 32; ++rr) {
            const int row = ch * 32 + rr;
            f32x4 v[4];
            if (MODE == 0) {
#pragma unroll
                for (int j = 0; j < 4; ++j) v[j] = *(const f32x4*)(P.x + (size_t)row * D + 256 * j + 4 * lane);
            } else {
#pragma unroll
                for (int j = 0; j < 4; ++j) { const u32x2 xw = *(const u32x2*)(XB + (size_t)row * D + 256 * j + 4 * lane); v[j] = (f32x4){bf_lo(xw.x), bf_hi(xw.x), bf_lo(xw.y), bf_hi(xw.y)}; }
            }
            if (MODE >= 1) {
                const f32x4 gt = *(const f32x4*)(gates + (size_t)row * 4);
                f32x4 a[4];
#pragma unroll
                for (int j = 0; j < 4; ++j) a[j] = (f32x4){0.f, 0.f, 0.f, 0.f};
#pragma unroll
                for (int k = 0; k < 4; ++k) {
                    const float gk = gt[k];
#pragma unroll
                    for (int j = 0; j < 4; ++j) { const unsigned y = *(const unsigned*)(Y + ((size_t)row * 4 + k) * D + 256 * j + 4 * lane);
                        const f32x2 p0 = __builtin_amdgcn_cvt_pk_f32_fp8((int)y, false), p1 = __builtin_amdgcn_cvt_pk_f32_fp8((int)y, true);
                        a[j].x += gk * p0.x; a[j].y += gk * p0.y; a[j].z += gk * p1.x; a[j].w += gk * p1.y; }
                }
#pragma unroll
                for (int j = 0; j < 4; ++j) { v[j] += cg[j] * a[j];
                    if (MODE == 2) *(f32x4*)(P.out + (size_t)row * D + 256 * j + 4 * lane) = v[j];
                    else { u32x2 xo; xo.x = cvt_pk_bf16(v[j].x, v[j].y); xo.y = cvt_pk_bf16(v[j].z, v[j].w); *(u32x2*)(XB + (size_t)row * D + 256 * j + 4 * lane) = xo; } }
            }
            if (MODE <= 1) {
                float ss = 0.f;
#pragma unroll
                for (int j = 0; j < 4; ++j) ss += (v[j].x * v[j].x + v[j].y * v[j].y) + (v[j].z * v[j].z + v[j].w * v[j].w);
                const float rstd = 1.0f / sqrtf(wave_sum(ss) * (1.0f / D) + EPS);
#pragma unroll
                for (int j = 0; j < 4; ++j) { const f32x4 h = v[j] * rstd * ca[j] + cc[j]; u32x2 o; o.x = cvt_pk_bf16(h.x, h.y); o.y = cvt_pk_bf16(h.z, h.w);
                    *(u32x2*)(H + (size_t)row * D + 256 * j + 4 * lane) = o; *(unsigned*)(H8 + (size_t)row * D + 256 * j + 4 * lane) = cvt_pk4_fp8(h.x, h.y, h.z, h.w); }
            }
        }
    }
}

struct Unit { int pm, pn, e, nrows, tbase, ks; };
typedef f32x4 Acc[2][2][4][2];

template <class Pb>
__device__ __forceinline__ void gemm_simple(LAS unsigned char* lds, const Pb& pb, int bid, int nblk) {
    const int tid = opaque_tid(), wid = __builtin_amdgcn_readfirstlane(tid >> 6), lane = tid & 63, wr = wid >> 2, wc = wid & 3, fr = lane & 15, fq = lane >> 4;
    constexpr int PITCH = 144;
    LAS unsigned char* sA = lds; LAS unsigned char* sB = lds + 256 * PITCH;
    Unit u;
    for (int i = 0; pb.next(i, bid, nblk, u); ++i) {
        Acc acc;
#pragma unroll
        for (int a = 0; a < 2; ++a)
#pragma unroll
            for (int b = 0; b < 2; ++b)
#pragma unroll
                for (int m = 0; m < 4; ++m)
#pragma unroll
                    for (int n = 0; n < 2; ++n) acc[a][b][m][n] = (f32x4){0.f, 0.f, 0.f, 0.f};
        unsigned ao[4], bo[4];
#pragma unroll
        for (int j = 0; j < 4; ++j) { const int q = tid + NT * j, row = q >> 3, c8 = q & 7;
            ao[j] = (unsigned)pb.a_row(u, row) * (unsigned)(pb.K * 2) + c8 * 16; bo[j] = (unsigned)pb.b_row(u, row) * (unsigned)(pb.K * 2) + c8 * 16; }
        for (int kt = 0; kt < pb.K / 64; ++kt) {
            u32x4 ra[4], rb[4];
#pragma unroll
            for (int j = 0; j < 4; ++j) { ra[j] = *(const u32x4*)(pb.A + ao[j] + kt * 128); rb[j] = *(const u32x4*)(pb.B + bo[j] + kt * 128); }
            __syncthreads();
#pragma unroll
            for (int j = 0; j < 4; ++j) { const int q = tid + NT * j, row = q >> 3, c8 = q & 7; *(LAS u32x4*)(sA + row * PITCH + c8 * 16) = ra[j]; *(LAS u32x4*)(sB + row * PITCH + c8 * 16) = rb[j]; }
            __syncthreads();
#pragma unroll
            for (int kk = 0; kk < 2; ++kk) {
                bf16x8 bfr[2][2];
#pragma unroll
                for (int b = 0; b < 2; ++b)
#pragma unroll
                    for (int n = 0; n < 2; ++n) bfr[b][n] = *(const LAS bf16x8*)(sB + (128 * b + 32 * wc + 16 * n + fr) * PITCH + (kk * 32 + fq * 8) * 2);
#pragma unroll
                for (int a = 0; a < 2; ++a) {
                    bf16x8 af[4];
#pragma unroll
                    for (int m = 0; m < 4; ++m) af[m] = *(const LAS bf16x8*)(sA + (128 * a + 64 * wr + 16 * m + fr) * PITCH + (kk * 32 + fq * 8) * 2);
#pragma unroll
                    for (int b = 0; b < 2; ++b)
#pragma unroll
                        for (int m = 0; m < 4; ++m)
#pragma unroll
                            for (int n = 0; n < 2; ++n) acc[a][b][m][n] = __builtin_amdgcn_mfma_f32_16x16x32_bf16(bfr[b][n], af[m], acc[a][b][m][n], 0, 0, 0);
                }
            }
        }
        pb.epi(acc, u, lds + AUX_OFF);
    }
    __syncthreads();
}

template <bool F8_, bool LOCAL> struct PbInProjT {
    static constexpr bool GATHER = false; __device__ __forceinline__ const int* list_block(const Unit&) const { return nullptr; }
    static constexpr bool F8 = F8_, AUX = false;
    const char* A; const char* B; int K;
    bf16* proj; const float* qg; const float* kg; const float* rope; int tile;
    __device__ __forceinline__ bool next(int i, int bid, int nblk, Unit& u) const { const int L = i * nblk + bid; u.e = 0; u.nrows = 256; u.tbase = 0; u.ks = 0;
        if (LOCAL) { if (i >= (F8_ ? 3 : 2)) return false; u.pm = tile; u.pn = F8_ ? i : 3 + i; return true; }
        if (F8_) { if (L >= 256 * 3) return false; u.pm = L / 3; u.pn = L % 3; } else { if (L >= 256 * 2) return false; u.pm = L >> 1; u.pn = 3 + (L & 1); }
        return true; }
    __device__ __forceinline__ int a_row(const Unit& u, int r) const { return 256 * u.pm + r; }
    __device__ __forceinline__ void a_rows4(const Unit& u, int r0, int (&rows)[4]) const { for (int j = 0; j < 4; ++j) rows[j] = 256 * u.pm + r0 + 64 * j; }
    __device__ __forceinline__ int4 a_rows_raw(const Unit&, int) const { return make_int4(0, 0, 0, 0); }
    __device__ __forceinline__ void a_rows_fin(const Unit& u, int r0, const int4&, int (&rows)[4]) const { a_rows4(u, r0, rows); }
    __device__ __forceinline__ int b_rowc(int rho) const { return 64 * ((rho >> 5) & 3) + 32 * (rho >> 7) + perm32(rho & 31); }
    __device__ __forceinline__ int b_base_row(const Unit& u) const { return 256 * u.pn; }
    __device__ __forceinline__ int b_row(const Unit& u, int rho) const { return b_base_row(u) + b_rowc(rho); }
    __device__ __forceinline__ void epi(const Acc& acc, const Unit& u, const LAS unsigned char* aux) const {
        const int t_ = opaque_tid(), w_ = __builtin_amdgcn_readfirstlane(t_ >> 6), wr = w_ >> 2, wc = w_ & 3, fr = t_ & 15, fq = (t_ >> 4) & 3;
        const int hg = 4 * u.pn + wc;
        const bool nrm = F8_ && hg < 10;
        constexpr float US = F8_ ? WUNSCALE : 1.0f;
        const float* gsrc = (hg < 8) ? qg : kg;
        f32x4 gv[2][2];
#pragma unroll
        for (int bj = 0; bj < 2; ++bj)
#pragma unroll
            for (int n = 0; n < 2; ++n) gv[bj][n] = nrm ? *(const f32x4*)(gsrc + 32 * bj + 8 * fq + 4 * n) * US : (f32x4){1.f, 1.f, 1.f, 1.f};
        const float qs = (hg < 8) ? QSCALE : (nrm ? 1.0f : US);
#pragma unroll
        for (int q = 0; q < 4; ++q) {
            const int ai = q >> 1, m0 = 2 * (q & 1);
            f32x4 rcs[2][2], rsn[2][2];
            if (nrm && fq < 2) {
#pragma unroll
                for (int mm = 0; mm < 2; ++mm) { const float* rp = rope + (size_t)(256 * u.pm + 128 * ai + 64 * wr + 16 * (m0 + mm) + fr) * 16;
#pragma unroll
                    for (int n = 0; n < 2; ++n) { rcs[mm][n] = *(const f32x4*)(rp + 4 * n); rsn[mm][n] = *(const f32x4*)(rp + 8 + 4 * n); } }
            }
#pragma unroll
            for (int mm = 0; mm < 2; ++mm) {
                const int m = m0 + mm;
                const int row = 256 * u.pm + 128 * ai + 64 * wr + 16 * m + fr;
                f32x4 v[2][2];
#pragma unroll
                for (int bj = 0; bj < 2; ++bj)
#pragma unroll
                    for (int n = 0; n < 2; ++n) v[bj][n] = acc[ai][bj][m][n];
                if (nrm) {
                    float ss = 0.f;
#pragma unroll
                    for (int bj = 0; bj < 2; ++bj)
#pragma unroll
                        for (int n = 0; n < 2; ++n) ss += (v[bj][n].x * v[bj][n].x + v[bj][n].y * v[bj][n].y) + (v[bj][n].z * v[bj][n].z + v[bj][n].w * v[bj][n].w);
                    ss = sum_x16(ss); ss = sum_x32(ss);
                    const float rstd = __builtin_amdgcn_rsqf(ss * (US * US / 64.0f) + EPS);
#pragma unroll
                    for (int bj = 0; bj < 2; ++bj)
#pragma unroll
                        for (int n = 0; n < 2; ++n) v[bj][n] = v[bj][n] * rstd * gv[bj][n];
#pragma unroll
                    for (int n = 0; n < 2; ++n) {
                        f32x4 pr;
                        pr.x = get_x16(v[0][n].x, fq & 1); pr.y = get_x16(v[0][n].y, fq & 1); pr.z = get_x16(v[0][n].z, fq & 1); pr.w = get_x16(v[0][n].w, fq & 1);
                        if (fq < 2) v[0][n] = (fq == 0) ? (v[0][n] * rcs[mm][n] - pr * rsn[mm][n]) : (v[0][n] * rcs[mm][n] + pr * rsn[mm][n]);
                    }
                }
                u32x4 o[2];
#pragma unroll
                for (int bj = 0; bj < 2; ++bj) {
                    o[bj].x = cvt_pk_bf16(v[bj][0].x * qs, v[bj][0].y * qs); o[bj].y = cvt_pk_bf16(v[bj][0].z * qs, v[bj][0].w * qs);
                    o[bj].z = cvt_pk_bf16(v[bj][1].x * qs, v[bj][1].y * qs); o[bj].w = cvt_pk_bf16(v[bj][1].z * qs, v[bj][1].w * qs);
                }
                { unsigned char* own = (unsigned char*)(proj + (size_t)row * NIN + 64 * hg); const bool odd = fr & 1;
                  store_line_pair(own, odd ? own - NIN * 2 : own + NIN * 2, true, true, o[0], o[1], fq, odd); }
            }
        }
    }
};

template <bool FIRST, bool LOCAL> struct PbOutProjT {
    static constexpr bool GATHER = false; __device__ __forceinline__ const int* list_block(const Unit&) const { return nullptr; }
    static constexpr bool F8 = true, AUX = true;
    const char* A; const char* B; int K;
    const float* xin32; bf16* xb; const float* gate1; int tile;
    __device__ __forceinline__ bool next(int i, int bid, int nblk, Unit& u) const { const int L = i * nblk + bid; u.e = 0; u.nrows = 256; u.tbase = 0; u.ks = 0;
        if (LOCAL) { if (i >= 4) return false; u.pm = tile; u.pn = i; return true; }
        if (L >= 256 * 4) return false; u.pm = L >> 2; u.pn = L & 3; return true; }
    __device__ __forceinline__ int a_row(const Unit& u, int r) const { return 256 * u.pm + r; }
    __device__ __forceinline__ void a_rows4(const Unit& u, int r0, int (&rows)[4]) const { for (int j = 0; j < 4; ++j) rows[j] = 256 * u.pm + r0 + 64 * j; }
    __device__ __forceinline__ int4 a_rows_raw(const Unit&, int) const { return make_int4(0, 0, 0, 0); }
    __device__ __forceinline__ void a_rows_fin(const Unit& u, int r0, const int4&, int (&rows)[4]) const { a_rows4(u, r0, rows); }
    __device__ __forceinline__ int b_rowc(int rho) const { return 64 * ((rho >> 5) & 3) + 32 * (rho >> 7) + perm32(rho & 31); }
    __device__ __forceinline__ int b_base_row(const Unit& u) const { return 256 * u.pn; }
    __device__ __forceinline__ int b_row(const Unit& u, int rho) const { return b_base_row(u) + b_rowc(rho); }
    __device__ __forceinline__ void stage_aux(const Unit& u, LAS unsigned char* aux, int wid, int lane) const {
        if (lane < 8) __builtin_amdgcn_raw_ptr_buffer_load_lds(__builtin_amdgcn_make_buffer_rsrc((void*)(gate1 + (size_t)((256 * u.pm) >> 13) * NMOD + 256 * u.pn), 0, 1024, 0x00020000), (LAS unsigned*)(aux + wid * 128), 16, (wid * 8 + lane) * 16, 0, 0, 0); }
    __device__ __forceinline__ void epi(const Acc& acc, const Unit& u, const LAS unsigned char* aux) const {
        const int t_ = opaque_tid(), w_ = __builtin_amdgcn_readfirstlane(t_ >> 6), wr = w_ >> 2, wc = w_ & 3, fr = t_ & 15, fq = (t_ >> 4) & 3;
        const int colw = 256 * u.pn + 64 * wc;
        const bool odd = fr & 1;
        f32x4 g[2][2];
#pragma unroll
        for (int bj = 0; bj < 2; ++bj)
#pragma unroll
            for (int n = 0; n < 2; ++n) g[bj][n] = *(const LAS f32x4*)(aux + (64 * wc + 32 * bj + 8 * fq + 4 * n) * 4) * (WUNSCALE / MIXSCALE);
        u32x4 raw[2][2][FIRST ? 4 : 2];
#define OP_LOAD(q_) do { _Pragma("unroll") for (int mm = 0; mm < 2; ++mm) { \
            const size_t row = (size_t)(256 * u.pm + 128 * ((q_) >> 1) + 64 * wr + 16 * (2 * ((q_) & 1) + mm) + fr); \
            if (FIRST) { _Pragma("unroll") for (int c = 0; c < 4; ++c) raw[(q_) & 1][mm][c] = *(const u32x4*)(xin32 + row * D + colw + 32 * (c >> 1) + 8 * fq + 4 * (c & 1)); } \
            else { const unsigned char* xi = (const unsigned char*)(xb + row * D + colw); const unsigned char* nb = odd ? xi - D * 2 : xi + D * 2; const int off = (odd ? 64 : 0) + 16 * fq; \
                raw[(q_) & 1][mm][0] = *(const u32x4*)((odd ? nb : xi) + off); raw[(q_) & 1][mm][1] = *(const u32x4*)((odd ? xi : nb) + off); } } } while (0)
        OP_LOAD(0);
#pragma unroll
        for (int q = 0; q < 4; ++q) {
            const int ai = q >> 1, m0 = 2 * (q & 1);
            if (q < 3) OP_LOAD(q + 1);
#pragma unroll
            for (int mm = 0; mm < 2; ++mm) {
                const size_t row = (size_t)(256 * u.pm + 128 * ai + 64 * wr + 16 * (m0 + mm) + fr);
                f32x4 xr[2][2];
                if (FIRST) {
#pragma unroll
                    for (int c = 0; c < 4; ++c) xr[c >> 1][c & 1] = __builtin_bit_cast(f32x4, raw[q & 1][mm][c]);
                } else {
                    const u32x4 a = raw[q & 1][mm][0], bq = raw[q & 1][mm][1];
                    const u32x4 got = dpp_swap1(odd ? a : bq);
                    const u32x4 lo = odd ? got : a, hi = odd ? bq : got;
                    xr[0][0] = (f32x4){bf_lo(lo.x), bf_hi(lo.x), bf_lo(lo.y), bf_hi(lo.y)}; xr[0][1] = (f32x4){bf_lo(lo.z), bf_hi(lo.z), bf_lo(lo.w), bf_hi(lo.w)};
                    xr[1][0] = (f32x4){bf_lo(hi.x), bf_hi(hi.x), bf_lo(hi.y), bf_hi(hi.y)}; xr[1][1] = (f32x4){bf_lo(hi.z), bf_hi(hi.z), bf_lo(hi.w), bf_hi(hi.w)};
                }
                u32x4 o[2];
#pragma unroll
                for (int bj = 0; bj < 2; ++bj) { const f32x4 r0 = xr[bj][0] + g[bj][0] * acc[ai][bj][m0 + mm][0], r1 = xr[bj][1] + g[bj][1] * acc[ai][bj][m0 + mm][1];
                    o[bj].x = cvt_pk_bf16(r0.x, r0.y); o[bj].y = cvt_pk_bf16(r0.z, r0.w); o[bj].z = cvt_pk_bf16(r1.x, r1.y); o[bj].w = cvt_pk_bf16(r1.z, r1.w); }
                unsigned char* xo = (unsigned char*)(xb + row * D + colw);
                store_line_pair(xo, odd ? xo - D * 2 : xo + D * 2, true, true, o[0], o[1], fq, odd);
            }
            asm volatile("" ::: "memory");
        }
#undef OP_LOAD
    }
};

struct MoeTab { const LAS int* cnt; const LAS int* tp; };
__device__ __forceinline__ void moe_build_tab(LAS int* tab, const int* tot) {
    if (threadIdx.x == 0) { int t = 0; for (int e = 0; e < NE; ++e) { const int c = tot[e]; tab[e] = c; tab[32 + e] = t; t += (c + 255) >> 8; } tab[64] = t; }
    __syncthreads();
}
__device__ __forceinline__ bool moe_unit(const LAS int* tab, int L, int ntn, Unit& u) {
    const int ntile = __builtin_amdgcn_readfirstlane(tab[64]);
    const int gt = L / ntn; if (gt >= ntile) return false;
    const int ln = (int)__builtin_amdgcn_mbcnt_hi(~0u, __builtin_amdgcn_mbcnt_lo(~0u, (unsigned)ntile >> 30));
    const int tpv = tab[32 + (ln & 31)];
    const int e = __builtin_amdgcn_readfirstlane(__popcll(__ballot(tpv <= gt) & 0xffffffffull)) - 1;
    const int tpe = __builtin_amdgcn_readfirstlane(tab[32 + e]), cnt = __builtin_amdgcn_readfirstlane(tab[e]);
    u.e = e; u.pm = gt - tpe; u.pn = L % ntn; u.tbase = gt * 256; const int rem = cnt - 256 * u.pm; u.nrows = rem < 256 ? rem : 256; u.ks = 0; return true;
}

struct PbGU {
    static constexpr bool GATHER = true; __device__ __forceinline__ const int* list_block(const Unit& u) const { return list + (size_t)u.e * NTOK + 256 * u.pm; }
    static constexpr bool F8 = true, AUX = true;
    const char* A; const char* B; int K;
    const LAS int* tab; const int* list; const float* bgu; unsigned char* act;
    __device__ __forceinline__ void stage_aux(const Unit& u, LAS unsigned char* aux, int wid, int lane) const {
        if (lane < 8) __builtin_amdgcn_raw_ptr_buffer_load_lds(__builtin_amdgcn_make_buffer_rsrc((void*)(bgu + (size_t)u.e * 2048 + 128 * u.pn), 0, 4096 + 512, 0x00020000), (LAS unsigned*)(aux + wid * 128), 16, (wid >> 2) * 4096 + (wid & 3) * 128 + lane * 16, 0, 0, 0); }
    __device__ __forceinline__ bool next(int i, int bid, int nblk, Unit& u) const { return moe_unit(tab, i * nblk + bid, 8, u); }
    __device__ __forceinline__ int a_row(const Unit& u, int r) const { const int v = list[(size_t)u.e * NTOK + 256 * u.pm + lperm(r)]; return r < u.nrows ? (v >> 2) : 0; }
    __device__ __forceinline__ void a_rows4(const Unit& u, int r0, int (&rows)[4]) const {
        a_rows_fin(u, r0, a_rows_raw(u, r0), rows); }
    __device__ __forceinline__ int4 a_rows_raw(const Unit& u, int r0) const { return *(const int4*)(list + (size_t)u.e * NTOK + 256 * u.pm + 4 * r0); }
    __device__ __forceinline__ void a_rows_fin(const Unit& u, int r0, const int4& v, int (&rows)[4]) const {
        rows[0] = (r0 < u.nrows) ? (v.x >> 2) : 0; rows[1] = (r0 + 64 < u.nrows) ? (v.y >> 2) : 0; rows[2] = (r0 + 128 < u.nrows) ? (v.z >> 2) : 0; rows[3] = (r0 + 192 < u.nrows) ? (v.w >> 2) : 0; }
    __device__ __forceinline__ int b_rowc(int rho) const { const int i = rho & 127; return ((rho >> 7) ? 1024 : 0) + (i & ~31) + perm32(i & 31); }
    __device__ __forceinline__ int b_base_row(const Unit& u) const { return u.e * 2048 + 128 * u.pn; }
    __device__ __forceinline__ int b_row(const Unit& u, int rho) const { return b_base_row(u) + b_rowc(rho); }
    __device__ __forceinline__ void epi(const Acc& acc, const Unit& u, const LAS unsigned char* aux) const {
        const int t_ = opaque_tid(), w_ = __builtin_amdgcn_readfirstlane(t_ >> 6), wr = w_ >> 2, wc = w_ & 3, fr = t_ & 15, fq = (t_ >> 4) & 3;
        const int col0 = 128 * u.pn + 32 * wc + 8 * fq;
        f32x4 bg[2], bu[2];
#pragma unroll
        for (int n = 0; n < 2; ++n) { bg[n] = *(const LAS f32x4*)(aux + (32 * wc + 8 * fq + 4 * n) * 4); bu[n] = *(const LAS f32x4*)(aux + 512 + (32 * wc + 8 * fq + 4 * n) * 4) + 1.0f; }
#pragma unroll
        for (int ai = 0; ai < 2; ++ai)
#pragma unroll
            for (int m = 0; m < 4; ++m) {
                const int r = 128 * ai + 64 * wr + 16 * m + fr;
                f32x2 o[4];
#pragma unroll
                for (int n = 0; n < 2; ++n)
#pragma unroll
                    for (int h = 0; h < 2; ++h) {
                        const f32x2 ag = {acc[ai][0][m][n][2 * h], acc[ai][0][m][n][2 * h + 1]}, au = {acc[ai][1][m][n][2 * h], acc[ai][1][m][n][2 * h + 1]};
                        const f32x2 bgv = {bg[n][2 * h], bg[n][2 * h + 1]}, buv = {bu[n][2 * h], bu[n][2 * h + 1]};
                        f32x2 g = ag * WUNSCALE + bgv, uu = au * WUNSCALE + buv;
                        g.x = fminf(g.x, 7.0f); g.y = fminf(g.y, 7.0f);
                        uu.x = __builtin_amdgcn_fmed3f(uu.x, -6.0f, 8.0f); uu.y = __builtin_amdgcn_fmed3f(uu.y, -6.0f, 8.0f);
                        const f32x2 t = g * (-1.702f * LOG2E);
                        f32x2 e; e.x = __builtin_amdgcn_exp2f(t.x); e.y = __builtin_amdgcn_exp2f(t.y);
                        const f32x2 d = e + 1.0f;
                        f32x2 rc; rc.x = __builtin_amdgcn_rcpf(d.x); rc.y = __builtin_amdgcn_rcpf(d.y);
                        o[2 * n + h] = (g * rc) * uu;
                    }
                u32x2 w; w.x = cvt_pk4_fp8(o[0].x, o[0].y, o[1].x, o[1].y); w.y = cvt_pk4_fp8(o[2].x, o[2].y, o[3].x, o[3].y);
                *(u32x2*)(act + (size_t)(u.tbase + r) * 1024 + col0) = w;
            }
    }
};

struct PbDown {
    static constexpr bool GATHER = false; __device__ __forceinline__ const int* list_block(const Unit&) const { return nullptr; }
    static constexpr bool F8 = true, AUX = true;
    const char* A; const char* B; int K;
    const LAS int* tab; const int* list; const float* bdn; unsigned char* ybuf;
    __device__ __forceinline__ void stage_aux(const Unit& u, LAS unsigned char* aux, int wid, int lane) const {
        if (lane < 8) { __builtin_amdgcn_raw_ptr_buffer_load_lds(__builtin_amdgcn_make_buffer_rsrc((void*)(bdn + (size_t)u.e * 1024 + 256 * u.pn), 0, 1024, 0x00020000), (LAS unsigned*)(aux + wid * 128), 16, (wid * 8 + lane) * 16, 0, 0, 0);
            __builtin_amdgcn_raw_ptr_buffer_load_lds(__builtin_amdgcn_make_buffer_rsrc((void*)(list + (size_t)u.e * NTOK + 256 * u.pm), 0, 1024, 0x00020000), (LAS unsigned*)(aux + 1024 + wid * 128), 16, (wid * 8 + lane) * 16, 0, 0, 0); } }
    __device__ __forceinline__ bool next(int i, int bid, int nblk, Unit& u) const { return moe_unit(tab, i * nblk + bid, 4, u); }
    __device__ __forceinline__ int a_row(const Unit& u, int r) const { return u.tbase + r; }
    __device__ __forceinline__ void a_rows4(const Unit& u, int r0, int (&rows)[4]) const { for (int j = 0; j < 4; ++j) rows[j] = u.tbase + r0 + 64 * j; }
    __device__ __forceinline__ int4 a_rows_raw(const Unit&, int) const { return make_int4(0, 0, 0, 0); }
    __device__ __forceinline__ void a_rows_fin(const Unit& u, int r0, const int4&, int (&rows)[4]) const { a_rows4(u, r0, rows); }
    __device__ __forceinline__ int b_rowc(int rho) const { return 64 * ((rho >> 5) & 3) + 16 * ((rho >> 2) & 3) + 8 * (rho >> 7) + 4 * ((rho >> 4) & 1) + (rho & 3); }
    __device__ __forceinline__ int b_base_row(const Unit& u) const { return u.e * 1024 + 256 * u.pn; }
    __device__ __forceinline__ int b_row(const Unit& u, int rho) const { return b_base_row(u) + b_rowc(rho); }
    __device__ __forceinline__ void epi(const Acc& acc, const Unit& u, const LAS unsigned char* aux) const {
        const int t_ = opaque_tid(), w_ = __builtin_amdgcn_readfirstlane(t_ >> 6), wr = w_ >> 2, wc = w_ & 3, fr = t_ & 15, fq = (t_ >> 4) & 3;
        const int col0 = 256 * u.pn + 64 * wc + 16 * fq;
        f32x4 bv[2][2];
#pragma unroll
        for (int bj = 0; bj < 2; ++bj)
#pragma unroll
            for (int n = 0; n < 2; ++n) bv[bj][n] = *(const LAS f32x4*)(aux + (64 * wc + 16 * fq + 8 * bj + 4 * n) * 4);
        int dst8[8];
#pragma unroll
        for (int q = 0; q < 8; ++q) dst8[q] = ((const LAS int*)(aux + 1024))[lperm(128 * (q >> 2) + 64 * wr + 16 * (q & 3) + fr)];
#pragma unroll
        for (int ai = 0; ai < 2; ++ai)
#pragma unroll
            for (int m = 0; m < 4; ++m) {
                const int r = 128 * ai + 64 * wr + 16 * m + fr;
                u32x4 w;
                { const f32x4 v00 = acc[ai][0][m][0] * WUNSCALE + bv[0][0], v01 = acc[ai][0][m][1] * WUNSCALE + bv[0][1], v10 = acc[ai][1][m][0] * WUNSCALE + bv[1][0], v11 = acc[ai][1][m][1] * WUNSCALE + bv[1][1];
                  w.x = cvt_pk4_fp8(v00.x, v00.y, v00.z, v00.w); w.y = cvt_pk4_fp8(v01.x, v01.y, v01.z, v01.w); w.z = cvt_pk4_fp8(v10.x, v10.y, v10.z, v10.w); w.w = cvt_pk4_fp8(v11.x, v11.y, v11.z, v11.w); }
                if (r < u.nrows) *(u32x4*)(ybuf + (size_t)dst8[ai * 4 + m] * 1024 + col0) = w;
            }
    }
};

__device__ __forceinline__ s16x4 lds_tr16(const LAS unsigned char* p) { return __builtin_bit_cast(s16x4, __builtin_amdgcn_ds_read_tr16_b64_v4i16((LAS s16x4*)p)); }

template <bool LOCAL = false>
__device__ __forceinline__ void attn_phase(const Params& P, LAS unsigned char* lds, int l, int bid, int nblk, int tile = -1) {
    const int tid = opaque_tid(), wid = __builtin_amdgcn_readfirstlane(tid >> 6), lane = tid & 63, r32 = lane & 31, hi = lane >> 5;
    unsigned char* ws = P.ws;
    const bf16* proj = (const bf16*)(ws + WS_PROJ);
    unsigned char* mix = ws + WS_MIX;
    constexpr int KP = 144;
    LAS unsigned char* sK = lds; LAS unsigned char* sV = lds + 256 * KP;
    LAS float* sPB = (LAS float*)(lds + 2 * 256 * KP);
    if (tid < 128) { *(LAS f32x4*)(sPB + 4 * tid) = *(const f32x4*)(P.pool_b + l * 512 + 4 * tid); *(LAS f32x4*)(sPB + 512 + 4 * tid) = *(const f32x4*)(P.pool_s + l * 512 + 4 * tid) * MIXSCALE; }
    u32x4 kreg[4], vreg[4];
#define ATT_FETCH(un) do { const int _kvh = (un) & 1, _n = ((un) >> 1) & 63, _b = (un) >> 7; const int _tok0 = _b * SEQ + _n * 128 - 128; \
        _Pragma("unroll") for (int j = 0; j < 4; ++j) { const int q = tid + NT * j, key = q >> 3, c8 = q & 7; \
            kreg[j] = (u32x4){0u, 0u, 0u, 0u}; vreg[j] = (u32x4){0u, 0u, 0u, 0u}; \
            if (_n > 0 || key >= 128) { const bf16* src_ = proj + (size_t)(_tok0 + key) * NIN + 512 + _kvh * 64 + c8 * 8; kreg[j] = *(const u32x4*)src_; vreg[j] = *(const u32x4*)(src_ + 128); } } } while (0)
    const int u0 = LOCAL ? 4 * tile : bid, us = LOCAL ? 1 : nblk, ue = LOCAL ? 4 * tile + 4 : NB * 64 * 2;
    if (u0 < ue) ATT_FETCH(u0);
    for (int unit = u0; unit < ue; unit += us) {
        const int kvh = unit & 1, n = (unit >> 1) & 63, b = unit >> 7;
        __syncthreads();
#pragma unroll
        for (int j = 0; j < 4; ++j) { const int q = tid + NT * j, key = q >> 3, c8 = q & 7; *(LAS u32x4*)(sK + key * KP + c8 * 16) = kreg[j]; *(LAS u32x4*)(sV + key * KP + c8 * 16) = vreg[j]; }
        const int hq = kvh * 4 + (wid >> 1);
        const float sink2 = P.sinks[l * 8 + hq] * LOG2E;
        bf16x8 qfa[2][4];
#pragma unroll
        for (int qt = 0; qt < 2; ++qt)
#pragma unroll
            for (int s = 0; s < 4; ++s) qfa[qt][s] = *(const bf16x8*)(proj + ((size_t)b * SEQ + n * 128 + 64 * (wid & 1) + 32 * qt + r32) * NIN + hq * 64 + 16 * s + 8 * hi);
        __syncthreads();
        if (unit + us < ue) ATT_FETCH(unit + us);
#pragma unroll
        for (int qt = 0; qt < 2; ++qt) {
            const int q0 = 64 * (wid & 1) + 32 * qt, qi = q0 + r32;
            const size_t qtok = (size_t)b * SEQ + n * 128 + qi;
            bf16x8 qf[4];
#pragma unroll
            for (int s = 0; s < 4; ++s) qf[s] = qfa[qt][s];
            f32x16 st[5];
#pragma unroll
            for (int kt = 0; kt < 5; ++kt) {
#pragma unroll
                for (int r = 0; r < 16; ++r) st[kt][r] = 0.f;
#pragma unroll
                for (int s = 0; s < 4; ++s) { const bf16x8 kf = *(const LAS bf16x8*)(sK + (q0 + 32 * kt + r32) * KP + (16 * s + 8 * hi) * 2); st[kt] = __builtin_amdgcn_mfma_f32_32x32x16_bf16(kf, qf[s], st[kt], 0, 0, 0); }
            }
            float mx = sink2;
            if (n > 0) {
#pragma unroll
                for (int r = 0; r < 16; ++r) { const int kk = (r & 3) + 8 * (r >> 2) + 4 * hi;
                    st[0][r] = (kk > r32) ? st[0][r] : -__builtin_inff(); st[4][r] = (kk <= r32) ? st[4][r] : -__builtin_inff(); }
            } else {
#pragma unroll
                for (int kt = 0; kt < 5; ++kt)
#pragma unroll
                    for (int r = 0; r < 16; ++r) {
                        const int kj = q0 + 32 * kt + (r & 3) + 8 * (r >> 2) + 4 * hi;
                        const bool ok = (kj > qi) && (kj <= qi + 128) && (kj >= 128);
                        st[kt][r] = ok ? st[kt][r] : -__builtin_inff();
                    }
            }
#pragma unroll
            for (int kt = 0; kt < 5; ++kt)
#pragma unroll
                for (int r = 0; r < 16; r += 2) mx = fmaxf(fmaxf(mx, st[kt][r]), st[kt][r + 1]);
            mx = max_x32(mx);
            float sum = 0.f;
#pragma unroll
            for (int kt = 0; kt < 5; ++kt)
#pragma unroll
                for (int r = 0; r < 16; ++r) { const float p = __builtin_amdgcn_exp2f(st[kt][r] - mx); st[kt][r] = p; sum += p; }
            sum = sum_x32(sum);
            sum += __builtin_amdgcn_exp2f(sink2 - mx);
            f32x16 o[2];
#pragma unroll
            for (int dt = 0; dt < 2; ++dt)
#pragma unroll
                for (int r = 0; r < 16; ++r) o[dt][r] = 0.f;
#pragma unroll
            for (int kt = 0; kt < 5; ++kt)
#pragma unroll
                for (int s2 = 0; s2 < 2; ++s2) {
                    u32x4 pw; pw.x = cvt_pk_bf16(st[kt][8 * s2 + 0], st[kt][8 * s2 + 1]); pw.y = cvt_pk_bf16(st[kt][8 * s2 + 2], st[kt][8 * s2 + 3]);
                    pw.z = cvt_pk_bf16(st[kt][8 * s2 + 4], st[kt][8 * s2 + 5]); pw.w = cvt_pk_bf16(st[kt][8 * s2 + 6], st[kt][8 * s2 + 7]);
                    const bf16x8 pf = __builtin_bit_cast(bf16x8, pw);
                    const int kb = q0 + 32 * kt + 16 * s2 + 4 * hi, i16 = lane & 15;
#pragma unroll
                    for (int dt = 0; dt < 2; ++dt) {
                        const int d0 = 32 * dt + 16 * ((lane >> 4) & 1);
                        const LAS unsigned char* a0 = sV + (kb + (i16 >> 2)) * KP + (d0 + 4 * (i16 & 3)) * 2;
                        const s16x4 v0 = lds_tr16(a0), v1 = lds_tr16(a0 + 8 * KP);
                        bf16x8 vf; vf[0] = v0[0]; vf[1] = v0[1]; vf[2] = v0[2]; vf[3] = v0[3]; vf[4] = v1[0]; vf[5] = v1[1]; vf[6] = v1[2]; vf[7] = v1[3];
                        o[dt] = __builtin_amdgcn_mfma_f32_32x32x16_bf16(vf, pf, o[dt], 0, 0, 0);
                    }
                }
            const float inv = MIXSCALE / sum;
#pragma unroll
            for (int dt = 0; dt < 2; ++dt)
#pragma unroll
                for (int gp = 0; gp < 2; ++gp) {
                    const unsigned wa = cvt_pk4_fp8(o[dt][8 * gp + 0] * inv, o[dt][8 * gp + 1] * inv, o[dt][8 * gp + 2] * inv, o[dt][8 * gp + 3] * inv);
                    const unsigned wb = cvt_pk4_fp8(o[dt][8 * gp + 4] * inv, o[dt][8 * gp + 5] * inv, o[dt][8 * gp + 6] * inv, o[dt][8 * gp + 7] * inv);
                    const auto sw = __builtin_amdgcn_permlane32_swap(wa, wb, false, false);
                    u32x2 w; w.x = sw[0]; w.y = sw[1];
                    *(u32x2*)(mix + qtok * D + hq * 64 + 32 * dt + 16 * gp + 8 * hi) = w;
                }
        }
    }
    for (int ch = (LOCAL ? 16 * tile : bid * 8) + wid; ch < (LOCAL ? 16 * tile + 16 : NTOK / 16); ch += (LOCAL ? 8 : nblk * 8)) {
        const int t0 = ch * 16, p0 = t0 & (SEQ - 1);
        const int col = 8 * lane, g = lane >> 4, w = 2 << g;
        u32x4 zr[31];
#pragma unroll
        for (int t = 0; t < 31; ++t) zr[t] = (t >= 15 || p0 > 0) ? *(const u32x4*)(proj + (size_t)(t0 + t - 15) * NIN + 768 + col) : (u32x4){0u, 0u, 0u, 0u};
        float pb_[8], ps_[8];
#pragma unroll
        for (int i = 0; i < 8; i += 4) { const f32x4 a = *(const LAS f32x4*)(sPB + col + i), s = *(const LAS f32x4*)(sPB + 512 + col + i);
            pb_[i] = a.x; pb_[i + 1] = a.y; pb_[i + 2] = a.z; pb_[i + 3] = a.w; ps_[i] = s.x; ps_[i + 1] = s.y; ps_[i + 2] = s.z; ps_[i + 3] = s.w; }
        float sum[8];
#pragma unroll
        for (int i = 0; i < 8; ++i) sum[i] = 0.f;
#pragma unroll
        for (int j = 1; j < 16; ++j) {
            const u32x4 z = zr[15 - j]; const float m = (j < w) ? 1.0f : 0.0f;
            sum[0] += m * bf_lo(z.x); sum[1] += m * bf_hi(z.x); sum[2] += m * bf_lo(z.y); sum[3] += m * bf_hi(z.y); sum[4] += m * bf_lo(z.z); sum[5] += m * bf_hi(z.z); sum[6] += m * bf_lo(z.w); sum[7] += m * bf_hi(z.w);
        }
#pragma unroll
        for (int t = 0; t < 16; ++t) {
            const u32x4 z = zr[15 + t];
            const float zz[8] = {bf_lo(z.x), bf_hi(z.x), bf_lo(z.y), bf_hi(z.y), bf_lo(z.z), bf_hi(z.z), bf_lo(z.w), bf_hi(z.w)};
            const int pos = p0 + t; const float ic = 1.0f / (float)((pos + 1 < w) ? (pos + 1) : w);
            float o[8];
#pragma unroll
            for (int i = 0; i < 8; ++i) { sum[i] += zz[i]; o[i] = (sum[i] * ic - zz[i] + pb_[i]) * ps_[i]; }
            u32x2 ow; ow.x = cvt_pk4_fp8(o[0], o[1], o[2], o[3]); ow.y = cvt_pk4_fp8(o[4], o[5], o[6], o[7]);
            *(u32x2*)(mix + (size_t)(t0 + t) * D + 512 + col) = ow;
            const u32x4 y = (g == 0) ? zr[15 + t - 1] : (g == 1) ? zr[15 + t - 3] : (g == 2) ? zr[15 + t - 7] : zr[15 + t - 15];
            sum[0] -= bf_lo(y.x); sum[1] -= bf_hi(y.x); sum[2] -= bf_lo(y.y); sum[3] -= bf_hi(y.y); sum[4] -= bf_lo(y.z); sum[5] -= bf_hi(y.z); sum[6] -= bf_lo(y.w); sum[7] -= bf_hi(y.w);
        }
    }
}

__device__ __forceinline__ void router_phase(const Params& P, LAS unsigned char* lds, int l, int bid, int nblk) {
    const int tid = opaque_tid(), wid = __builtin_amdgcn_readfirstlane(tid >> 6), lane = tid & 63, fr = lane & 15, fq = lane >> 4;
    unsigned char* ws = P.ws;
    const float* mod = (const float*)(ws + WS_MOD);
    float* gates = (float*)(ws + WS_GATES);
    constexpr int RP = 2064;
    LAS unsigned char* rwT = lds;
    LAS float* lg = (LAS float*)(lds + 66048);
    LAS unsigned long long* emask = (LAS unsigned long long*)(lds + 66048 + 33792);
    LAS unsigned short* sel = (LAS unsigned short*)(emask + 128);
    __syncthreads();
    for (int idx = tid; idx < 1024 * 32; idx += NT) { const int k = idx >> 5, e = idx & 31; const float v = P.rw[(size_t)l * 32768 + idx];
        *(LAS unsigned short*)(rwT + e * RP + k * 2) = (unsigned short)(cvt_pk_bf16(v, 0.f) & 0xffffu); }
    LAS float* cav = (LAS float*)(lds + 106496);
    LAS float* ccv = cav + 1024;
    for (int tile = bid; tile < NTOK / 256; tile += nblk) {
        const int tok0 = tile * 256, b = tok0 >> 13;
        for (int c = tid; c < D; c += NT) { cav[c] = P.n2g[l * D + c] * (1.0f + mod[(size_t)(l * NB + b) * NMOD + 4 * D + c]); ccv[c] = mod[(size_t)(l * NB + b) * NMOD + 3 * D + c]; }
        __syncthreads();
#pragma unroll 1
        for (int rg = 0; rg < 2; ++rg) {
            const size_t row = (size_t)(tok0 + 32 * wid + 16 * rg + fr);
            const bf16* xp = (const bf16*)(ws + WS_XB) + row * D + 16 * fq;
            float ss = 0.f;
#pragma unroll 4
            for (int p = 0; p < 16; ++p)
#pragma unroll
                for (int t = 0; t < 2; ++t) { const u32x4 w = *(const u32x4*)(xp + 64 * p + 8 * t); const float a0_ = bf_lo(w.x), a1_ = bf_hi(w.x), a2_ = bf_lo(w.y), a3_ = bf_hi(w.y), a4_ = bf_lo(w.z), a5_ = bf_hi(w.z), a6_ = bf_lo(w.w), a7_ = bf_hi(w.w);
                    ss += (a0_ * a0_ + a1_ * a1_) + (a2_ * a2_ + a3_ * a3_) + (a4_ * a4_ + a5_ * a5_) + (a6_ * a6_ + a7_ * a7_); }
            ss = sum_x16(ss); ss = sum_x32(ss);
            const float rstd = __builtin_amdgcn_rsqf(ss * (1.0f / D) + EPS);
            f32x4 a0 = (f32x4){0.f, 0.f, 0.f, 0.f}, a1 = a0;
            u32x4 cur[2], nxt[2];
            cur[0] = *(const u32x4*)(xp); cur[1] = *(const u32x4*)(xp + 8);
#pragma unroll 2
            for (int p = 0; p < 16; ++p) {
                const int pn = (p + 1) & 15;
                nxt[0] = *(const u32x4*)(xp + 64 * pn); nxt[1] = *(const u32x4*)(xp + 64 * pn + 8);
                const int c0 = 64 * p + 16 * fq;
                unsigned hw[2][4]; float hv[16];
#pragma unroll
                for (int t = 0; t < 2; ++t) {
                    const u32x4 w = cur[t];
                    const float xv[8] = {bf_lo(w.x), bf_hi(w.x), bf_lo(w.y), bf_hi(w.y), bf_lo(w.z), bf_hi(w.z), bf_lo(w.w), bf_hi(w.w)};
                    const f32x4 g0 = *(const LAS f32x4*)(cav + c0 + 8 * t), g1 = *(const LAS f32x4*)(cav + c0 + 8 * t + 4), s0 = *(const LAS f32x4*)(ccv + c0 + 8 * t), s1 = *(const LAS f32x4*)(ccv + c0 + 8 * t + 4);
                    hv[8 * t + 0] = xv[0] * rstd * g0.x + s0.x; hv[8 * t + 1] = xv[1] * rstd * g0.y + s0.y; hv[8 * t + 2] = xv[2] * rstd * g0.z + s0.z; hv[8 * t + 3] = xv[3] * rstd * g0.w + s0.w;
                    hv[8 * t + 4] = xv[4] * rstd * g1.x + s1.x; hv[8 * t + 5] = xv[5] * rstd * g1.y + s1.y; hv[8 * t + 6] = xv[6] * rstd * g1.z + s1.z; hv[8 * t + 7] = xv[7] * rstd * g1.w + s1.w;
                    hw[t][0] = cvt_pk_bf16(hv[8 * t + 0], hv[8 * t + 1]); hw[t][1] = cvt_pk_bf16(hv[8 * t + 2], hv[8 * t + 3]); hw[t][2] = cvt_pk_bf16(hv[8 * t + 4], hv[8 * t + 5]); hw[t][3] = cvt_pk_bf16(hv[8 * t + 6], hv[8 * t + 7]);
                }
                u32x4 h8; h8.x = cvt_pk4_fp8(hv[0], hv[1], hv[2], hv[3]); h8.y = cvt_pk4_fp8(hv[4], hv[5], hv[6], hv[7]); h8.z = cvt_pk4_fp8(hv[8], hv[9], hv[10], hv[11]); h8.w = cvt_pk4_fp8(hv[12], hv[13], hv[14], hv[15]);
                *(u32x4*)(ws + WS_H8 + row * D + c0) = h8;
#pragma unroll
                for (int t = 0; t < 2; ++t) {
                    const bf16x8 af = __builtin_bit_cast(bf16x8, (u32x4){hw[t][0], hw[t][1], hw[t][2], hw[t][3]});
                    const bf16x8 b0 = *(const LAS bf16x8*)(rwT + fr * RP + (c0 + 8 * t) * 2), b1 = *(const LAS bf16x8*)(rwT + (16 + fr) * RP + (c0 + 8 * t) * 2);
                    a0 = __builtin_amdgcn_mfma_f32_16x16x32_bf16(af, b0, a0, 0, 0, 0); a1 = __builtin_amdgcn_mfma_f32_16x16x32_bf16(af, b1, a1, 0, 0, 0);
                }
                cur[0] = nxt[0]; cur[1] = nxt[1];
            }
            const float rb0 = P.rb[l * 32 + fr], rb1 = P.rb[l * 32 + 16 + fr];
#pragma unroll
            for (int r = 0; r < 4; ++r) { const int lrow = 32 * wid + 16 * rg + 4 * fq + r; lg[lrow * 33 + fr] = a0[r] + rb0; lg[lrow * 33 + 16 + fr] = a1[r] + rb1; }
        }
        __syncthreads();
        if (tid < 256) {
            float v[32];
#pragma unroll
            for (int e = 0; e < 32; ++e) v[e] = lg[tid * 33 + e];
            float tv[4]; int ti[4];
#pragma unroll
            for (int k = 0; k < 4; ++k) {
                float best = -__builtin_inff(); int bi = 0;
#pragma unroll
                for (int e = 0; e < 32; ++e) { const bool gt = v[e] > best; best = gt ? v[e] : best; bi = gt ? e : bi; }
                tv[k] = best; ti[k] = bi;
#pragma unroll
                for (int e = 0; e < 32; ++e) v[e] = (e == bi) ? -__builtin_inff() : v[e];
            }
            const float e1 = __expf(tv[1] - tv[0]), e2 = __expf(tv[2] - tv[0]), e3 = __expf(tv[3] - tv[0]);
            const float inv = 1.0f / (1.0f + e1 + e2 + e3);
            *(f32x4*)(gates + (size_t)(tok0 + tid) * 4) = (f32x4){inv, e1 * inv, e2 * inv, e3 * inv};
#pragma unroll
            for (int k = 0; k < 4; ++k) sel[tid * 4 + k] = (unsigned short)ti[k];
#pragma unroll
            for (int e = 0; e < 32; ++e) { const unsigned long long m = __ballot((ti[0] == e) | (ti[1] == e) | (ti[2] == e) | (ti[3] == e)); if (lane == 0) emask[e * 4 + wid] = m; }
        }
        __syncthreads();
        if (tid < 256) {
            int* selg = (int*)(ws + WS_SEL);
            const unsigned long long lt = (1ull << lane) - 1ull;
            int so[4];
#pragma unroll
            for (int k = 0; k < 4; ++k) {
                const int e = sel[tid * 4 + k]; int r = 0;
                for (int w = 0; w < 4; ++w) { const unsigned long long m = emask[e * 4 + w]; r += (w < wid) ? __popcll(m) : ((w == wid) ? __popcll(m & lt) : 0); }
                so[k] = (e << 16) | r;
            }
            *(int4*)(selg + (size_t)(tok0 + tid) * 4) = make_int4(so[0], so[1], so[2], so[3]);
        }
        if (tid < 32) { int c = 0; for (int w = 0; w < 4; ++w) c += __popcll(emask[tid * 4 + w]); ((int*)(ws + WS_CNTB))[(size_t)(l * 256 + tile) * 32 + tid] = c; }
        __syncthreads();
    }
}

__device__ __forceinline__ void place_phase(const Params& P, LAS unsigned char* lds, int l, int bid, int nblk) {
    const int tid = opaque_tid();
    unsigned char* ws = P.ws;
    const int* cntb = (const int*)(ws + WS_CNTB) + (size_t)l * 256 * 32;
    const int* selg = (const int*)(ws + WS_SEL);
    int* list = (int*)(ws + WS_LIST);
    LAS int* red = (LAS int*)lds;
    LAS int* base = red + 512;
    const int e = tid & 31, part = tid >> 5;
    __syncthreads();
    for (int tile = bid; tile < NTOK / 256 + 1; tile += nblk) {
        int s = 0;
        for (int q = 0; q < 16; ++q) { const int t = part * 16 + q; if (t < tile) s += cntb[t * 32 + e]; }
        red[part * 32 + e] = s;
        __syncthreads();
        if (tid < 32) { int b = 0; for (int p = 0; p < 16; ++p) b += red[p * 32 + tid]; base[tid] = b; if (tile == NTOK / 256) ((int*)(ws + WS_TOT))[l * 32 + tid] = b; }
        __syncthreads();
        if (tile < NTOK / 256 && tid < 256) {
            const int tok = tile * 256 + tid; const int4 v = *(const int4*)(selg + (size_t)tok * 4);
            const int vv[4] = {v.x, v.y, v.z, v.w};
#pragma unroll
            for (int k = 0; k < 4; ++k) { const int ee = vv[k] >> 16, r = vv[k] & 0xffff; { const int rk = base[ee] + r; list[(size_t)ee * NTOK + (rk & ~255) + lperm(rk & 255)] = tok * 4 + k; } }
        }
        __syncthreads();
    }
}

constexpr int BK = 64, HALF = 128, HTB = HALF * BK * 2;
__device__ __forceinline__ int lds_byte(int r, int c) { const int st = (r >> 4) * 2 + (c >> 5), rr = r & 15, cc = c & 31, ob = rr * 64 + cc * 2; return st * 1024 + (ob ^ (((ob >> 9) & 1) << 5)); }
__device__ __forceinline__ void stage_rc(int b, int& R, int& C) { const int st = b / 1024, sb = b % 1024, swz = sb ^ (((sb >> 9) & 1) << 5); R = (st >> 1) * 16 + swz / 64; C = (st & 1) * 32 + (swz % 64) / 2; }

template <bool F8> struct FragT;
template <> struct FragT<false> {
    struct A { bf16x8 k[2]; };
    static __device__ __forceinline__ void load(A& d, const LAS unsigned char* p) { d.k[0] = *(const LAS bf16x8*)p; d.k[1] = *(const LAS bf16x8*)(p + 1024); }
    static __device__ __forceinline__ f32x4 mma(const A& a, const A& b, f32x4 c) { c = __builtin_amdgcn_mfma_f32_16x16x32_bf16(a.k[0], b.k[0], c, 0, 0, 0); return __builtin_amdgcn_mfma_f32_16x16x32_bf16(a.k[1], b.k[1], c, 0, 0, 0); }
};
template <> struct FragT<true> {
    typedef i32x8 A;
    static __device__ __forceinline__ void load(A& d, const LAS unsigned char* p) { const i32x4 lo = *(const LAS i32x4*)p, hi = *(const LAS i32x4*)(p + 1024); d = __builtin_shufflevector(lo, hi, 0, 1, 2, 3, 4, 5, 6, 7); }
    static __device__ __forceinline__ f32x4 mma(const A& a, const A& b, f32x4 c) { const int one = 0x7f7f7f7f;
        asm volatile("v_mfma_scale_f32_16x16x128_f8f6f4 %0, %1, %2, %0, %3, %3 op_sel_hi:[0,0,0]" : "+v"(c) : "v"(a), "v"(b), "v"(one)); return c; }
};
template <class Pb>
__device__ __forceinline__ void gemm_phase8(LAS unsigned char* lds, const Pb& pb, int bid, int nblk) {
    const int tid = opaque_tid(), wid = __builtin_amdgcn_readfirstlane(tid >> 6), lane = tid & 63, wr = wid >> 2, wc = wid & 3, fr = lane & 15, fq = lane >> 4;
    constexpr bool F8 = Pb::F8;
    const int RB = F8 ? pb.K : pb.K * 2;
    const int nt = RB / 128;
    int Rp[2], Cp[2];
#pragma unroll
    for (int i = 0; i < 2; ++i) stage_rc(tid * 16 + i * 8192, Rp[i], Cp[i]);
    unsigned voB[2][2];
#pragma unroll
    for (int h = 0; h < 2; ++h)
#pragma unroll
        for (int i = 0; i < 2; ++i) voB[h][i] = (unsigned)pb.b_rowc(128 * h + Rp[i]) * (unsigned)RB + (unsigned)Cp[i] * 2u;
    const unsigned ldsw = (unsigned)wid * 1024u;
    const int aoff = lds_byte(wr * 64 + fr, fq * 8), boff = lds_byte(wc * 32 + fr, fq * 8);
#define PG8_SA(b, h) (((b) * 2 + (h)) * HTB)
#define PG8_SB(b, h) ((4 + (b) * 2 + (h)) * HTB)
#define PG8_STAGE(bufoff, rsrc, soff, voff) do { _Pragma("unroll") for (int _i = 0; _i < 2; ++_i) \
        __builtin_amdgcn_raw_ptr_buffer_load_lds(rsrc, (LAS unsigned*)(lds + (bufoff) + ldsw + _i * 8192), 16, (int)(voff)[_i], (int)(soff), 0, 0); } while (0)
#define PG8_LDA(dst, b, h) do { _Pragma("unroll") for (int m = 0; m < 4; ++m) FragT<F8>::load(dst[m], lds + PG8_SA(b, h) + aoff + m * 2048); } while (0)
#define PG8_LDB(dst, b, h) do { _Pragma("unroll") for (int n = 0; n < 2; ++n) FragT<F8>::load(dst[n], lds + PG8_SB(b, h) + boff + n * 2048); } while (0)
#define PG8_MMA(ai, bj, At, Bt) do { __builtin_amdgcn_s_setprio(1); _Pragma("unroll") for (int m = 0; m < 4; ++m) _Pragma("unroll") for (int n = 0; n < 2; ++n) \
        acc[ai][bj][m][n] = FragT<F8>::mma(Bt[n], At[m], acc[ai][bj][m][n]); __builtin_amdgcn_s_setprio(0); } while (0)
#define PG8_WAIT_V(n) asm volatile("s_waitcnt vmcnt(" #n ")" ::: "memory")
#define PG8_WAIT_L(n) asm volatile("s_waitcnt lgkmcnt(" #n ")" ::: "memory")
#define PG8_BAR __builtin_amdgcn_s_barrier()
#define PG8_SCHED __builtin_amdgcn_sched_barrier(0)
#define PG8_VOA(dst, un) do { int _r[4]; pb.a_rows4(un, Rp[0], _r); _Pragma("unroll") for (int h = 0; h < 2; ++h) _Pragma("unroll") for (int i = 0; i < 2; ++i) dst[h][i] = (unsigned)_r[2 * h + i] * (unsigned)RB + (unsigned)Cp[i] * 2u; } while (0)
    Unit cur, nxt; int ui = 0;
    if (!pb.next(0, bid, nblk, cur)) return;
    Acc acc;
#pragma unroll
    for (int a = 0; a < 2; ++a)
#pragma unroll
        for (int b = 0; b < 2; ++b)
#pragma unroll
            for (int m = 0; m < 4; ++m)
#pragma unroll
                for (int n = 0; n < 2; ++n) acc[a][b][m][n] = (f32x4){0.f, 0.f, 0.f, 0.f};
    typename FragT<F8>::A At[4]; typename FragT<F8>::A B0[2], B1[2];
    unsigned voAc[2][2], voAn[2][2];
    PG8_VOA(voAc, cur);
    const __amdgpu_buffer_rsrc_t rA = __builtin_amdgcn_make_buffer_rsrc((void*)pb.A, 0, 0x7fffffff, 0x00020000), rB = __builtin_amdgcn_make_buffer_rsrc((void*)pb.B, 0, 0x7fffffff, 0x00020000);
    unsigned cB = (unsigned)pb.b_base_row(cur) * (unsigned)RB;
    { const unsigned k0 = (unsigned)(cur.ks & (nt - 1)) * 128u, k1 = (unsigned)((cur.ks + 1) & (nt - 1)) * 128u;
    PG8_STAGE(PG8_SB(0, 0), rB, cB + k0, voB[0]); PG8_STAGE(PG8_SB(0, 1), rB, cB + k0, voB[1]); PG8_STAGE(PG8_SA(0, 0), rA, k0, voAc[0]); PG8_STAGE(PG8_SA(0, 1), rA, k0, voAc[1]);
    if (wr == 1) PG8_BAR;
    PG8_WAIT_V(2); PG8_BAR;
    PG8_STAGE(PG8_SB(1, 0), rB, cB + k1, voB[0]); PG8_STAGE(PG8_SA(1, 0), rA, k1, voAc[0]); PG8_STAGE(PG8_SB(1, 1), rB, cB + k1, voB[1]); }
    PG8_WAIT_V(6); PG8_BAR;
    for (;;) {
        const bool has_next = pb.next(ui + 1, bid, nblk, nxt);
        unsigned nB = cB; int nks = cur.ks; int4 rawn = make_int4(0, 0, 0, 0);
        if (has_next) { nB = (unsigned)pb.b_base_row(nxt) * (unsigned)RB; nks = nxt.ks;
            if constexpr (Pb::GATHER) {
                if (lane < 8) __builtin_amdgcn_raw_ptr_buffer_load_lds(__builtin_amdgcn_make_buffer_rsrc((void*)pb.list_block(nxt), 0, 1024, 0x00020000), (LAS unsigned*)(lds + LSTAGE_OFF + wid * 128), 16, (wid * 8 + lane) * 16, 0, 0, 0);
            } else rawn = pb.a_rows_raw(nxt, Rp[0]); }
        if constexpr (Pb::AUX) pb.stage_aux(cur, lds + AUX_OFF + (ui & 1) * 2048, wid, lane);
        asm volatile(".p2align 8" ::: "memory");
        for (int t = 0; t < nt; t += 2) {
            const bool last = (t == nt - 2);
            const unsigned a1 = (unsigned)((t + 1 + cur.ks) & (nt - 1)) * 128u;
            const int ks2 = last ? nks : (t + 2 + cur.ks);
            const unsigned a2 = (unsigned)(ks2 & (nt - 1)) * 128u, a3 = (unsigned)((ks2 + 1) & (nt - 1)) * 128u;
            const unsigned bb = last ? nB : cB;
            const unsigned b2 = bb + a2, b3 = bb + a3;
            unsigned sa[2][2];
            if (last) {
                if (has_next) { int _r[4]; if constexpr (Pb::GATHER) { const i32x4 t_ = *(const LAS i32x4*)(lds + LSTAGE_OFF + Rp[0] * 16); rawn = make_int4(t_.x, t_.y, t_.z, t_.w); }
                    pb.a_rows_fin(nxt, Rp[0], rawn, _r);
#pragma unroll
                    for (int h = 0; h < 2; ++h)
#pragma unroll
                        for (int i = 0; i < 2; ++i) voAn[h][i] = (unsigned)_r[2 * h + i] * (unsigned)RB + (unsigned)Cp[i] * 2u; }
                else {
#pragma unroll
                    for (int h = 0; h < 2; ++h)
#pragma unroll
                        for (int i = 0; i < 2; ++i) voAn[h][i] = voAc[h][i]; }
            }
#pragma unroll
            for (int h = 0; h < 2; ++h)
#pragma unroll
                for (int i = 0; i < 2; ++i) sa[h][i] = last ? voAn[h][i] : voAc[h][i];
            PG8_LDB(B0, 0, 0); PG8_LDB(B1, 0, 1); PG8_SCHED; PG8_LDA(At, 0, 0); PG8_STAGE(PG8_SA(1, 1), rA, a1, voAc[1]);
            PG8_WAIT_V(8); PG8_WAIT_L(0); PG8_BAR; PG8_MMA(0, 0, At, B0); PG8_MMA(0, 1, At, B1); PG8_BAR; PG8_SCHED;
            PG8_LDA(At, 0, 1); PG8_STAGE(PG8_SB(0, 0), rB, b2, voB[0]); PG8_STAGE(PG8_SB(0, 1), rB, b2, voB[1]); PG8_STAGE(PG8_SA(0, 0), rA, a2, sa[0]);
            PG8_WAIT_V(8); PG8_WAIT_L(0); PG8_BAR; PG8_MMA(1, 0, At, B0); PG8_MMA(1, 1, At, B1); PG8_BAR; PG8_SCHED;
            PG8_LDB(B0, 1, 0); PG8_LDB(B1, 1, 1); PG8_SCHED; PG8_LDA(At, 1, 0); PG8_STAGE(PG8_SA(0, 1), rA, a2, sa[1]);
            PG8_WAIT_V(8); PG8_WAIT_L(0); PG8_BAR; PG8_MMA(0, 0, At, B0); PG8_MMA(0, 1, At, B1); PG8_BAR; PG8_SCHED;
            PG8_LDA(At, 1, 1); PG8_STAGE(PG8_SB(1, 0), rB, b3, voB[0]); PG8_STAGE(PG8_SB(1, 1), rB, b3, voB[1]); PG8_STAGE(PG8_SA(1, 0), rA, a3, sa[0]);
            PG8_WAIT_V(8); PG8_WAIT_L(0); PG8_BAR; PG8_MMA(1, 0, At, B0); PG8_MMA(1, 1, At, B1); PG8_BAR; PG8_SCHED;
        }
        if (wr == 0) PG8_BAR;
        if constexpr (F8) asm volatile("s_nop 15\n\ts_nop 15" ::: "memory");
        pb.epi(acc, cur, lds + AUX_OFF + (ui & 1) * 2048);
        if (!has_next) break;
#pragma unroll
        for (int a = 0; a < 2; ++a)
#pragma unroll
            for (int b = 0; b < 2; ++b)
#pragma unroll
                for (int m = 0; m < 4; ++m)
#pragma unroll
                    for (int n = 0; n < 2; ++n) acc[a][b][m][n] = (f32x4){0.f, 0.f, 0.f, 0.f};
        cur = nxt; cB = nB; ++ui;
#pragma unroll
        for (int h = 0; h < 2; ++h)
#pragma unroll
            for (int i = 0; i < 2; ++i) voAc[h][i] = voAn[h][i];
        if (wr == 1) PG8_BAR;
    }
    PG8_WAIT_V(0);
    PG8_BAR;
#undef PG8_SA
#undef PG8_SB
#undef PG8_STAGE
#undef PG8_LDA
#undef PG8_LDB
#undef PG8_MMA
#undef PG8_WAIT_V
#undef PG8_WAIT_L
#undef PG8_BAR
#undef PG8_SCHED
#undef PG8_VOA
}

#ifndef FAST_INPROJ
#define FAST_INPROJ 1
#endif
#ifndef FAST_OUTPROJ
#define FAST_OUTPROJ 1
#endif
#ifndef FAST_GU
#define FAST_GU 1
#endif
#ifndef FAST_DOWN
#define FAST_DOWN 1
#endif
template <bool FAST, class Pb> __device__ __forceinline__ void gemm_run(LAS unsigned char* lds, const Pb& pb, int bid, int nblk) {
    if constexpr (FAST) gemm_phase8(lds, pb, bid, nblk); else gemm_simple(lds, pb, bid, nblk);
}

#ifndef STAG_OUT
#define STAG_OUT 700
#endif
#ifndef STAG_IN
#define STAG_IN 0
#endif
#ifndef STAG_GU
#define STAG_GU 0
#endif
#ifndef STAG_DN
#define STAG_DN 0
#endif
__device__ __forceinline__ void phase_stagger(bool on, unsigned ticks) {
    if (on && ticks) { const unsigned long long t0 = __builtin_amdgcn_s_memrealtime(); while (__builtin_amdgcn_s_memrealtime() - t0 < ticks) __builtin_amdgcn_s_sleep(8); }
}
template <bool LOCAL = false>
__device__ __forceinline__ void inproj_phase(const Params& P, LAS unsigned char* lds, int l, int bid, int nblk, int tile = -1) {
    unsigned char* ws = P.ws;
    if (!LOCAL) phase_stagger((bid / 3) & 1, STAG_IN);
    { PbInProjT<true, LOCAL> pb; pb.A = (const char*)(ws + WS_H8); pb.B = (const char*)(ws + WS_WIN8) + (size_t)l * (768 * 1024); pb.K = 1024;
      pb.proj = (bf16*)(ws + WS_PROJ); pb.qg = P.qg + l * 64; pb.kg = P.kg + l * 64; pb.rope = (const float*)(ws + WS_ROPE); pb.tile = tile;
      gemm_phase8(lds, pb, bid, nblk); }
    { PbInProjT<false, LOCAL> pb; pb.A = (const char*)(ws + WS_H); pb.B = (const char*)(ws + WS_WIN) + (size_t)l * (1280 * 1024 * 2); pb.K = 1024;
      pb.proj = (bf16*)(ws + WS_PROJ); pb.qg = P.qg + l * 64; pb.kg = P.kg + l * 64; pb.rope = (const float*)(ws + WS_ROPE); pb.tile = tile;
      gemm_phase8(lds, pb, bid, nblk); }
}
template <bool LOCAL = false>
__device__ __forceinline__ void outproj_phase(const Params& P, LAS unsigned char* lds, int l, int bid, int nblk, int tile = -1) {
    unsigned char* ws = P.ws;
    if (!LOCAL) phase_stagger((bid >> 2) & 1, STAG_OUT);
    if (l == 0) { PbOutProjT<true, LOCAL> pb; pb.A = (const char*)(ws + WS_MIX); pb.B = (const char*)(ws + WS_WOUT); pb.K = 1024;
        pb.xin32 = P.x; pb.xb = (bf16*)(ws + WS_XB); pb.gate1 = (const float*)(ws + WS_MOD) + 2 * D; pb.tile = tile; gemm_phase8(lds, pb, bid, nblk); }
    else { PbOutProjT<false, LOCAL> pb; pb.A = (const char*)(ws + WS_MIX); pb.B = (const char*)(ws + WS_WOUT) + (size_t)l * (1024 * 1024); pb.K = 1024;
        pb.xin32 = nullptr; pb.xb = (bf16*)(ws + WS_XB); pb.gate1 = (const float*)(ws + WS_MOD) + (size_t)l * NB * NMOD + 2 * D; pb.tile = tile; gemm_phase8(lds, pb, bid, nblk); }
}
__device__ __forceinline__ void gu_phase(const Params& P, LAS unsigned char* lds, int l, int bid, int nblk) {
    unsigned char* ws = P.ws;
    LAS int* tab = (LAS int*)(lds + 131072);
    __syncthreads();
    moe_build_tab(tab, (const int*)(ws + WS_TOT) + l * 32);
    phase_stagger((bid >> 3) & 1, STAG_GU);
    PbGU pb; pb.A = (const char*)(ws + WS_H8); pb.B = (const char*)(ws + WS_WGU) + (size_t)l * 32 * (2048 * 1024); pb.K = 1024;
    pb.tab = tab; pb.list = (const int*)(ws + WS_LIST); pb.bgu = P.bgu + (size_t)l * 32 * 2048; pb.act = ws + WS_ACT;
    gemm_phase8(lds, pb, bid, nblk);
}
__device__ __forceinline__ void down_phase(const Params& P, LAS unsigned char* lds, int l, int bid, int nblk) {
    unsigned char* ws = P.ws;
    LAS int* tab = (LAS int*)(lds + 131072);
    __syncthreads();
    moe_build_tab(tab, (const int*)(ws + WS_TOT) + l * 32);
    phase_stagger((bid >> 2) & 1, STAG_DN);
    PbDown pb; pb.A = (const char*)(ws + WS_ACT); pb.B = (const char*)(ws + WS_WDN) + (size_t)l * 32 * (1024 * 1024); pb.K = 1024;
    pb.tab = tab; pb.list = (const int*)(ws + WS_LIST); pb.bdn = P.bdn + (size_t)l * 32 * 1024; pb.ybuf = ws + WS_YBUF;
    gemm_phase8(lds, pb, bid, nblk);
}

#define XB_TMO      128
#define XB_XCNT(j)  (256  + 64 * (j))
#define XB_XSUB(j)  (1280 + 64 * (j))
#define XB_XGEN(j)  (2304 + 64 * (j))
#define XB_TOP      3328
#define XB_TOPGEN   3392
#define XCD_BAR_WORDS 3456
#define XB_SPIN_CAP (1u << 18)
__device__ __forceinline__ unsigned xb_ld(unsigned* p)              { return __hip_atomic_load(p, __ATOMIC_RELAXED, __HIP_MEMORY_SCOPE_AGENT); }
__device__ __forceinline__ unsigned xb_add(unsigned* p, unsigned v) { return __hip_atomic_fetch_add(p, v, __ATOMIC_RELAXED, __HIP_MEMORY_SCOPE_AGENT); }
__device__ __forceinline__ unsigned xb_xcc_id() { return (unsigned)__builtin_amdgcn_s_getreg((3 << 11) | 20) & 0xFu; }
#define XB_SPIN(cond, bar) do { unsigned _sp = 0; while (cond) { __builtin_amdgcn_s_sleep(1); \
    if ((++_sp & 255u) == 0u) { if (xb_ld(&(bar)[XB_TMO])) break; if (_sp > XB_SPIN_CAP) { atomicAdd(&(bar)[XB_TMO], 1u); break; } } } } while (0)
struct XcdBarrier { unsigned* bar; unsigned x; volatile LAS unsigned* st; };
__device__ __forceinline__ XcdBarrier xcd_barrier_post(unsigned* bar, volatile LAS unsigned* st) {
    XcdBarrier b; b.bar = bar; b.x = xb_xcc_id(); b.st = st;
    if (threadIdx.x == 0) (void)xb_add(&bar[XB_XCNT(b.x)], 1u);
    return b;
}
__device__ __forceinline__ void xcd_barrier_complete(unsigned* bar, unsigned x, unsigned& nloc, unsigned& nx) {
    const unsigned G = gridDim.x * gridDim.y * gridDim.z;
    unsigned sum, cnt, mine, sp = 0u;
    for (;;) {
        sum = 0u; cnt = 0u; mine = 0u;
#pragma unroll
        for (unsigned j = 0; j < 16; ++j) { const unsigned c = xb_ld(&bar[XB_XCNT(j)]); sum += c; cnt += (c > 0u) ? 1u : 0u; mine = (j == x) ? c : mine; }
        if (sum == G) break;
        __builtin_amdgcn_s_sleep(1);
        if ((++sp & 255u) == 0u) { if (xb_ld(&bar[XB_TMO])) break; if (sp > XB_SPIN_CAP) { atomicAdd(&bar[XB_TMO], 1u); break; } }
    }
    nloc = mine > 0u ? mine : 1u; nx = cnt > 0u ? cnt : 1u;
}
__device__ __forceinline__ void xcd_barrier(const XcdBarrier& b) {
    asm volatile("s_waitcnt vmcnt(0)" ::: "memory");
    __syncthreads();
    if (threadIdx.x == 0) {
        unsigned* bar = b.bar; const unsigned bx = xb_xcc_id();
        __builtin_amdgcn_s_waitcnt(0);
        unsigned nloc = b.st[0], nx = b.st[1];
        if (nloc == 0u) { xcd_barrier_complete(bar, bx, nloc, nx); b.st[0] = nloc; b.st[1] = nx; }
        const unsigned old = xb_add(&bar[XB_XSUB(bx)], 1u);
        const unsigned gen = old / nloc;
        if (old + 1u == (gen + 1u) * nloc) {
            __builtin_amdgcn_fence(__ATOMIC_RELEASE, "agent");
            asm volatile("s_waitcnt vmcnt(0)" ::: "memory");
            const unsigned og = xb_add(&bar[XB_TOP], 1u);
            const unsigned tg = og / nx;
            if (og + 1u == (tg + 1u) * nx) xb_add(&bar[XB_TOPGEN], 1u);
            else XB_SPIN(xb_ld(&bar[XB_TOPGEN]) == tg, bar);
            __builtin_amdgcn_fence(__ATOMIC_ACQUIRE, "agent");
            xb_add(&bar[XB_XGEN(bx)], 1u);
            asm volatile("s_waitcnt vmcnt(0)" ::: "memory");
        } else {
            XB_SPIN(xb_ld(&bar[XB_XGEN(bx)]) == gen, bar);
            __builtin_amdgcn_fence(__ATOMIC_ACQUIRE, "agent");
            asm volatile("s_waitcnt vmcnt(0)" ::: "memory");
        }
    }
    __syncthreads();
}


#if ONE_LAUNCH
#ifndef CHAIN
#define CHAIN 1
#endif
#ifndef CHAIN_FLAG
#define CHAIN_FLAG 1
#endif
#ifndef SEAM_MASK
#define SEAM_MASK 7
#endif
#define local_seam(k) do { if ((SEAM_MASK >> (k)) & 1) { asm volatile("s_waitcnt vmcnt(0)" ::: "memory"); __syncthreads(); } else xcd_barrier(bar); } while (0)
constexpr int TAB_OFF = 131072, MISC_OFF = 131072 + 512;
__global__ void __launch_bounds__(NT, 2) mega_fwd(Params P) {
    extern __shared__ __attribute__((aligned(16))) unsigned char dyn_lds[];
    LAS unsigned char* lds = (LAS unsigned char*)dyn_lds;
    volatile LAS unsigned* MISC = (volatile LAS unsigned*)(lds + MISC_OFF);
    if (threadIdx.x < 32) MISC[threadIdx.x] = 0u;
    __syncthreads();
    XcdBarrier bar = xcd_barrier_post((unsigned*)(P.ws + WS_CTL) + CW_BAR, MISC + 8);
    const int bid = blockIdx.x, nblk = gridDim.x;
    const int vb = (nblk % 8 == 0) ? (bid % 8) * (nblk / 8) + bid / 8 : bid;
#ifndef REP_P0
#define REP_P0 1
#endif
#ifndef REP_INPROJ
#define REP_INPROJ 1
#endif
#ifndef REP_ATTN
#define REP_ATTN 1
#endif
#ifndef REP_GU
#define REP_GU 1
#endif
#ifndef REP_DOWN
#define REP_DOWN 1
#endif
    for (int r = 0; r < REP_P0; ++r) { p0_prologue(P, lds, bid, nblk); xcd_barrier(bar); }
    for (int l = 0; l < DEPTH; ++l) {
#if CHAIN
        {   const int tile = bid;
            unsigned* flag = (unsigned*)(P.ws + WS_CTL) + CW_FLAG;
            if (l == 0) norm1_phase<0>(P, l, tile, NTOK / 256); else norm1_phase<1>(P, l, tile, NTOK / 256);
            local_seam(0);
            inproj_phase<true>(P, lds, l, tile, NTOK / 256, tile);
#if CHAIN_FLAG
            if (threadIdx.x == 0) {
                __builtin_amdgcn_fence(__ATOMIC_RELEASE, "agent");
                asm volatile("s_waitcnt vmcnt(0)" ::: "memory");
                __hip_atomic_store(&flag[tile * 16], (unsigned)(l + 1), __ATOMIC_RELAXED, __HIP_MEMORY_SCOPE_AGENT);
                if (tile & 31) { unsigned* bw = (unsigned*)(P.ws + WS_CTL) + CW_BAR; XB_SPIN(xb_ld(&flag[(tile - 1) * 16]) < (unsigned)(l + 1), bw); }
            }
            __syncthreads();
            __builtin_amdgcn_fence(__ATOMIC_ACQUIRE, "agent");
#else
            xcd_barrier(bar);
#endif
            attn_phase<true>(P, lds, l, tile, NTOK / 256, tile);
            local_seam(1);
            outproj_phase<true>(P, lds, l, tile, NTOK / 256, tile);
            local_seam(2);
            router_phase(P, lds, l, tile, NTOK / 256);
        }
        xcd_barrier(bar);
#else
        if (l == 0) norm1_phase<0>(P, l, bid, nblk); else norm1_phase<1>(P, l, bid, nblk);
        xcd_barrier(bar);
        for (int r = 0; r < REP_INPROJ; ++r) { inproj_phase(P, lds, l, vb, nblk); xcd_barrier(bar); }
        for (int r = 0; r < REP_ATTN; ++r) { attn_phase(P, lds, l, bid, nblk); xcd_barrier(bar); }
        outproj_phase(P, lds, l, vb, nblk);
        xcd_barrier(bar);
        router_phase(P, lds, l, bid, nblk);
        xcd_barrier(bar);
#endif
        place_phase(P, lds, l, bid, nblk);
        xcd_barrier(bar);
        for (int r = 0; r < REP_GU; ++r) { gu_phase(P, lds, l, vb, nblk); xcd_barrier(bar); }
        for (int r = 0; r < REP_DOWN; ++r) { down_phase(P, lds, l, vb, nblk); xcd_barrier(bar); }
    }
    norm1_phase<2>(P, 0, bid, nblk);
}
#else
extern __shared__ __attribute__((aligned(16))) unsigned char dyn_lds[];
#define KLDS ((LAS unsigned char*)dyn_lds)
__global__ void __launch_bounds__(NT, 2) k_prologue(Params P) { p0_prologue(P, KLDS, blockIdx.x, gridDim.x); }
__global__ void __launch_bounds__(NT, 2) k_norm1_0(Params P, int l) { norm1_phase<0>(P, l, blockIdx.x, gridDim.x); }
__global__ void __launch_bounds__(NT, 2) k_norm1_1(Params P, int l) { norm1_phase<1>(P, l, blockIdx.x, gridDim.x); }
__global__ void __launch_bounds__(NT, 2) k_final(Params P) { norm1_phase<2>(P, 0, blockIdx.x, gridDim.x); }
__global__ void __launch_bounds__(NT, 2) k_inproj(Params P, int l) { inproj_phase(P, KLDS, l, blockIdx.x, gridDim.x); }
__global__ void __launch_bounds__(NT, 2) k_attn(Params P, int l) { attn_phase(P, KLDS, l, blockIdx.x, gridDim.x); }
__global__ void __launch_bounds__(NT, 2) k_outproj(Params P, int l) { outproj_phase(P, KLDS, l, blockIdx.x, gridDim.x); }
__global__ void __launch_bounds__(NT, 2) k_router(Params P, int l) { router_phase(P, KLDS, l, blockIdx.x, gridDim.x); }
__global__ void __launch_bounds__(NT, 2) k_place(Params P, int l) { place_phase(P, KLDS, l, blockIdx.x, gridDim.x); }
__global__ void __launch_bounds__(NT, 2) k_gu(Params P, int l) { gu_phase(P, KLDS, l, blockIdx.x, gridDim.x); }
__global__ void __launch_bounds__(NT, 2) k_down(Params P, int l) { down_phase(P, KLDS, l, blockIdx.x, gridDim.x); }

#endif

extern "C" void kernel_launch(void* const* d_in, const int* in_sizes, int n_in, void* d_out, int out_size, void* d_ws, size_t ws_size, hipStream_t stream) {
    static int ready = 0;
    if (ready == 0) {
        if (n_in != 21 || out_size != NTOK * D || ws_size < WS_END) { fprintf(stderr, "kernel_launch: unexpected shapes (n_in %d out %d ws %zu)\n", n_in, out_size, ws_size); ready = -1; return; }
#if ONE_LAUNCH
        const void* ks[] = {(const void*)mega_fwd};
#else
        const void* ks[] = {(const void*)k_prologue, (const void*)k_norm1_0, (const void*)k_norm1_1, (const void*)k_final, (const void*)k_inproj, (const void*)k_attn, (const void*)k_outproj, (const void*)k_router, (const void*)k_gu, (const void*)k_down, (const void*)k_place};
#endif
        for (auto k : ks) if (hipFuncSetAttribute(k, hipFuncAttributeMaxDynamicSharedMemorySize, LDS_BYTES) != hipSuccess) { fprintf(stderr, "kernel_launch: hipFuncSetAttribute failed\n"); ready = -1; return; }
        ready = 1;
    }
    if (ready < 0) return;
    (void)hipMemsetAsync((char*)d_ws + WS_CTL, 0, CTL_ZERO_BYTES, stream);
    Params P{};
    P.x = (const float*)d_in[0]; P.c = (const float*)d_in[1]; P.pos = (const int*)d_in[2]; P.ada_w = (const float*)d_in[3]; P.ada_b = (const float*)d_in[4]; P.n1g = (const float*)d_in[5];
    P.w_in = (const float*)d_in[6]; P.qg = (const float*)d_in[7]; P.kg = (const float*)d_in[8]; P.sinks = (const float*)d_in[9]; P.pool_w = (const float*)d_in[10]; P.pool_b = (const float*)d_in[11];
    P.pool_s = (const float*)d_in[12]; P.w_out = (const float*)d_in[13]; P.n2g = (const float*)d_in[14]; P.rw = (const float*)d_in[15]; P.rb = (const float*)d_in[16]; P.wgu = (const float*)d_in[17];
    P.bgu = (const float*)d_in[18]; P.wdn = (const float*)d_in[19]; P.bdn = (const float*)d_in[20]; P.out = (float*)d_out; P.ws = (unsigned char*)d_ws;
    const dim3 g(256), b(NT);
#if ONE_LAUNCH
    hipLaunchKernelGGL(mega_fwd, g, b, LDS_BYTES, stream, P);
#else
    hipLaunchKernelGGL(k_prologue, g, b, LDS_BYTES, stream, P);
    for (int l = 0; l < DEPTH; ++l) {
        if (l == 0) hipLaunchKernelGGL(k_norm1_0, g, b, LDS_BYTES, stream, P, l); else hipLaunchKernelGGL(k_norm1_1, g, b, LDS_BYTES, stream, P, l);
        hipLaunchKernelGGL(k_inproj, g, b, LDS_BYTES, stream, P, l);
        hipLaunchKernelGGL(k_attn, g, b, LDS_BYTES, stream, P, l);
        hipLaunchKernelGGL(k_outproj, g, b, LDS_BYTES, stream, P, l);
        hipLaunchKernelGGL(k_router, g, b, LDS_BYTES, stream, P, l);
        hipLaunchKernelGGL(k_place, g, b, LDS_BYTES, stream, P, l);
        hipLaunchKernelGGL(k_gu, g, b, LDS_BYTES, stream, P, l);
        hipLaunchKernelGGL(k_down, g, b, LDS_BYTES, stream, P, l);
    }
    hipLaunchKernelGGL(k_final, g, b, LDS_BYTES, stream, P);
#endif
}
```
